# Optimizing an MI355X kernel written in HIP

```python
import jax, jax.numpy as jnp
from jax import lax
import numpy as np

D_MODEL = 1024
BATCH = 8
SEQ = 2048
DEPTH = 2

SB_HEADS = 8
SB_HEAD_DIM = 64
SB_WIDTH = SB_HEADS * SB_HEAD_DIM
SB_BLOCK = 128
SSD_WIDTH = D_MODEL
SSD_HEAD_DIM = 64
SSD_HEADS = SSD_WIDTH // SSD_HEAD_DIM
SSD_GROUPS = 2
SSD_STATE = 64
SSD_CONV = 4
SSD_CHUNK = 128
SSD_CONV_CH = SSD_WIDTH + 2 * SSD_GROUPS * SSD_STATE
RW_HEAD_DIM = 64
RW_WIDTH = D_MODEL // 2
RW_HEADS = RW_WIDTH // RW_HEAD_DIM
RW_DECAY_RANK = 64
RW_ICLR_RANK = 64
N_BRANCH = 3
SB_COLS = 4 * SB_WIDTH
SSD_COLS = SSD_WIDTH + SSD_CONV_CH + SSD_HEADS
RW_COLS = 4 * RW_WIDTH + RW_DECAY_RANK + RW_ICLR_RANK
GATE_COLS = N_BRANCH * D_MODEL
N_IN = SB_COLS + SSD_COLS + RW_COLS + GATE_COLS
RMS_EPS = 1e-6
GN_EPS = 64e-5

kernel_name = "hybrid_sba_ssd_rwkv7_gated"


def _split(x, sizes):
    idx = np.cumsum(sizes)[:-1].tolist()
    return jnp.split(x, idx, axis=-1)


def rms_norm(x, g):
    xf = x.astype(jnp.float32)
    y = xf * lax.rsqrt(jnp.mean(xf * xf, axis=-1, keepdims=True) + RMS_EPS)
    return (y * g.astype(jnp.float32)).astype(x.dtype)


def stick_breaking_attention(q, k, v):
    b, s, h, dh = q.shape
    scale = dh ** -0.5
    outs = []
    for i in range(s // SB_BLOCK):
        q0 = i * SB_BLOCK
        end = q0 + SB_BLOCK
        qb, kb, vb = q[:, q0:end], k[:, :end], v[:, :end]
        z = jnp.einsum('bqhd,bkhd->bhqk', qb, kb).astype(jnp.float32) * scale
        t_idx = q0 + jnp.arange(SB_BLOCK)
        s_idx = jnp.arange(end)
        mask = s_idx[None, :] < t_idx[:, None]
        log_beta = jax.nn.log_sigmoid(z)
        log_keep = jnp.where(mask, jax.nn.log_sigmoid(-z), 0.0)
        after = lax.cumsum(log_keep, axis=3, reverse=True) - log_keep
        att = jnp.where(mask, jnp.exp(log_beta + after), 0.0)
        outs.append(jnp.einsum('bhqk,bkhd->bqhd', att.astype(v.dtype), vb))
    return jnp.concatenate(outs, axis=1).reshape(b, s, h * dh)


def causal_depthwise_conv(x, w, bias):
    kw, ch = w.shape
    y = lax.conv_general_dilated(x, w[:, None, :], window_strides=(1,), padding=[(kw - 1, 0)],
                                 dimension_numbers=('NWC', 'WIO', 'NWC'), feature_group_count=ch)
    return y + bias


def segsum(a):
    t = a.shape[-1]
    rep = jnp.broadcast_to(a[..., None], a.shape + (t,))
    strict = jnp.tril(jnp.ones((t, t), dtype=bool), -1)
    cs = jnp.cumsum(jnp.where(strict, rep, 0), axis=-2)
    return jnp.where(jnp.tril(jnp.ones((t, t), dtype=bool)), cs, -jnp.inf)


def ssd_mixer(xbc_raw, dt_raw, conv_w, conv_b, dt_bias, a_log, d_skip):
    b, s, _ = xbc_raw.shape
    c, l, g = s // SSD_CHUNK, SSD_CHUNK, SSD_GROUPS
    j, p, n = SSD_HEADS // SSD_GROUPS, SSD_HEAD_DIM, SSD_STATE
    xbc = jax.nn.silu(causal_depthwise_conv(xbc_raw, conv_w, conv_b))
    xs, bm, cm = _split(xbc, [SSD_WIDTH, g * n, g * n])
    xs = xs.reshape(b, c, l, g, j, p)
    bm = bm.reshape(b, c, l, g, n)
    cm = cm.reshape(b, c, l, g, n)
    dt = jax.nn.softplus(dt_raw + dt_bias).reshape(b, c, l, g, j)
    a_head = -jnp.exp(a_log).reshape(g, j)
    da = jnp.moveaxis(dt * a_head, 2, -1)
    x_dt = xs * dt[..., None]
    a_cs = jnp.cumsum(da, axis=-1)
    decay_in = jnp.exp(segsum(da))
    cb = jnp.einsum('bclgn,bcsgn->bcgls', cm, bm)
    y_diag = jnp.einsum('bcgls,bcgjls,bcsgjp->bclgjp', cb, decay_in, x_dt)
    decay_states = jnp.exp(a_cs[..., -1:] - a_cs)
    states = jnp.einsum('bclgn,bcgjl,bclgjp->bcgjpn', bm, decay_states, x_dt)
    last = jnp.pad(jnp.moveaxis(a_cs[..., -1], 1, -1), [(0, 0), (0, 0), (0, 0), (1, 0)])
    decay_chunk = jnp.exp(segsum(last))
    states_p = jnp.concatenate([jnp.zeros_like(states[:, :1]), states], axis=1)
    new_states = jnp.einsum('bgjzc,bcgjpn->bzgjpn', decay_chunk, states_p)
    prev_states = new_states[:, :-1]
    y_off = jnp.einsum('bclgn,bcgjpn,bcgjl->bclgjp', cm, prev_states, jnp.exp(a_cs))
    y = y_diag + y_off + xs * d_skip.reshape(g, j)[:, :, None]
    return y.reshape(b, s, SSD_WIDTH)


def _rwkv7_step(state, inp):
    r_t, w_t, k_t, v_t, kk_t, a_t = inp
    sa = jnp.einsum('bhij,bhj->bhi', state, -kk_t)
    state = (state * w_t[:, :, None, :] + sa[..., None] * (kk_t * a_t)[:, :, None, :]
             + v_t[..., None] * k_t[:, :, None, :])
    y_t = jnp.einsum('bhij,bhj->bhi', state, r_t)
    return state, y_t


def rwkv7_mixer(slab, mu, w0, w_up, a0, a_up, k_k, k_a, r_k, ln_g, ln_b):
    b, s, _ = slab.shape
    hh, nn = RW_HEADS, RW_HEAD_DIM
    prev = jnp.pad(slab[:, :-1], [(0, 0), (1, 0), (0, 0)])
    mixed = slab + (prev - slab) * mu
    r, k, v, gate, w_lo, a_lo = _split(mixed, [RW_WIDTH] * 4 + [RW_DECAY_RANK, RW_ICLR_RANK])
    w = -jax.nn.softplus(-(w0 + jnp.tanh(w_lo) @ w_up)) - 0.5
    decay = jnp.exp(-jnp.exp(w.astype(jnp.float32)))
    a = jax.nn.sigmoid(a0 + a_lo @ a_up)
    kk = (k * k_k).reshape(b, s, hh, nn).astype(jnp.float32)
    kk = kk / jnp.maximum(jnp.sqrt(jnp.sum(kk * kk, axis=-1, keepdims=True)), 1e-12)
    k = k * (1 + (a - 1) * k_a)
    heads = lambda t: t.reshape(b, s, hh, nn).astype(jnp.float32)
    r4, k4, v4, a4, w4 = heads(r), heads(k), heads(v), heads(a), heads(decay)
    seq_first = lambda t: jnp.moveaxis(t, 1, 0)
    state0 = jnp.zeros((b, hh, nn, nn), jnp.float32)
    _, ys = lax.scan(_rwkv7_step, state0,
                     (seq_first(r4), seq_first(w4), seq_first(k4), seq_first(v4), seq_first(kk), seq_first(a4)))
    y = jnp.moveaxis(ys, 0, 1)
    mean = jnp.mean(y, axis=-1, keepdims=True)
    var = jnp.mean(jnp.square(y - mean), axis=-1, keepdims=True)
    y = ((y - mean) * lax.rsqrt(var + GN_EPS)).reshape(b, s, RW_WIDTH) * ln_g + ln_b
    bonus = jnp.sum(r4 * k4 * r_k, axis=-1, keepdims=True) * v4
    y = y + bonus.reshape(b, s, RW_WIDTH)
    return y.astype(slab.dtype), gate


def hybrid_layer(x, norm_g, w_in, conv_w, conv_b, dt_bias, a_log, d_skip, ssd_norm_g,
                 rw_mu, rw_w0, rw_w_up, rw_a0, rw_a_up, rw_k_k, rw_k_a, rw_r_k, rw_ln_g, rw_ln_b,
                 w_out_sb, w_out_ssd, w_out_rw, w_o):
    b, s, _ = x.shape
    h = rms_norm(x, norm_g)
    proj = h @ w_in
    sb_cols, ssd_cols, rw_cols, gate_cols = _split(proj, [SB_COLS, SSD_COLS, RW_COLS, GATE_COLS])
    q, k, v, sb_gate = _split(sb_cols, [SB_WIDTH] * 4)
    shp = (b, s, SB_HEADS, SB_HEAD_DIM)
    y_sb = stick_breaking_attention(q.reshape(shp), k.reshape(shp), v.reshape(shp)) * jax.nn.silu(sb_gate)
    z, xbc, dt_raw = _split(ssd_cols, [SSD_WIDTH, SSD_CONV_CH, SSD_HEADS])
    y_ssd = ssd_mixer(xbc, dt_raw, conv_w, conv_b, dt_bias, a_log, d_skip)
    y_ssd = rms_norm(y_ssd * jax.nn.silu(z), ssd_norm_g)
    y_rw, rw_gate = rwkv7_mixer(rw_cols, rw_mu, rw_w0, rw_w_up, rw_a0, rw_a_up, rw_k_k, rw_k_a,
                                rw_r_k, rw_ln_g, rw_ln_b)
    y_rw = y_rw * jax.nn.silu(rw_gate)
    g_sb, g_ssd, g_rw = _split(jax.nn.sigmoid(gate_cols), [D_MODEL] * N_BRANCH)
    merged = g_sb * (y_sb @ w_out_sb) + g_ssd * (y_ssd @ w_out_ssd) + g_rw * (y_rw @ w_out_rw)
    return x + merged @ w_o


def setup_inputs(seed: int = 0) -> dict:
    key = jax.random.key(seed)
    ks = jax.random.split(key, 24)
    f32 = jnp.float32
    nrm = lambda k, shp, sc: jax.random.normal(k, shp, f32) * sc
    dt0 = jnp.exp(jax.random.uniform(ks[5], (DEPTH, SSD_HEADS), f32, np.log(1e-3), np.log(1e-1)))
    return {
        "x": nrm(ks[0], (BATCH, SEQ, D_MODEL), 1.0),
        "norm_g": 1.0 + nrm(ks[1], (DEPTH, D_MODEL), 0.02),
        "w_in": nrm(ks[2], (DEPTH, D_MODEL, N_IN), D_MODEL ** -0.5),
        "conv_w": nrm(ks[3], (DEPTH, SSD_CONV, SSD_CONV_CH), SSD_CONV ** -0.5),
        "conv_b": nrm(ks[4], (DEPTH, SSD_CONV_CH), 0.02),
        "dt_bias": dt0 + jnp.log(-jnp.expm1(-dt0)),
        "a_log": jnp.log(jax.random.uniform(ks[6], (DEPTH, SSD_HEADS), f32, 1.0, 16.0)),
        "d_skip": 1.0 + nrm(ks[7], (DEPTH, SSD_HEADS), 0.02),
        "ssd_norm_g": 1.0 + nrm(ks[8], (DEPTH, SSD_WIDTH), 0.02),
        "rw_mu": jax.random.uniform(ks[9], (DEPTH, RW_COLS), f32, 0.0, 1.0),
        "rw_w0": jax.random.uniform(ks[10], (DEPTH, RW_WIDTH), f32, -6.0, -1.0),
        "rw_w_up": nrm(ks[11], (DEPTH, RW_DECAY_RANK, RW_WIDTH), 0.1),
        "rw_a0": nrm(ks[12], (DEPTH, RW_WIDTH), 0.1),
        "rw_a_up": nrm(ks[13], (DEPTH, RW_ICLR_RANK, RW_WIDTH), 0.1),
        "rw_k_k": 0.85 + nrm(ks[14], (DEPTH, RW_WIDTH), 0.02),
        "rw_k_a": 1.0 + nrm(ks[15], (DEPTH, RW_WIDTH), 0.02),
        "rw_r_k": nrm(ks[16], (DEPTH, RW_HEADS, RW_HEAD_DIM), 0.1),
        "rw_ln_g": 1.0 + nrm(ks[17], (DEPTH, RW_WIDTH), 0.02),
        "rw_ln_b": nrm(ks[18], (DEPTH, RW_WIDTH), 0.02),
        "w_out_sb": nrm(ks[19], (DEPTH, SB_WIDTH, D_MODEL), SB_WIDTH ** -0.5),
        "w_out_ssd": nrm(ks[20], (DEPTH, SSD_WIDTH, D_MODEL), SSD_WIDTH ** -0.5),
        "w_out_rw": nrm(ks[21], (DEPTH, RW_WIDTH, D_MODEL), RW_WIDTH ** -0.5),
        "w_o": nrm(ks[22], (DEPTH, D_MODEL, D_MODEL), D_MODEL ** -0.5),
        "final_g": 1.0 + nrm(ks[23], (D_MODEL,), 0.02),
    }


def reference(x, norm_g, w_in, conv_w, conv_b, dt_bias, a_log, d_skip, ssd_norm_g,
              rw_mu, rw_w0, rw_w_up, rw_a0, rw_a_up, rw_k_k, rw_k_a, rw_r_k, rw_ln_g, rw_ln_b,
              w_out_sb, w_out_ssd, w_out_rw, w_o, final_g):
    for i in range(DEPTH):
        x = hybrid_layer(x, norm_g[i], w_in[i], conv_w[i], conv_b[i], dt_bias[i], a_log[i], d_skip[i],
                         ssd_norm_g[i], rw_mu[i], rw_w0[i], rw_w_up[i], rw_a0[i], rw_a_up[i], rw_k_k[i],
                         rw_k_a[i], rw_r_k[i], rw_ln_g[i], rw_ln_b[i], w_out_sb[i], w_out_ssd[i],
                         w_out_rw[i], w_o[i])
    return rms_norm(x, final_g)
```

```cpp
#include <hip/hip_runtime.h>
#include <hip/hip_cooperative_groups.h>
#include <cstdio>
namespace cg = cooperative_groups;

#define LAS __attribute__((address_space(3)))
typedef unsigned short bf16_t;
typedef short bf16x8 __attribute__((ext_vector_type(8)));
typedef float f32x4 __attribute__((ext_vector_type(4)));
typedef unsigned u32x4 __attribute__((ext_vector_type(4)));
typedef unsigned u32x2 __attribute__((ext_vector_type(2)));

constexpr int TOK = 16384, SEQ = 2048, DM = 1024, NIN = 9616;
constexpr int LDP = 7680;
constexpr int C_Q = 0, C_K = 512, C_V = 1024, C_SBG = 1536, C_Z = 2048, C_XBC = 3072, C_RW = 4352, C_DT = 6528, C_H = 6656;
constexpr int C_M = 0, C_G = 3072, C_YRW = 4352;
constexpr int R_GATE = 6656, R_SB = 9728, R_SSD = 10752, R_RWO = 11776, R_WO = 12800, WT_ROWS = 13824;
constexpr size_t OFF_P = 0, SZ_P = (size_t)TOK * LDP * 2;
constexpr size_t OFF_WT = OFF_P + SZ_P, SZ_WT = (size_t)WT_ROWS * 1024 * 2;
constexpr size_t OFF_YRAW = OFF_WT + SZ_WT, SZ_YRAW = (size_t)TOK * 512 * 2;
constexpr size_t OFF_SSQ = OFF_YRAW + SZ_YRAW, SZ_SSQ = (size_t)TOK * 32 * 4;
constexpr size_t OFF_RSTD = OFF_SSQ + SZ_SSQ, SZ_RSTD = (size_t)TOK * 4;
constexpr size_t OFF_BONUS = OFF_RSTD + SZ_RSTD, SZ_BONUS = (size_t)TOK * 8 * 4;
constexpr size_t OFF_BAR = OFF_BONUS + SZ_BONUS, SZ_BAR = 16384;
constexpr size_t OFF_BCC = OFF_BAR + SZ_BAR, SZ_BCC = (size_t)TOK * 256 * 2;
constexpr size_t WS_NEED = OFF_BCC + SZ_BCC;
constexpr int LDS_BYTES = 135168;

struct Params { const float* in[24]; float* out; unsigned char* ws; };

typedef float f32x2_t __attribute__((ext_vector_type(2)));
typedef __bf16 bf16x2_t __attribute__((ext_vector_type(2)));
__device__ __forceinline__ unsigned cvt_pk_bf16(float lo, float hi) { const f32x2_t v = {lo, hi}; return __builtin_bit_cast(unsigned, __builtin_convertvector(v, bf16x2_t)); }
__device__ __forceinline__ float bf_lo(unsigned u) { return __uint_as_float(u << 16); }
__device__ __forceinline__ float bf_hi(unsigned u) { return __uint_as_float(u & 0xFFFF0000u); }
__device__ __forceinline__ float bf2f(bf16_t h) { return __uint_as_float(((unsigned)h) << 16); }
__device__ __forceinline__ float sigmoidf_(float x) { return __builtin_amdgcn_rcpf(1.f + __expf(-x)); }
__device__ __forceinline__ float siluf_(float x) { return x * __builtin_amdgcn_rcpf(1.f + __expf(-x)); }
__device__ __forceinline__ float softplusf_(float x) { return fmaxf(x, 0.f) + __logf(1.f + __expf(-fabsf(x))); }
template <int CTRL> __device__ __forceinline__ float dppf(float x) { return __int_as_float(__builtin_amdgcn_update_dpp(0, __float_as_int(x), CTRL, 0xF, 0xF, true)); }
__device__ __forceinline__ float allred16(float x) { x += dppf<0xB1>(x); x += dppf<0x4E>(x); x += dppf<0x141>(x); x += dppf<0x140>(x); return x; }
__device__ __forceinline__ int opaque_tid() { int t; asm volatile("v_mov_b32 %0, %1" : "=v"(t) : "v"((int)threadIdx.x)); return t; }
__device__ __forceinline__ float wave_sum(float v) {
#pragma unroll
    for (int o = 1; o < 64; o <<= 1) v += __shfl_xor(v, o);
    return v;
}

namespace pg8 {
constexpr int BM = 256, BK = 64, HALF = 128, HTB = HALF * BK * 2, NXCD = 8, WGM = 8;
constexpr unsigned LDA_B = LDP * 2, LDB_B = 2048;
__device__ __forceinline__ int lds_byte(int r, int c) { const int st = (r >> 4) * 2 + (c >> 5), rr = r & 15, cc = c & 31, ob = rr * 64 + cc * 2; return st * 1024 + (ob ^ (((ob >> 9) & 1) << 5)); }
__device__ __forceinline__ void stage_rc(int b, int& R, int& C) { const int st = b / 1024, sb = b % 1024, swz = sb ^ (((sb >> 9) & 1) << 5); R = (st >> 1) * 16 + swz / 64; C = (st & 1) * 32 + (swz % 64) / 2; }
__device__ __forceinline__ int perm32(int rho) { const int n = rho >> 4, i = rho & 15; return 8 * (i >> 2) + 4 * n + (i & 3); }
struct UnitD { const char* A; const char* B; int nt, pm, pn, kind; };
__device__ __forceinline__ void tile_of(int L, int nM, int nN, int& pm, int& pn) {
    const int nwg = nM * nN; int wgid = L;
    { const int q = nwg / NXCD, r = nwg % NXCD, xcd = wgid % NXCD, off = wgid / NXCD; wgid = (xcd < r ? xcd * (q + 1) : r * (q + 1) + (xcd - r) * q) + off; }
    const int nig = WGM * nN, gid = wgid / nig, fm = gid * WGM, gsz = (nM - fm) < WGM ? (nM - fm) : WGM;
    pm = fm + ((wgid % nig) % gsz); pn = (wgid % nig) / gsz;
}

template <bool PERM, class Sched, class Epi>
__device__ __forceinline__ void gemm_phase(LAS unsigned char* lds, const Sched& S, const Epi& E) {
    const int tid = opaque_tid(), wid = __builtin_amdgcn_readfirstlane(tid >> 6), lane = tid & 63, wr = wid >> 2, wc = wid & 3, fr = lane & 15, fq = lane >> 4;
    unsigned voffA[2], voffB[2];
#pragma unroll
    for (int i = 0; i < 2; ++i) { int R, C; stage_rc(tid * 16 + i * 8192, R, C); const int Rb = PERM ? ((R & ~31) + perm32(R & 31)) : R;
        voffA[i] = (unsigned)R * LDA_B + (unsigned)C * 2u; voffB[i] = (unsigned)Rb * LDB_B + (unsigned)C * 2u; }
    const size_t kstep = (size_t)(BK * 2);
    const size_t hstepA = (size_t)HALF * LDA_B, hstepB = (size_t)HALF * LDB_B;
    const unsigned ldsw = (unsigned)wid * 1024u;
    const int aoff = lds_byte(wr * 64 + fr, fq * 8), boff = lds_byte(wc * 32 + fr, fq * 8);
#define PG8_SA(b, h) (((b) * 2 + (h)) * HTB)
#define PG8_SB(b, h) ((4 + (b) * 2 + (h)) * HTB)
#define PG8_STAGE(bufoff, gbase, voff) do { _Pragma("unroll") for (int _i = 0; _i < 2; ++_i) \
        __builtin_amdgcn_global_load_lds((const unsigned*)((const char*)(gbase) + (voff)[_i]), (LAS unsigned*)(lds + (bufoff) + ldsw + _i * 8192), 16, 0, 0); } while (0)
#define PG8_LDA(dst, b, h) do { _Pragma("unroll") for (int m = 0; m < 4; ++m) _Pragma("unroll") for (int k = 0; k < 2; ++k) dst[m][k] = *(const LAS bf16x8*)(lds + PG8_SA(b, h) + aoff + m * 2048 + k * 1024); } while (0)
#define PG8_LDB(dst, b, h) do { _Pragma("unroll") for (int n = 0; n < 2; ++n) _Pragma("unroll") for (int k = 0; k < 2; ++k) dst[n][k] = *(const LAS bf16x8*)(lds + PG8_SB(b, h) + boff + n * 2048 + k * 1024); } while (0)
#define PG8_MMA(ai, bj, At, Bt) do { __builtin_amdgcn_s_setprio(1); _Pragma("unroll") for (int m = 0; m < 4; ++m) _Pragma("unroll") for (int n = 0; n < 2; ++n) _Pragma("unroll") for (int k = 0; k < 2; ++k) \
        acc[ai][bj][m][n] = __builtin_amdgcn_mfma_f32_16x16x32_bf16(Bt[n][k], At[m][k], acc[ai][bj][m][n], 0, 0, 0); __builtin_amdgcn_s_setprio(0); } while (0)
#define PG8_WAIT_V(n) asm volatile("s_waitcnt vmcnt(" #n ")" ::: "memory")
#define PG8_WAIT_L(n) asm volatile("s_waitcnt lgkmcnt(" #n ")" ::: "memory")
#define PG8_BAR __builtin_amdgcn_s_barrier()
#define PG8_SCHED __builtin_amdgcn_sched_barrier(0)
    UnitD cur, nxt; int ui = 0;
    if (!S.next(0, cur)) return;
    f32x4 acc[2][2][4][2];
#pragma unroll
    for (int a = 0; a < 2; ++a)
#pragma unroll
        for (int b = 0; b < 2; ++b)
#pragma unroll
            for (int m = 0; m < 4; ++m)
#pragma unroll
                for (int n = 0; n < 2; ++n) acc[a][b][m][n] = (f32x4){0.f, 0.f, 0.f, 0.f};
    bf16x8 At[4][2], B0[2][2], B1[2][2];
    const char* cA = cur.A; const char* cB = cur.B;
    PG8_STAGE(PG8_SB(0, 0), cB, voffB); PG8_STAGE(PG8_SA(0, 0), cA, voffA); PG8_STAGE(PG8_SB(0, 1), cB + hstepB, voffB); PG8_STAGE(PG8_SA(0, 1), cA + hstepA, voffA);
    if (wr == 1) PG8_BAR;
    PG8_WAIT_V(4); PG8_BAR;
    PG8_STAGE(PG8_SB(1, 0), cB + kstep, voffB); PG8_STAGE(PG8_SA(1, 0), cA + kstep, voffA); PG8_STAGE(PG8_SB(1, 1), cB + hstepB + kstep, voffB);
    PG8_WAIT_V(6); PG8_BAR;
    for (;;) {
        const bool has_next = S.next(ui + 1, nxt);
        const char* nA = has_next ? nxt.A : cA; const char* nB = has_next ? nxt.B : cB;
        const int nt = cur.nt;
        for (int t = 0; t < nt; t += 2) {
            const bool last = (t == nt - 2);
            const char* a1 = cA + (size_t)(t + 1) * kstep;
            const char* a2 = last ? nA : cA + (size_t)(t + 2) * kstep; const char* b2 = last ? nB : cB + (size_t)(t + 2) * kstep;
            const char* a3 = a2 + kstep; const char* b3 = b2 + kstep;
            PG8_LDB(B0, 0, 0); PG8_SCHED; PG8_LDA(At, 0, 0); PG8_STAGE(PG8_SA(1, 1), a1 + hstepA, voffA);
            PG8_WAIT_L(8); PG8_BAR; PG8_WAIT_L(0); PG8_MMA(0, 0, At, B0); PG8_BAR; PG8_SCHED;
            PG8_LDB(B1, 0, 1); PG8_STAGE(PG8_SB(0, 0), b2, voffB);
            PG8_BAR; PG8_WAIT_L(0); PG8_MMA(0, 1, At, B1); PG8_BAR;
            PG8_LDA(At, 0, 1); PG8_STAGE(PG8_SA(0, 0), a2, voffA);
            PG8_BAR; PG8_WAIT_L(0); PG8_MMA(1, 0, At, B0); PG8_BAR; PG8_SCHED;
            PG8_STAGE(PG8_SB(0, 1), b2 + hstepB, voffB);
            PG8_WAIT_V(6); PG8_BAR; PG8_MMA(1, 1, At, B1); PG8_BAR;
            PG8_LDB(B0, 1, 0); PG8_SCHED; PG8_LDA(At, 1, 0); PG8_STAGE(PG8_SA(0, 1), a2 + hstepA, voffA);
            PG8_WAIT_L(8); PG8_BAR; PG8_WAIT_L(0); PG8_MMA(0, 0, At, B0); PG8_BAR; PG8_SCHED;
            PG8_LDB(B1, 1, 1); PG8_STAGE(PG8_SB(1, 0), b3, voffB);
            PG8_BAR; PG8_WAIT_L(0); PG8_MMA(0, 1, At, B1); PG8_BAR;
            PG8_LDA(At, 1, 1); PG8_STAGE(PG8_SA(1, 0), a3, voffA);
            PG8_BAR; PG8_WAIT_L(0); PG8_MMA(1, 0, At, B0); PG8_BAR; PG8_SCHED;
            PG8_STAGE(PG8_SB(1, 1), b3 + hstepB, voffB);
            PG8_WAIT_V(6); PG8_BAR; PG8_MMA(1, 1, At, B1); PG8_BAR;
        }
        E(acc, cur, wr, wc, fr, fq);
        if (!has_next) break;
#pragma unroll
        for (int a = 0; a < 2; ++a)
#pragma unroll
            for (int b = 0; b < 2; ++b)
#pragma unroll
                for (int m = 0; m < 4; ++m)
#pragma unroll
                    for (int n = 0; n < 2; ++n) acc[a][b][m][n] = (f32x4){0.f, 0.f, 0.f, 0.f};
        cur = nxt; cA = nA; cB = nB; ++ui;
    }
    PG8_WAIT_V(0);
    if (wr == 0) PG8_BAR;
    PG8_BAR;
#undef PG8_SA
#undef PG8_SB
#undef PG8_STAGE
#undef PG8_LDA
#undef PG8_LDB
#undef PG8_MMA
#undef PG8_WAIT_V
#undef PG8_WAIT_L
#undef PG8_BAR
#undef PG8_SCHED
}
}
using pg8::UnitD;

struct SchedInproj {
    const char* P; const char* WT; int G, c;
    __device__ __forceinline__ bool next(int i, UnitD& u) const {
        const int L = i * G + c; if (L >= 64 * 26) return false;
        int pm, pn; pg8::tile_of(L, 64, 26, pm, pn);
        u.A = P + ((size_t)pm * 256 * LDP + C_H) * 2; u.B = WT + (size_t)pn * 256 * 2048; u.nt = 16; u.pm = pm; u.pn = pn; u.kind = 0; return true;
    }
};
struct EpiInproj {
    bf16_t* P;
    __device__ __forceinline__ void operator()(const f32x4 (&acc)[2][2][4][2], const UnitD& u, int wr, int wc, int fr, int fq) const {
        const int row0 = u.pm * 256 + wr * 64 + fr, col0 = u.pn * 256 + wc * 32 + 8 * fq;
#pragma unroll
        for (int ai = 0; ai < 2; ++ai)
#pragma unroll
            for (int m = 0; m < 4; ++m) { bf16_t* rowp = P + (size_t)(row0 + ai * 128 + m * 16) * LDP + col0;
#pragma unroll
                for (int bj = 0; bj < 2; ++bj) { const f32x4 v0 = acc[ai][bj][m][0], v1 = acc[ai][bj][m][1];
                    u32x4 o; o.x = cvt_pk_bf16(v0[0], v0[1]); o.y = cvt_pk_bf16(v0[2], v0[3]); o.z = cvt_pk_bf16(v1[0], v1[1]); o.w = cvt_pk_bf16(v1[2], v1[3]);
                    *(u32x4*)(rowp + bj * 128) = o; } }
    }
};
struct SchedC1 {
    const char* P; const char* WT; int G, c;
    __device__ __forceinline__ bool next(int i, UnitD& u) const {
        const int ti = i / 6, sub = i - ti * 6, L = ti * G + c; if (L >= 256) return false;
        int pm, pn; pg8::tile_of(L, 64, 4, pm, pn);
        const int br = sub >> 1;
        if (!(sub & 1)) { u.A = P + ((size_t)pm * 256 * LDP + C_H) * 2; u.B = WT + (size_t)(R_GATE + br * 1024 + pn * 256) * 2048; u.nt = 16; }
        else { const int acol = br == 0 ? C_SBG : (br == 1 ? C_Z : C_YRW); const int brow = br == 0 ? R_SB : (br == 1 ? R_SSD : R_RWO);
            u.A = P + ((size_t)pm * 256 * LDP + acol) * 2; u.B = WT + (size_t)(brow + pn * 256) * 2048; u.nt = br == 1 ? 16 : 8; }
        u.pm = pm; u.pn = pn; u.kind = sub; return true;
    }
};
struct EpiC1 {
    bf16_t* P; const float* rstd;
    __device__ __forceinline__ void operator()(const f32x4 (&acc)[2][2][4][2], const UnitD& u, int wr, int wc, int fr, int fq) const {
        const int row0 = u.pm * 256 + wr * 64 + fr, col0 = u.pn * 256 + wc * 32 + 8 * fq;
        const int kind = u.kind;
#pragma unroll
        for (int ai = 0; ai < 2; ++ai)
#pragma unroll
            for (int m = 0; m < 4; ++m) { const int row = row0 + ai * 128 + m * 16; bf16_t* rowp = P + (size_t)row * LDP + col0;
                const float sc = (kind == 3) ? rstd[row] : 1.f;
#pragma unroll
                for (int bj = 0; bj < 2; ++bj) { const f32x4 v0 = acc[ai][bj][m][0], v1 = acc[ai][bj][m][1];
                    float v[8] = {v0[0], v0[1], v0[2], v0[3], v1[0], v1[1], v1[2], v1[3]};
                    u32x4* gp = (u32x4*)(rowp + C_G + bj * 128); u32x4* mp = (u32x4*)(rowp + C_M + bj * 128);
                    if (!(kind & 1)) {
#pragma unroll
                        for (int e = 0; e < 8; ++e) v[e] = sigmoidf_(v[e]);
                        u32x4 o; o.x = cvt_pk_bf16(v[0], v[1]); o.y = cvt_pk_bf16(v[2], v[3]); o.z = cvt_pk_bf16(v[4], v[5]); o.w = cvt_pk_bf16(v[6], v[7]);
                        *gp = o;
                    } else {
                        const u32x4 g = *gp;
                        float r[8];
                        r[0] = bf_lo(g.x) * v[0] * sc; r[1] = bf_hi(g.x) * v[1] * sc; r[2] = bf_lo(g.y) * v[2] * sc; r[3] = bf_hi(g.y) * v[3] * sc;
                        r[4] = bf_lo(g.z) * v[4] * sc; r[5] = bf_hi(g.z) * v[5] * sc; r[6] = bf_lo(g.w) * v[6] * sc; r[7] = bf_hi(g.w) * v[7] * sc;
                        if (kind != 1) { const u32x4 mo = *mp;
                            r[0] += bf_lo(mo.x); r[1] += bf_hi(mo.x); r[2] += bf_lo(mo.y); r[3] += bf_hi(mo.y); r[4] += bf_lo(mo.z); r[5] += bf_hi(mo.z); r[6] += bf_lo(mo.w); r[7] += bf_hi(mo.w); }
                        u32x4 o; o.x = cvt_pk_bf16(r[0], r[1]); o.y = cvt_pk_bf16(r[2], r[3]); o.z = cvt_pk_bf16(r[4], r[5]); o.w = cvt_pk_bf16(r[6], r[7]);
                        *mp = o;
                    } } }
    }
};
struct SchedOut {
    const char* P; const char* WT; int G, c;
    __device__ __forceinline__ bool next(int i, UnitD& u) const {
        const int L = i * G + c; if (L >= 256) return false;
        int pm, pn; pg8::tile_of(L, 64, 4, pm, pn);
        u.A = P + ((size_t)pm * 256 * LDP + C_M) * 2; u.B = WT + (size_t)(R_WO + pn * 256) * 2048; u.nt = 16; u.pm = pm; u.pn = pn; u.kind = 0; return true;
    }
};
struct EpiOut {
    const float* Xin; float* Xout;
    __device__ __forceinline__ void operator()(const f32x4 (&acc)[2][2][4][2], const UnitD& u, int wr, int wc, int fr, int fq) const {
        const int row0 = u.pm * 256 + wr * 64 + fr, col0 = u.pn * 256 + wc * 32 + 4 * fq;
#pragma unroll
        for (int ai = 0; ai < 2; ++ai)
#pragma unroll
            for (int m = 0; m < 4; ++m) { const size_t ro = (size_t)(row0 + ai * 128 + m * 16) * DM + col0;
#pragma unroll
                for (int bj = 0; bj < 2; ++bj)
#pragma unroll
                    for (int n = 0; n < 2; ++n) { const f32x4 xi = *(const f32x4*)(Xin + ro + bj * 128 + n * 16); *(f32x4*)(Xout + ro + bj * 128 + n * 16) = xi + acc[ai][bj][m][n]; } }
    }
};

__device__ __forceinline__ void phase0(const Params& p, int layer, unsigned char* shm) {
    const int tid = opaque_tid(), wave = tid >> 6, lane = tid & 63;
    bf16_t* P = (bf16_t*)(p.ws + OFF_P); bf16_t* WT = (bf16_t*)(p.ws + OFF_WT);
    const float* Xin = layer == 0 ? p.in[0] : p.out;
    const float* ng = p.in[1] + layer * DM;
    f32x4 gn[4];
#pragma unroll
    for (int i = 0; i < 4; ++i) gn[i] = *(const f32x4*)(ng + i * 256 + lane * 4);
    for (int row0 = (blockIdx.x * 8 + wave) * 4; row0 < TOK; row0 += gridDim.x * 32) {
        f32x4 v[4][4]; float ss[4];
#pragma unroll
        for (int rr = 0; rr < 4; ++rr) { const float* xr = Xin + (size_t)(row0 + rr) * DM;
#pragma unroll
            for (int i = 0; i < 4; ++i) v[rr][i] = *(const f32x4*)(xr + i * 256 + lane * 4); }
#pragma unroll
        for (int rr = 0; rr < 4; ++rr) { float a = 0.f;
#pragma unroll
            for (int i = 0; i < 4; ++i) a += v[rr][i][0] * v[rr][i][0] + v[rr][i][1] * v[rr][i][1] + v[rr][i][2] * v[rr][i][2] + v[rr][i][3] * v[rr][i][3];
            ss[rr] = wave_sum(a); }
#pragma unroll
        for (int rr = 0; rr < 4; ++rr) { const float rs = rsqrtf(ss[rr] * (1.f / DM) + 1e-6f);
#pragma unroll
            for (int i = 0; i < 4; ++i) { const f32x4 g = gn[i];
                u32x2 o; o.x = cvt_pk_bf16(v[rr][i][0] * rs * g[0], v[rr][i][1] * rs * g[1]); o.y = cvt_pk_bf16(v[rr][i][2] * rs * g[2], v[rr][i][3] * rs * g[3]);
                *(u32x2*)(P + (size_t)(row0 + rr) * LDP + C_H + i * 256 + lane * 4) = o; } }
    }
    float* T = (float*)shm + wave * (64 * 65);
    const float* w_in = p.in[2] + (size_t)layer * DM * NIN;
    const float* sg = p.in[8] + layer * DM;
    for (int job = blockIdx.x * 8 + wave; job < 3200; job += gridDim.x * 8) {
        const float* src; int srcN, k0, n0, dstrow; bool is_in = false, is_ssd = false;
        if (job < 2432) { is_in = true; src = w_in; srcN = NIN; const int ntile = job >> 4; k0 = (job & 15) * 64; n0 = ntile * 64; dstrow = n0; }
        else { int r = job - 2432;
            if (r < 128) { src = p.in[19] + (size_t)layer * 512 * DM; k0 = (r >> 4) * 64; n0 = (r & 15) * 64; dstrow = R_SB + n0; }
            else if (r < 384) { r -= 128; src = p.in[20] + (size_t)layer * DM * DM; k0 = (r >> 4) * 64; n0 = (r & 15) * 64; dstrow = R_SSD + n0; is_ssd = true; }
            else if (r < 512) { r -= 384; src = p.in[21] + (size_t)layer * 512 * DM; k0 = (r >> 4) * 64; n0 = (r & 15) * 64; dstrow = R_RWO + n0; }
            else { r -= 512; src = p.in[22] + (size_t)layer * DM * DM; k0 = (r >> 4) * 64; n0 = (r & 15) * 64; dstrow = R_WO + n0; }
            srcN = DM; }
        const int n4 = (lane & 15) * 4, np = n0 + n4; int sc = np;
        if (is_in) { if (np < 4352) sc = np; else if (np < 6528) sc = np + 16; else if (np < 6544) sc = np - 6528 + 4352; else if (np < 6656) sc = -1; else sc = np - 112; }
        f32x4 v[16];
#pragma unroll
        for (int i = 0; i < 16; ++i) { const int k = (lane >> 4) + 4 * i; v[i] = (f32x4){0.f, 0.f, 0.f, 0.f};
            if (sc >= 0) v[i] = *(const f32x4*)(src + (size_t)(k0 + k) * srcN + sc); }
#pragma unroll
        for (int i = 0; i < 16; ++i) { const int k = (lane >> 4) + 4 * i; f32x4 x = v[i];
            if (is_ssd) x = x * sg[k0 + k];
            T[k * 65 + n4] = x[0]; T[k * 65 + n4 + 1] = x[1]; T[k * 65 + n4 + 2] = x[2]; T[k * 65 + n4 + 3] = x[3]; }
        asm volatile("s_waitcnt lgkmcnt(0)" ::: "memory"); __builtin_amdgcn_wave_barrier(); asm volatile("" ::: "memory");
#pragma unroll
        for (int j = 0; j < 8; ++j) { const int r = lane + 64 * j, n = r >> 3, kc = (r & 7) * 8; const float* sp = T + kc * 65 + n;
            u32x4 o; o.x = cvt_pk_bf16(sp[0], sp[65]); o.y = cvt_pk_bf16(sp[130], sp[195]); o.z = cvt_pk_bf16(sp[260], sp[325]); o.w = cvt_pk_bf16(sp[390], sp[455]);
            *(u32x4*)(WT + (size_t)(dstrow + n) * 1024 + k0 + kc) = o; }
        asm volatile("s_waitcnt lgkmcnt(0)" ::: "memory"); __builtin_amdgcn_wave_barrier(); asm volatile("" ::: "memory");
    }
    __syncthreads();
}

__device__ __forceinline__ void attn_item(const Params& p, unsigned char* shm, int item) {
    const int qb = item & 15, h = (item >> 4) & 7, b = item >> 7;
    bf16_t* P = (bf16_t*)(p.ws + OFF_P);
    const int tid = opaque_tid(), wave = tid >> 6, lane = tid & 63, lq = lane & 15, g = lane >> 4;
    const size_t rowbase = (size_t)b * SEQ;
    const int t = qb * 128 + wave * 16 + lq;
    const int tmax = qb * 128 + wave * 16 + 15;
    constexpr int ABUF = 64 * 144 + 64 * 136;
    const bf16_t* qp = P + (rowbase + t) * LDP + C_Q + h * 64 + 8 * g;
    const bf16x8 qf0 = *(const bf16x8*)qp, qf1 = *(const bf16x8*)(qp + 32);
    bf16x8 TT[4][2];
#pragma unroll
    for (int a = 0; a < 4; ++a)
#pragma unroll
        for (int ks = 0; ks < 2; ++ks)
#pragma unroll
            for (int e = 0; e < 8; ++e) { const int j = 16 * (2 * ks + (e >> 2)) + 4 * g + (e & 3); TT[a][ks][e] = (j > 16 * a + lq) ? (short)0x3F80 : (short)0; }
    f32x4 o[4];
#pragma unroll
    for (int i = 0; i < 4; ++i) o[i] = (f32x4){0.f, 0.f, 0.f, 0.f};
    float R = 0.f;
    LAS volatile int* flg = (LAS volatile int*)((LAS unsigned char*)shm + 2 * ABUF);
    const int st_s = tid >> 3, st_dc = (tid & 7) * 8;
    const bf16_t* st_base = P + (rowbase + st_s) * LDP + h * 64 + st_dc;
    auto stage_write = [&](unsigned char* buf, const u32x4& kv, const u32x4& vv) {
        bf16_t* Ksw = (bf16_t*)buf; bf16_t* Vtw = (bf16_t*)(buf + 64 * 144); const int s_ = st_s, dc = st_dc;
        *(u32x4*)(Ksw + s_ * 72 + dc) = kv;
        Vtw[(dc + 0) * 68 + s_] = (bf16_t)(vv.x & 0xFFFF); Vtw[(dc + 1) * 68 + s_] = (bf16_t)(vv.x >> 16);
        Vtw[(dc + 2) * 68 + s_] = (bf16_t)(vv.y & 0xFFFF); Vtw[(dc + 3) * 68 + s_] = (bf16_t)(vv.y >> 16);
        Vtw[(dc + 4) * 68 + s_] = (bf16_t)(vv.z & 0xFFFF); Vtw[(dc + 5) * 68 + s_] = (bf16_t)(vv.z >> 16);
        Vtw[(dc + 6) * 68 + s_] = (bf16_t)(vv.w & 0xFFFF); Vtw[(dc + 7) * 68 + s_] = (bf16_t)(vv.w >> 16);
    };
    if (tid == 0) { flg[0] = 1; flg[1] = 0; flg[2] = 0; }
    { const bf16_t* kr = st_base + (size_t)(2 * qb + 1) * 64 * LDP; const u32x4 kv0 = *(const u32x4*)(kr + C_K), vv0 = *(const u32x4*)(kr + C_V); stage_write(shm, kv0, vv0); }
    int itn = 0, cur = 0;
    for (int kt = 2 * qb + 1; kt >= 0; --kt) {
        __syncthreads();
        const int f0 = itn % 3, f1 = (itn + 1) % 3, f2 = (itn + 2) % 3;
        if (flg[f0] == 0) break;
        if (tid == 0) flg[f2] = 0;
        u32x4 kvn = (u32x4){0u, 0u, 0u, 0u}, vvn = (u32x4){0u, 0u, 0u, 0u};
        if (kt > 0) { const bf16_t* kr = st_base + (size_t)(kt - 1) * 64 * LDP; kvn = *(const u32x4*)(kr + C_K); vvn = *(const u32x4*)(kr + C_V); }
        const bf16_t* Ks = (const bf16_t*)(shm + cur * ABUF); const bf16_t* Vt = (const bf16_t*)(shm + cur * ABUF + 64 * 144);
        const bool walive = __any(R > -104.f);
        const bool act = (kt * 64 < tmax) && walive;
        if (act) {
            float lb[4][4], lk[4][4];
#pragma unroll
            for (int sub = 0; sub < 4; ++sub) {
                const bf16_t* kp = Ks + (16 * sub + lq) * 72 + 8 * g;
                const bf16x8 k0 = *(const bf16x8*)kp, k1 = *(const bf16x8*)(kp + 32);
                f32x4 s4 = (f32x4){0.f, 0.f, 0.f, 0.f};
                s4 = __builtin_amdgcn_mfma_f32_16x16x32_bf16(k0, qf0, s4, 0, 0, 0);
                s4 = __builtin_amdgcn_mfma_f32_16x16x32_bf16(k1, qf1, s4, 0, 0, 0);
#pragma unroll
                for (int r = 0; r < 4; ++r) { const float z = s4[r] * 0.125f; const bool mk = (kt * 64 + 16 * sub + 4 * g + r) < t;
                    const float l = fminf(z, 0.f) - __logf(1.f + __expf(-fabsf(z)));
                    lb[sub][r] = mk ? l : -1e30f; lk[sub][r] = mk ? (l - z) : 0.f; }
            }
            bf16x8 hi[2], lo[2];
#pragma unroll
            for (int ks = 0; ks < 2; ++ks) {
                unsigned hw[4], lw[4];
#pragma unroll
                for (int w2 = 0; w2 < 4; ++w2) { const int sub = 2 * ks + (w2 >> 1), r0 = (w2 & 1) * 2; const float a0 = lk[sub][r0], a1 = lk[sub][r0 + 1];
                    hw[w2] = cvt_pk_bf16(a0, a1); lw[w2] = cvt_pk_bf16(a0 - bf_lo(hw[w2]), a1 - bf_hi(hw[w2])); }
                u32x4 hv = (u32x4){hw[0], hw[1], hw[2], hw[3]}, lv = (u32x4){lw[0], lw[1], lw[2], lw[3]};
                hi[ks] = __builtin_bit_cast(bf16x8, hv); lo[ks] = __builtin_bit_cast(bf16x8, lv);
            }
            f32x4 aft[4];
#pragma unroll
            for (int a = 0; a < 4; ++a) { f32x4 c = (f32x4){0.f, 0.f, 0.f, 0.f};
#pragma unroll
                for (int ks = 0; ks < 2; ++ks) { c = __builtin_amdgcn_mfma_f32_16x16x32_bf16(TT[a][ks], hi[ks], c, 0, 0, 0); c = __builtin_amdgcn_mfma_f32_16x16x32_bf16(TT[a][ks], lo[ks], c, 0, 0, 0); }
                aft[a] = c; }
            float tot = aft[0][0] + lk[0][0];
            tot = __shfl(tot, lq);
            bf16x8 pf[2];
#pragma unroll
            for (int ks = 0; ks < 2; ++ks) { unsigned pw[4];
#pragma unroll
                for (int w2 = 0; w2 < 4; ++w2) { const int sub = 2 * ks + (w2 >> 1), r0 = (w2 & 1) * 2;
                    const float e0 = __expf(lb[sub][r0] + aft[sub][r0] + R), e1 = __expf(lb[sub][r0 + 1] + aft[sub][r0 + 1] + R);
                    pw[w2] = cvt_pk_bf16(e0, e1); }
                u32x4 pv = (u32x4){pw[0], pw[1], pw[2], pw[3]}; pf[ks] = __builtin_bit_cast(bf16x8, pv); }
            R += tot;
#pragma unroll
            for (int ds = 0; ds < 4; ++ds)
#pragma unroll
                for (int ks = 0; ks < 2; ++ks) { const bf16_t* vp = Vt + (16 * ds + lq) * 68 + 32 * ks + 4 * g;
                    const u32x2 v0 = *(const u32x2*)vp, v1 = *(const u32x2*)(vp + 16);
                    u32x4 vv = (u32x4){v0.x, v0.y, v1.x, v1.y};
                    o[ds] = __builtin_amdgcn_mfma_f32_16x16x32_bf16(__builtin_bit_cast(bf16x8, vv), pf[ks], o[ds], 0, 0, 0); }
        }
        if (__any(R > -104.f) && lane == 0) flg[f1] = 1;
        if (kt > 0) stage_write(shm + (cur ^ 1) * ABUF, kvn, vvn);
        cur ^= 1; ++itn;
    }
#pragma unroll
    for (int ds = 0; ds < 4; ++ds) { bf16_t* gp = P + (rowbase + t) * LDP + C_SBG + h * 64 + 16 * ds + 4 * g;
        const u32x2 gv = *(const u32x2*)gp;
        u32x2 ov; ov.x = cvt_pk_bf16(o[ds][0] * siluf_(bf_lo(gv.x)), o[ds][1] * siluf_(bf_hi(gv.x))); ov.y = cvt_pk_bf16(o[ds][2] * siluf_(bf_lo(gv.y)), o[ds][3] * siluf_(bf_hi(gv.y)));
        *(u32x2*)gp = ov; }
    __syncthreads();
}

__device__ __forceinline__ void bc_prepass(const Params& p, int layer) {
    const bf16_t* P = (const bf16_t*)(p.ws + OFF_P); bf16_t* BCc = (bf16_t*)(p.ws + OFF_BCC);
    const float* cw = p.in[3] + (size_t)layer * 4 * 1280; const float* cb = p.in[4] + layer * 1280;
    const int gt = blockIdx.x * 512 + opaque_tid(), gs = gridDim.x * 512;
    const int c = (gt & 63) * 4, chn = 1024 + c;
    const f32x4 bias = *(const f32x4*)(cb + chn);
    f32x4 w[4];
#pragma unroll
    for (int k = 0; k < 4; ++k) w[k] = *(const f32x4*)(cw + k * 1280 + chn);
    for (int idx0 = gt; idx0 < TOK * 64; idx0 += 4 * gs) {
        u32x2 xv[4][4]; bool ok[4];
#pragma unroll
        for (int u = 0; u < 4; ++u) { const int idx = idx0 + u * gs; ok[u] = idx < TOK * 64; const int tok = ok[u] ? (idx >> 6) : 0; const int t = tok & (SEQ - 1);
            const bf16_t* xp = P + (size_t)tok * LDP + C_XBC + chn;
#pragma unroll
            for (int k = 0; k < 4; ++k) { const int ts = t - 3 + k; const unsigned xm = ts >= 0 ? 0xFFFFFFFFu : 0u;
                u32x2 x = *(const u32x2*)(xp + (ptrdiff_t)(ts >= 0 ? k - 3 : 0) * LDP); x.x &= xm; x.y &= xm; xv[u][k] = x; } }
#pragma unroll
        for (int u = 0; u < 4; ++u) { const int idx = idx0 + u * gs; const int tok = ok[u] ? (idx >> 6) : 0;
            f32x4 a = bias;
#pragma unroll
            for (int k = 0; k < 4; ++k) { a[0] += w[k][0] * bf_lo(xv[u][k].x); a[1] += w[k][1] * bf_hi(xv[u][k].x); a[2] += w[k][2] * bf_lo(xv[u][k].y); a[3] += w[k][3] * bf_hi(xv[u][k].y); }
            u32x2 o; o.x = cvt_pk_bf16(siluf_(a[0]), siluf_(a[1])); o.y = cvt_pk_bf16(siluf_(a[2]), siluf_(a[3]));
            if (ok[u]) *(u32x2*)(BCc + (size_t)tok * 256 + c) = o; }
    }
}

__device__ __forceinline__ void ssd_item(const Params& p, int layer, unsigned char* shm, int item) {
    const int ph = item & 1, hh = (item >> 1) & 15, b = item >> 5, grp = hh >> 3;
    bf16_t* P = (bf16_t*)(p.ws + OFF_P); float* SSQ = (float*)(p.ws + OFF_SSQ);
    const int tid = opaque_tid(), wave = tid >> 6, lane = tid & 63, lq = lane & 15, g = lane >> 4;
    const size_t rowbase = (size_t)b * SEQ;
    const float* cw = p.in[3] + (size_t)layer * 4 * 1280; const float* cb = p.in[4] + layer * 1280;
    const float dtb = p.in[5][layer * 16 + hh], Aneg = -__expf(p.in[6][layer * 16 + hh]), Dsk = p.in[7][layer * 16 + hh];
    float* XS = (float*)shm;
    float* YS = XS + 2048;
    float* DTs = YS + 2048;
    float* ACS = DTs + 64;
    bf16_t* Cb = (bf16_t*)(ACS + 64);
    bf16_t* Bb = Cb + 64 * 72;
    bf16_t* BT = Bb + 64 * 72;
    bf16_t* Mx = BT + 64 * 72;
    bf16_t* XT = Mx + 64 * 72;
    bf16_t* XwT = XT + 32 * 72;
    bf16_t* SbT = XwT + 32 * 72;
    f32x4 Sacc = (f32x4){0.f, 0.f, 0.f, 0.f};
    const bf16_t* BCc = (const bf16_t*)(p.ws + OFF_BCC);
    const int x_tt = tid >> 3, x_c = (tid & 7) * 4, x_chn = hh * 64 + ph * 32 + x_c;
    const int bc_q = tid & 7;
    const f32x4 xbias = *(const f32x4*)(cb + x_chn);
    f32x4 xw[4];
#pragma unroll
    for (int k = 0; k < 4; ++k) xw[k] = *(const f32x4*)(cw + k * 1280 + x_chn);
    u32x2 sx[4]; u32x4 bc0, bc1; bf16_t sdt = 0;
    auto ssd_load = [&](int tb) {
        const int t = tb + x_tt;
        const bf16_t* xp = P + (rowbase + t) * LDP + C_XBC + x_chn;
#pragma unroll
        for (int k = 0; k < 4; ++k) { const int ts = t - 3 + k; const unsigned xm = ts >= 0 ? 0xFFFFFFFFu : 0u;
            u32x2 xv = *(const u32x2*)(xp + (ptrdiff_t)(ts >= 0 ? k - 3 : 0) * LDP); xv.x &= xm; xv.y &= xm; sx[k] = xv; }
        const bf16_t* bp = BCc + (rowbase + t) * 256 + (bc_q < 4 ? grp * 64 + bc_q * 16 : 128 + grp * 64 + (bc_q - 4) * 16);
        bc0 = *(const u32x4*)bp; bc1 = *(const u32x4*)(bp + 8);
        if (tid < 64) sdt = P[(rowbase + tb + tid) * LDP + C_DT + hh];
    };
    ssd_load(0);
    for (int ch = 0; ch < SEQ / 64; ++ch) {
        const int t0 = ch * 64;
        __syncthreads();
        const int o_tt = tid >> 3, o_p4 = (tid & 7) * 4;
        bf16_t* zp = P + (rowbase + t0 + o_tt) * LDP + C_Z + hh * 64 + ph * 32 + o_p4;
        const u32x2 zv = *(const u32x2*)zp;
        { f32x4 a = xbias;
#pragma unroll
            for (int k = 0; k < 4; ++k) { a[0] += xw[k][0] * bf_lo(sx[k].x); a[1] += xw[k][1] * bf_hi(sx[k].x); a[2] += xw[k][2] * bf_lo(sx[k].y); a[3] += xw[k][3] * bf_hi(sx[k].y); }
            a[0] = siluf_(a[0]); a[1] = siluf_(a[1]); a[2] = siluf_(a[2]); a[3] = siluf_(a[3]);
            const unsigned q0 = cvt_pk_bf16(a[0], a[1]), q1 = cvt_pk_bf16(a[2], a[3]); const int tt = x_tt, c = x_c;
            *(f32x4*)(XS + tt * 32 + c) = a;
            XT[(c + 0) * 72 + tt] = (bf16_t)(q0 & 0xFFFF); XT[(c + 1) * 72 + tt] = (bf16_t)(q0 >> 16); XT[(c + 2) * 72 + tt] = (bf16_t)(q1 & 0xFFFF); XT[(c + 3) * 72 + tt] = (bf16_t)(q1 >> 16);
            if (bc_q < 4) { const int n = bc_q * 16; *(u32x4*)(Bb + tt * 72 + n) = bc0; *(u32x4*)(Bb + tt * 72 + n + 8) = bc1;
                const unsigned wv[8] = {bc0.x, bc0.y, bc0.z, bc0.w, bc1.x, bc1.y, bc1.z, bc1.w};
#pragma unroll
                for (int e = 0; e < 8; ++e) { BT[(n + 2 * e) * 72 + tt] = (bf16_t)(wv[e] & 0xFFFF); BT[(n + 2 * e + 1) * 72 + tt] = (bf16_t)(wv[e] >> 16); } }
            else { const int n = (bc_q - 4) * 16; *(u32x4*)(Cb + tt * 72 + n) = bc0; *(u32x4*)(Cb + tt * 72 + n + 8) = bc1; } }
        if (tid < 64) { const float dt = softplusf_(bf2f(sdt) + dtb); DTs[tid] = dt;
            float x = dt * Aneg;
#pragma unroll
            for (int o = 1; o < 64; o <<= 1) { const float v = __shfl_up(x, o); if (lane >= o) x += v; }
            ACS[tid] = x; }
        if (ch + 1 < SEQ / 64) ssd_load(t0 + 64);
        __syncthreads();
        const float acsL = ACS[63];
        { const int pp = tid >> 4, s4 = (tid & 15) * 4; float v[4];
#pragma unroll
            for (int e = 0; e < 4; ++e) { const int sidx = s4 + e; v[e] = XS[sidx * 32 + pp] * DTs[sidx] * __expf(acsL - ACS[sidx]); }
            *(u32x2*)(XwT + pp * 72 + s4) = (u32x2){cvt_pk_bf16(v[0], v[1]), cvt_pk_bf16(v[2], v[3])}; }
        { const int pi = wave >> 2, ni = wave & 3;
#pragma unroll
            for (int r = 0; r < 4; ++r) SbT[(16 * pi + 4 * g + r) * 72 + 16 * ni + lq] = (bf16_t)(cvt_pk_bf16(Sacc[r], 0.f) & 0xFFFF); }
        { const int ti = wave >> 1;
#pragma unroll
            for (int sj = 0; sj < 2; ++sj) { const int si = 2 * (wave & 1) + sj;
                f32x4 acc = (f32x4){0.f, 0.f, 0.f, 0.f};
                if (si <= ti) {
                    const bf16_t* ap = Cb + (16 * ti + lq) * 72 + 8 * g; const bf16_t* bp = Bb + (16 * si + lq) * 72 + 8 * g;
                    acc = __builtin_amdgcn_mfma_f32_16x16x32_bf16(*(const bf16x8*)ap, *(const bf16x8*)bp, acc, 0, 0, 0);
                    acc = __builtin_amdgcn_mfma_f32_16x16x32_bf16(*(const bf16x8*)(ap + 32), *(const bf16x8*)(bp + 32), acc, 0, 0, 0);
                }
                const int sidx = 16 * si + lq; const float as = ACS[sidx], ds = DTs[sidx];
#pragma unroll
                for (int r = 0; r < 4; ++r) { const int t = 16 * ti + 4 * g + r; const float val = (sidx <= t) ? acc[r] * __expf(ACS[t] - as) * ds : 0.f;
                    Mx[t * 72 + sidx] = (bf16_t)(cvt_pk_bf16(val, 0.f) & 0xFFFF); } } }
        __syncthreads();
        { const int ti = wave >> 1, pi = wave & 1;
            const bf16_t* ap = Mx + (16 * ti + lq) * 72 + 8 * g; const bf16_t* bp = XT + (16 * pi + lq) * 72 + 8 * g;
            const bf16_t* cp = Cb + (16 * ti + lq) * 72 + 8 * g; const bf16_t* sp = SbT + (16 * pi + lq) * 72 + 8 * g;
            f32x4 a1 = (f32x4){0.f, 0.f, 0.f, 0.f}, a2 = (f32x4){0.f, 0.f, 0.f, 0.f};
            a1 = __builtin_amdgcn_mfma_f32_16x16x32_bf16(*(const bf16x8*)ap, *(const bf16x8*)bp, a1, 0, 0, 0);
            a1 = __builtin_amdgcn_mfma_f32_16x16x32_bf16(*(const bf16x8*)(ap + 32), *(const bf16x8*)(bp + 32), a1, 0, 0, 0);
            a2 = __builtin_amdgcn_mfma_f32_16x16x32_bf16(*(const bf16x8*)cp, *(const bf16x8*)sp, a2, 0, 0, 0);
            a2 = __builtin_amdgcn_mfma_f32_16x16x32_bf16(*(const bf16x8*)(cp + 32), *(const bf16x8*)(sp + 32), a2, 0, 0, 0);
#pragma unroll
            for (int r = 0; r < 4; ++r) { const int t = 16 * ti + 4 * g + r, pc = 16 * pi + lq;
                YS[t * 32 + pc] = a1[r] + __expf(ACS[t]) * a2[r] + Dsk * XS[t * 32 + pc]; } }
        { const int pi = wave >> 2, ni = wave & 3; const float dl = __expf(acsL);
            Sacc = Sacc * dl;
            const bf16_t* ap = XwT + (16 * pi + lq) * 72 + 8 * g; const bf16_t* bp = BT + (16 * ni + lq) * 72 + 8 * g;
            Sacc = __builtin_amdgcn_mfma_f32_16x16x32_bf16(*(const bf16x8*)ap, *(const bf16x8*)bp, Sacc, 0, 0, 0);
            Sacc = __builtin_amdgcn_mfma_f32_16x16x32_bf16(*(const bf16x8*)(ap + 32), *(const bf16x8*)(bp + 32), Sacc, 0, 0, 0); }
        __syncthreads();
        { const int tt = o_tt, p4 = o_p4; const f32x4 y4 = *(const f32x4*)(YS + tt * 32 + p4);
            const float u0 = y4[0] * siluf_(bf_lo(zv.x)), u1 = y4[1] * siluf_(bf_hi(zv.x)), u2 = y4[2] * siluf_(bf_lo(zv.y)), u3 = y4[3] * siluf_(bf_hi(zv.y));
            u32x2 ov; ov.x = cvt_pk_bf16(u0, u1); ov.y = cvt_pk_bf16(u2, u3); *(u32x2*)zp = ov;
            float q = u0 * u0 + u1 * u1 + u2 * u2 + u3 * u3;
            q += __shfl_xor(q, 1); q += __shfl_xor(q, 2); q += __shfl_xor(q, 4);
            if ((tid & 7) == 0) SSQ[(rowbase + t0 + tt) * 32 + hh * 2 + ph] = q; }
    }
    __syncthreads();
}

__device__ __forceinline__ float fast_tanh(float x) { return 1.f - 2.f * __builtin_amdgcn_rcpf(1.f + __expf(2.f * x)); }
__device__ __forceinline__ void pbar4(LAS volatile unsigned* cnt, unsigned& tgt, int lane) {
    tgt += 4u;
    asm volatile("s_waitcnt lgkmcnt(0)" ::: "memory");
    if (lane == 0) __hip_atomic_fetch_add((LAS unsigned*)cnt, 1u, __ATOMIC_RELAXED, __HIP_MEMORY_SCOPE_WORKGROUP);
    while (*cnt < tgt) __builtin_amdgcn_s_sleep(1);
    asm volatile("" ::: "memory");
}
__device__ __forceinline__ void rwkv_item(const Params& p, int layer, unsigned char* shm, int item) {
    const int qtr = item & 3, h = (item >> 2) & 7, b = item >> 5;
    bf16_t* P = (bf16_t*)(p.ws + OFF_P); bf16_t* YRAW = (bf16_t*)(p.ws + OFF_YRAW); float* BONUS = (float*)(p.ws + OFF_BONUS);
    const int tid = opaque_tid(), wave = tid >> 6, lane = tid & 63, lq = lane & 15, g = lane >> 4;
    const size_t rowbase = (size_t)b * SEQ;
    const float* mu = p.in[9] + layer * 2176;
    const float* w0 = p.in[10] + layer * 512; const float* wup = p.in[11] + (size_t)layer * 64 * 512;
    const float* a0 = p.in[12] + layer * 512; const float* aup = p.in[13] + (size_t)layer * 64 * 512;
    const float* kkp = p.in[14] + layer * 512; const float* kap = p.in[15] + layer * 512; const float* rkp = p.in[16] + layer * 512;
    constexpr int SETF = 6 * 2048;
    float* SET0 = (float*)shm;
    float* AA = SET0 + 2 * SETF;
    float* Yb = AA + 2048;
    bf16_t* WLb = (bf16_t*)(Yb + 1024);
    bf16_t* ALb = WLb + 32 * 72;
    LAS volatile unsigned* pcnt = (LAS volatile unsigned*)((LAS unsigned char*)shm + (2 * SETF + 2048 + 1024) * 4 + 2 * 32 * 72 * 2);
    const int csub = wave & 3;
    bf16x8 bfr[2][2]; float lw0[2];
#pragma unroll
    for (int mat = 0; mat < 2; ++mat) { const float* up = (mat ? aup : wup) + h * 64 + csub * 16 + lq;
#pragma unroll
        for (int ks = 0; ks < 2; ++ks) { unsigned w[4];
#pragma unroll
            for (int e2 = 0; e2 < 4; ++e2) { const int m0 = 32 * ks + 8 * g + 2 * e2; w[e2] = cvt_pk_bf16(up[(size_t)m0 * 512], up[(size_t)(m0 + 1) * 512]); }
            u32x4 wv = (u32x4){w[0], w[1], w[2], w[3]}; bfr[mat][ks] = __builtin_bit_cast(bf16x8, wv); }
        lw0[mat] = (mat ? a0 : w0)[h * 64 + csub * 16 + lq]; }
    const int ej = (tid & 15) * 4;
    const f32x4 c_kk = *(const f32x4*)(kkp + h * 64 + ej), c_ka = *(const f32x4*)(kap + h * 64 + ej), c_rk = *(const f32x4*)(rkp + h * 64 + ej);
    const f32x4 mu_r = *(const f32x4*)(mu + h * 64 + ej), mu_k = *(const f32x4*)(mu + 512 + h * 64 + ej), mu_v = *(const f32x4*)(mu + 1024 + h * 64 + ej);
    const f32x4 mu_w = *(const f32x4*)(mu + 2048 + ej), mu_a = *(const f32x4*)(mu + 2112 + ej);
    float s0 = 0.f, s1 = 0.f, s2 = 0.f, s3 = 0.f;
    const int irow = qtr * 16 + (wave & 3) * 4 + g;
    unsigned ptgt = 0u;
    const int pm = tid - 256, e2t = pm >> 4;
    u32x2 cva[2][5], pva[2][5];
    auto rw_load = [&](int ch) {
#pragma unroll
        for (int ps = 0; ps < 2; ++ps) { const int tl = e2t + 16 * ps, t = ch * 32 + tl; const bf16_t* cur = P + (rowbase + t) * LDP + C_RW; const bool hp = t > 0; const bf16_t* prv = hp ? cur - LDP : cur;
#pragma unroll
            for (int i = 0; i < 5; ++i) { const int col = (i == 0 ? h * 64 : i == 1 ? 512 + h * 64 : i == 2 ? 1024 + h * 64 : i == 3 ? 2048 : 2112) + ej;
                cva[ps][i] = *(const u32x2*)(cur + col); pva[ps][i] = *(const u32x2*)(prv + col); } }
    };
    auto prep = [&](int ch, float* SET) {
        float* Rm = SET; float* Km = SET + 2048; float* Vm = SET + 4096; float* DEC = SET + 6144; float* KK = SET + 8192; float* BB = SET + 10240;
#pragma unroll
        for (int ps = 0; ps < 2; ++ps) { const int tl = e2t + 16 * ps, t = ch * 32 + tl; const unsigned pmask = t > 0 ? 0xFFFFFFFFu : 0u;
#pragma unroll
            for (int i = 0; i < 5; ++i) {
                const u32x2 cv = cva[ps][i]; u32x2 pv = pva[ps][i]; pv.x &= pmask; pv.y &= pmask;
                const f32x4 m4 = i == 0 ? mu_r : i == 1 ? mu_k : i == 2 ? mu_v : i == 3 ? mu_w : mu_a;
                float c[4] = {bf_lo(cv.x), bf_hi(cv.x), bf_lo(cv.y), bf_hi(cv.y)}; const float q[4] = {bf_lo(pv.x), bf_hi(pv.x), bf_lo(pv.y), bf_hi(pv.y)};
#pragma unroll
                for (int e = 0; e < 4; ++e) c[e] = c[e] + (q[e] - c[e]) * m4[e];
                if (i == 0) *(f32x4*)(Rm + tl * 64 + ej) = (f32x4){c[0], c[1], c[2], c[3]};
                else if (i == 1) *(f32x4*)(Km + tl * 64 + ej) = (f32x4){c[0], c[1], c[2], c[3]};
                else if (i == 2) *(f32x4*)(Vm + tl * 64 + ej) = (f32x4){c[0], c[1], c[2], c[3]};
                else if (i == 3) { u32x2 o; o.x = cvt_pk_bf16(fast_tanh(c[0]), fast_tanh(c[1])); o.y = cvt_pk_bf16(fast_tanh(c[2]), fast_tanh(c[3])); *(u32x2*)(WLb + tl * 72 + ej) = o; }
                else { u32x2 o; o.x = cvt_pk_bf16(c[0], c[1]); o.y = cvt_pk_bf16(c[2], c[3]); *(u32x2*)(ALb + tl * 72 + ej) = o; } } }
        if (ch + 1 < SEQ / 32) rw_load(ch + 1);
        pbar4(pcnt, ptgt, lane);
#pragma unroll
        for (int mat = 0; mat < 2; ++mat)
#pragma unroll
            for (int ts = 0; ts < 2; ++ts) { const bf16_t* ap = (mat ? ALb : WLb) + (16 * ts + lq) * 72 + 8 * g;
                const bf16x8 a0f = *(const bf16x8*)ap, a1f = *(const bf16x8*)(ap + 32);
                f32x4 c = (f32x4){0.f, 0.f, 0.f, 0.f};
                c = __builtin_amdgcn_mfma_f32_16x16x32_bf16(a0f, bfr[mat][0], c, 0, 0, 0);
                c = __builtin_amdgcn_mfma_f32_16x16x32_bf16(a1f, bfr[mat][1], c, 0, 0, 0);
#pragma unroll
                for (int r = 0; r < 4; ++r) { const int tt = 16 * ts + 4 * g + r; const float x = lw0[mat] + c[r];
                    if (mat == 0) DEC[tt * 64 + csub * 16 + lq] = __expf(-0.60653066f * sigmoidf_(x));
                    else AA[tt * 64 + csub * 16 + lq] = sigmoidf_(x); } }
        pbar4(pcnt, ptgt, lane);
#pragma unroll
        for (int ps = 0; ps < 2; ++ps) { const int tl = e2t + 16 * ps;
            const f32x4 k4 = *(const f32x4*)(Km + tl * 64 + ej), a4 = *(const f32x4*)(AA + tl * 64 + ej), r4 = *(const f32x4*)(Rm + tl * 64 + ej);
            f32x4 kr, kt; float ss = 0.f, bo = 0.f;
#pragma unroll
            for (int e = 0; e < 4; ++e) { kr[e] = k4[e] * c_kk[e]; ss += kr[e] * kr[e]; kt[e] = k4[e] * (1.f + (a4[e] - 1.f) * c_ka[e]); bo += r4[e] * kt[e] * c_rk[e]; }
            ss = allred16(ss); bo = allred16(bo);
            const float inv = __builtin_amdgcn_rsqf(fmaxf(ss, 1e-24f));
            f32x4 kk4, b4;
#pragma unroll
            for (int e = 0; e < 4; ++e) { kk4[e] = kr[e] * inv; b4[e] = kk4[e] * a4[e]; }
            *(f32x4*)(Km + tl * 64 + ej) = kt; *(f32x4*)(KK + tl * 64 + ej) = kk4; *(f32x4*)(BB + tl * 64 + ej) = b4;
            if (qtr == 0 && (tid & 15) == 0) BONUS[(rowbase + ch * 32 + tl) * 8 + h] = bo; }
    };
    auto yraw_store = [&](int ch) {
#pragma unroll
        for (int ps = 0; ps < 2; ++ps) { const int tl = e2t + 16 * ps, il = tid & 15;
            YRAW[(rowbase + ch * 32 + tl) * 512 + h * 64 + qtr * 16 + il] = (bf16_t)(cvt_pk_bf16(Yb[(ch & 1) * 512 + tl * 16 + il], 0.f) & 0xFFFF); }
    };
    if (tid == 0) *pcnt = 0u;
    __syncthreads();
    if (wave >= 4) { rw_load(0); prep(0, SET0); }
    for (int ch = 0; ch < SEQ / 32; ++ch) {
        __syncthreads();
        if (wave < 4) {
            const float* SET = SET0 + (ch & 1) * SETF;
            const float* Rm = SET; const float* Km = SET + 2048; const float* Vm = SET + 4096; const float* DEC = SET + 6144; const float* KK = SET + 8192; const float* BB = SET + 10240;
            float* Yw = Yb + (ch & 1) * 512;
#define RW_LOAD(W, K, KKv, Bv, Rv, V, tt_) do { W = *(const f32x4*)(DEC + (tt_) * 64 + lq * 4); K = *(const f32x4*)(Km + (tt_) * 64 + lq * 4); KKv = *(const f32x4*)(KK + (tt_) * 64 + lq * 4); \
        Bv = *(const f32x4*)(BB + (tt_) * 64 + lq * 4); Rv = *(const f32x4*)(Rm + (tt_) * 64 + lq * 4); V = Vm[(tt_) * 64 + irow]; } while (0)
#define RW_STEP(W, K, KKv, Bv, Rv, V, tt_) do { float sa = s0 * KKv[0] + s1 * KKv[1] + s2 * KKv[2] + s3 * KKv[3]; \
        const float u0 = s0 * W[0] + V * K[0], u1 = s1 * W[1] + V * K[1], u2 = s2 * W[2] + V * K[2], u3 = s3 * W[3] + V * K[3]; \
        sa = -allred16(sa); s0 = u0 + sa * Bv[0]; s1 = u1 + sa * Bv[1]; s2 = u2 + sa * Bv[2]; s3 = u3 + sa * Bv[3]; \
        float y = s0 * Rv[0] + s1 * Rv[1] + s2 * Rv[2] + s3 * Rv[3]; y = allred16(y); if (lq == 0) Yw[(tt_) * 16 + wave * 4 + g] = y; } while (0)
            f32x4 wA, kA, kkA, bA, rA, wB, kB, kkB, bB, rB; float vA, vB;
            RW_LOAD(wA, kA, kkA, bA, rA, vA, 0);
            for (int tt = 0; tt < 32; tt += 2) {
                RW_LOAD(wB, kB, kkB, bB, rB, vB, tt + 1);
                RW_STEP(wA, kA, kkA, bA, rA, vA, tt);
                const int t2 = (tt + 2 < 32) ? tt + 2 : 31;
                RW_LOAD(wA, kA, kkA, bA, rA, vA, t2);
                RW_STEP(wB, kB, kkB, bB, rB, vB, tt + 1);
            }
#undef RW_LOAD
#undef RW_STEP
        } else {
            if (ch > 0) yraw_store(ch - 1);
            if (ch + 1 < SEQ / 32) prep(ch + 1, SET0 + ((ch + 1) & 1) * SETF);
        }
    }
    __syncthreads();
    if (wave >= 4) yraw_store(SEQ / 32 - 1);
    __syncthreads();
}

__device__ __forceinline__ void rw_post(const Params& p, int layer) {
    bf16_t* P = (bf16_t*)(p.ws + OFF_P); const bf16_t* YRAW = (const bf16_t*)(p.ws + OFF_YRAW);
    const float* BONUS = (const float*)(p.ws + OFF_BONUS); const float* SSQ = (const float*)(p.ws + OFF_SSQ); float* RSTD = (float*)(p.ws + OFF_RSTD);
    const float* mu = p.in[9] + layer * 2176; const float* lng = p.in[17] + layer * 512; const float* lnb = p.in[18] + layer * 512;
    const int gt = blockIdx.x * 512 + opaque_tid(), gs = gridDim.x * 512;
    {
        const int c = (gt & 127) * 4, h = c >> 6;
        const f32x4 muv = *(const f32x4*)(mu + 1024 + c), mug = *(const f32x4*)(mu + 1536 + c);
        const f32x4 lg = *(const f32x4*)(lng + c), lb = *(const f32x4*)(lnb + c);
        for (int idx0 = gt; idx0 < TOK * 128; idx0 += 4 * gs) {
            u32x2 yv[4], vc[4], gc[4], vp[4], gp[4]; float bn[4]; unsigned pm[4]; bool ok[4];
#pragma unroll
            for (int u = 0; u < 4; ++u) { const int idx = idx0 + u * gs; ok[u] = idx < TOK * 128; const int tok = ok[u] ? (idx >> 7) : 0;
                const bf16_t* cur = P + (size_t)tok * LDP + C_RW; const bool hp = (tok & (SEQ - 1)) > 0; const bf16_t* prv = hp ? cur - LDP : cur; pm[u] = hp ? 0xFFFFFFFFu : 0u;
                yv[u] = *(const u32x2*)(YRAW + (size_t)tok * 512 + c);
                vc[u] = *(const u32x2*)(cur + 1024 + c); gc[u] = *(const u32x2*)(cur + 1536 + c);
                vp[u] = *(const u32x2*)(prv + 1024 + c); gp[u] = *(const u32x2*)(prv + 1536 + c);
                bn[u] = BONUS[(size_t)tok * 8 + h]; }
#pragma unroll
            for (int u = 0; u < 4; ++u) { const int idx = idx0 + u * gs; const int tok = ok[u] ? (idx >> 7) : 0;
                float y[4] = {bf_lo(yv[u].x), bf_hi(yv[u].x), bf_lo(yv[u].y), bf_hi(yv[u].y)};
                const float mean = allred16(y[0] + y[1] + y[2] + y[3]) * (1.f / 64.f);
                float d[4], vs = 0.f;
#pragma unroll
                for (int e = 0; e < 4; ++e) { d[e] = y[e] - mean; vs += d[e] * d[e]; }
                const float var = allred16(vs) * (1.f / 64.f);
                const float rs = rsqrtf(var + 64e-5f);
                const unsigned m = pm[u];
                const float vcur[4] = {bf_lo(vc[u].x), bf_hi(vc[u].x), bf_lo(vc[u].y), bf_hi(vc[u].y)}, vprv[4] = {bf_lo(vp[u].x & m), bf_hi(vp[u].x & m), bf_lo(vp[u].y & m), bf_hi(vp[u].y & m)};
                const float gcur[4] = {bf_lo(gc[u].x), bf_hi(gc[u].x), bf_lo(gc[u].y), bf_hi(gc[u].y)}, gprv[4] = {bf_lo(gp[u].x & m), bf_hi(gp[u].x & m), bf_lo(gp[u].y & m), bf_hi(gp[u].y & m)};
                float o[4];
#pragma unroll
                for (int e = 0; e < 4; ++e) { const float vm = vcur[e] + (vprv[e] - vcur[e]) * muv[e], gm = gcur[e] + (gprv[e] - gcur[e]) * mug[e];
                    o[e] = (d[e] * rs * lg[e] + lb[e] + bn[u] * vm) * siluf_(gm); }
                u32x2 ov; ov.x = cvt_pk_bf16(o[0], o[1]); ov.y = cvt_pk_bf16(o[2], o[3]);
                if (ok[u]) *(u32x2*)(P + (size_t)tok * LDP + C_YRW + c) = ov; }
        }
    }
    for (int tok = gt; tok < TOK; tok += gs) { const f32x4* q = (const f32x4*)(SSQ + (size_t)tok * 32); float s = 0.f;
#pragma unroll
        for (int i = 0; i < 8; ++i) { const f32x4 v = q[i]; s += v[0] + v[1] + v[2] + v[3]; }
        RSTD[tok] = rsqrtf(s * (1.f / 1024.f) + 1e-6f); }
}

#define XB_TMO      128
#define XB_XCNT(j)  (256  + 64 * (j))
#define XB_XSUB(j)  (1280 + 64 * (j))
#define XB_XGEN(j)  (2304 + 64 * (j))
#define XB_TOP      3328
#define XB_TOPGEN   3392
#define XCD_BAR_WORDS 3456
#define XB_SPIN_CAP (1u << 18)
__device__ __forceinline__ unsigned xb_ld(unsigned* p)              { return __hip_atomic_load(p, __ATOMIC_RELAXED, __HIP_MEMORY_SCOPE_AGENT); }
__device__ __forceinline__ unsigned xb_add(unsigned* p, unsigned v) { return __hip_atomic_fetch_add(p, v, __ATOMIC_RELAXED, __HIP_MEMORY_SCOPE_AGENT); }
__device__ __forceinline__ unsigned xb_xcc_id() { return (unsigned)__builtin_amdgcn_s_getreg((3 << 11) | 20) & 0xFu; }
#define XB_SPIN(cond, bar) do { unsigned _sp = 0; while (cond) { __builtin_amdgcn_s_sleep(1); \
    if ((++_sp & 255u) == 0u) { if (xb_ld(&(bar)[XB_TMO])) break; if (_sp > XB_SPIN_CAP) { atomicAdd(&(bar)[XB_TMO], 1u); break; } } } } while (0)
struct XcdBarrier { unsigned* bar; unsigned x; volatile LAS unsigned* st; };
__device__ __forceinline__ XcdBarrier xcd_barrier_post(unsigned* bar, volatile LAS unsigned* st) {
    XcdBarrier b; b.bar = bar; b.x = xb_xcc_id(); b.st = st;
    if (threadIdx.x == 0) (void)xb_add(&bar[XB_XCNT(b.x)], 1u);
    return b;
}
__device__ __forceinline__ void xcd_barrier_complete(unsigned* bar, unsigned x, unsigned& nloc, unsigned& nx) {
    const unsigned G = gridDim.x * gridDim.y * gridDim.z;
    unsigned sum, cnt, mine, sp = 0u;
    for (;;) {
        sum = 0u; cnt = 0u; mine = 0u;
#pragma unroll
        for (unsigned j = 0; j < 16; ++j) { const unsigned c = xb_ld(&bar[XB_XCNT(j)]); sum += c; cnt += (c > 0u) ? 1u : 0u; mine = (j == x) ? c : mine; }
        if (sum == G) break;
        __builtin_amdgcn_s_sleep(1);
        if ((++sp & 255u) == 0u) { if (xb_ld(&bar[XB_TMO])) break; if (sp > XB_SPIN_CAP) { atomicAdd(&bar[XB_TMO], 1u); break; } }
    }
    nloc = mine > 0u ? mine : 1u; nx = cnt > 0u ? cnt : 1u;
}
__device__ __forceinline__ void xcd_barrier(const XcdBarrier& b) {
    asm volatile("s_waitcnt vmcnt(0)" ::: "memory");
    __syncthreads();
    if (threadIdx.x == 0) {
        unsigned* bar = b.bar;
        __builtin_amdgcn_s_waitcnt(0);
        unsigned nloc = b.st[0], nx = b.st[1];
        if (nloc == 0u) { xcd_barrier_complete(bar, b.x, nloc, nx); b.st[0] = nloc; b.st[1] = nx; }
        const unsigned old = xb_add(&bar[XB_XSUB(b.x)], 1u);
        const unsigned gen = old / nloc;
        if (old + 1u == (gen + 1u) * nloc) {
            __builtin_amdgcn_fence(__ATOMIC_RELEASE, "agent");
            asm volatile("s_waitcnt vmcnt(0)" ::: "memory");
            const unsigned og = xb_add(&bar[XB_TOP], 1u);
            const unsigned tg = og / nx;
            if (og + 1u == (tg + 1u) * nx) xb_add(&bar[XB_TOPGEN], 1u);
            else XB_SPIN(xb_ld(&bar[XB_TOPGEN]) == tg, bar);
            __builtin_amdgcn_fence(__ATOMIC_ACQUIRE, "agent");
            xb_add(&bar[XB_XGEN(b.x)], 1u);
            asm volatile("s_waitcnt vmcnt(0)" ::: "memory");
        } else {
            XB_SPIN(xb_ld(&bar[XB_XGEN(b.x)]) == gen, bar);
            __builtin_amdgcn_fence(__ATOMIC_ACQUIRE, "agent");
            asm volatile("s_waitcnt vmcnt(0)" ::: "memory");
        }
    }
    __syncthreads();
}

#define GSYNC() xcd_barrier(xb)
__global__ void __launch_bounds__(512, 2) mega(Params p) {
    extern __shared__ __attribute__((aligned(16))) unsigned char shm[];
    cg::grid_group grid = cg::this_grid();
    volatile LAS unsigned* xst = (volatile LAS unsigned*)((LAS unsigned char*)shm + LDS_BYTES - 16);
    if (threadIdx.x == 0) { xst[0] = 0u; xst[1] = 0u; }
    __syncthreads();
    const XcdBarrier xb = xcd_barrier_post((unsigned*)(p.ws + OFF_BAR), xst);
    const char* Pc = (const char*)(p.ws + OFF_P); const char* WTc = (const char*)(p.ws + OFF_WT);
    bf16_t* P = (bf16_t*)(p.ws + OFF_P);
    const int G = gridDim.x, c = blockIdx.x;
    for (int layer = 0; layer < 2; ++layer) {
        phase0(p, layer, shm);
        if (layer == 0) grid.sync(); else GSYNC();
        { SchedInproj S{Pc, WTc, G, c}; EpiInproj E{P}; pg8::gemm_phase<true>((LAS unsigned char*)shm, S, E); }
        GSYNC();
        bc_prepass(p, layer);
        GSYNC();
        for (int it = c; it < 256; it += G) rwkv_item(p, layer, shm, it);
        for (int it = c; it < 256; it += G) ssd_item(p, layer, shm, it);
        for (int it = c; it < 1024; it += G) attn_item(p, shm, it);
        GSYNC();
        rw_post(p, layer);
        GSYNC();
        { SchedC1 S{Pc, WTc, G, c}; EpiC1 E{P, (const float*)(p.ws + OFF_RSTD)}; pg8::gemm_phase<true>((LAS unsigned char*)shm, S, E); }
        GSYNC();
        { SchedOut S{Pc, WTc, G, c}; EpiOut E{layer == 0 ? p.in[0] : p.out, p.out}; pg8::gemm_phase<false>((LAS unsigned char*)shm, S, E); }
        GSYNC();
    }
    { const int tid = opaque_tid(), wave = tid >> 6, lane = tid & 63; const float* fg = p.in[23];
        for (int row = blockIdx.x * 8 + wave; row < TOK; row += gridDim.x * 8) { float* xr = p.out + (size_t)row * DM;
            f32x4 v[4]; float ss = 0.f;
#pragma unroll
            for (int i = 0; i < 4; ++i) { v[i] = *(const f32x4*)(xr + i * 256 + lane * 4); ss += v[i][0] * v[i][0] + v[i][1] * v[i][1] + v[i][2] * v[i][2] + v[i][3] * v[i][3]; }
            ss = wave_sum(ss);
            const float rs = rsqrtf(ss * (1.f / DM) + 1e-6f);
#pragma unroll
            for (int i = 0; i < 4; ++i) { const f32x4 g = *(const f32x4*)(fg + i * 256 + lane * 4); *(f32x4*)(xr + i * 256 + lane * 4) = v[i] * rs * g; } } }
}

extern "C" void kernel_launch(void* const* d_in, const int* in_sizes, int n_in, void* d_out, int out_size, void* d_ws, size_t ws_size, hipStream_t stream) {
    static int grid_blocks = 0;
    if (grid_blocks == 0) {
        if (n_in != 24 || out_size != TOK * DM || ws_size < WS_NEED) { fprintf(stderr, "kernel_launch: unexpected shapes (n_in %d out %d ws %zu need %zu)\n", n_in, out_size, ws_size, (size_t)WS_NEED); grid_blocks = -1; return; }
        int dev = 0, cus = 0, per_cu = 0;
        hipGetDevice(&dev);
        hipDeviceGetAttribute(&cus, hipDeviceAttributeMultiprocessorCount, dev);
        hipFuncSetAttribute((const void*)mega, hipFuncAttributeMaxDynamicSharedMemorySize, LDS_BYTES);
        hipOccupancyMaxActiveBlocksPerMultiprocessor(&per_cu, (const void*)mega, 512, LDS_BYTES);
        if (per_cu < 1) { fprintf(stderr, "kernel_launch: occupancy query says %d blocks per CU\n", per_cu); grid_blocks = -1; return; }
        if (per_cu > 1) per_cu = 1;
        grid_blocks = cus * per_cu;
        grid_blocks &= ~7;
    }
    if (grid_blocks < 0) return;
    Params p{};
    for (int i = 0; i < 24; ++i) p.in[i] = (const float*)d_in[i];
    p.out = (float*)d_out; p.ws = (unsigned char*)d_ws;
    (void)hipMemsetAsync((unsigned char*)d_ws + OFF_BAR, 0, SZ_BAR, stream);
    void* args[] = {&p};
    hipError_t e = hipLaunchCooperativeKernel((const void*)mega, dim3(grid_blocks), dim3(512), args, LDS_BYTES, stream);
    if (e != hipSuccess) fprintf(stderr, "cooperative launch failed: %s (grid %d)\n", hipGetErrorString(e), grid_blocks);
}
```

```cpp
#include <hip/hip_runtime.h>
#include <hip/hip_cooperative_groups.h>
#include <cstdio>
namespace cg = cooperative_groups;

#define LAS __attribute__((address_space(3)))
typedef unsigned short bf16_t;
typedef short bf16x8 __attribute__((ext_vector_type(8)));
typedef float f32x4 __attribute__((ext_vector_type(4)));
typedef unsigned u32x4 __attribute__((ext_vector_type(4)));
typedef unsigned u32x2 __attribute__((ext_vector_type(2)));

constexpr int TOK = 16384, SEQ = 2048, DM = 1024, NIN = 9616;
constexpr int LDP = 7680;
constexpr int C_Q = 0, C_K = 512, C_V = 1024, C_SBG = 1536, C_Z = 2048, C_XBC = 3072, C_RW = 4352, C_DT = 6528, C_H = 6656;
constexpr int C_M = 0, C_G = 3072, C_YRW = 4352;
constexpr int R_GATE = 6656, R_SB = 9728, R_SSD = 10752, R_RWO = 11776, R_WO = 12800, WT_ROWS = 13824;
constexpr size_t OFF_P = 0, SZ_P = (size_t)TOK * LDP * 2;
constexpr size_t OFF_WT = OFF_P + SZ_P, SZ_WT = (size_t)WT_ROWS * 1024 * 2;
constexpr size_t OFF_YRAW = OFF_WT + SZ_WT, SZ_YRAW = (size_t)TOK * 512 * 2;
constexpr size_t OFF_SSQ = OFF_YRAW + SZ_YRAW, SZ_SSQ = (size_t)TOK * 32 * 4;
constexpr size_t OFF_RSTD = OFF_SSQ + SZ_SSQ, SZ_RSTD = (size_t)TOK * 4;
constexpr size_t OFF_BONUS = OFF_RSTD + SZ_RSTD, SZ_BONUS = (size_t)TOK * 8 * 4;
constexpr size_t OFF_BAR = OFF_BONUS + SZ_BONUS, SZ_BAR = 16384;
constexpr size_t OFF_BCC = OFF_BAR + SZ_BAR, SZ_BCC = (size_t)TOK * 256 * 2;
constexpr size_t WS_NEED = OFF_BCC + SZ_BCC;
constexpr int LDS_BYTES = 135168;

struct Params { const float* in[24]; float* out; unsigned char* ws; };

typedef float f32x2_t __attribute__((ext_vector_type(2)));
typedef __bf16 bf16x2_t __attribute__((ext_vector_type(2)));
__device__ __forceinline__ unsigned cvt_pk_bf16(float lo, float hi) { const f32x2_t v = {lo, hi}; return __builtin_bit_cast(unsigned, __builtin_convertvector(v, bf16x2_t)); }
__device__ __forceinline__ float bf_lo(unsigned u) { return __uint_as_float(u << 16); }
__device__ __forceinline__ float bf_hi(unsigned u) { return __uint_as_float(u & 0xFFFF0000u); }
__device__ __forceinline__ float bf2f(bf16_t h) { return __uint_as_float(((unsigned)h) << 16); }
__device__ __forceinline__ float sigmoidf_(float x) { return __builtin_amdgcn_rcpf(1.f + __expf(-x)); }
__device__ __forceinline__ float siluf_(float x) { return x * __builtin_amdgcn_rcpf(1.f + __expf(-x)); }
__device__ __forceinline__ float softplusf_(float x) { return fmaxf(x, 0.f) + __logf(1.f + __expf(-fabsf(x))); }
template <int CTRL> __device__ __forceinline__ float dppf(float x) { return __int_as_float(__builtin_amdgcn_update_dpp(0, __float_as_int(x), CTRL, 0xF, 0xF, true)); }
__device__ __forceinline__ float allred16(float x) { x += dppf<0xB1>(x); x += dppf<0x4E>(x); x += dppf<0x141>(x); x += dppf<0x140>(x); return x; }
__device__ __forceinline__ int opaque_tid() { int t; asm volatile("v_mov_b32 %0, %1" : "=v"(t) : "v"((int)threadIdx.x)); return t; }
__device__ __forceinline__ float wave_sum(float v) {
#pragma unroll
    for (int o = 1; o < 64; o <<= 1) v += __shfl_xor(v, o);
    return v;
}

namespace pg8 {
constexpr int BM = 256, BK = 64, HALF = 128, HTB = HALF * BK * 2, NXCD = 8, WGM = 8;
constexpr unsigned LDA_B = LDP * 2, LDB_B = 2048;
__device__ __forceinline__ int lds_byte(int r, int c) { const int st = (r >> 4) * 2 + (c >> 5), rr = r & 15, cc = c & 31, ob = rr * 64 + cc * 2; return st * 1024 + (ob ^ (((ob >> 9) & 1) << 5)); }
__device__ __forceinline__ void stage_rc(int b, int& R, int& C) { const int st = b / 1024, sb = b % 1024, swz = sb ^ (((sb >> 9) & 1) << 5); R = (st >> 1) * 16 + swz / 64; C = (st & 1) * 32 + (swz % 64) / 2; }
__device__ __forceinline__ int perm32(int rho) { const int n = rho >> 4, i = rho & 15; return 8 * (i >> 2) + 4 * n + (i & 3); }
struct UnitD { const char* A; const char* B; int nt, pm, pn, kind; };
__device__ __forceinline__ void tile_of(int L, int nM, int nN, int& pm, int& pn) {
    const int nwg = nM * nN; int wgid = L;
    { const int q = nwg / NXCD, r = nwg % NXCD, xcd = wgid % NXCD, off = wgid / NXCD; wgid = (xcd < r ? xcd * (q + 1) : r * (q + 1) + (xcd - r) * q) + off; }
    const int nig = WGM * nN, gid = wgid / nig, fm = gid * WGM, gsz = (nM - fm) < WGM ? (nM - fm) : WGM;
    pm = fm + ((wgid % nig) % gsz); pn = (wgid % nig) / gsz;
}

template <bool PERM, class Sched, class Epi>
__device__ __forceinline__ void gemm_phase(LAS unsigned char* lds, const Sched& S, const Epi& E) {
    const int tid = opaque_tid(), wid = __builtin_amdgcn_readfirstlane(tid >> 6), lane = tid & 63, wr = wid >> 2, wc = wid & 3, fr = lane & 15, fq = lane >> 4;
    unsigned voffA[2], voffB[2];
#pragma unroll
    for (int i = 0; i < 2; ++i) { int R, C; stage_rc(tid * 16 + i * 8192, R, C); const int Rb = PERM ? ((R & ~31) + perm32(R & 31)) : R;
        voffA[i] = (unsigned)R * LDA_B + (unsigned)C * 2u; voffB[i] = (unsigned)Rb * LDB_B + (unsigned)C * 2u; }
    const size_t kstep = (size_t)(BK * 2);
    const size_t hstepA = (size_t)HALF * LDA_B, hstepB = (size_t)HALF * LDB_B;
    const unsigned ldsw = (unsigned)wid * 1024u;
    const int aoff = lds_byte(wr * 64 + fr, fq * 8), boff = lds_byte(wc * 32 + fr, fq * 8);
#define PG8_SA(b, h) (((b) * 2 + (h)) * HTB)
#define PG8_SB(b, h) ((4 + (b) * 2 + (h)) * HTB)
#define PG8_STAGE(bufoff, gbase, voff) do { _Pragma("unroll") for (int _i = 0; _i < 2; ++_i) \
        __builtin_amdgcn_global_load_lds((const unsigned*)((const char*)(gbase) + (voff)[_i]), (LAS unsigned*)(lds + (bufoff) + ldsw + _i * 8192), 16, 0, 0); } while (0)
#define PG8_LDA(dst, b, h) do { _Pragma("unroll") for (int m = 0; m < 4; ++m) _Pragma("unroll") for (int k = 0; k < 2; ++k) dst[m][k] = *(const LAS bf16x8*)(lds + PG8_SA(b, h) + aoff + m * 2048 + k * 1024); } while (0)
#define PG8_LDB(dst, b, h) do { _Pragma("unroll") for (int n = 0; n < 2; ++n) _Pragma("unroll") for (int k = 0; k < 2; ++k) dst[n][k] = *(const LAS bf16x8*)(lds + PG8_SB(b, h) + boff + n * 2048 + k * 1024); } while (0)
#define PG8_MMA(ai, bj, At, Bt) do { __builtin_amdgcn_s_setprio(1); _Pragma("unroll") for (int m = 0; m < 4; ++m) _Pragma("unroll") for (int n = 0; n < 2; ++n) _Pragma("unroll") for (int k = 0; k < 2; ++k) \
        acc[ai][bj][m][n] = __builtin_amdgcn_mfma_f32_16x16x32_bf16(Bt[n][k], At[m][k], acc[ai][bj][m][n], 0, 0, 0); __builtin_amdgcn_s_setprio(0); } while (0)
#define PG8_WAIT_V(n) asm volatile("s_waitcnt vmcnt(" #n ")" ::: "memory")
#define PG8_WAIT_L(n) asm volatile("s_waitcnt lgkmcnt(" #n ")" ::: "memory")
#define PG8_BAR __builtin_amdgcn_s_barrier()
#define PG8_SCHED __builtin_amdgcn_sched_barrier(0)
    UnitD cur, nxt; int ui = 0;
    if (!S.next(0, cur)) return;
    f32x4 acc[2][2][4][2];
#pragma unroll
    for (int a = 0; a < 2; ++a)
#pragma unroll
        for (int b = 0; b < 2; ++b)
#pragma unroll
            for (int m = 0; m < 4; ++m)
#pragma unroll
                for (int n = 0; n < 2; ++n) acc[a][b][m][n] = (f32x4){0.f, 0.f, 0.f, 0.f};
    bf16x8 At[4][2], B0[2][2], B1[2][2];
    const char* cA = cur.A; const char* cB = cur.B;
    PG8_STAGE(PG8_SB(0, 0), cB, voffB); PG8_STAGE(PG8_SA(0, 0), cA, voffA); PG8_STAGE(PG8_SB(0, 1), cB + hstepB, voffB); PG8_STAGE(PG8_SA(0, 1), cA + hstepA, voffA);
    if (wr == 1) PG8_BAR;
    PG8_WAIT_V(4); PG8_BAR;
    PG8_STAGE(PG8_SB(1, 0), cB + kstep, voffB); PG8_STAGE(PG8_SA(1, 0), cA + kstep, voffA); PG8_STAGE(PG8_SB(1, 1), cB + hstepB + kstep, voffB);
    PG8_WAIT_V(6); PG8_BAR;
    for (;;) {
        const bool has_next = S.next(ui + 1, nxt);
        const char* nA = has_next ? nxt.A : cA; const char* nB = has_next ? nxt.B : cB;
        const int nt = cur.nt;
        for (int t = 0; t < nt; t += 2) {
            const bool last = (t == nt - 2);
            const char* a1 = cA + (size_t)(t + 1) * kstep;
            const char* a2 = last ? nA : cA + (size_t)(t + 2) * kstep; const char* b2 = last ? nB : cB + (size_t)(t + 2) * kstep;
            const char* a3 = a2 + kstep; const char* b3 = b2 + kstep;
            PG8_LDB(B0, 0, 0); PG8_SCHED; PG8_LDA(At, 0, 0); PG8_STAGE(PG8_SA(1, 1), a1 + hstepA, voffA);
            PG8_WAIT_L(8); PG8_BAR; PG8_WAIT_L(0); PG8_MMA(0, 0, At, B0); PG8_BAR; PG8_SCHED;
            PG8_LDB(B1, 0, 1); PG8_STAGE(PG8_SB(0, 0), b2, voffB);
            PG8_BAR; PG8_WAIT_L(0); PG8_MMA(0, 1, At, B1); PG8_BAR;
            PG8_LDA(At, 0, 1); PG8_STAGE(PG8_SA(0, 0), a2, voffA);
            PG8_BAR; PG8_WAIT_L(0); PG8_MMA(1, 0, At, B0); PG8_BAR; PG8_SCHED;
            PG8_STAGE(PG8_SB(0, 1), b2 + hstepB, voffB);
            PG8_WAIT_V(6); PG8_BAR; PG8_MMA(1, 1, At, B1); PG8_BAR;
            PG8_LDB(B0, 1, 0); PG8_SCHED; PG8_LDA(At, 1, 0); PG8_STAGE(PG8_SA(0, 1), a2 + hstepA, voffA);
            PG8_WAIT_L(8); PG8_BAR; PG8_WAIT_L(0); PG8_MMA(0, 0, At, B0); PG8_BAR; PG8_SCHED;
            PG8_LDB(B1, 1, 1); PG8_STAGE(PG8_SB(1, 0), b3, voffB);
            PG8_BAR; PG8_WAIT_L(0); PG8_MMA(0, 1, At, B1); PG8_BAR;
            PG8_LDA(At, 1, 1); PG8_STAGE(PG8_SA(1, 0), a3, voffA);
            PG8_BAR; PG8_WAIT_L(0); PG8_MMA(1, 0, At, B0); PG8_BAR; PG8_SCHED;
            PG8_STAGE(PG8_SB(1, 1), b3 + hstepB, voffB);
            PG8_WAIT_V(6); PG8_BAR; PG8_MMA(1, 1, At, B1); PG8_BAR;
        }
        E(acc, cur, wr, wc, fr, fq);
        if (!has_next) break;
#pragma unroll
        for (int a = 0; a < 2; ++a)
#pragma unroll
            for (int b = 0; b < 2; ++b)
#pragma unroll
                for (int m = 0; m < 4; ++m)
#pragma unroll
                    for (int n = 0; n < 2; ++n) acc[a][b][m][n] = (f32x4){0.f, 0.f, 0.f, 0.f};
        cur = nxt; cA = nA; cB = nB; ++ui;
    }
    PG8_WAIT_V(0);
    if (wr == 0) PG8_BAR;
    PG8_BAR;
#undef PG8_SA
#undef PG8_SB
#undef PG8_STAGE
#undef PG8_LDA
#undef PG8_LDB
#undef PG8_MMA
#undef PG8_WAIT_V
#undef PG8_WAIT_L
#undef PG8_BAR
#undef PG8_SCHED
}
}
using pg8::UnitD;

struct SchedInproj {
    const char* P; const char* WT; int G, c;
    __device__ __forceinline__ bool next(int i, UnitD& u) const {
        const int L = i * G + c; if (L >= 64 * 26) return false;
        int pm, pn; pg8::tile_of(L, 64, 26, pm, pn);
        u.A = P + ((size_t)pm * 256 * LDP + C_H) * 2; u.B = WT + (size_t)pn * 256 * 2048; u.nt = 16; u.pm = pm; u.pn = pn; u.kind = 0; return true;
    }
};
struct EpiInproj {
    bf16_t* P;
    __device__ __forceinline__ void operator()(const f32x4 (&acc)[2][2][4][2], const UnitD& u, int wr, int wc, int fr, int fq) const {
        const int row0 = u.pm * 256 + wr * 64 + fr, col0 = u.pn * 256 + wc * 32 + 8 * fq;
#pragma unroll
        for (int ai = 0; ai < 2; ++ai)
#pragma unroll
            for (int m = 0; m < 4; ++m) { bf16_t* rowp = P + (size_t)(row0 + ai * 128 + m * 16) * LDP + col0;
#pragma unroll
                for (int bj = 0; bj < 2; ++bj) { const f32x4 v0 = acc[ai][bj][m][0], v1 = acc[ai][bj][m][1];
                    u32x4 o; o.x = cvt_pk_bf16(v0[0], v0[1]); o.y = cvt_pk_bf16(v0[2], v0[3]); o.z = cvt_pk_bf16(v1[0], v1[1]); o.w = cvt_pk_bf16(v1[2], v1[3]);
                    *(u32x4*)(rowp + bj * 128) = o; } }
    }
};
struct SchedC1 {
    const char* P; const char* WT; int G, c;
    __device__ __forceinline__ bool next(int i, UnitD& u) const {
        const int ti = i / 6, sub = i - ti * 6, L = ti * G + c; if (L >= 256) return false;
        int pm, pn; pg8::tile_of(L, 64, 4, pm, pn);
        const int br = sub >> 1;
        if (!(sub & 1)) { u.A = P + ((size_t)pm * 256 * LDP + C_H) * 2; u.B = WT + (size_t)(R_GATE + br * 1024 + pn * 256) * 2048; u.nt = 16; }
        else { const int acol = br == 0 ? C_SBG : (br == 1 ? C_Z : C_YRW); const int brow = br == 0 ? R_SB : (br == 1 ? R_SSD : R_RWO);
            u.A = P + ((size_t)pm * 256 * LDP + acol) * 2; u.B = WT + (size_t)(brow + pn * 256) * 2048; u.nt = br == 1 ? 16 : 8; }
        u.pm = pm; u.pn = pn; u.kind = sub; return true;
    }
};
struct EpiC1 {
    bf16_t* P; const float* rstd;
    __device__ __forceinline__ void operator()(const f32x4 (&acc)[2][2][4][2], const UnitD& u, int wr, int wc, int fr, int fq) const {
        const int row0 = u.pm * 256 + wr * 64 + fr, col0 = u.pn * 256 + wc * 32 + 8 * fq;
        const int kind = u.kind;
#pragma unroll
        for (int ai = 0; ai < 2; ++ai)
#pragma unroll
            for (int m = 0; m < 4; ++m) { const int row = row0 + ai * 128 + m * 16; bf16_t* rowp = P + (size_t)row * LDP + col0;
                const float sc = (kind == 3) ? rstd[row] : 1.f;
#pragma unroll
                for (int bj = 0; bj < 2; ++bj) { const f32x4 v0 = acc[ai][bj][m][0], v1 = acc[ai][bj][m][1];
                    float v[8] = {v0[0], v0[1], v0[2], v0[3], v1[0], v1[1], v1[2], v1[3]};
                    u32x4* gp = (u32x4*)(rowp + C_G + bj * 128); u32x4* mp = (u32x4*)(rowp + C_M + bj * 128);
                    if (!(kind & 1)) {
#pragma unroll
                        for (int e = 0; e < 8; ++e) v[e] = sigmoidf_(v[e]);
                        u32x4 o; o.x = cvt_pk_bf16(v[0], v[1]); o.y = cvt_pk_bf16(v[2], v[3]); o.z = cvt_pk_bf16(v[4], v[5]); o.w = cvt_pk_bf16(v[6], v[7]);
                        *gp = o;
                    } else {
                        const u32x4 g = *gp;
                        float r[8];
                        r[0] = bf_lo(g.x) * v[0] * sc; r[1] = bf_hi(g.x) * v[1] * sc; r[2] = bf_lo(g.y) * v[2] * sc; r[3] = bf_hi(g.y) * v[3] * sc;
                        r[4] = bf_lo(g.z) * v[4] * sc; r[5] = bf_hi(g.z) * v[5] * sc; r[6] = bf_lo(g.w) * v[6] * sc; r[7] = bf_hi(g.w) * v[7] * sc;
                        if (kind != 1) { const u32x4 mo = *mp;
                            r[0] += bf_lo(mo.x); r[1] += bf_hi(mo.x); r[2] += bf_lo(mo.y); r[3] += bf_hi(mo.y); r[4] += bf_lo(mo.z); r[5] += bf_hi(mo.z); r[6] += bf_lo(mo.w); r[7] += bf_hi(mo.w); }
                        u32x4 o; o.x = cvt_pk_bf16(r[0], r[1]); o.y = cvt_pk_bf16(r[2], r[3]); o.z = cvt_pk_bf16(r[4], r[5]); o.w = cvt_pk_bf16(r[6], r[7]);
                        *mp = o;
                    } } }
    }
};
struct SchedOut {
    const char* P; const char* WT; int G, c;
    __device__ __forceinline__ bool next(int i, UnitD& u) const {
        const int L = i * G + c; if (L >= 256) return false;
        int pm, pn; pg8::tile_of(L, 64, 4, pm, pn);
        u.A = P + ((size_t)pm * 256 * LDP + C_M) * 2; u.B = WT + (size_t)(R_WO + pn * 256) * 2048; u.nt = 16; u.pm = pm; u.pn = pn; u.kind = 0; return true;
    }
};
struct EpiOut {
    const float* Xin; float* Xout;
    __device__ __forceinline__ void operator()(const f32x4 (&acc)[2][2][4][2], const UnitD& u, int wr, int wc, int fr, int fq) const {
        const int row0 = u.pm * 256 + wr * 64 + fr, col0 = u.pn * 256 + wc * 32 + 4 * fq;
#pragma unroll
        for (int ai = 0; ai < 2; ++ai)
#pragma unroll
            for (int m = 0; m < 4; ++m) { const size_t ro = (size_t)(row0 + ai * 128 + m * 16) * DM + col0;
#pragma unroll
                for (int bj = 0; bj < 2; ++bj)
#pragma unroll
                    for (int n = 0; n < 2; ++n) { const f32x4 xi = *(const f32x4*)(Xin + ro + bj * 128 + n * 16); *(f32x4*)(Xout + ro + bj * 128 + n * 16) = xi + acc[ai][bj][m][n]; } }
    }
};

__device__ __forceinline__ void phase0(const Params& p, int layer, unsigned char* shm) {
    const int tid = opaque_tid(), wave = tid >> 6, lane = tid & 63;
    bf16_t* P = (bf16_t*)(p.ws + OFF_P); bf16_t* WT = (bf16_t*)(p.ws + OFF_WT);
    const float* Xin = layer == 0 ? p.in[0] : p.out;
    const float* ng = p.in[1] + layer * DM;
    f32x4 gn[4];
#pragma unroll
    for (int i = 0; i < 4; ++i) gn[i] = *(const f32x4*)(ng + i * 256 + lane * 4);
    for (int row0 = (blockIdx.x * 8 + wave) * 4; row0 < TOK; row0 += gridDim.x * 32) {
        f32x4 v[4][4]; float ss[4];
#pragma unroll
        for (int rr = 0; rr < 4; ++rr) { const float* xr = Xin + (size_t)(row0 + rr) * DM;
#pragma unroll
            for (int i = 0; i < 4; ++i) v[rr][i] = *(const f32x4*)(xr + i * 256 + lane * 4); }
#pragma unroll
        for (int rr = 0; rr < 4; ++rr) { float a = 0.f;
#pragma unroll
            for (int i = 0; i < 4; ++i) a += v[rr][i][0] * v[rr][i][0] + v[rr][i][1] * v[rr][i][1] + v[rr][i][2] * v[rr][i][2] + v[rr][i][3] * v[rr][i][3];
            ss[rr] = wave_sum(a); }
#pragma unroll
        for (int rr = 0; rr < 4; ++rr) { const float rs = rsqrtf(ss[rr] * (1.f / DM) + 1e-6f);
#pragma unroll
            for (int i = 0; i < 4; ++i) { const f32x4 g = gn[i];
                u32x2 o; o.x = cvt_pk_bf16(v[rr][i][0] * rs * g[0], v[rr][i][1] * rs * g[1]); o.y = cvt_pk_bf16(v[rr][i][2] * rs * g[2], v[rr][i][3] * rs * g[3]);
                *(u32x2*)(P + (size_t)(row0 + rr) * LDP + C_H + i * 256 + lane * 4) = o; } }
    }
    float* T = (float*)shm + wave * (64 * 65);
    const float* w_in = p.in[2] + (size_t)layer * DM * NIN;
    const float* sg = p.in[8] + layer * DM;
    for (int job = blockIdx.x * 8 + wave; job < 3200; job += gridDim.x * 8) {
        const float* src; int srcN, k0, n0, dstrow; bool is_in = false, is_ssd = false;
        if (job < 2432) { is_in = true; src = w_in; srcN = NIN; const int ntile = job >> 4; k0 = (job & 15) * 64; n0 = ntile * 64; dstrow = n0; }
        else { int r = job - 2432;
            if (r < 128) { src = p.in[19] + (size_t)layer * 512 * DM; k0 = (r >> 4) * 64; n0 = (r & 15) * 64; dstrow = R_SB + n0; }
            else if (r < 384) { r -= 128; src = p.in[20] + (size_t)layer * DM * DM; k0 = (r >> 4) * 64; n0 = (r & 15) * 64; dstrow = R_SSD + n0; is_ssd = true; }
            else if (r < 512) { r -= 384; src = p.in[21] + (size_t)layer * 512 * DM; k0 = (r >> 4) * 64; n0 = (r & 15) * 64; dstrow = R_RWO + n0; }
            else { r -= 512; src = p.in[22] + (size_t)layer * DM * DM; k0 = (r >> 4) * 64; n0 = (r & 15) * 64; dstrow = R_WO + n0; }
            srcN = DM; }
        const int n4 = (lane & 15) * 4, np = n0 + n4; int sc = np;
        if (is_in) { if (np < 4352) sc = np; else if (np < 6528) sc = np + 16; else if (np < 6544) sc = np - 6528 + 4352; else if (np < 6656) sc = -1; else sc = np - 112; }
        f32x4 v[16];
#pragma unroll
        for (int i = 0; i < 16; ++i) { const int k = (lane >> 4) + 4 * i; v[i] = (f32x4){0.f, 0.f, 0.f, 0.f};
            if (sc >= 0) v[i] = *(const f32x4*)(src + (size_t)(k0 + k) * srcN + sc); }
#pragma unroll
        for (int i = 0; i < 16; ++i) { const int k = (lane >> 4) + 4 * i; f32x4 x = v[i];
            if (is_ssd) x = x * sg[k0 + k];
            T[k * 65 + n4] = x[0]; T[k * 65 + n4 + 1] = x[1]; T[k * 65 + n4 + 2] = x[2]; T[k * 65 + n4 + 3] = x[3]; }
        asm volatile("s_waitcnt lgkmcnt(0)" ::: "memory"); __builtin_amdgcn_wave_barrier(); asm volatile("" ::: "memory");
#pragma unroll
        for (int j = 0; j < 8; ++j) { const int r = lane + 64 * j, n = r >> 3, kc = (r & 7) * 8; const float* sp = T + kc * 65 + n;
            u32x4 o; o.x = cvt_pk_bf16(sp[0], sp[65]); o.y = cvt_pk_bf16(sp[130], sp[195]); o.z = cvt_pk_bf16(sp[260], sp[325]); o.w = cvt_pk_bf16(sp[390], sp[455]);
            *(u32x4*)(WT + (size_t)(dstrow + n) * 1024 + k0 + kc) = o; }
        asm volatile("s_waitcnt lgkmcnt(0)" ::: "memory"); __builtin_amdgcn_wave_barrier(); asm volatile("" ::: "memory");
    }
    __syncthreads();
}

__device__ __forceinline__ void attn_item(const Params& p, unsigned char* shm, int item) {
    const int qb = item & 15, h = (item >> 4) & 7, b = item >> 7;
    bf16_t* P = (bf16_t*)(p.ws + OFF_P);
    const int tid = opaque_tid(), wave = tid >> 6, lane = tid & 63, lq = lane & 15, g = lane >> 4;
    const size_t rowbase = (size_t)b * SEQ;
    const int t = qb * 128 + wave * 16 + lq;
    const int tmax = qb * 128 + wave * 16 + 15;
    constexpr int ABUF = 64 * 144 + 64 * 136;
    const bf16_t* qp = P + (rowbase + t) * LDP + C_Q + h * 64 + 8 * g;
    const bf16x8 qf0 = *(const bf16x8*)qp, qf1 = *(const bf16x8*)(qp + 32);
    bf16x8 TT[4][2];
#pragma unroll
    for (int a = 0; a < 4; ++a)
#pragma unroll
        for (int ks = 0; ks < 2; ++ks)
#pragma unroll
            for (int e = 0; e < 8; ++e) { const int j = 16 * (2 * ks + (e >> 2)) + 4 * g + (e & 3); TT[a][ks][e] = (j > 16 * a + lq) ? (short)0x3F80 : (short)0; }
    f32x4 o[4];
#pragma unroll
    for (int i = 0; i < 4; ++i) o[i] = (f32x4){0.f, 0.f, 0.f, 0.f};
    float R = 0.f;
    LAS volatile int* flg = (LAS volatile int*)((LAS unsigned char*)shm + 2 * ABUF);
    const int st_s = tid >> 3, st_dc = (tid & 7) * 8;
    const bf16_t* st_base = P + (rowbase + st_s) * LDP + h * 64 + st_dc;
    auto stage_write = [&](unsigned char* buf, const u32x4& kv, const u32x4& vv) {
        bf16_t* Ksw = (bf16_t*)buf; bf16_t* Vtw = (bf16_t*)(buf + 64 * 144); const int s_ = st_s, dc = st_dc;
        *(u32x4*)(Ksw + s_ * 72 + dc) = kv;
        Vtw[(dc + 0) * 68 + s_] = (bf16_t)(vv.x & 0xFFFF); Vtw[(dc + 1) * 68 + s_] = (bf16_t)(vv.x >> 16);
        Vtw[(dc + 2) * 68 + s_] = (bf16_t)(vv.y & 0xFFFF); Vtw[(dc + 3) * 68 + s_] = (bf16_t)(vv.y >> 16);
        Vtw[(dc + 4) * 68 + s_] = (bf16_t)(vv.z & 0xFFFF); Vtw[(dc + 5) * 68 + s_] = (bf16_t)(vv.z >> 16);
        Vtw[(dc + 6) * 68 + s_] = (bf16_t)(vv.w & 0xFFFF); Vtw[(dc + 7) * 68 + s_] = (bf16_t)(vv.w >> 16);
    };
    if (tid == 0) { flg[0] = 1; flg[1] = 0; flg[2] = 0; }
    { const bf16_t* kr = st_base + (size_t)(2 * qb + 1) * 64 * LDP; const u32x4 kv0 = *(const u32x4*)(kr + C_K), vv0 = *(const u32x4*)(kr + C_V); stage_write(shm, kv0, vv0); }
    int itn = 0, cur = 0;
    for (int kt = 2 * qb + 1; kt >= 0; --kt) {
        __syncthreads();
        const int f0 = itn % 3, f1 = (itn + 1) % 3, f2 = (itn + 2) % 3;
        if (flg[f0] == 0) break;
        if (tid == 0) flg[f2] = 0;
        u32x4 kvn = (u32x4){0u, 0u, 0u, 0u}, vvn = (u32x4){0u, 0u, 0u, 0u};
        if (kt > 0) { const bf16_t* kr = st_base + (size_t)(kt - 1) * 64 * LDP; kvn = *(const u32x4*)(kr + C_K); vvn = *(const u32x4*)(kr + C_V); }
        const bf16_t* Ks = (const bf16_t*)(shm + cur * ABUF); const bf16_t* Vt = (const bf16_t*)(shm + cur * ABUF + 64 * 144);
        const bool walive = __any(R > -104.f);
        const bool act = (kt * 64 < tmax) && walive;
        if (act) {
            float lb[4][4], lk[4][4];
#pragma unroll
            for (int sub = 0; sub < 4; ++sub) {
                const bf16_t* kp = Ks + (16 * sub + lq) * 72 + 8 * g;
                const bf16x8 k0 = *(const bf16x8*)kp, k1 = *(const bf16x8*)(kp + 32);
                f32x4 s4 = (f32x4){0.f, 0.f, 0.f, 0.f};
                s4 = __builtin_amdgcn_mfma_f32_16x16x32_bf16(k0, qf0, s4, 0, 0, 0);
                s4 = __builtin_amdgcn_mfma_f32_16x16x32_bf16(k1, qf1, s4, 0, 0, 0);
#pragma unroll
                for (int r = 0; r < 4; ++r) { const float z = s4[r] * 0.125f; const bool mk = (kt * 64 + 16 * sub + 4 * g + r) < t;
                    const float l = fminf(z, 0.f) - __logf(1.f + __expf(-fabsf(z)));
                    lb[sub][r] = mk ? l : -1e30f; lk[sub][r] = mk ? (l - z) : 0.f; }
            }
            bf16x8 hi[2], lo[2];
#pragma unroll
            for (int ks = 0; ks < 2; ++ks) {
                unsigned hw[4], lw[4];
#pragma unroll
                for (int w2 = 0; w2 < 4; ++w2) { const int sub = 2 * ks + (w2 >> 1), r0 = (w2 & 1) * 2; const float a0 = lk[sub][r0], a1 = lk[sub][r0 + 1];
                    hw[w2] = cvt_pk_bf16(a0, a1); lw[w2] = cvt_pk_bf16(a0 - bf_lo(hw[w2]), a1 - bf_hi(hw[w2])); }
                u32x4 hv = (u32x4){hw[0], hw[1], hw[2], hw[3]}, lv = (u32x4){lw[0], lw[1], lw[2], lw[3]};
                hi[ks] = __builtin_bit_cast(bf16x8, hv); lo[ks] = __builtin_bit_cast(bf16x8, lv);
            }
            f32x4 aft[4];
#pragma unroll
            for (int a = 0; a < 4; ++a) { f32x4 c = (f32x4){0.f, 0.f, 0.f, 0.f};
#pragma unroll
                for (int ks = 0; ks < 2; ++ks) { c = __builtin_amdgcn_mfma_f32_16x16x32_bf16(TT[a][ks], hi[ks], c, 0, 0, 0); c = __builtin_amdgcn_mfma_f32_16x16x32_bf16(TT[a][ks], lo[ks], c, 0, 0, 0); }
                aft[a] = c; }
            float tot = aft[0][0] + lk[0][0];
            tot = __shfl(tot, lq);
            bf16x8 pf[2];
#pragma unroll
            for (int ks = 0; ks < 2; ++ks) { unsigned pw[4];
#pragma unroll
                for (int w2 = 0; w2 < 4; ++w2) { const int sub = 2 * ks + (w2 >> 1), r0 = (w2 & 1) * 2;
                    const float e0 = __expf(lb[sub][r0] + aft[sub][r0] + R), e1 = __expf(lb[sub][r0 + 1] + aft[sub][r0 + 1] + R);
                    pw[w2] = cvt_pk_bf16(e0, e1); }
                u32x4 pv = (u32x4){pw[0], pw[1], pw[2], pw[3]}; pf[ks] = __builtin_bit_cast(bf16x8, pv); }
            R += tot;
#pragma unroll
            for (int ds = 0; ds < 4; ++ds)
#pragma unroll
                for (int ks = 0; ks < 2; ++ks) { const bf16_t* vp = Vt + (16 * ds + lq) * 68 + 32 * ks + 4 * g;
                    const u32x2 v0 = *(const u32x2*)vp, v1 = *(const u32x2*)(vp + 16);
                    u32x4 vv = (u32x4){v0.x, v0.y, v1.x, v1.y};
                    o[ds] = __builtin_amdgcn_mfma_f32_16x16x32_bf16(__builtin_bit_cast(bf16x8, vv), pf[ks], o[ds], 0, 0, 0); }
        }
        if (__any(R > -104.f) && lane == 0) flg[f1] = 1;
        if (kt > 0) stage_write(shm + (cur ^ 1) * ABUF, kvn, vvn);
        cur ^= 1; ++itn;
    }
#pragma unroll
    for (int ds = 0; ds < 4; ++ds) { bf16_t* gp = P + (rowbase + t) * LDP + C_SBG + h * 64 + 16 * ds + 4 * g;
        const u32x2 gv = *(const u32x2*)gp;
        u32x2 ov; ov.x = cvt_pk_bf16(o[ds][0] * siluf_(bf_lo(gv.x)), o[ds][1] * siluf_(bf_hi(gv.x))); ov.y = cvt_pk_bf16(o[ds][2] * siluf_(bf_lo(gv.y)), o[ds][3] * siluf_(bf_hi(gv.y)));
        *(u32x2*)gp = ov; }
    __syncthreads();
}

__device__ __forceinline__ void bc_prepass(const Params& p, int layer) {
    const bf16_t* P = (const bf16_t*)(p.ws + OFF_P); bf16_t* BCc = (bf16_t*)(p.ws + OFF_BCC);
    const float* cw = p.in[3] + (size_t)layer * 4 * 1280; const float* cb = p.in[4] + layer * 1280;
    const int gt = blockIdx.x * 512 + opaque_tid(), gs = gridDim.x * 512;
    const int c = (gt & 63) * 4, chn = 1024 + c;
    const f32x4 bias = *(const f32x4*)(cb + chn);
    f32x4 w[4];
#pragma unroll
    for (int k = 0; k < 4; ++k) w[k] = *(const f32x4*)(cw + k * 1280 + chn);
    for (int idx0 = gt; idx0 < TOK * 64; idx0 += 4 * gs) {
        u32x2 xv[4][4]; bool ok[4];
#pragma unroll
        for (int u = 0; u < 4; ++u) { const int idx = idx0 + u * gs; ok[u] = idx < TOK * 64; const int tok = ok[u] ? (idx >> 6) : 0; const int t = tok & (SEQ - 1);
            const bf16_t* xp = P + (size_t)tok * LDP + C_XBC + chn;
#pragma unroll
            for (int k = 0; k < 4; ++k) { const int ts = t - 3 + k; const unsigned xm = ts >= 0 ? 0xFFFFFFFFu : 0u;
                u32x2 x = *(const u32x2*)(xp + (ptrdiff_t)(ts >= 0 ? k - 3 : 0) * LDP); x.x &= xm; x.y &= xm; xv[u][k] = x; } }
#pragma unroll
        for (int u = 0; u < 4; ++u) { const int idx = idx0 + u * gs; const int tok = ok[u] ? (idx >> 6) : 0;
            f32x4 a = bias;
#pragma unroll
            for (int k = 0; k < 4; ++k) { a[0] += w[k][0] * bf_lo(xv[u][k].x); a[1] += w[k][1] * bf_hi(xv[u][k].x); a[2] += w[k][2] * bf_lo(xv[u][k].y); a[3] += w[k][3] * bf_hi(xv[u][k].y); }
            u32x2 o; o.x = cvt_pk_bf16(siluf_(a[0]), siluf_(a[1])); o.y = cvt_pk_bf16(siluf_(a[2]), siluf_(a[3]));
            if (ok[u]) *(u32x2*)(BCc + (size_t)tok * 256 + c) = o; }
    }
}

__device__ __forceinline__ void ssd_item(const Params& p, int layer, unsigned char* shm, int item) {
    const int ph = item & 1, hh = (item >> 1) & 15, b = item >> 5, grp = hh >> 3;
    bf16_t* P = (bf16_t*)(p.ws + OFF_P); float* SSQ = (float*)(p.ws + OFF_SSQ);
    const int tid = opaque_tid(), wave = tid >> 6, lane = tid & 63, lq = lane & 15, g = lane >> 4;
    const size_t rowbase = (size_t)b * SEQ;
    const float* cw = p.in[3] + (size_t)layer * 4 * 1280; const float* cb = p.in[4] + layer * 1280;
    const float dtb = p.in[5][layer * 16 + hh], Aneg = -__expf(p.in[6][layer * 16 + hh]), Dsk = p.in[7][layer * 16 + hh];
    float* XS = (float*)shm;
    float* YS = XS + 2048;
    float* DTs = YS + 2048;
    float* ACS = DTs + 64;
    bf16_t* Cb = (bf16_t*)(ACS + 64);
    bf16_t* Bb = Cb + 64 * 72;
    bf16_t* BT = Bb + 64 * 72;
    bf16_t* Mx = BT + 64 * 72;
    bf16_t* XT = Mx + 64 * 72;
    bf16_t* XwT = XT + 32 * 72;
    bf16_t* SbT = XwT + 32 * 72;
    f32x4 Sacc = (f32x4){0.f, 0.f, 0.f, 0.f};
    const bf16_t* BCc = (const bf16_t*)(p.ws + OFF_BCC);
    const int x_tt = tid >> 3, x_c = (tid & 7) * 4, x_chn = hh * 64 + ph * 32 + x_c;
    const int bc_q = tid & 7;
    const f32x4 xbias = *(const f32x4*)(cb + x_chn);
    f32x4 xw[4];
#pragma unroll
    for (int k = 0; k < 4; ++k) xw[k] = *(const f32x4*)(cw + k * 1280 + x_chn);
    u32x2 sx[4]; u32x4 bc0, bc1; bf16_t sdt = 0;
    auto ssd_load = [&](int tb) {
        const int t = tb + x_tt;
        const bf16_t* xp = P + (rowbase + t) * LDP + C_XBC + x_chn;
#pragma unroll
        for (int k = 0; k < 4; ++k) { const int ts = t - 3 + k; const unsigned xm = ts >= 0 ? 0xFFFFFFFFu : 0u;
            u32x2 xv = *(const u32x2*)(xp + (ptrdiff_t)(ts >= 0 ? k - 3 : 0) * LDP); xv.x &= xm; xv.y &= xm; sx[k] = xv; }
        const bf16_t* bp = BCc + (rowbase + t) * 256 + (bc_q < 4 ? grp * 64 + bc_q * 16 : 128 + grp * 64 + (bc_q - 4) * 16);
        bc0 = *(const u32x4*)bp; bc1 = *(const u32x4*)(bp + 8);
        if (tid < 64) sdt = P[(rowbase + tb + tid) * LDP + C_DT + hh];
    };
    ssd_load(0);
    for (int ch = 0; ch < SEQ / 64; ++ch) {
        const int t0 = ch * 64;
        __syncthreads();
        const int o_tt = tid >> 3, o_p4 = (tid & 7) * 4;
        bf16_t* zp = P + (rowbase + t0 + o_tt) * LDP + C_Z + hh * 64 + ph * 32 + o_p4;
        const u32x2 zv = *(const u32x2*)zp;
        { f32x4 a = xbias;
#pragma unroll
            for (int k = 0; k < 4; ++k) { a[0] += xw[k][0] * bf_lo(sx[k].x); a[1] += xw[k][1] * bf_hi(sx[k].x); a[2] += xw[k][2] * bf_lo(sx[k].y); a[3] += xw[k][3] * bf_hi(sx[k].y); }
            a[0] = siluf_(a[0]); a[1] = siluf_(a[1]); a[2] = siluf_(a[2]); a[3] = siluf_(a[3]);
            const unsigned q0 = cvt_pk_bf16(a[0], a[1]), q1 = cvt_pk_bf16(a[2], a[3]); const int tt = x_tt, c = x_c;
            *(f32x4*)(XS + tt * 32 + c) = a;
            XT[(c + 0) * 72 + tt] = (bf16_t)(q0 & 0xFFFF); XT[(c + 1) * 72 + tt] = (bf16_t)(q0 >> 16); XT[(c + 2) * 72 + tt] = (bf16_t)(q1 & 0xFFFF); XT[(c + 3) * 72 + tt] = (bf16_t)(q1 >> 16);
            if (bc_q < 4) { const int n = bc_q * 16; *(u32x4*)(Bb + tt * 72 + n) = bc0; *(u32x4*)(Bb + tt * 72 + n + 8) = bc1;
                const unsigned wv[8] = {bc0.x, bc0.y, bc0.z, bc0.w, bc1.x, bc1.y, bc1.z, bc1.w};
#pragma unroll
                for (int e = 0; e < 8; ++e) { BT[(n + 2 * e) * 72 + tt] = (bf16_t)(wv[e] & 0xFFFF); BT[(n + 2 * e + 1) * 72 + tt] = (bf16_t)(wv[e] >> 16); } }
            else { const int n = (bc_q - 4) * 16; *(u32x4*)(Cb + tt * 72 + n) = bc0; *(u32x4*)(Cb + tt * 72 + n + 8) = bc1; } }
        if (tid < 64) { const float dt = softplusf_(bf2f(sdt) + dtb); DTs[tid] = dt;
            float x = dt * Aneg;
#pragma unroll
            for (int o = 1; o < 64; o <<= 1) { const float v = __shfl_up(x, o); if (lane >= o) x += v; }
            ACS[tid] = x; }
        if (ch + 1 < SEQ / 64) ssd_load(t0 + 64);
        __syncthreads();
        const float acsL = ACS[63];
        { const int pp = tid >> 4, s4 = (tid & 15) * 4; float v[4];
#pragma unroll
            for (int e = 0; e < 4; ++e) { const int sidx = s4 + e; v[e] = XS[sidx * 32 + pp] * DTs[sidx] * __expf(acsL - ACS[sidx]); }
            *(u32x2*)(XwT + pp * 72 + s4) = (u32x2){cvt_pk_bf16(v[0], v[1]), cvt_pk_bf16(v[2], v[3])}; }
        { const int pi = wave >> 2, ni = wave & 3;
#pragma unroll
            for (int r = 0; r < 4; ++r) SbT[(16 * pi + 4 * g + r) * 72 + 16 * ni + lq] = (bf16_t)(cvt_pk_bf16(Sacc[r], 0.f) & 0xFFFF); }
        { const int ti = wave >> 1;
#pragma unroll
            for (int sj = 0; sj < 2; ++sj) { const int si = 2 * (wave & 1) + sj;
                f32x4 acc = (f32x4){0.f, 0.f, 0.f, 0.f};
                if (si <= ti) {
                    const bf16_t* ap = Cb + (16 * ti + lq) * 72 + 8 * g; const bf16_t* bp = Bb + (16 * si + lq) * 72 + 8 * g;
                    acc = __builtin_amdgcn_mfma_f32_16x16x32_bf16(*(const bf16x8*)ap, *(const bf16x8*)bp, acc, 0, 0, 0);
                    acc = __builtin_amdgcn_mfma_f32_16x16x32_bf16(*(const bf16x8*)(ap + 32), *(const bf16x8*)(bp + 32), acc, 0, 0, 0);
                }
                const int sidx = 16 * si + lq; const float as = ACS[sidx], ds = DTs[sidx];
#pragma unroll
                for (int r = 0; r < 4; ++r) { const int t = 16 * ti + 4 * g + r; const float val = (sidx <= t) ? acc[r] * __expf(ACS[t] - as) * ds : 0.f;
                    Mx[t * 72 + sidx] = (bf16_t)(cvt_pk_bf16(val, 0.f) & 0xFFFF); } } }
        __syncthreads();
        { const int ti = wave >> 1, pi = wave & 1;
            const bf16_t* ap = Mx + (16 * ti + lq) * 72 + 8 * g; const bf16_t* bp = XT + (16 * pi + lq) * 72 + 8 * g;
            const bf16_t* cp = Cb + (16 * ti + lq) * 72 + 8 * g; const bf16_t* sp = SbT + (16 * pi + lq) * 72 + 8 * g;
            f32x4 a1 = (f32x4){0.f, 0.f, 0.f, 0.f}, a2 = (f32x4){0.f, 0.f, 0.f, 0.f};
            a1 = __builtin_amdgcn_mfma_f32_16x16x32_bf16(*(const bf16x8*)ap, *(const bf16x8*)bp, a1, 0, 0, 0);
            a1 = __builtin_amdgcn_mfma_f32_16x16x32_bf16(*(const bf16x8*)(ap + 32), *(const bf16x8*)(bp + 32), a1, 0, 0, 0);
            a2 = __builtin_amdgcn_mfma_f32_16x16x32_bf16(*(const bf16x8*)cp, *(const bf16x8*)sp, a2, 0, 0, 0);
            a2 = __builtin_amdgcn_mfma_f32_16x16x32_bf16(*(const bf16x8*)(cp + 32), *(const bf16x8*)(sp + 32), a2, 0, 0, 0);
#pragma unroll
            for (int r = 0; r < 4; ++r) { const int t = 16 * ti + 4 * g + r, pc = 16 * pi + lq;
                YS[t * 32 + pc] = a1[r] + __expf(ACS[t]) * a2[r] + Dsk * XS[t * 32 + pc]; } }
        { const int pi = wave >> 2, ni = wave & 3; const float dl = __expf(acsL);
            Sacc = Sacc * dl;
            const bf16_t* ap = XwT + (16 * pi + lq) * 72 + 8 * g; const bf16_t* bp = BT + (16 * ni + lq) * 72 + 8 * g;
            Sacc = __builtin_amdgcn_mfma_f32_16x16x32_bf16(*(const bf16x8*)ap, *(const bf16x8*)bp, Sacc, 0, 0, 0);
            Sacc = __builtin_amdgcn_mfma_f32_16x16x32_bf16(*(const bf16x8*)(ap + 32), *(const bf16x8*)(bp + 32), Sacc, 0, 0, 0); }
        __syncthreads();
        { const int tt = o_tt, p4 = o_p4; const f32x4 y4 = *(const f32x4*)(YS + tt * 32 + p4);
            const float u0 = y4[0] * siluf_(bf_lo(zv.x)), u1 = y4[1] * siluf_(bf_hi(zv.x)), u2 = y4[2] * siluf_(bf_lo(zv.y)), u3 = y4[3] * siluf_(bf_hi(zv.y));
            u32x2 ov; ov.x = cvt_pk_bf16(u0, u1); ov.y = cvt_pk_bf16(u2, u3); *(u32x2*)zp = ov;
            float q = u0 * u0 + u1 * u1 + u2 * u2 + u3 * u3;
            q += __shfl_xor(q, 1); q += __shfl_xor(q, 2); q += __shfl_xor(q, 4);
            if ((tid & 7) == 0) SSQ[(rowbase + t0 + tt) * 32 + hh * 2 + ph] = q; }
    }
    __syncthreads();
}

__device__ __forceinline__ float fast_tanh(float x) { return 1.f - 2.f * __builtin_amdgcn_rcpf(1.f + __expf(2.f * x)); }
__device__ __forceinline__ void pbar4(LAS volatile unsigned* cnt, unsigned& tgt, int lane) {
    tgt += 4u;
    asm volatile("s_waitcnt lgkmcnt(0)" ::: "memory");
    if (lane == 0) __hip_atomic_fetch_add((LAS unsigned*)cnt, 1u, __ATOMIC_RELAXED, __HIP_MEMORY_SCOPE_WORKGROUP);
    while (*cnt < tgt) __builtin_amdgcn_s_sleep(1);
    asm volatile("" ::: "memory");
}
__device__ __forceinline__ void rwkv_item(const Params& p, int layer, unsigned char* shm, int item) {
    const int half = item & 1, h = (item >> 1) & 7, b = item >> 4;
    bf16_t* P = (bf16_t*)(p.ws + OFF_P); bf16_t* YRAW = (bf16_t*)(p.ws + OFF_YRAW); float* BONUS = (float*)(p.ws + OFF_BONUS);
    const int tid = opaque_tid(), wave = tid >> 6, lane = tid & 63, lq = lane & 15, g = lane >> 4;
    const size_t rowbase = (size_t)b * SEQ;
    const float* mu = p.in[9] + layer * 2176;
    const float* w0 = p.in[10] + layer * 512; const float* wup = p.in[11] + (size_t)layer * 64 * 512;
    const float* a0 = p.in[12] + layer * 512; const float* aup = p.in[13] + (size_t)layer * 64 * 512;
    const float* kkp = p.in[14] + layer * 512; const float* kap = p.in[15] + layer * 512; const float* rkp = p.in[16] + layer * 512;
    constexpr int SETF = 6 * 2048;
    float* SET0 = (float*)shm;
    float* AA = SET0 + 2 * SETF;
    float* Yb = AA + 2048;
    bf16_t* WLb = (bf16_t*)(Yb + 2048);
    bf16_t* ALb = WLb + 32 * 72;
    LAS volatile unsigned* pcnt = (LAS volatile unsigned*)((LAS unsigned char*)shm + (2 * SETF + 2048 + 2048) * 4 + 2 * 32 * 72 * 2);
    const int csub = wave & 3;
    bf16x8 bfr[2][2]; float lw0[2];
#pragma unroll
    for (int mat = 0; mat < 2; ++mat) { const float* up = (mat ? aup : wup) + h * 64 + csub * 16 + lq;
#pragma unroll
        for (int ks = 0; ks < 2; ++ks) { unsigned w[4];
#pragma unroll
            for (int e2 = 0; e2 < 4; ++e2) { const int m0 = 32 * ks + 8 * g + 2 * e2; w[e2] = cvt_pk_bf16(up[(size_t)m0 * 512], up[(size_t)(m0 + 1) * 512]); }
            u32x4 wv = (u32x4){w[0], w[1], w[2], w[3]}; bfr[mat][ks] = __builtin_bit_cast(bf16x8, wv); }
        lw0[mat] = (mat ? a0 : w0)[h * 64 + csub * 16 + lq]; }
    const int ej = (tid & 15) * 4;
    const f32x4 c_kk = *(const f32x4*)(kkp + h * 64 + ej), c_ka = *(const f32x4*)(kap + h * 64 + ej), c_rk = *(const f32x4*)(rkp + h * 64 + ej);
    const f32x4 mu_r = *(const f32x4*)(mu + h * 64 + ej), mu_k = *(const f32x4*)(mu + 512 + h * 64 + ej), mu_v = *(const f32x4*)(mu + 1024 + h * 64 + ej);
    const f32x4 mu_w = *(const f32x4*)(mu + 2048 + ej), mu_a = *(const f32x4*)(mu + 2112 + ej);
    f32x4 sA = (f32x4){0.f, 0.f, 0.f, 0.f}, sB = (f32x4){0.f, 0.f, 0.f, 0.f};
    const int irow = half * 32 + (wave & 3) * 8 + g * 2;
    unsigned ptgt = 0u;
    const int pm = tid - 256, e2t = pm >> 4;
    u32x2 cva[2][5], pva[2][5];
    auto rw_load = [&](int ch) {
#pragma unroll
        for (int ps = 0; ps < 2; ++ps) { const int tl = e2t + 16 * ps, t = ch * 32 + tl; const bf16_t* cur = P + (rowbase + t) * LDP + C_RW; const bool hp = t > 0; const bf16_t* prv = hp ? cur - LDP : cur;
#pragma unroll
            for (int i = 0; i < 5; ++i) { const int col = (i == 0 ? h * 64 : i == 1 ? 512 + h * 64 : i == 2 ? 1024 + h * 64 : i == 3 ? 2048 : 2112) + ej;
                cva[ps][i] = *(const u32x2*)(cur + col); pva[ps][i] = *(const u32x2*)(prv + col); } }
    };
    auto prep = [&](int ch, float* SET) {
        float* Rm = SET; float* Km = SET + 2048; float* Vm = SET + 4096; float* DEC = SET + 6144; float* KK = SET + 8192; float* BB = SET + 10240;
#pragma unroll
        for (int ps = 0; ps < 2; ++ps) { const int tl = e2t + 16 * ps, t = ch * 32 + tl; const unsigned pmask = t > 0 ? 0xFFFFFFFFu : 0u;
#pragma unroll
            for (int i = 0; i < 5; ++i) {
                const u32x2 cv = cva[ps][i]; u32x2 pv = pva[ps][i]; pv.x &= pmask; pv.y &= pmask;
                const f32x4 m4 = i == 0 ? mu_r : i == 1 ? mu_k : i == 2 ? mu_v : i == 3 ? mu_w : mu_a;
                float c[4] = {bf_lo(cv.x), bf_hi(cv.x), bf_lo(cv.y), bf_hi(cv.y)}; const float q[4] = {bf_lo(pv.x), bf_hi(pv.x), bf_lo(pv.y), bf_hi(pv.y)};
#pragma unroll
                for (int e = 0; e < 4; ++e) c[e] = c[e] + (q[e] - c[e]) * m4[e];
                if (i == 0) *(f32x4*)(Rm + tl * 64 + ej) = (f32x4){c[0], c[1], c[2], c[3]};
                else if (i == 1) *(f32x4*)(Km + tl * 64 + ej) = (f32x4){c[0], c[1], c[2], c[3]};
                else if (i == 2) *(f32x4*)(Vm + tl * 64 + ej) = (f32x4){c[0], c[1], c[2], c[3]};
                else if (i == 3) { u32x2 o; o.x = cvt_pk_bf16(fast_tanh(c[0]), fast_tanh(c[1])); o.y = cvt_pk_bf16(fast_tanh(c[2]), fast_tanh(c[3])); *(u32x2*)(WLb + tl * 72 + ej) = o; }
                else { u32x2 o; o.x = cvt_pk_bf16(c[0], c[1]); o.y = cvt_pk_bf16(c[2], c[3]); *(u32x2*)(ALb + tl * 72 + ej) = o; } } }
        if (ch + 1 < SEQ / 32) rw_load(ch + 1);
        pbar4(pcnt, ptgt, lane);
#pragma unroll
        for (int mat = 0; mat < 2; ++mat)
#pragma unroll
            for (int ts = 0; ts < 2; ++ts) { const bf16_t* ap = (mat ? ALb : WLb) + (16 * ts + lq) * 72 + 8 * g;
                const bf16x8 a0f = *(const bf16x8*)ap, a1f = *(const bf16x8*)(ap + 32);
                f32x4 c = (f32x4){0.f, 0.f, 0.f, 0.f};
                c = __builtin_amdgcn_mfma_f32_16x16x32_bf16(a0f, bfr[mat][0], c, 0, 0, 0);
                c = __builtin_amdgcn_mfma_f32_16x16x32_bf16(a1f, bfr[mat][1], c, 0, 0, 0);
#pragma unroll
                for (int r = 0; r < 4; ++r) { const int tt = 16 * ts + 4 * g + r; const float x = lw0[mat] + c[r];
                    if (mat == 0) DEC[tt * 64 + csub * 16 + lq] = __expf(-0.60653066f * sigmoidf_(x));
                    else AA[tt * 64 + csub * 16 + lq] = sigmoidf_(x); } }
        pbar4(pcnt, ptgt, lane);
#pragma unroll
        for (int ps = 0; ps < 2; ++ps) { const int tl = e2t + 16 * ps;
            const f32x4 k4 = *(const f32x4*)(Km + tl * 64 + ej), a4 = *(const f32x4*)(AA + tl * 64 + ej), r4 = *(const f32x4*)(Rm + tl * 64 + ej);
            f32x4 kr, kt; float ss = 0.f, bo = 0.f;
#pragma unroll
            for (int e = 0; e < 4; ++e) { kr[e] = k4[e] * c_kk[e]; ss += kr[e] * kr[e]; kt[e] = k4[e] * (1.f + (a4[e] - 1.f) * c_ka[e]); bo += r4[e] * kt[e] * c_rk[e]; }
            ss = allred16(ss); bo = allred16(bo);
            const float inv = __builtin_amdgcn_rsqf(fmaxf(ss, 1e-24f));
            f32x4 kk4, b4;
#pragma unroll
            for (int e = 0; e < 4; ++e) { kk4[e] = kr[e] * inv; b4[e] = kk4[e] * a4[e]; }
            *(f32x4*)(Km + tl * 64 + ej) = kt; *(f32x4*)(KK + tl * 64 + ej) = kk4; *(f32x4*)(BB + tl * 64 + ej) = b4;
            if (half == 0 && (tid & 15) == 0) BONUS[(rowbase + ch * 32 + tl) * 8 + h] = bo; }
    };
    auto yraw_store = [&](int ch) {
#pragma unroll
        for (int ps = 0; ps < 2; ++ps)
#pragma unroll
            for (int q = 0; q < 2; ++q) { const int tl = e2t + 16 * ps, il = (tid & 15) + 16 * q;
                YRAW[(rowbase + ch * 32 + tl) * 512 + h * 64 + half * 32 + il] = (bf16_t)(cvt_pk_bf16(Yb[(ch & 1) * 1024 + tl * 32 + il], 0.f) & 0xFFFF); }
    };
    if (tid == 0) *pcnt = 0u;
    __syncthreads();
    if (wave >= 4) { rw_load(0); prep(0, SET0); }
    for (int ch = 0; ch < SEQ / 32; ++ch) {
        __syncthreads();
        if (wave < 4) {
            const float* SET = SET0 + (ch & 1) * SETF;
            const float* Rm = SET; const float* Km = SET + 2048; const float* Vm = SET + 4096; const float* DEC = SET + 6144; const float* KK = SET + 8192; const float* BB = SET + 10240;
            float* Yw = Yb + (ch & 1) * 1024;
            struct Ops { f32x4 w, k, q, b, r; float v0, v1; };
            auto ld = [&](Ops& o, int tt) { const int off = tt * 64 + lq * 4;
                o.w = *(const f32x4*)(DEC + off); o.k = *(const f32x4*)(Km + off); o.q = *(const f32x4*)(KK + off); o.b = *(const f32x4*)(BB + off); o.r = *(const f32x4*)(Rm + off);
                const float* vp = Vm + tt * 64 + irow; o.v0 = vp[0]; o.v1 = vp[1]; };
            auto step = [&](const Ops& o, int tt) {
                const f32x4 da = sA * o.q, db = sB * o.q; float sa0 = (da[0] + da[1]) + (da[2] + da[3]), sa1 = (db[0] + db[1]) + (db[2] + db[3]);
                const f32x4 uA = sA * o.w + o.k * o.v0, uB = sB * o.w + o.k * o.v1;
                sa0 = -allred16(sa0); sa1 = -allred16(sa1);
                sA = uA + o.b * sa0; sB = uB + o.b * sa1;
                const f32x4 ea = sA * o.r, eb = sB * o.r; float y0 = (ea[0] + ea[1]) + (ea[2] + ea[3]), y1 = (eb[0] + eb[1]) + (eb[2] + eb[3]);
                y0 = allred16(y0); y1 = allred16(y1);
                if (lq == 0) { float* yp = Yw + tt * 32 + (wave & 3) * 8 + g * 2; yp[0] = y0; yp[1] = y1; } };
            Ops oa, ob;
            ld(oa, 0);
            for (int tt = 0; tt < 32; tt += 2) {
                ld(ob, tt + 1);
                step(oa, tt);
                ld(oa, (tt + 2 < 32) ? tt + 2 : 31);
                step(ob, tt + 1);
            }
        } else {
            if (ch > 0) yraw_store(ch - 1);
            if (ch + 1 < SEQ / 32) prep(ch + 1, SET0 + ((ch + 1) & 1) * SETF);
        }
    }
    __syncthreads();
    if (wave >= 4) yraw_store(SEQ / 32 - 1);
    __syncthreads();
}

__device__ __forceinline__ void rw_post(const Params& p, int layer) {
    bf16_t* P = (bf16_t*)(p.ws + OFF_P); const bf16_t* YRAW = (const bf16_t*)(p.ws + OFF_YRAW);
    const float* BONUS = (const float*)(p.ws + OFF_BONUS); const float* SSQ = (const float*)(p.ws + OFF_SSQ); float* RSTD = (float*)(p.ws + OFF_RSTD);
    const float* mu = p.in[9] + layer * 2176; const float* lng = p.in[17] + layer * 512; const float* lnb = p.in[18] + layer * 512;
    const int gt = blockIdx.x * 512 + opaque_tid(), gs = gridDim.x * 512;
    {
        const int c = (gt & 127) * 4, h = c >> 6;
        const f32x4 muv = *(const f32x4*)(mu + 1024 + c), mug = *(const f32x4*)(mu + 1536 + c);
        const f32x4 lg = *(const f32x4*)(lng + c), lb = *(const f32x4*)(lnb + c);
        for (int idx0 = gt; idx0 < TOK * 128; idx0 += 4 * gs) {
            u32x2 yv[4], vc[4], gc[4], vp[4], gp[4]; float bn[4]; unsigned pm[4]; bool ok[4];
#pragma unroll
            for (int u = 0; u < 4; ++u) { const int idx = idx0 + u * gs; ok[u] = idx < TOK * 128; const int tok = ok[u] ? (idx >> 7) : 0;
                const bf16_t* cur = P + (size_t)tok * LDP + C_RW; const bool hp = (tok & (SEQ - 1)) > 0; const bf16_t* prv = hp ? cur - LDP : cur; pm[u] = hp ? 0xFFFFFFFFu : 0u;
                yv[u] = *(const u32x2*)(YRAW + (size_t)tok * 512 + c);
                vc[u] = *(const u32x2*)(cur + 1024 + c); gc[u] = *(const u32x2*)(cur + 1536 + c);
                vp[u] = *(const u32x2*)(prv + 1024 + c); gp[u] = *(const u32x2*)(prv + 1536 + c);
                bn[u] = BONUS[(size_t)tok * 8 + h]; }
#pragma unroll
            for (int u = 0; u < 4; ++u) { const int idx = idx0 + u * gs; const int tok = ok[u] ? (idx >> 7) : 0;
                float y[4] = {bf_lo(yv[u].x), bf_hi(yv[u].x), bf_lo(yv[u].y), bf_hi(yv[u].y)};
                const float mean = allred16(y[0] + y[1] + y[2] + y[3]) * (1.f / 64.f);
                float d[4], vs = 0.f;
#pragma unroll
                for (int e = 0; e < 4; ++e) { d[e] = y[e] - mean; vs += d[e] * d[e]; }
                const float var = allred16(vs) * (1.f / 64.f);
                const float rs = rsqrtf(var + 64e-5f);
                const unsigned m = pm[u];
                const float vcur[4] = {bf_lo(vc[u].x), bf_hi(vc[u].x), bf_lo(vc[u].y), bf_hi(vc[u].y)}, vprv[4] = {bf_lo(vp[u].x & m), bf_hi(vp[u].x & m), bf_lo(vp[u].y & m), bf_hi(vp[u].y & m)};
                const float gcur[4] = {bf_lo(gc[u].x), bf_hi(gc[u].x), bf_lo(gc[u].y), bf_hi(gc[u].y)}, gprv[4] = {bf_lo(gp[u].x & m), bf_hi(gp[u].x & m), bf_lo(gp[u].y & m), bf_hi(gp[u].y & m)};
                float o[4];
#pragma unroll
                for (int e = 0; e < 4; ++e) { const float vm = vcur[e] + (vprv[e] - vcur[e]) * muv[e], gm = gcur[e] + (gprv[e] - gcur[e]) * mug[e];
                    o[e] = (d[e] * rs * lg[e] + lb[e] + bn[u] * vm) * siluf_(gm); }
                u32x2 ov; ov.x = cvt_pk_bf16(o[0], o[1]); ov.y = cvt_pk_bf16(o[2], o[3]);
                if (ok[u]) *(u32x2*)(P + (size_t)tok * LDP + C_YRW + c) = ov; }
        }
    }
    for (int tok = gt; tok < TOK; tok += gs) { const f32x4* q = (const f32x4*)(SSQ + (size_t)tok * 32); float s = 0.f;
#pragma unroll
        for (int i = 0; i < 8; ++i) { const f32x4 v = q[i]; s += v[0] + v[1] + v[2] + v[3]; }
        RSTD[tok] = rsqrtf(s * (1.f / 1024.f) + 1e-6f); }
}

#define XB_TMO      128
#define XB_XCNT(j)  (256  + 64 * (j))
#define XB_XSUB(j)  (1280 + 64 * (j))
#define XB_XGEN(j)  (2304 + 64 * (j))
#define XB_TOP      3328
#define XB_TOPGEN   3392
#define XCD_BAR_WORDS 3456
#define XB_SPIN_CAP (1u << 18)
__device__ __forceinline__ unsigned xb_ld(unsigned* p)              { return __hip_atomic_load(p, __ATOMIC_RELAXED, __HIP_MEMORY_SCOPE_AGENT); }
__device__ __forceinline__ unsigned xb_add(unsigned* p, unsigned v) { return __hip_atomic_fetch_add(p, v, __ATOMIC_RELAXED, __HIP_MEMORY_SCOPE_AGENT); }
__device__ __forceinline__ unsigned xb_xcc_id() { return (unsigned)__builtin_amdgcn_s_getreg((3 << 11) | 20) & 0xFu; }
#define XB_SPIN(cond, bar) do { unsigned _sp = 0; while (cond) { __builtin_amdgcn_s_sleep(1); \
    if ((++_sp & 255u) == 0u) { if (xb_ld(&(bar)[XB_TMO])) break; if (_sp > XB_SPIN_CAP) { atomicAdd(&(bar)[XB_TMO], 1u); break; } } } } while (0)
struct XcdBarrier { unsigned* bar; unsigned x; volatile LAS unsigned* st; };
__device__ __forceinline__ XcdBarrier xcd_barrier_post(unsigned* bar, volatile LAS unsigned* st) {
    XcdBarrier b; b.bar = bar; b.x = xb_xcc_id(); b.st = st;
    if (threadIdx.x == 0) (void)xb_add(&bar[XB_XCNT(b.x)], 1u);
    return b;
}
__device__ __forceinline__ void xcd_barrier_complete(unsigned* bar, unsigned x, unsigned& nloc, unsigned& nx) {
    const unsigned G = gridDim.x * gridDim.y * gridDim.z;
    unsigned sum, cnt, mine, sp = 0u;
    for (;;) {
        sum = 0u; cnt = 0u; mine = 0u;
#pragma unroll
        for (unsigned j = 0; j < 16; ++j) { const unsigned c = xb_ld(&bar[XB_XCNT(j)]); sum += c; cnt += (c > 0u) ? 1u : 0u; mine = (j == x) ? c : mine; }
        if (sum == G) break;
        __builtin_amdgcn_s_sleep(1);
        if ((++sp & 255u) == 0u) { if (xb_ld(&bar[XB_TMO])) break; if (sp > XB_SPIN_CAP) { atomicAdd(&bar[XB_TMO], 1u); break; } }
    }
    nloc = mine > 0u ? mine : 1u; nx = cnt > 0u ? cnt : 1u;
}
__device__ __forceinline__ void xcd_barrier(const XcdBarrier& b) {
    asm volatile("s_waitcnt vmcnt(0)" ::: "memory");
    __syncthreads();
    if (threadIdx.x == 0) {
        unsigned* bar = b.bar;
        __builtin_amdgcn_s_waitcnt(0);
        unsigned nloc = b.st[0], nx = b.st[1];
        if (nloc == 0u) { xcd_barrier_complete(bar, b.x, nloc, nx); b.st[0] = nloc; b.st[1] = nx; }
        const unsigned old = xb_add(&bar[XB_XSUB(b.x)], 1u);
        const unsigned gen = old / nloc;
        if (old + 1u == (gen + 1u) * nloc) {
            __builtin_amdgcn_fence(__ATOMIC_RELEASE, "agent");
            asm volatile("s_waitcnt vmcnt(0)" ::: "memory");
            const unsigned og = xb_add(&bar[XB_TOP], 1u);
            const unsigned tg = og / nx;
            if (og + 1u == (tg + 1u) * nx) xb_add(&bar[XB_TOPGEN], 1u);
            else XB_SPIN(xb_ld(&bar[XB_TOPGEN]) == tg, bar);
            __builtin_amdgcn_fence(__ATOMIC_ACQUIRE, "agent");
            xb_add(&bar[XB_XGEN(b.x)], 1u);
            asm volatile("s_waitcnt vmcnt(0)" ::: "memory");
        } else {
            XB_SPIN(xb_ld(&bar[XB_XGEN(b.x)]) == gen, bar);
            __builtin_amdgcn_fence(__ATOMIC_ACQUIRE, "agent");
            asm volatile("s_waitcnt vmcnt(0)" ::: "memory");
        }
    }
    __syncthreads();
}

#define GSYNC() xcd_barrier(xb)
__global__ void __launch_bounds__(512, 2) mega(Params p) {
    extern __shared__ __attribute__((aligned(16))) unsigned char shm[];
    cg::grid_group grid = cg::this_grid();
    volatile LAS unsigned* xst = (volatile LAS unsigned*)((LAS unsigned char*)shm + LDS_BYTES - 16);
    if (threadIdx.x == 0) { xst[0] = 0u; xst[1] = 0u; }
    __syncthreads();
    const XcdBarrier xb = xcd_barrier_post((unsigned*)(p.ws + OFF_BAR), xst);
    const char* Pc = (const char*)(p.ws + OFF_P); const char* WTc = (const char*)(p.ws + OFF_WT);
    bf16_t* P = (bf16_t*)(p.ws + OFF_P);
    const int G = gridDim.x, c = blockIdx.x;
    for (int layer = 0; layer < 2; ++layer) {
        phase0(p, layer, shm);
        if (layer == 0) grid.sync(); else GSYNC();
        { SchedInproj S{Pc, WTc, G, c}; EpiInproj E{P}; pg8::gemm_phase<true>((LAS unsigned char*)shm, S, E); }
        GSYNC();
        bc_prepass(p, layer);
        GSYNC();
        { const int Gh = G >> 1;
            if (c < Gh) { for (int it = c; it < 128; it += Gh) rwkv_item(p, layer, shm, it); }
            else { const int c2 = c - Gh;
                for (int it = c2; it < 256; it += Gh) ssd_item(p, layer, shm, it);
                for (int it = c2; it < 1024; it += Gh) attn_item(p, shm, it); } }
        GSYNC();
        rw_post(p, layer);
        GSYNC();
        { SchedC1 S{Pc, WTc, G, c}; EpiC1 E{P, (const float*)(p.ws + OFF_RSTD)}; pg8::gemm_phase<true>((LAS unsigned char*)shm, S, E); }
        GSYNC();
        { SchedOut S{Pc, WTc, G, c}; EpiOut E{layer == 0 ? p.in[0] : p.out, p.out}; pg8::gemm_phase<false>((LAS unsigned char*)shm, S, E); }
        GSYNC();
    }
    { const int tid = opaque_tid(), wave = tid >> 6, lane = tid & 63; const float* fg = p.in[23];
        for (int row = blockIdx.x * 8 + wave; row < TOK; row += gridDim.x * 8) { float* xr = p.out + (size_t)row * DM;
            f32x4 v[4]; float ss = 0.f;
#pragma unroll
            for (int i = 0; i < 4; ++i) { v[i] = *(const f32x4*)(xr + i * 256 + lane * 4); ss += v[i][0] * v[i][0] + v[i][1] * v[i][1] + v[i][2] * v[i][2] + v[i][3] * v[i][3]; }
            ss = wave_sum(ss);
            const float rs = rsqrtf(ss * (1.f / DM) + 1e-6f);
#pragma unroll
            for (int i = 0; i < 4; ++i) { const f32x4 g = *(const f32x4*)(fg + i * 256 + lane * 4); *(f32x4*)(xr + i * 256 + lane * 4) = v[i] * rs * g; } } }
}

extern "C" void kernel_launch(void* const* d_in, const int* in_sizes, int n_in, void* d_out, int out_size, void* d_ws, size_t ws_size, hipStream_t stream) {
    static int grid_blocks = 0;
    if (grid_blocks == 0) {
        if (n_in != 24 || out_size != TOK * DM || ws_size < WS_NEED) { fprintf(stderr, "kernel_launch: unexpected shapes (n_in %d out %d ws %zu need %zu)\n", n_in, out_size, ws_size, (size_t)WS_NEED); grid_blocks = -1; return; }
        int dev = 0, cus = 0, per_cu = 0;
        hipGetDevice(&dev);
        hipDeviceGetAttribute(&cus, hipDeviceAttributeMultiprocessorCount, dev);
        hipFuncSetAttribute((const void*)mega, hipFuncAttributeMaxDynamicSharedMemorySize, LDS_BYTES);
        hipOccupancyMaxActiveBlocksPerMultiprocessor(&per_cu, (const void*)mega, 512, LDS_BYTES);
        if (per_cu < 1) { fprintf(stderr, "kernel_launch: occupancy query says %d blocks per CU\n", per_cu); grid_blocks = -1; return; }
        if (per_cu > 1) per_cu = 1;
        grid_blocks = cus * per_cu;
        grid_blocks &= ~7;
    }
    if (grid_blocks < 0) return;
    Params p{};
    for (int i = 0; i < 24; ++i) p.in[i] = (const float*)d_in[i];
    p.out = (float*)d_out; p.ws = (unsigned char*)d_ws;
    (void)hipMemsetAsync((unsigned char*)d_ws + OFF_BAR, 0, SZ_BAR, stream);
    void* args[] = {&p};
    hipError_t e = hipLaunchCooperativeKernel((const void*)mega, dim3(grid_blocks), dim3(512), args, LDS_BYTES, stream);
    if (e != hipSuccess) fprintf(stderr, "cooperative launch failed: %s (grid %d)\n", hipGetErrorString(e), grid_blocks);
}
```

```cpp
#include <hip/hip_runtime.h>
#include <hip/hip_cooperative_groups.h>
#include <cstdio>
namespace cg = cooperative_groups;

#define LAS __attribute__((address_space(3)))
typedef unsigned short bf16_t;
typedef short bf16x8 __attribute__((ext_vector_type(8)));
typedef float f32x4 __attribute__((ext_vector_type(4)));
typedef unsigned u32x4 __attribute__((ext_vector_type(4)));
typedef unsigned u32x2 __attribute__((ext_vector_type(2)));

constexpr int TOK = 16384, SEQ = 2048, DM = 1024, NIN = 9616;
constexpr int LDP = 7680;
constexpr int C_Q = 0, C_K = 512, C_V = 1024, C_SBG = 1536, C_Z = 2048, C_XBC = 3072, C_RW = 4352, C_DT = 6528, C_H = 6656;
constexpr int C_M = 0, C_G = 3072, C_YRW = 4352;
constexpr int R_GATE = 6656, R_SB = 9728, R_SSD = 10752, R_RWO = 11776, R_WO = 12800, WT_ROWS = 13824;
constexpr size_t OFF_P = 0, SZ_P = (size_t)TOK * LDP * 2;
constexpr size_t OFF_WT = OFF_P + SZ_P, SZ_WT = (size_t)WT_ROWS * 1024 * 2;
constexpr size_t OFF_YRAW = OFF_WT + SZ_WT, SZ_YRAW = (size_t)TOK * 512 * 2;
constexpr size_t OFF_SSQ = OFF_YRAW + SZ_YRAW, SZ_SSQ = (size_t)TOK * 32 * 4;
constexpr size_t OFF_RSTD = OFF_SSQ + SZ_SSQ, SZ_RSTD = (size_t)TOK * 4;
constexpr size_t OFF_BONUS = OFF_RSTD + SZ_RSTD, SZ_BONUS = (size_t)TOK * 8 * 4;
constexpr size_t OFF_BAR = OFF_BONUS + SZ_BONUS, SZ_BAR = 16384;
constexpr size_t OFF_BCC = OFF_BAR + SZ_BAR, SZ_BCC = (size_t)TOK * 256 * 2;
constexpr size_t WS_NEED = OFF_BCC + SZ_BCC;
constexpr int LDS_BYTES = 135168;

struct Params { const float* in[24]; float* out; unsigned char* ws; };

typedef float f32x2_t __attribute__((ext_vector_type(2)));
typedef __bf16 bf16x2_t __attribute__((ext_vector_type(2)));
__device__ __forceinline__ unsigned cvt_pk_bf16(float lo, float hi) { const f32x2_t v = {lo, hi}; return __builtin_bit_cast(unsigned, __builtin_convertvector(v, bf16x2_t)); }
__device__ __forceinline__ float bf_lo(unsigned u) { return __uint_as_float(u << 16); }
__device__ __forceinline__ float bf_hi(unsigned u) { return __uint_as_float(u & 0xFFFF0000u); }
__device__ __forceinline__ float bf2f(bf16_t h) { return __uint_as_float(((unsigned)h) << 16); }
__device__ __forceinline__ float sigmoidf_(float x) { return __builtin_amdgcn_rcpf(1.f + __expf(-x)); }
__device__ __forceinline__ float siluf_(float x) { return x * __builtin_amdgcn_rcpf(1.f + __expf(-x)); }
__device__ __forceinline__ float softplusf_(float x) { return fmaxf(x, 0.f) + __logf(1.f + __expf(-fabsf(x))); }
template <int CTRL> __device__ __forceinline__ float dppf(float x) { return __int_as_float(__builtin_amdgcn_update_dpp(0, __float_as_int(x), CTRL, 0xF, 0xF, true)); }
__device__ __forceinline__ float allred16(float x) { x += dppf<0xB1>(x); x += dppf<0x4E>(x); x += dppf<0x141>(x); x += dppf<0x140>(x); return x; }
__device__ __forceinline__ int opaque_tid() { int t; asm volatile("v_mov_b32 %0, %1" : "=v"(t) : "v"((int)threadIdx.x)); return t; }
__device__ __forceinline__ float wave_sum(float v) {
#pragma unroll
    for (int o = 1; o < 64; o <<= 1) v += __shfl_xor(v, o);
    return v;
}

namespace pg8 {
constexpr int BM = 256, BK = 64, HALF = 128, HTB = HALF * BK * 2, NXCD = 8, WGM = 8;
constexpr unsigned LDA_B = LDP * 2, LDB_B = 2048;
__device__ __forceinline__ int lds_byte(int r, int c) { const int st = (r >> 4) * 2 + (c >> 5), rr = r & 15, cc = c & 31, ob = rr * 64 + cc * 2; return st * 1024 + (ob ^ (((ob >> 9) & 1) << 5)); }
__device__ __forceinline__ void stage_rc(int b, int& R, int& C) { const int st = b / 1024, sb = b % 1024, swz = sb ^ (((sb >> 9) & 1) << 5); R = (st >> 1) * 16 + swz / 64; C = (st & 1) * 32 + (swz % 64) / 2; }
__device__ __forceinline__ int perm32(int rho) { const int n = rho >> 4, i = rho & 15; return 8 * (i >> 2) + 4 * n + (i & 3); }
struct UnitD { const char* A; const char* B; int nt, pm, pn, kind; };
__device__ __forceinline__ void tile_of(int L, int nM, int nN, int& pm, int& pn) {
    const int nwg = nM * nN; int wgid = L;
    { const int q = nwg / NXCD, r = nwg % NXCD, xcd = wgid % NXCD, off = wgid / NXCD; wgid = (xcd < r ? xcd * (q + 1) : r * (q + 1) + (xcd - r) * q) + off; }
    const int nig = WGM * nN, gid = wgid / nig, fm = gid * WGM, gsz = (nM - fm) < WGM ? (nM - fm) : WGM;
    pm = fm + ((wgid % nig) % gsz); pn = (wgid % nig) / gsz;
}

template <bool PERM, class Sched, class Epi>
__device__ __forceinline__ void gemm_phase(LAS unsigned char* lds, const Sched& S, const Epi& E) {
    const int tid = opaque_tid(), wid = __builtin_amdgcn_readfirstlane(tid >> 6), lane = tid & 63, wr = wid >> 2, wc = wid & 3, fr = lane & 15, fq = lane >> 4;
    unsigned voffA[2], voffB[2];
#pragma unroll
    for (int i = 0; i < 2; ++i) { int R, C; stage_rc(tid * 16 + i * 8192, R, C); const int Rb = PERM ? ((R & ~31) + perm32(R & 31)) : R;
        voffA[i] = (unsigned)R * LDA_B + (unsigned)C * 2u; voffB[i] = (unsigned)Rb * LDB_B + (unsigned)C * 2u; }
    const size_t kstep = (size_t)(BK * 2);
    const size_t hstepA = (size_t)HALF * LDA_B, hstepB = (size_t)HALF * LDB_B;
    const unsigned ldsw = (unsigned)wid * 1024u;
    const int aoff = lds_byte(wr * 64 + fr, fq * 8), boff = lds_byte(wc * 32 + fr, fq * 8);
#define PG8_SA(b, h) (((b) * 2 + (h)) * HTB)
#define PG8_SB(b, h) ((4 + (b) * 2 + (h)) * HTB)
#define PG8_STAGE(bufoff, gbase, voff) do { _Pragma("unroll") for (int _i = 0; _i < 2; ++_i) \
        __builtin_amdgcn_global_load_lds((const unsigned*)((const char*)(gbase) + (voff)[_i]), (LAS unsigned*)(lds + (bufoff) + ldsw + _i * 8192), 16, 0, 0); } while (0)
#define PG8_LDA(dst, b, h) do { _Pragma("unroll") for (int m = 0; m < 4; ++m) _Pragma("unroll") for (int k = 0; k < 2; ++k) dst[m][k] = *(const LAS bf16x8*)(lds + PG8_SA(b, h) + aoff + m * 2048 + k * 1024); } while (0)
#define PG8_LDB(dst, b, h) do { _Pragma("unroll") for (int n = 0; n < 2; ++n) _Pragma("unroll") for (int k = 0; k < 2; ++k) dst[n][k] = *(const LAS bf16x8*)(lds + PG8_SB(b, h) + boff + n * 2048 + k * 1024); } while (0)
#define PG8_MMA(ai, bj, At, Bt) do { __builtin_amdgcn_s_setprio(1); _Pragma("unroll") for (int m = 0; m < 4; ++m) _Pragma("unroll") for (int n = 0; n < 2; ++n) _Pragma("unroll") for (int k = 0; k < 2; ++k) \
        acc[ai][bj][m][n] = __builtin_amdgcn_mfma_f32_16x16x32_bf16(Bt[n][k], At[m][k], acc[ai][bj][m][n], 0, 0, 0); __builtin_amdgcn_s_setprio(0); } while (0)
#define PG8_WAIT_V(n) asm volatile("s_waitcnt vmcnt(" #n ")" ::: "memory")
#define PG8_WAIT_L(n) asm volatile("s_waitcnt lgkmcnt(" #n ")" ::: "memory")
#define PG8_BAR __builtin_amdgcn_s_barrier()
#define PG8_SCHED __builtin_amdgcn_sched_barrier(0)
    UnitD cur, nxt; int ui = 0;
    if (!S.next(0, cur)) return;
    f32x4 acc[2][2][4][2];
#pragma unroll
    for (int a = 0; a < 2; ++a)
#pragma unroll
        for (int b = 0; b < 2; ++b)
#pragma unroll
            for (int m = 0; m < 4; ++m)
#pragma unroll
                for (int n = 0; n < 2; ++n) acc[a][b][m][n] = (f32x4){0.f, 0.f, 0.f, 0.f};
    bf16x8 At[4][2], B0[2][2], B1[2][2];
    const char* cA = cur.A; const char* cB = cur.B;
    PG8_STAGE(PG8_SB(0, 0), cB, voffB); PG8_STAGE(PG8_SA(0, 0), cA, voffA); PG8_STAGE(PG8_SB(0, 1), cB + hstepB, voffB); PG8_STAGE(PG8_SA(0, 1), cA + hstepA, voffA);
    if (wr == 1) PG8_BAR;
    PG8_WAIT_V(4); PG8_BAR;
    PG8_STAGE(PG8_SB(1, 0), cB + kstep, voffB); PG8_STAGE(PG8_SA(1, 0), cA + kstep, voffA); PG8_STAGE(PG8_SB(1, 1), cB + hstepB + kstep, voffB);
    PG8_WAIT_V(6); PG8_BAR;
    for (;;) {
        const bool has_next = S.next(ui + 1, nxt);
        const char* nA = has_next ? nxt.A : cA; const char* nB = has_next ? nxt.B : cB;
        const int nt = cur.nt;
        for (int t = 0; t < nt; t += 2) {
            const bool last = (t == nt - 2);
            const char* a1 = cA + (size_t)(t + 1) * kstep;
            const char* a2 = last ? nA : cA + (size_t)(t + 2) * kstep; const char* b2 = last ? nB : cB + (size_t)(t + 2) * kstep;
            const char* a3 = a2 + kstep; const char* b3 = b2 + kstep;
            PG8_LDB(B0, 0, 0); PG8_SCHED; PG8_LDA(At, 0, 0); PG8_STAGE(PG8_SA(1, 1), a1 + hstepA, voffA);
            PG8_WAIT_L(8); PG8_BAR; PG8_WAIT_L(0); PG8_MMA(0, 0, At, B0); PG8_BAR; PG8_SCHED;
            PG8_LDB(B1, 0, 1); PG8_STAGE(PG8_SB(0, 0), b2, voffB);
            PG8_BAR; PG8_WAIT_L(0); PG8_MMA(0, 1, At, B1); PG8_BAR;
            PG8_LDA(At, 0, 1); PG8_STAGE(PG8_SA(0, 0), a2, voffA);
            PG8_BAR; PG8_WAIT_L(0); PG8_MMA(1, 0, At, B0); PG8_BAR; PG8_SCHED;
            PG8_STAGE(PG8_SB(0, 1), b2 + hstepB, voffB);
            PG8_WAIT_V(6); PG8_BAR; PG8_MMA(1, 1, At, B1); PG8_BAR;
            PG8_LDB(B0, 1, 0); PG8_SCHED; PG8_LDA(At, 1, 0); PG8_STAGE(PG8_SA(0, 1), a2 + hstepA, voffA);
            PG8_WAIT_L(8); PG8_BAR; PG8_WAIT_L(0); PG8_MMA(0, 0, At, B0); PG8_BAR; PG8_SCHED;
            PG8_LDB(B1, 1, 1); PG8_STAGE(PG8_SB(1, 0), b3, voffB);
            PG8_BAR; PG8_WAIT_L(0); PG8_MMA(0, 1, At, B1); PG8_BAR;
            PG8_LDA(At, 1, 1); PG8_STAGE(PG8_SA(1, 0), a3, voffA);
            PG8_BAR; PG8_WAIT_L(0); PG8_MMA(1, 0, At, B0); PG8_BAR; PG8_SCHED;
            PG8_STAGE(PG8_SB(1, 1), b3 + hstepB, voffB);
            PG8_WAIT_V(6); PG8_BAR; PG8_MMA(1, 1, At, B1); PG8_BAR;
        }
        E(acc, cur, wr, wc, fr, fq);
        if (!has_next) break;
#pragma unroll
        for (int a = 0; a < 2; ++a)
#pragma unroll
            for (int b = 0; b < 2; ++b)
#pragma unroll
                for (int m = 0; m < 4; ++m)
#pragma unroll
                    for (int n = 0; n < 2; ++n) acc[a][b][m][n] = (f32x4){0.f, 0.f, 0.f, 0.f};
        cur = nxt; cA = nA; cB = nB; ++ui;
    }
    PG8_WAIT_V(0);
    if (wr == 0) PG8_BAR;
    PG8_BAR;
#undef PG8_SA
#undef PG8_SB
#undef PG8_STAGE
#undef PG8_LDA
#undef PG8_LDB
#undef PG8_MMA
#undef PG8_WAIT_V
#undef PG8_WAIT_L
#undef PG8_BAR
#undef PG8_SCHED
}
}
using pg8::UnitD;

struct SchedInproj {
    const char* P; const char* WT; int G, c;
    __device__ __forceinline__ bool next(int i, UnitD& u) const {
        const int L = i * G + c; if (L >= 64 * 26) return false;
        int pm, pn; pg8::tile_of(L, 64, 26, pm, pn);
        u.A = P + ((size_t)pm * 256 * LDP + C_H) * 2; u.B = WT + (size_t)pn * 256 * 2048; u.nt = 16; u.pm = pm; u.pn = pn; u.kind = 0; return true;
    }
};
struct EpiInproj {
    bf16_t* P;
    __device__ __forceinline__ void operator()(const f32x4 (&acc)[2][2][4][2], const UnitD& u, int wr, int wc, int fr, int fq) const {
        const int row0 = u.pm * 256 + wr * 64 + fr, col0 = u.pn * 256 + wc * 32 + 8 * fq;
#pragma unroll
        for (int ai = 0; ai < 2; ++ai)
#pragma unroll
            for (int m = 0; m < 4; ++m) { bf16_t* rowp = P + (size_t)(row0 + ai * 128 + m * 16) * LDP + col0;
#pragma unroll
                for (int bj = 0; bj < 2; ++bj) { const f32x4 v0 = acc[ai][bj][m][0], v1 = acc[ai][bj][m][1];
                    u32x4 o; o.x = cvt_pk_bf16(v0[0], v0[1]); o.y = cvt_pk_bf16(v0[2], v0[3]); o.z = cvt_pk_bf16(v1[0], v1[1]); o.w = cvt_pk_bf16(v1[2], v1[3]);
                    *(u32x4*)(rowp + bj * 128) = o; } }
    }
};
struct SchedC1 {
    const char* P; const char* WT; int G, c;
    __device__ __forceinline__ bool next(int i, UnitD& u) const {
        const int ti = i / 6, sub = i - ti * 6, L = ti * G + c; if (L >= 256) return false;
        int pm, pn; pg8::tile_of(L, 64, 4, pm, pn);
        const int br = sub >> 1;
        if (!(sub & 1)) { u.A = P + ((size_t)pm * 256 * LDP + C_H) * 2; u.B = WT + (size_t)(R_GATE + br * 1024 + pn * 256) * 2048; u.nt = 16; }
        else { const int acol = br == 0 ? C_SBG : (br == 1 ? C_Z : C_YRW); const int brow = br == 0 ? R_SB : (br == 1 ? R_SSD : R_RWO);
            u.A = P + ((size_t)pm * 256 * LDP + acol) * 2; u.B = WT + (size_t)(brow + pn * 256) * 2048; u.nt = br == 1 ? 16 : 8; }
        u.pm = pm; u.pn = pn; u.kind = sub; return true;
    }
};
struct EpiC1 {
    bf16_t* P; const float* rstd;
    __device__ __forceinline__ void operator()(const f32x4 (&acc)[2][2][4][2], const UnitD& u, int wr, int wc, int fr, int fq) const {
        const int row0 = u.pm * 256 + wr * 64 + fr, col0 = u.pn * 256 + wc * 32 + 8 * fq;
        const int kind = u.kind;
#pragma unroll
        for (int ai = 0; ai < 2; ++ai)
#pragma unroll
            for (int m = 0; m < 4; ++m) { const int row = row0 + ai * 128 + m * 16; bf16_t* rowp = P + (size_t)row * LDP + col0;
                const float sc = (kind == 3) ? rstd[row] : 1.f;
#pragma unroll
                for (int bj = 0; bj < 2; ++bj) { const f32x4 v0 = acc[ai][bj][m][0], v1 = acc[ai][bj][m][1];
                    float v[8] = {v0[0], v0[1], v0[2], v0[3], v1[0], v1[1], v1[2], v1[3]};
                    u32x4* gp = (u32x4*)(rowp + C_G + bj * 128); u32x4* mp = (u32x4*)(rowp + C_M + bj * 128);
                    if (!(kind & 1)) {
#pragma unroll
                        for (int e = 0; e < 8; ++e) v[e] = sigmoidf_(v[e]);
                        u32x4 o; o.x = cvt_pk_bf16(v[0], v[1]); o.y = cvt_pk_bf16(v[2], v[3]); o.z = cvt_pk_bf16(v[4], v[5]); o.w = cvt_pk_bf16(v[6], v[7]);
                        *gp = o;
                    } else {
                        const u32x4 g = *gp;
                        float r[8];
                        r[0] = bf_lo(g.x) * v[0] * sc; r[1] = bf_hi(g.x) * v[1] * sc; r[2] = bf_lo(g.y) * v[2] * sc; r[3] = bf_hi(g.y) * v[3] * sc;
                        r[4] = bf_lo(g.z) * v[4] * sc; r[5] = bf_hi(g.z) * v[5] * sc; r[6] = bf_lo(g.w) * v[6] * sc; r[7] = bf_hi(g.w) * v[7] * sc;
                        if (kind != 1) { const u32x4 mo = *mp;
                            r[0] += bf_lo(mo.x); r[1] += bf_hi(mo.x); r[2] += bf_lo(mo.y); r[3] += bf_hi(mo.y); r[4] += bf_lo(mo.z); r[5] += bf_hi(mo.z); r[6] += bf_lo(mo.w); r[7] += bf_hi(mo.w); }
                        u32x4 o; o.x = cvt_pk_bf16(r[0], r[1]); o.y = cvt_pk_bf16(r[2], r[3]); o.z = cvt_pk_bf16(r[4], r[5]); o.w = cvt_pk_bf16(r[6], r[7]);
                        *mp = o;
                    } } }
    }
};
struct SchedOut {
    const char* P; const char* WT; int G, c;
    __device__ __forceinline__ bool next(int i, UnitD& u) const {
        const int L = i * G + c; if (L >= 256) return false;
        int pm, pn; pg8::tile_of(L, 64, 4, pm, pn);
        u.A = P + ((size_t)pm * 256 * LDP + C_M) * 2; u.B = WT + (size_t)(R_WO + pn * 256) * 2048; u.nt = 16; u.pm = pm; u.pn = pn; u.kind = 0; return true;
    }
};
struct EpiOut {
    const float* Xin; float* Xout;
    __device__ __forceinline__ void operator()(const f32x4 (&acc)[2][2][4][2], const UnitD& u, int wr, int wc, int fr, int fq) const {
        const int row0 = u.pm * 256 + wr * 64 + fr, col0 = u.pn * 256 + wc * 32 + 4 * fq;
#pragma unroll
        for (int ai = 0; ai < 2; ++ai)
#pragma unroll
            for (int m = 0; m < 4; ++m) { const size_t ro = (size_t)(row0 + ai * 128 + m * 16) * DM + col0;
#pragma unroll
                for (int bj = 0; bj < 2; ++bj)
#pragma unroll
                    for (int n = 0; n < 2; ++n) { const f32x4 xi = *(const f32x4*)(Xin + ro + bj * 128 + n * 16); *(f32x4*)(Xout + ro + bj * 128 + n * 16) = xi + acc[ai][bj][m][n]; } }
    }
};

__device__ __forceinline__ void phase0(const Params& p, int layer, unsigned char* shm) {
    const int tid = opaque_tid(), wave = tid >> 6, lane = tid & 63;
    bf16_t* P = (bf16_t*)(p.ws + OFF_P); bf16_t* WT = (bf16_t*)(p.ws + OFF_WT);
    const float* Xin = layer == 0 ? p.in[0] : p.out;
    const float* ng = p.in[1] + layer * DM;
    f32x4 gn[4];
#pragma unroll
    for (int i = 0; i < 4; ++i) gn[i] = *(const f32x4*)(ng + i * 256 + lane * 4);
    for (int row0 = (blockIdx.x * 8 + wave) * 4; row0 < TOK; row0 += gridDim.x * 32) {
        f32x4 v[4][4]; float ss[4];
#pragma unroll
        for (int rr = 0; rr < 4; ++rr) { const float* xr = Xin + (size_t)(row0 + rr) * DM;
#pragma unroll
            for (int i = 0; i < 4; ++i) v[rr][i] = *(const f32x4*)(xr + i * 256 + lane * 4); }
#pragma unroll
        for (int rr = 0; rr < 4; ++rr) { float a = 0.f;
#pragma unroll
            for (int i = 0; i < 4; ++i) a += v[rr][i][0] * v[rr][i][0] + v[rr][i][1] * v[rr][i][1] + v[rr][i][2] * v[rr][i][2] + v[rr][i][3] * v[rr][i][3];
            ss[rr] = wave_sum(a); }
#pragma unroll
        for (int rr = 0; rr < 4; ++rr) { const float rs = rsqrtf(ss[rr] * (1.f / DM) + 1e-6f);
#pragma unroll
            for (int i = 0; i < 4; ++i) { const f32x4 g = gn[i];
                u32x2 o; o.x = cvt_pk_bf16(v[rr][i][0] * rs * g[0], v[rr][i][1] * rs * g[1]); o.y = cvt_pk_bf16(v[rr][i][2] * rs * g[2], v[rr][i][3] * rs * g[3]);
                *(u32x2*)(P + (size_t)(row0 + rr) * LDP + C_H + i * 256 + lane * 4) = o; } }
    }
    float* T = (float*)shm + wave * (64 * 65);
    const float* w_in = p.in[2] + (size_t)layer * DM * NIN;
    const float* sg = p.in[8] + layer * DM;
    for (int job = blockIdx.x * 8 + wave; job < 3200; job += gridDim.x * 8) {
        const float* src; int srcN, k0, n0, dstrow; bool is_in = false, is_ssd = false;
        if (job < 2432) { is_in = true; src = w_in; srcN = NIN; const int ntile = job >> 4; k0 = (job & 15) * 64; n0 = ntile * 64; dstrow = n0; }
        else { int r = job - 2432;
            if (r < 128) { src = p.in[19] + (size_t)layer * 512 * DM; k0 = (r >> 4) * 64; n0 = (r & 15) * 64; dstrow = R_SB + n0; }
            else if (r < 384) { r -= 128; src = p.in[20] + (size_t)layer * DM * DM; k0 = (r >> 4) * 64; n0 = (r & 15) * 64; dstrow = R_SSD + n0; is_ssd = true; }
            else if (r < 512) { r -= 384; src = p.in[21] + (size_t)layer * 512 * DM; k0 = (r >> 4) * 64; n0 = (r & 15) * 64; dstrow = R_RWO + n0; }
            else { r -= 512; src = p.in[22] + (size_t)layer * DM * DM; k0 = (r >> 4) * 64; n0 = (r & 15) * 64; dstrow = R_WO + n0; }
            srcN = DM; }
        const int n4 = (lane & 15) * 4, np = n0 + n4; int sc = np;
        if (is_in) { if (np < 4352) sc = np; else if (np < 6528) sc = np + 16; else if (np < 6544) sc = np - 6528 + 4352; else if (np < 6656) sc = -1; else sc = np - 112; }
        f32x4 v[16];
#pragma unroll
        for (int i = 0; i < 16; ++i) { const int k = (lane >> 4) + 4 * i; v[i] = (f32x4){0.f, 0.f, 0.f, 0.f};
            if (sc >= 0) v[i] = *(const f32x4*)(src + (size_t)(k0 + k) * srcN + sc); }
#pragma unroll
        for (int i = 0; i < 16; ++i) { const int k = (lane >> 4) + 4 * i; f32x4 x = v[i];
            if (is_ssd) x = x * sg[k0 + k];
            T[k * 65 + n4] = x[0]; T[k * 65 + n4 + 1] = x[1]; T[k * 65 + n4 + 2] = x[2]; T[k * 65 + n4 + 3] = x[3]; }
        asm volatile("s_waitcnt lgkmcnt(0)" ::: "memory"); __builtin_amdgcn_wave_barrier(); asm volatile("" ::: "memory");
#pragma unroll
        for (int j = 0; j < 8; ++j) { const int r = lane + 64 * j, n = r >> 3, kc = (r & 7) * 8; const float* sp = T + kc * 65 + n;
            u32x4 o; o.x = cvt_pk_bf16(sp[0], sp[65]); o.y = cvt_pk_bf16(sp[130], sp[195]); o.z = cvt_pk_bf16(sp[260], sp[325]); o.w = cvt_pk_bf16(sp[390], sp[455]);
            *(u32x4*)(WT + (size_t)(dstrow + n) * 1024 + k0 + kc) = o; }
        asm volatile("s_waitcnt lgkmcnt(0)" ::: "memory"); __builtin_amdgcn_wave_barrier(); asm volatile("" ::: "memory");
    }
    __syncthreads();
}

__device__ __forceinline__ void attn_item(const Params& p, unsigned char* shm, int item) {
    const int qb = item & 15, h = (item >> 4) & 7, b = item >> 7;
    bf16_t* P = (bf16_t*)(p.ws + OFF_P);
    const int tid = opaque_tid(), wave = tid >> 6, lane = tid & 63, lq = lane & 15, g = lane >> 4;
    const size_t rowbase = (size_t)b * SEQ;
    const int t = qb * 128 + wave * 16 + lq;
    const int tmax = qb * 128 + wave * 16 + 15;
    constexpr int ABUF = 64 * 144 + 64 * 136;
    const bf16_t* qp = P + (rowbase + t) * LDP + C_Q + h * 64 + 8 * g;
    const bf16x8 qf0 = *(const bf16x8*)qp, qf1 = *(const bf16x8*)(qp + 32);
    bf16x8 TT[4][2];
#pragma unroll
    for (int a = 0; a < 4; ++a)
#pragma unroll
        for (int ks = 0; ks < 2; ++ks)
#pragma unroll
            for (int e = 0; e < 8; ++e) { const int j = 16 * (2 * ks + (e >> 2)) + 4 * g + (e & 3); TT[a][ks][e] = (j > 16 * a + lq) ? (short)0x3F80 : (short)0; }
    f32x4 o[4];
#pragma unroll
    for (int i = 0; i < 4; ++i) o[i] = (f32x4){0.f, 0.f, 0.f, 0.f};
    float R = 0.f;
    LAS volatile int* flg = (LAS volatile int*)((LAS unsigned char*)shm + 2 * ABUF);
    const int st_s = tid >> 3, st_dc = (tid & 7) * 8;
    const bf16_t* st_base = P + (rowbase + st_s) * LDP + h * 64 + st_dc;
    auto stage_write = [&](unsigned char* buf, const u32x4& kv, const u32x4& vv) {
        bf16_t* Ksw = (bf16_t*)buf; bf16_t* Vtw = (bf16_t*)(buf + 64 * 144); const int s_ = st_s, dc = st_dc;
        *(u32x4*)(Ksw + s_ * 72 + dc) = kv;
        Vtw[(dc + 0) * 68 + s_] = (bf16_t)(vv.x & 0xFFFF); Vtw[(dc + 1) * 68 + s_] = (bf16_t)(vv.x >> 16);
        Vtw[(dc + 2) * 68 + s_] = (bf16_t)(vv.y & 0xFFFF); Vtw[(dc + 3) * 68 + s_] = (bf16_t)(vv.y >> 16);
        Vtw[(dc + 4) * 68 + s_] = (bf16_t)(vv.z & 0xFFFF); Vtw[(dc + 5) * 68 + s_] = (bf16_t)(vv.z >> 16);
        Vtw[(dc + 6) * 68 + s_] = (bf16_t)(vv.w & 0xFFFF); Vtw[(dc + 7) * 68 + s_] = (bf16_t)(vv.w >> 16);
    };
    if (tid == 0) { flg[0] = 1; flg[1] = 0; flg[2] = 0; }
    { const bf16_t* kr = st_base + (size_t)(2 * qb + 1) * 64 * LDP; const u32x4 kv0 = *(const u32x4*)(kr + C_K), vv0 = *(const u32x4*)(kr + C_V); stage_write(shm, kv0, vv0); }
    int itn = 0, cur = 0;
    for (int kt = 2 * qb + 1; kt >= 0; --kt) {
        __syncthreads();
        const int f0 = itn % 3, f1 = (itn + 1) % 3, f2 = (itn + 2) % 3;
        if (flg[f0] == 0) break;
        if (tid == 0) flg[f2] = 0;
        u32x4 kvn = (u32x4){0u, 0u, 0u, 0u}, vvn = (u32x4){0u, 0u, 0u, 0u};
        if (kt > 0) { const bf16_t* kr = st_base + (size_t)(kt - 1) * 64 * LDP; kvn = *(const u32x4*)(kr + C_K); vvn = *(const u32x4*)(kr + C_V); }
        const bf16_t* Ks = (const bf16_t*)(shm + cur * ABUF); const bf16_t* Vt = (const bf16_t*)(shm + cur * ABUF + 64 * 144);
        const bool walive = __any(R > -104.f);
        const bool act = (kt * 64 < tmax) && walive;
        if (act) {
            float lb[4][4], lk[4][4];
#pragma unroll
            for (int sub = 0; sub < 4; ++sub) {
                const bf16_t* kp = Ks + (16 * sub + lq) * 72 + 8 * g;
                const bf16x8 k0 = *(const bf16x8*)kp, k1 = *(const bf16x8*)(kp + 32);
                f32x4 s4 = (f32x4){0.f, 0.f, 0.f, 0.f};
                s4 = __builtin_amdgcn_mfma_f32_16x16x32_bf16(k0, qf0, s4, 0, 0, 0);
                s4 = __builtin_amdgcn_mfma_f32_16x16x32_bf16(k1, qf1, s4, 0, 0, 0);
#pragma unroll
                for (int r = 0; r < 4; ++r) { const float z = s4[r] * 0.125f; const bool mk = (kt * 64 + 16 * sub + 4 * g + r) < t;
                    const float l = fminf(z, 0.f) - __logf(1.f + __expf(-fabsf(z)));
                    lb[sub][r] = mk ? l : -1e30f; lk[sub][r] = mk ? (l - z) : 0.f; }
            }
            bf16x8 hi[2], lo[2];
#pragma unroll
            for (int ks = 0; ks < 2; ++ks) {
                unsigned hw[4], lw[4];
#pragma unroll
                for (int w2 = 0; w2 < 4; ++w2) { const int sub = 2 * ks + (w2 >> 1), r0 = (w2 & 1) * 2; const float a0 = lk[sub][r0], a1 = lk[sub][r0 + 1];
                    hw[w2] = cvt_pk_bf16(a0, a1); lw[w2] = cvt_pk_bf16(a0 - bf_lo(hw[w2]), a1 - bf_hi(hw[w2])); }
                u32x4 hv = (u32x4){hw[0], hw[1], hw[2], hw[3]}, lv = (u32x4){lw[0], lw[1], lw[2], lw[3]};
                hi[ks] = __builtin_bit_cast(bf16x8, hv); lo[ks] = __builtin_bit_cast(bf16x8, lv);
            }
            f32x4 aft[4];
#pragma unroll
            for (int a = 0; a < 4; ++a) { f32x4 c = (f32x4){0.f, 0.f, 0.f, 0.f};
#pragma unroll
                for (int ks = 0; ks < 2; ++ks) { c = __builtin_amdgcn_mfma_f32_16x16x32_bf16(TT[a][ks], hi[ks], c, 0, 0, 0); c = __builtin_amdgcn_mfma_f32_16x16x32_bf16(TT[a][ks], lo[ks], c, 0, 0, 0); }
                aft[a] = c; }
            float tot = aft[0][0] + lk[0][0];
            tot = __shfl(tot, lq);
            bf16x8 pf[2];
#pragma unroll
            for (int ks = 0; ks < 2; ++ks) { unsigned pw[4];
#pragma unroll
                for (int w2 = 0; w2 < 4; ++w2) { const int sub = 2 * ks + (w2 >> 1), r0 = (w2 & 1) * 2;
                    const float e0 = __expf(lb[sub][r0] + aft[sub][r0] + R), e1 = __expf(lb[sub][r0 + 1] + aft[sub][r0 + 1] + R);
                    pw[w2] = cvt_pk_bf16(e0, e1); }
                u32x4 pv = (u32x4){pw[0], pw[1], pw[2], pw[3]}; pf[ks] = __builtin_bit_cast(bf16x8, pv); }
            R += tot;
#pragma unroll
            for (int ds = 0; ds < 4; ++ds)
#pragma unroll
                for (int ks = 0; ks < 2; ++ks) { const bf16_t* vp = Vt + (16 * ds + lq) * 68 + 32 * ks + 4 * g;
                    const u32x2 v0 = *(const u32x2*)vp, v1 = *(const u32x2*)(vp + 16);
                    u32x4 vv = (u32x4){v0.x, v0.y, v1.x, v1.y};
                    o[ds] = __builtin_amdgcn_mfma_f32_16x16x32_bf16(__builtin_bit_cast(bf16x8, vv), pf[ks], o[ds], 0, 0, 0); }
        }
        if (__any(R > -104.f) && lane == 0) flg[f1] = 1;
        if (kt > 0) stage_write(shm + (cur ^ 1) * ABUF, kvn, vvn);
        cur ^= 1; ++itn;
    }
#pragma unroll
    for (int ds = 0; ds < 4; ++ds) { bf16_t* gp = P + (rowbase + t) * LDP + C_SBG + h * 64 + 16 * ds + 4 * g;
        const u32x2 gv = *(const u32x2*)gp;
        u32x2 ov; ov.x = cvt_pk_bf16(o[ds][0] * siluf_(bf_lo(gv.x)), o[ds][1] * siluf_(bf_hi(gv.x))); ov.y = cvt_pk_bf16(o[ds][2] * siluf_(bf_lo(gv.y)), o[ds][3] * siluf_(bf_hi(gv.y)));
        *(u32x2*)gp = ov; }
    __syncthreads();
}

__device__ __forceinline__ void bc_prepass(const Params& p, int layer, int blk, int nblk) {
    const bf16_t* P = (const bf16_t*)(p.ws + OFF_P); bf16_t* BCc = (bf16_t*)(p.ws + OFF_BCC);
    const float* cw = p.in[3] + (size_t)layer * 4 * 1280; const float* cb = p.in[4] + layer * 1280;
    const int gt = blk * 512 + opaque_tid(), gs = nblk * 512;
    const int c = (gt & 63) * 4, chn = 1024 + c;
    const f32x4 bias = *(const f32x4*)(cb + chn);
    f32x4 w[4];
#pragma unroll
    for (int k = 0; k < 4; ++k) w[k] = *(const f32x4*)(cw + k * 1280 + chn);
    for (int idx0 = gt; idx0 < TOK * 64; idx0 += 4 * gs) {
        u32x2 xv[4][4]; bool ok[4];
#pragma unroll
        for (int u = 0; u < 4; ++u) { const int idx = idx0 + u * gs; ok[u] = idx < TOK * 64; const int tok = ok[u] ? (idx >> 6) : 0; const int t = tok & (SEQ - 1);
            const bf16_t* xp = P + (size_t)tok * LDP + C_XBC + chn;
#pragma unroll
            for (int k = 0; k < 4; ++k) { const int ts = t - 3 + k; const unsigned xm = ts >= 0 ? 0xFFFFFFFFu : 0u;
                u32x2 x = *(const u32x2*)(xp + (ptrdiff_t)(ts >= 0 ? k - 3 : 0) * LDP); x.x &= xm; x.y &= xm; xv[u][k] = x; } }
#pragma unroll
        for (int u = 0; u < 4; ++u) { const int idx = idx0 + u * gs; const int tok = ok[u] ? (idx >> 6) : 0;
            f32x4 a = bias;
#pragma unroll
            for (int k = 0; k < 4; ++k) { a[0] += w[k][0] * bf_lo(xv[u][k].x); a[1] += w[k][1] * bf_hi(xv[u][k].x); a[2] += w[k][2] * bf_lo(xv[u][k].y); a[3] += w[k][3] * bf_hi(xv[u][k].y); }
            u32x2 o; o.x = cvt_pk_bf16(siluf_(a[0]), siluf_(a[1])); o.y = cvt_pk_bf16(siluf_(a[2]), siluf_(a[3]));
            if (ok[u]) *(u32x2*)(BCc + (size_t)tok * 256 + c) = o; }
    }
}

__device__ __forceinline__ void ssd_item(const Params& p, int layer, unsigned char* shm, int item) {
    const int ph = item & 1, hh = (item >> 1) & 15, b = item >> 5, grp = hh >> 3;
    bf16_t* P = (bf16_t*)(p.ws + OFF_P); float* SSQ = (float*)(p.ws + OFF_SSQ);
    const int tid = opaque_tid(), wave = tid >> 6, lane = tid & 63, lq = lane & 15, g = lane >> 4;
    const size_t rowbase = (size_t)b * SEQ;
    const float* cw = p.in[3] + (size_t)layer * 4 * 1280; const float* cb = p.in[4] + layer * 1280;
    const float dtb = p.in[5][layer * 16 + hh], Aneg = -__expf(p.in[6][layer * 16 + hh]), Dsk = p.in[7][layer * 16 + hh];
    float* XS = (float*)shm;
    float* YS = XS + 2048;
    float* DTs = YS + 2048;
    float* ACS = DTs + 64;
    bf16_t* Cb = (bf16_t*)(ACS + 64);
    bf16_t* Bb = Cb + 64 * 72;
    bf16_t* BT = Bb + 64 * 72;
    bf16_t* Mx = BT + 64 * 72;
    bf16_t* XT = Mx + 64 * 72;
    bf16_t* XwT = XT + 32 * 72;
    bf16_t* SbT = XwT + 32 * 72;
    f32x4 Sacc = (f32x4){0.f, 0.f, 0.f, 0.f};
    const bf16_t* BCc = (const bf16_t*)(p.ws + OFF_BCC);
    const int x_tt = tid >> 3, x_c = (tid & 7) * 4, x_chn = hh * 64 + ph * 32 + x_c;
    const int bc_q = tid & 7;
    const f32x4 xbias = *(const f32x4*)(cb + x_chn);
    f32x4 xw[4];
#pragma unroll
    for (int k = 0; k < 4; ++k) xw[k] = *(const f32x4*)(cw + k * 1280 + x_chn);
    u32x2 sx[4]; u32x4 bc0, bc1; bf16_t sdt = 0;
    auto ssd_load = [&](int tb) {
        const int t = tb + x_tt;
        const bf16_t* xp = P + (rowbase + t) * LDP + C_XBC + x_chn;
#pragma unroll
        for (int k = 0; k < 4; ++k) { const int ts = t - 3 + k; const unsigned xm = ts >= 0 ? 0xFFFFFFFFu : 0u;
            u32x2 xv = *(const u32x2*)(xp + (ptrdiff_t)(ts >= 0 ? k - 3 : 0) * LDP); xv.x &= xm; xv.y &= xm; sx[k] = xv; }
        const bf16_t* bp = BCc + (rowbase + t) * 256 + (bc_q < 4 ? grp * 64 + bc_q * 16 : 128 + grp * 64 + (bc_q - 4) * 16);
        bc0 = *(const u32x4*)bp; bc1 = *(const u32x4*)(bp + 8);
        if (tid < 64) sdt = P[(rowbase + tb + tid) * LDP + C_DT + hh];
    };
    ssd_load(0);
    for (int ch = 0; ch < SEQ / 64; ++ch) {
        const int t0 = ch * 64;
        __syncthreads();
        const int o_tt = tid >> 3, o_p4 = (tid & 7) * 4;
        bf16_t* zp = P + (rowbase + t0 + o_tt) * LDP + C_Z + hh * 64 + ph * 32 + o_p4;
        const u32x2 zv = *(const u32x2*)zp;
        { f32x4 a = xbias;
#pragma unroll
            for (int k = 0; k < 4; ++k) { a[0] += xw[k][0] * bf_lo(sx[k].x); a[1] += xw[k][1] * bf_hi(sx[k].x); a[2] += xw[k][2] * bf_lo(sx[k].y); a[3] += xw[k][3] * bf_hi(sx[k].y); }
            a[0] = siluf_(a[0]); a[1] = siluf_(a[1]); a[2] = siluf_(a[2]); a[3] = siluf_(a[3]);
            const unsigned q0 = cvt_pk_bf16(a[0], a[1]), q1 = cvt_pk_bf16(a[2], a[3]); const int tt = x_tt, c = x_c;
            *(f32x4*)(XS + tt * 32 + c) = a;
            XT[(c + 0) * 72 + tt] = (bf16_t)(q0 & 0xFFFF); XT[(c + 1) * 72 + tt] = (bf16_t)(q0 >> 16); XT[(c + 2) * 72 + tt] = (bf16_t)(q1 & 0xFFFF); XT[(c + 3) * 72 + tt] = (bf16_t)(q1 >> 16);
            if (bc_q < 4) { const int n = bc_q * 16; *(u32x4*)(Bb + tt * 72 + n) = bc0; *(u32x4*)(Bb + tt * 72 + n + 8) = bc1;
                const unsigned wv[8] = {bc0.x, bc0.y, bc0.z, bc0.w, bc1.x, bc1.y, bc1.z, bc1.w};
#pragma unroll
                for (int e = 0; e < 8; ++e) { BT[(n + 2 * e) * 72 + tt] = (bf16_t)(wv[e] & 0xFFFF); BT[(n + 2 * e + 1) * 72 + tt] = (bf16_t)(wv[e] >> 16); } }
            else { const int n = (bc_q - 4) * 16; *(u32x4*)(Cb + tt * 72 + n) = bc0; *(u32x4*)(Cb + tt * 72 + n + 8) = bc1; } }
        if (tid < 64) { const float dt = softplusf_(bf2f(sdt) + dtb); DTs[tid] = dt;
            float x = dt * Aneg;
#pragma unroll
            for (int o = 1; o < 64; o <<= 1) { const float v = __shfl_up(x, o); if (lane >= o) x += v; }
            ACS[tid] = x; }
        if (ch + 1 < SEQ / 64) ssd_load(t0 + 64);
        __syncthreads();
        const float acsL = ACS[63];
        { const int pp = tid >> 4, s4 = (tid & 15) * 4; float v[4];
#pragma unroll
            for (int e = 0; e < 4; ++e) { const int sidx = s4 + e; v[e] = XS[sidx * 32 + pp] * DTs[sidx] * __expf(acsL - ACS[sidx]); }
            *(u32x2*)(XwT + pp * 72 + s4) = (u32x2){cvt_pk_bf16(v[0], v[1]), cvt_pk_bf16(v[2], v[3])}; }
        { const int pi = wave >> 2, ni = wave & 3;
#pragma unroll
            for (int r = 0; r < 4; ++r) SbT[(16 * pi + 4 * g + r) * 72 + 16 * ni + lq] = (bf16_t)(cvt_pk_bf16(Sacc[r], 0.f) & 0xFFFF); }
        { const int ti = wave >> 1;
#pragma unroll
            for (int sj = 0; sj < 2; ++sj) { const int si = 2 * (wave & 1) + sj;
                f32x4 acc = (f32x4){0.f, 0.f, 0.f, 0.f};
                if (si <= ti) {
                    const bf16_t* ap = Cb + (16 * ti + lq) * 72 + 8 * g; const bf16_t* bp = Bb + (16 * si + lq) * 72 + 8 * g;
                    acc = __builtin_amdgcn_mfma_f32_16x16x32_bf16(*(const bf16x8*)ap, *(const bf16x8*)bp, acc, 0, 0, 0);
                    acc = __builtin_amdgcn_mfma_f32_16x16x32_bf16(*(const bf16x8*)(ap + 32), *(const bf16x8*)(bp + 32), acc, 0, 0, 0);
                }
                const int sidx = 16 * si + lq; const float as = ACS[sidx], ds = DTs[sidx];
#pragma unroll
                for (int r = 0; r < 4; ++r) { const int t = 16 * ti + 4 * g + r; const float val = (sidx <= t) ? acc[r] * __expf(ACS[t] - as) * ds : 0.f;
                    Mx[t * 72 + sidx] = (bf16_t)(cvt_pk_bf16(val, 0.f) & 0xFFFF); } } }
        __syncthreads();
        { const int ti = wave >> 1, pi = wave & 1;
            const bf16_t* ap = Mx + (16 * ti + lq) * 72 + 8 * g; const bf16_t* bp = XT + (16 * pi + lq) * 72 + 8 * g;
            const bf16_t* cp = Cb + (16 * ti + lq) * 72 + 8 * g; const bf16_t* sp = SbT + (16 * pi + lq) * 72 + 8 * g;
            f32x4 a1 = (f32x4){0.f, 0.f, 0.f, 0.f}, a2 = (f32x4){0.f, 0.f, 0.f, 0.f};
            a1 = __builtin_amdgcn_mfma_f32_16x16x32_bf16(*(const bf16x8*)ap, *(const bf16x8*)bp, a1, 0, 0, 0);
            a1 = __builtin_amdgcn_mfma_f32_16x16x32_bf16(*(const bf16x8*)(ap + 32), *(const bf16x8*)(bp + 32), a1, 0, 0, 0);
            a2 = __builtin_amdgcn_mfma_f32_16x16x32_bf16(*(const bf16x8*)cp, *(const bf16x8*)sp, a2, 0, 0, 0);
            a2 = __builtin_amdgcn_mfma_f32_16x16x32_bf16(*(const bf16x8*)(cp + 32), *(const bf16x8*)(sp + 32), a2, 0, 0, 0);
#pragma unroll
            for (int r = 0; r < 4; ++r) { const int t = 16 * ti + 4 * g + r, pc = 16 * pi + lq;
                YS[t * 32 + pc] = a1[r] + __expf(ACS[t]) * a2[r] + Dsk * XS[t * 32 + pc]; } }
        { const int pi = wave >> 2, ni = wave & 3; const float dl = __expf(acsL);
            Sacc = Sacc * dl;
            const bf16_t* ap = XwT + (16 * pi + lq) * 72 + 8 * g; const bf16_t* bp = BT + (16 * ni + lq) * 72 + 8 * g;
            Sacc = __builtin_amdgcn_mfma_f32_16x16x32_bf16(*(const bf16x8*)ap, *(const bf16x8*)bp, Sacc, 0, 0, 0);
            Sacc = __builtin_amdgcn_mfma_f32_16x16x32_bf16(*(const bf16x8*)(ap + 32), *(const bf16x8*)(bp + 32), Sacc, 0, 0, 0); }
        __syncthreads();
        { const int tt = o_tt, p4 = o_p4; const f32x4 y4 = *(const f32x4*)(YS + tt * 32 + p4);
            const float u0 = y4[0] * siluf_(bf_lo(zv.x)), u1 = y4[1] * siluf_(bf_hi(zv.x)), u2 = y4[2] * siluf_(bf_lo(zv.y)), u3 = y4[3] * siluf_(bf_hi(zv.y));
            u32x2 ov; ov.x = cvt_pk_bf16(u0, u1); ov.y = cvt_pk_bf16(u2, u3); *(u32x2*)zp = ov;
            float q = u0 * u0 + u1 * u1 + u2 * u2 + u3 * u3;
            q += __shfl_xor(q, 1); q += __shfl_xor(q, 2); q += __shfl_xor(q, 4);
            if ((tid & 7) == 0) SSQ[(rowbase + t0 + tt) * 32 + hh * 2 + ph] = q; }
    }
    __syncthreads();
}

__device__ __forceinline__ float fast_tanh(float x) { return 1.f - 2.f * __builtin_amdgcn_rcpf(1.f + __expf(2.f * x)); }
__device__ __forceinline__ void pbar4(LAS volatile unsigned* cnt, unsigned& tgt, int lane) {
    tgt += 4u;
    asm volatile("s_waitcnt lgkmcnt(0)" ::: "memory");
    if (lane == 0) __hip_atomic_fetch_add((LAS unsigned*)cnt, 1u, __ATOMIC_RELAXED, __HIP_MEMORY_SCOPE_WORKGROUP);
    while (*cnt < tgt) __builtin_amdgcn_s_sleep(1);
    asm volatile("" ::: "memory");
}
__device__ __forceinline__ void rwkv_item(const Params& p, int layer, unsigned char* shm, int item) {
    const int half = item & 1, h = (item >> 1) & 7, b = item >> 4;
    bf16_t* P = (bf16_t*)(p.ws + OFF_P); bf16_t* YRAW = (bf16_t*)(p.ws + OFF_YRAW); float* BONUS = (float*)(p.ws + OFF_BONUS);
    const int tid = opaque_tid(), wave = tid >> 6, lane = tid & 63, lq = lane & 15, g = lane >> 4;
    const size_t rowbase = (size_t)b * SEQ;
    const float* mu = p.in[9] + layer * 2176;
    const float* w0 = p.in[10] + layer * 512; const float* wup = p.in[11] + (size_t)layer * 64 * 512;
    const float* a0 = p.in[12] + layer * 512; const float* aup = p.in[13] + (size_t)layer * 64 * 512;
    const float* kkp = p.in[14] + layer * 512; const float* kap = p.in[15] + layer * 512; const float* rkp = p.in[16] + layer * 512;
    constexpr int SETF = 6 * 2048;
    float* SET0 = (float*)shm;
    float* AA = SET0 + 2 * SETF;
    float* Yb = AA + 2048;
    bf16_t* WLb = (bf16_t*)(Yb + 2048);
    bf16_t* ALb = WLb + 32 * 72;
    LAS volatile unsigned* pcnt = (LAS volatile unsigned*)((LAS unsigned char*)shm + (2 * SETF + 2048 + 2048) * 4 + 2 * 32 * 72 * 2);
    const int csub = wave & 3;
    bf16x8 bfr[2][2]; float lw0[2];
#pragma unroll
    for (int mat = 0; mat < 2; ++mat) { const float* up = (mat ? aup : wup) + h * 64 + csub * 16 + lq;
#pragma unroll
        for (int ks = 0; ks < 2; ++ks) { unsigned w[4];
#pragma unroll
            for (int e2 = 0; e2 < 4; ++e2) { const int m0 = 32 * ks + 8 * g + 2 * e2; w[e2] = cvt_pk_bf16(up[(size_t)m0 * 512], up[(size_t)(m0 + 1) * 512]); }
            u32x4 wv = (u32x4){w[0], w[1], w[2], w[3]}; bfr[mat][ks] = __builtin_bit_cast(bf16x8, wv); }
        lw0[mat] = (mat ? a0 : w0)[h * 64 + csub * 16 + lq]; }
    const int ej = (tid & 15) * 4;
    const f32x4 c_kk = *(const f32x4*)(kkp + h * 64 + ej), c_ka = *(const f32x4*)(kap + h * 64 + ej), c_rk = *(const f32x4*)(rkp + h * 64 + ej);
    const f32x4 mu_r = *(const f32x4*)(mu + h * 64 + ej), mu_k = *(const f32x4*)(mu + 512 + h * 64 + ej), mu_v = *(const f32x4*)(mu + 1024 + h * 64 + ej);
    const f32x4 mu_w = *(const f32x4*)(mu + 2048 + ej), mu_a = *(const f32x4*)(mu + 2112 + ej);
    f32x4 sA = (f32x4){0.f, 0.f, 0.f, 0.f}, sB = (f32x4){0.f, 0.f, 0.f, 0.f};
    const int irow = half * 32 + (wave & 3) * 8 + g * 2;
    unsigned ptgt = 0u;
    const int pm = tid - 256, e2t = pm >> 4;
    u32x2 cva[2][5], pva[2][5];
    auto rw_load = [&](int ch) {
#pragma unroll
        for (int ps = 0; ps < 2; ++ps) { const int tl = e2t + 16 * ps, t = ch * 32 + tl; const bf16_t* cur = P + (rowbase + t) * LDP + C_RW; const bool hp = t > 0; const bf16_t* prv = hp ? cur - LDP : cur;
#pragma unroll
            for (int i = 0; i < 5; ++i) { const int col = (i == 0 ? h * 64 : i == 1 ? 512 + h * 64 : i == 2 ? 1024 + h * 64 : i == 3 ? 2048 : 2112) + ej;
                cva[ps][i] = *(const u32x2*)(cur + col); pva[ps][i] = *(const u32x2*)(prv + col); } }
    };
    auto prep = [&](int ch, float* SET) {
        float* Rm = SET; float* Km = SET + 2048; float* Vm = SET + 4096; float* DEC = SET + 6144; float* KK = SET + 8192; float* BB = SET + 10240;
#pragma unroll
        for (int ps = 0; ps < 2; ++ps) { const int tl = e2t + 16 * ps, t = ch * 32 + tl; const unsigned pmask = t > 0 ? 0xFFFFFFFFu : 0u;
#pragma unroll
            for (int i = 0; i < 5; ++i) {
                const u32x2 cv = cva[ps][i]; u32x2 pv = pva[ps][i]; pv.x &= pmask; pv.y &= pmask;
                const f32x4 m4 = i == 0 ? mu_r : i == 1 ? mu_k : i == 2 ? mu_v : i == 3 ? mu_w : mu_a;
                float c[4] = {bf_lo(cv.x), bf_hi(cv.x), bf_lo(cv.y), bf_hi(cv.y)}; const float q[4] = {bf_lo(pv.x), bf_hi(pv.x), bf_lo(pv.y), bf_hi(pv.y)};
#pragma unroll
                for (int e = 0; e < 4; ++e) c[e] = c[e] + (q[e] - c[e]) * m4[e];
                if (i == 0) *(f32x4*)(Rm + tl * 64 + ej) = (f32x4){c[0], c[1], c[2], c[3]};
                else if (i == 1) *(f32x4*)(Km + tl * 64 + ej) = (f32x4){c[0], c[1], c[2], c[3]};
                else if (i == 2) *(f32x4*)(Vm + tl * 64 + ej) = (f32x4){c[0], c[1], c[2], c[3]};
                else if (i == 3) { u32x2 o; o.x = cvt_pk_bf16(fast_tanh(c[0]), fast_tanh(c[1])); o.y = cvt_pk_bf16(fast_tanh(c[2]), fast_tanh(c[3])); *(u32x2*)(WLb + tl * 72 + ej) = o; }
                else { u32x2 o; o.x = cvt_pk_bf16(c[0], c[1]); o.y = cvt_pk_bf16(c[2], c[3]); *(u32x2*)(ALb + tl * 72 + ej) = o; } } }
        if (ch + 1 < SEQ / 32) rw_load(ch + 1);
        pbar4(pcnt, ptgt, lane);
#pragma unroll
        for (int mat = 0; mat < 2; ++mat)
#pragma unroll
            for (int ts = 0; ts < 2; ++ts) { const bf16_t* ap = (mat ? ALb : WLb) + (16 * ts + lq) * 72 + 8 * g;
                const bf16x8 a0f = *(const bf16x8*)ap, a1f = *(const bf16x8*)(ap + 32);
                f32x4 c = (f32x4){0.f, 0.f, 0.f, 0.f};
                c = __builtin_amdgcn_mfma_f32_16x16x32_bf16(a0f, bfr[mat][0], c, 0, 0, 0);
                c = __builtin_amdgcn_mfma_f32_16x16x32_bf16(a1f, bfr[mat][1], c, 0, 0, 0);
#pragma unroll
                for (int r = 0; r < 4; ++r) { const int tt = 16 * ts + 4 * g + r; const float x = lw0[mat] + c[r];
                    if (mat == 0) DEC[tt * 64 + csub * 16 + lq] = __expf(-0.60653066f * sigmoidf_(x));
                    else AA[tt * 64 + csub * 16 + lq] = sigmoidf_(x); } }
        pbar4(pcnt, ptgt, lane);
#pragma unroll
        for (int ps = 0; ps < 2; ++ps) { const int tl = e2t + 16 * ps;
            const f32x4 k4 = *(const f32x4*)(Km + tl * 64 + ej), a4 = *(const f32x4*)(AA + tl * 64 + ej), r4 = *(const f32x4*)(Rm + tl * 64 + ej);
            f32x4 kr, kt; float ss = 0.f, bo = 0.f;
#pragma unroll
            for (int e = 0; e < 4; ++e) { kr[e] = k4[e] * c_kk[e]; ss += kr[e] * kr[e]; kt[e] = k4[e] * (1.f + (a4[e] - 1.f) * c_ka[e]); bo += r4[e] * kt[e] * c_rk[e]; }
            ss = allred16(ss); bo = allred16(bo);
            const float inv = __builtin_amdgcn_rsqf(fmaxf(ss, 1e-24f));
            f32x4 kk4, b4;
#pragma unroll
            for (int e = 0; e < 4; ++e) { kk4[e] = kr[e] * inv; b4[e] = kk4[e] * a4[e]; }
            *(f32x4*)(Km + tl * 64 + ej) = kt; *(f32x4*)(KK + tl * 64 + ej) = kk4; *(f32x4*)(BB + tl * 64 + ej) = b4;
            if (half == 0 && (tid & 15) == 0) BONUS[(rowbase + ch * 32 + tl) * 8 + h] = bo; }
    };
    auto yraw_store = [&](int ch) {
#pragma unroll
        for (int ps = 0; ps < 2; ++ps)
#pragma unroll
            for (int q = 0; q < 2; ++q) { const int tl = e2t + 16 * ps, il = (tid & 15) + 16 * q;
                YRAW[(rowbase + ch * 32 + tl) * 512 + h * 64 + half * 32 + il] = (bf16_t)(cvt_pk_bf16(Yb[(ch & 1) * 1024 + tl * 32 + il], 0.f) & 0xFFFF); }
    };
    if (tid == 0) *pcnt = 0u;
    __syncthreads();
    if (wave >= 4) { rw_load(0); prep(0, SET0); }
    for (int ch = 0; ch < SEQ / 32; ++ch) {
        __syncthreads();
        if (wave < 4) {
            const float* SET = SET0 + (ch & 1) * SETF;
            const float* Rm = SET; const float* Km = SET + 2048; const float* Vm = SET + 4096; const float* DEC = SET + 6144; const float* KK = SET + 8192; const float* BB = SET + 10240;
            float* Yw = Yb + (ch & 1) * 1024;
            struct Ops { f32x4 w, k, q, b, r; float v0, v1; };
            auto ld = [&](Ops& o, int tt) { const int off = tt * 64 + lq * 4;
                o.w = *(const f32x4*)(DEC + off); o.k = *(const f32x4*)(Km + off); o.q = *(const f32x4*)(KK + off); o.b = *(const f32x4*)(BB + off); o.r = *(const f32x4*)(Rm + off);
                const float* vp = Vm + tt * 64 + irow; o.v0 = vp[0]; o.v1 = vp[1]; };
            auto step = [&](const Ops& o, int tt) {
                const f32x4 da = sA * o.q, db = sB * o.q; float sa0 = (da[0] + da[1]) + (da[2] + da[3]), sa1 = (db[0] + db[1]) + (db[2] + db[3]);
                const f32x4 uA = sA * o.w + o.k * o.v0, uB = sB * o.w + o.k * o.v1;
                sa0 = -allred16(sa0); sa1 = -allred16(sa1);
                sA = uA + o.b * sa0; sB = uB + o.b * sa1;
                const f32x4 ea = sA * o.r, eb = sB * o.r; float y0 = (ea[0] + ea[1]) + (ea[2] + ea[3]), y1 = (eb[0] + eb[1]) + (eb[2] + eb[3]);
                y0 = allred16(y0); y1 = allred16(y1);
                if (lq == 0) { float* yp = Yw + tt * 32 + (wave & 3) * 8 + g * 2; yp[0] = y0; yp[1] = y1; } };
            Ops oa, ob;
            ld(oa, 0);
            for (int tt = 0; tt < 32; tt += 2) {
                ld(ob, tt + 1);
                step(oa, tt);
                ld(oa, (tt + 2 < 32) ? tt + 2 : 31);
                step(ob, tt + 1);
            }
        } else {
            if (ch > 0) yraw_store(ch - 1);
            if (ch + 1 < SEQ / 32) prep(ch + 1, SET0 + ((ch + 1) & 1) * SETF);
        }
    }
    __syncthreads();
    if (wave >= 4) yraw_store(SEQ / 32 - 1);
    __syncthreads();
}

__device__ __forceinline__ void rw_post(const Params& p, int layer) {
    bf16_t* P = (bf16_t*)(p.ws + OFF_P); const bf16_t* YRAW = (const bf16_t*)(p.ws + OFF_YRAW);
    const float* BONUS = (const float*)(p.ws + OFF_BONUS); const float* SSQ = (const float*)(p.ws + OFF_SSQ); float* RSTD = (float*)(p.ws + OFF_RSTD);
    const float* mu = p.in[9] + layer * 2176; const float* lng = p.in[17] + layer * 512; const float* lnb = p.in[18] + layer * 512;
    const int gt = blockIdx.x * 512 + opaque_tid(), gs = gridDim.x * 512;
    {
        const int c = (gt & 127) * 4, h = c >> 6;
        const f32x4 muv = *(const f32x4*)(mu + 1024 + c), mug = *(const f32x4*)(mu + 1536 + c);
        const f32x4 lg = *(const f32x4*)(lng + c), lb = *(const f32x4*)(lnb + c);
        for (int idx0 = gt; idx0 < TOK * 128; idx0 += 4 * gs) {
            u32x2 yv[4], vc[4], gc[4], vp[4], gp[4]; float bn[4]; unsigned pm[4]; bool ok[4];
#pragma unroll
            for (int u = 0; u < 4; ++u) { const int idx = idx0 + u * gs; ok[u] = idx < TOK * 128; const int tok = ok[u] ? (idx >> 7) : 0;
                const bf16_t* cur = P + (size_t)tok * LDP + C_RW; const bool hp = (tok & (SEQ - 1)) > 0; const bf16_t* prv = hp ? cur - LDP : cur; pm[u] = hp ? 0xFFFFFFFFu : 0u;
                yv[u] = *(const u32x2*)(YRAW + (size_t)tok * 512 + c);
                vc[u] = *(const u32x2*)(cur + 1024 + c); gc[u] = *(const u32x2*)(cur + 1536 + c);
                vp[u] = *(const u32x2*)(prv + 1024 + c); gp[u] = *(const u32x2*)(prv + 1536 + c);
                bn[u] = BONUS[(size_t)tok * 8 + h]; }
#pragma unroll
            for (int u = 0; u < 4; ++u) { const int idx = idx0 + u * gs; const int tok = ok[u] ? (idx >> 7) : 0;
                float y[4] = {bf_lo(yv[u].x), bf_hi(yv[u].x), bf_lo(yv[u].y), bf_hi(yv[u].y)};
                const float mean = allred16(y[0] + y[1] + y[2] + y[3]) * (1.f / 64.f);
                float d[4], vs = 0.f;
#pragma unroll
                for (int e = 0; e < 4; ++e) { d[e] = y[e] - mean; vs += d[e] * d[e]; }
                const float var = allred16(vs) * (1.f / 64.f);
                const float rs = rsqrtf(var + 64e-5f);
                const unsigned m = pm[u];
                const float vcur[4] = {bf_lo(vc[u].x), bf_hi(vc[u].x), bf_lo(vc[u].y), bf_hi(vc[u].y)}, vprv[4] = {bf_lo(vp[u].x & m), bf_hi(vp[u].x & m), bf_lo(vp[u].y & m), bf_hi(vp[u].y & m)};
                const float gcur[4] = {bf_lo(gc[u].x), bf_hi(gc[u].x), bf_lo(gc[u].y), bf_hi(gc[u].y)}, gprv[4] = {bf_lo(gp[u].x & m), bf_hi(gp[u].x & m), bf_lo(gp[u].y & m), bf_hi(gp[u].y & m)};
                float o[4];
#pragma unroll
                for (int e = 0; e < 4; ++e) { const float vm = vcur[e] + (vprv[e] - vcur[e]) * muv[e], gm = gcur[e] + (gprv[e] - gcur[e]) * mug[e];
                    o[e] = (d[e] * rs * lg[e] + lb[e] + bn[u] * vm) * siluf_(gm); }
                u32x2 ov; ov.x = cvt_pk_bf16(o[0], o[1]); ov.y = cvt_pk_bf16(o[2], o[3]);
                if (ok[u]) *(u32x2*)(P + (size_t)tok * LDP + C_YRW + c) = ov; }
        }
    }
    for (int tok = gt; tok < TOK; tok += gs) { const f32x4* q = (const f32x4*)(SSQ + (size_t)tok * 32); float s = 0.f;
#pragma unroll
        for (int i = 0; i < 8; ++i) { const f32x4 v = q[i]; s += v[0] + v[1] + v[2] + v[3]; }
        RSTD[tok] = rsqrtf(s * (1.f / 1024.f) + 1e-6f); }
}

#define XB_TMO      128
#define XB_XCNT(j)  (256  + 64 * (j))
#define XB_XSUB(j)  (1280 + 64 * (j))
#define XB_XGEN(j)  (2304 + 64 * (j))
#define XB_TOP      3328
#define XB_TOPGEN   3392
#define XCD_BAR_WORDS 3456
#define XB_SPIN_CAP (1u << 18)
__device__ __forceinline__ unsigned xb_ld(unsigned* p)              { return __hip_atomic_load(p, __ATOMIC_RELAXED, __HIP_MEMORY_SCOPE_AGENT); }
__device__ __forceinline__ unsigned xb_add(unsigned* p, unsigned v) { return __hip_atomic_fetch_add(p, v, __ATOMIC_RELAXED, __HIP_MEMORY_SCOPE_AGENT); }
__device__ __forceinline__ unsigned xb_xcc_id() { return (unsigned)__builtin_amdgcn_s_getreg((3 << 11) | 20) & 0xFu; }
#define XB_SPIN(cond, bar) do { unsigned _sp = 0; while (cond) { __builtin_amdgcn_s_sleep(1); \
    if ((++_sp & 255u) == 0u) { if (xb_ld(&(bar)[XB_TMO])) break; if (_sp > XB_SPIN_CAP) { atomicAdd(&(bar)[XB_TMO], 1u); break; } } } } while (0)
struct XcdBarrier { unsigned* bar; unsigned x; volatile LAS unsigned* st; };
__device__ __forceinline__ XcdBarrier xcd_barrier_post(unsigned* bar, volatile LAS unsigned* st) {
    XcdBarrier b; b.bar = bar; b.x = xb_xcc_id(); b.st = st;
    if (threadIdx.x == 0) (void)xb_add(&bar[XB_XCNT(b.x)], 1u);
    return b;
}
__device__ __forceinline__ void xcd_barrier_complete(unsigned* bar, unsigned x, unsigned& nloc, unsigned& nx) {
    const unsigned G = gridDim.x * gridDim.y * gridDim.z;
    unsigned sum, cnt, mine, sp = 0u;
    for (;;) {
        sum = 0u; cnt = 0u; mine = 0u;
#pragma unroll
        for (unsigned j = 0; j < 16; ++j) { const unsigned c = xb_ld(&bar[XB_XCNT(j)]); sum += c; cnt += (c > 0u) ? 1u : 0u; mine = (j == x) ? c : mine; }
        if (sum == G) break;
        __builtin_amdgcn_s_sleep(1);
        if ((++sp & 255u) == 0u) { if (xb_ld(&bar[XB_TMO])) break; if (sp > XB_SPIN_CAP) { atomicAdd(&bar[XB_TMO], 1u); break; } }
    }
    nloc = mine > 0u ? mine : 1u; nx = cnt > 0u ? cnt : 1u;
}
__device__ __forceinline__ void xcd_barrier(const XcdBarrier& b) {
    asm volatile("s_waitcnt vmcnt(0)" ::: "memory");
    __syncthreads();
    if (threadIdx.x == 0) {
        unsigned* bar = b.bar;
        __builtin_amdgcn_s_waitcnt(0);
        unsigned nloc = b.st[0], nx = b.st[1];
        if (nloc == 0u) { xcd_barrier_complete(bar, b.x, nloc, nx); b.st[0] = nloc; b.st[1] = nx; }
        const unsigned old = xb_add(&bar[XB_XSUB(b.x)], 1u);
        const unsigned gen = old / nloc;
        if (old + 1u == (gen + 1u) * nloc) {
            __builtin_amdgcn_fence(__ATOMIC_RELEASE, "agent");
            asm volatile("s_waitcnt vmcnt(0)" ::: "memory");
            const unsigned og = xb_add(&bar[XB_TOP], 1u);
            const unsigned tg = og / nx;
            if (og + 1u == (tg + 1u) * nx) xb_add(&bar[XB_TOPGEN], 1u);
            else XB_SPIN(xb_ld(&bar[XB_TOPGEN]) == tg, bar);
            __builtin_amdgcn_fence(__ATOMIC_ACQUIRE, "agent");
            xb_add(&bar[XB_XGEN(b.x)], 1u);
            asm volatile("s_waitcnt vmcnt(0)" ::: "memory");
        } else {
            XB_SPIN(xb_ld(&bar[XB_XGEN(b.x)]) == gen, bar);
            __builtin_amdgcn_fence(__ATOMIC_ACQUIRE, "agent");
            asm volatile("s_waitcnt vmcnt(0)" ::: "memory");
        }
    }
    __syncthreads();
}

#define GSYNC() xcd_barrier(xb)
__global__ void __launch_bounds__(512, 2) mega(Params p) {
    extern __shared__ __attribute__((aligned(16))) unsigned char shm[];
    cg::grid_group grid = cg::this_grid();
    volatile LAS unsigned* xst = (volatile LAS unsigned*)((LAS unsigned char*)shm + LDS_BYTES - 16);
    if (threadIdx.x == 0) { xst[0] = 0u; xst[1] = 0u; }
    __syncthreads();
    const XcdBarrier xb = xcd_barrier_post((unsigned*)(p.ws + OFF_BAR), xst);
    const char* Pc = (const char*)(p.ws + OFF_P); const char* WTc = (const char*)(p.ws + OFF_WT);
    bf16_t* P = (bf16_t*)(p.ws + OFF_P);
    const int G = gridDim.x, c = blockIdx.x;
    for (int layer = 0; layer < 2; ++layer) {
        phase0(p, layer, shm);
        if (layer == 0) grid.sync(); else GSYNC();
        { SchedInproj S{Pc, WTc, G, c}; EpiInproj E{P}; pg8::gemm_phase<true>((LAS unsigned char*)shm, S, E); }
        GSYNC();
        { const int Gh = G >> 1;
            if (c < Gh) { for (int it = c; it < 128; it += Gh) rwkv_item(p, layer, shm, it); }
            else { const int c2 = c - Gh;
                bc_prepass(p, layer, c2, G - Gh);
                asm volatile("s_waitcnt vmcnt(0)" ::: "memory");
                __syncthreads();
                if (threadIdx.x == 0) { unsigned* cw_ = (unsigned*)(p.ws + OFF_BAR) + 3520; const unsigned need = (unsigned)(G - Gh) * (unsigned)(layer + 1);
                    __builtin_amdgcn_fence(__ATOMIC_RELEASE, "agent"); asm volatile("s_waitcnt vmcnt(0)" ::: "memory");
                    (void)xb_add(cw_, 1u);
                    unsigned sp_ = 0; while (xb_ld(cw_) < need) { __builtin_amdgcn_s_sleep(2); if (++sp_ > (1u << 22)) break; }
                    __builtin_amdgcn_fence(__ATOMIC_ACQUIRE, "agent"); asm volatile("s_waitcnt vmcnt(0)" ::: "memory"); }
                __syncthreads();
                for (int it = c2; it < 256; it += Gh) ssd_item(p, layer, shm, it);
                for (int it = c2; it < 1024; it += Gh) attn_item(p, shm, it); } }
        GSYNC();
        rw_post(p, layer);
        GSYNC();
        { SchedC1 S{Pc, WTc, G, c}; EpiC1 E{P, (const float*)(p.ws + OFF_RSTD)}; pg8::gemm_phase<true>((LAS unsigned char*)shm, S, E); }
        GSYNC();
        { SchedOut S{Pc, WTc, G, c}; EpiOut E{layer == 0 ? p.in[0] : p.out, p.out}; pg8::gemm_phase<false>((LAS unsigned char*)shm, S, E); }
        GSYNC();
    }
    { const int tid = opaque_tid(), wave = tid >> 6, lane = tid & 63; const float* fg = p.in[23];
        for (int row = blockIdx.x * 8 + wave; row < TOK; row += gridDim.x * 8) { float* xr = p.out + (size_t)row * DM;
            f32x4 v[4]; float ss = 0.f;
#pragma unroll
            for (int i = 0; i < 4; ++i) { v[i] = *(const f32x4*)(xr + i * 256 + lane * 4); ss += v[i][0] * v[i][0] + v[i][1] * v[i][1] + v[i][2] * v[i][2] + v[i][3] * v[i][3]; }
            ss = wave_sum(ss);
            const float rs = rsqrtf(ss * (1.f / DM) + 1e-6f);
#pragma unroll
            for (int i = 0; i < 4; ++i) { const f32x4 g = *(const f32x4*)(fg + i * 256 + lane * 4); *(f32x4*)(xr + i * 256 + lane * 4) = v[i] * rs * g; } } }
}

extern "C" void kernel_launch(void* const* d_in, const int* in_sizes, int n_in, void* d_out, int out_size, void* d_ws, size_t ws_size, hipStream_t stream) {
    static int grid_blocks = 0;
    if (grid_blocks == 0) {
        if (n_in != 24 || out_size != TOK * DM || ws_size < WS_NEED) { fprintf(stderr, "kernel_launch: unexpected shapes (n_in %d out %d ws %zu need %zu)\n", n_in, out_size, ws_size, (size_t)WS_NEED); grid_blocks = -1; return; }
        int dev = 0, cus = 0, per_cu = 0;
        hipGetDevice(&dev);
        hipDeviceGetAttribute(&cus, hipDeviceAttributeMultiprocessorCount, dev);
        hipFuncSetAttribute((const void*)mega, hipFuncAttributeMaxDynamicSharedMemorySize, LDS_BYTES);
        hipOccupancyMaxActiveBlocksPerMultiprocessor(&per_cu, (const void*)mega, 512, LDS_BYTES);
        if (per_cu < 1) { fprintf(stderr, "kernel_launch: occupancy query says %d blocks per CU\n", per_cu); grid_blocks = -1; return; }
        if (per_cu > 1) per_cu = 1;
        grid_blocks = cus * per_cu;
        grid_blocks &= ~7;
    }
    if (grid_blocks < 0) return;
    Params p{};
    for (int i = 0; i < 24; ++i) p.in[i] = (const float*)d_in[i];
    p.out = (float*)d_out; p.ws = (unsigned char*)d_ws;
    (void)hipMemsetAsync((unsigned char*)d_ws + OFF_BAR, 0, SZ_BAR, stream);
    void* args[] = {&p};
    hipError_t e = hipLaunchCooperativeKernel((const void*)mega, dim3(grid_blocks), dim3(512), args, LDS_BYTES, stream);
    if (e != hipSuccess) fprintf(stderr, "cooperative launch failed: %s (grid %d)\n", hipGetErrorString(e), grid_blocks);
}
```

```cpp
#include <hip/hip_runtime.h>
#include <hip/hip_cooperative_groups.h>
#include <cstdio>
namespace cg = cooperative_groups;

#define LAS __attribute__((address_space(3)))
typedef unsigned short bf16_t;
typedef short bf16x8 __attribute__((ext_vector_type(8)));
typedef float f32x4 __attribute__((ext_vector_type(4)));
typedef unsigned u32x4 __attribute__((ext_vector_type(4)));
typedef unsigned u32x2 __attribute__((ext_vector_type(2)));

constexpr int TOK = 16384, SEQ = 2048, DM = 1024, NIN = 9616;
constexpr int LDP = 7680;
constexpr int C_Q = 0, C_K = 512, C_V = 1024, C_SBG = 1536, C_Z = 2048, C_XBC = 3072, C_RW = 4352, C_DT = 6528, C_H = 6656;
constexpr int C_M = 0, C_G = 3072, C_YRW = 4352;
constexpr int R_GATE = 6656, R_SB = 9728, R_SSD = 10752, R_RWO = 11776, R_WO = 12800, WT_ROWS = 13824;
constexpr size_t OFF_P = 0, SZ_P = (size_t)TOK * LDP * 2;
constexpr size_t OFF_WT = OFF_P + SZ_P, SZ_WT = (size_t)WT_ROWS * 1024 * 2;
constexpr size_t OFF_YRAW = OFF_WT + SZ_WT, SZ_YRAW = (size_t)TOK * 512 * 2;
constexpr size_t OFF_SSQ = OFF_YRAW + SZ_YRAW, SZ_SSQ = (size_t)TOK * 32 * 4;
constexpr size_t OFF_RSTD = OFF_SSQ + SZ_SSQ, SZ_RSTD = (size_t)TOK * 4;
constexpr size_t OFF_BONUS = OFF_RSTD + SZ_RSTD, SZ_BONUS = (size_t)TOK * 8 * 4;
constexpr size_t OFF_BAR = OFF_BONUS + SZ_BONUS, SZ_BAR = 16384;
constexpr size_t OFF_BCC = OFF_BAR + SZ_BAR, SZ_BCC = (size_t)TOK * 256 * 2;
constexpr size_t WS_NEED = OFF_BCC + SZ_BCC;
constexpr int LDS_BYTES = 135168;

struct Params { const float* in[24]; float* out; unsigned char* ws; };

typedef float f32x2_t __attribute__((ext_vector_type(2)));
typedef __bf16 bf16x2_t __attribute__((ext_vector_type(2)));
__device__ __forceinline__ unsigned cvt_pk_bf16(float lo, float hi) { const f32x2_t v = {lo, hi}; return __builtin_bit_cast(unsigned, __builtin_convertvector(v, bf16x2_t)); }
__device__ __forceinline__ float bf_lo(unsigned u) { return __uint_as_float(u << 16); }
__device__ __forceinline__ float bf_hi(unsigned u) { return __uint_as_float(u & 0xFFFF0000u); }
__device__ __forceinline__ float bf2f(bf16_t h) { return __uint_as_float(((unsigned)h) << 16); }
__device__ __forceinline__ float sigmoidf_(float x) { return __builtin_amdgcn_rcpf(1.f + __expf(-x)); }
__device__ __forceinline__ float siluf_(float x) { return x * __builtin_amdgcn_rcpf(1.f + __expf(-x)); }
__device__ __forceinline__ float softplusf_(float x) { return fmaxf(x, 0.f) + __logf(1.f + __expf(-fabsf(x))); }
template <int CTRL> __device__ __forceinline__ float dppf(float x) { return __int_as_float(__builtin_amdgcn_update_dpp(0, __float_as_int(x), CTRL, 0xF, 0xF, true)); }
__device__ __forceinline__ float allred16(float x) { x += dppf<0xB1>(x); x += dppf<0x4E>(x); x += dppf<0x141>(x); x += dppf<0x140>(x); return x; }
__device__ __forceinline__ int opaque_tid() { int t; asm volatile("v_mov_b32 %0, %1" : "=v"(t) : "v"((int)threadIdx.x)); return t; }
__device__ __forceinline__ float wave_sum(float v) {
#pragma unroll
    for (int o = 1; o < 64; o <<= 1) v += __shfl_xor(v, o);
    return v;
}

namespace pg8 {
constexpr int BM = 256, BK = 64, HALF = 128, HTB = HALF * BK * 2, NXCD = 8, WGM = 8;
constexpr unsigned LDA_B = LDP * 2, LDB_B = 2048;
__device__ __forceinline__ int lds_byte(int r, int c) { const int st = (r >> 4) * 2 + (c >> 5), rr = r & 15, cc = c & 31, ob = rr * 64 + cc * 2; return st * 1024 + (ob ^ (((ob >> 9) & 1) << 5)); }
__device__ __forceinline__ void stage_rc(int b, int& R, int& C) { const int st = b / 1024, sb = b % 1024, swz = sb ^ (((sb >> 9) & 1) << 5); R = (st >> 1) * 16 + swz / 64; C = (st & 1) * 32 + (swz % 64) / 2; }
__device__ __forceinline__ int perm32(int rho) { const int n = rho >> 4, i = rho & 15; return 8 * (i >> 2) + 4 * n + (i & 3); }
struct UnitD { const char* A; const char* B; int nt, pm, pn, kind; };
__device__ __forceinline__ void tile_of(int L, int nM, int nN, int& pm, int& pn) {
    const int nwg = nM * nN; int wgid = L;
    { const int q = nwg / NXCD, r = nwg % NXCD, xcd = wgid % NXCD, off = wgid / NXCD; wgid = (xcd < r ? xcd * (q + 1) : r * (q + 1) + (xcd - r) * q) + off; }
    const int nig = WGM * nN, gid = wgid / nig, fm = gid * WGM, gsz = (nM - fm) < WGM ? (nM - fm) : WGM;
    pm = fm + ((wgid % nig) % gsz); pn = (wgid % nig) / gsz;
}

template <bool PERM, class Sched, class Epi>
__device__ __forceinline__ void gemm_phase(LAS unsigned char* lds, const Sched& S, const Epi& E) {
    const int tid = opaque_tid(), wid = __builtin_amdgcn_readfirstlane(tid >> 6), lane = tid & 63, wr = wid >> 2, wc = wid & 3, fr = lane & 15, fq = lane >> 4;
    unsigned voffA[2], voffB[2];
#pragma unroll
    for (int i = 0; i < 2; ++i) { int R, C; stage_rc(tid * 16 + i * 8192, R, C); const int Rb = PERM ? ((R & ~31) + perm32(R & 31)) : R;
        voffA[i] = (unsigned)R * LDA_B + (unsigned)C * 2u; voffB[i] = (unsigned)Rb * LDB_B + (unsigned)C * 2u; }
    const size_t kstep = (size_t)(BK * 2);
    const size_t hstepA = (size_t)HALF * LDA_B, hstepB = (size_t)HALF * LDB_B;
    const unsigned ldsw = (unsigned)wid * 1024u;
    const int aoff = lds_byte(wr * 64 + fr, fq * 8), boff = lds_byte(wc * 32 + fr, fq * 8);
#define PG8_SA(b, h) (((b) * 2 + (h)) * HTB)
#define PG8_SB(b, h) ((4 + (b) * 2 + (h)) * HTB)
#define PG8_STAGE(bufoff, gbase, voff) do { _Pragma("unroll") for (int _i = 0; _i < 2; ++_i) \
        __builtin_amdgcn_global_load_lds((const unsigned*)((const char*)(gbase) + (voff)[_i]), (LAS unsigned*)(lds + (bufoff) + ldsw + _i * 8192), 16, 0, 0); } while (0)
#define PG8_LDA(dst, b, h) do { _Pragma("unroll") for (int m = 0; m < 4; ++m) _Pragma("unroll") for (int k = 0; k < 2; ++k) dst[m][k] = *(const LAS bf16x8*)(lds + PG8_SA(b, h) + aoff + m * 2048 + k * 1024); } while (0)
#define PG8_LDB(dst, b, h) do { _Pragma("unroll") for (int n = 0; n < 2; ++n) _Pragma("unroll") for (int k = 0; k < 2; ++k) dst[n][k] = *(const LAS bf16x8*)(lds + PG8_SB(b, h) + boff + n * 2048 + k * 1024); } while (0)
#define PG8_MMA(ai, bj, At, Bt) do { __builtin_amdgcn_s_setprio(1); _Pragma("unroll") for (int m = 0; m < 4; ++m) _Pragma("unroll") for (int n = 0; n < 2; ++n) _Pragma("unroll") for (int k = 0; k < 2; ++k) \
        acc[ai][bj][m][n] = __builtin_amdgcn_mfma_f32_16x16x32_bf16(Bt[n][k], At[m][k], acc[ai][bj][m][n], 0, 0, 0); __builtin_amdgcn_s_setprio(0); } while (0)
#define PG8_WAIT_V(n) asm volatile("s_waitcnt vmcnt(" #n ")" ::: "memory")
#define PG8_WAIT_L(n) asm volatile("s_waitcnt lgkmcnt(" #n ")" ::: "memory")
#define PG8_BAR __builtin_amdgcn_s_barrier()
#define PG8_SCHED __builtin_amdgcn_sched_barrier(0)
    UnitD cur, nxt; int ui = 0;
    if (!S.next(0, cur)) return;
    f32x4 acc[2][2][4][2];
#pragma unroll
    for (int a = 0; a < 2; ++a)
#pragma unroll
        for (int b = 0; b < 2; ++b)
#pragma unroll
            for (int m = 0; m < 4; ++m)
#pragma unroll
                for (int n = 0; n < 2; ++n) acc[a][b][m][n] = (f32x4){0.f, 0.f, 0.f, 0.f};
    bf16x8 At[4][2], B0[2][2], B1[2][2];
    const char* cA = cur.A; const char* cB = cur.B;
    PG8_STAGE(PG8_SB(0, 0), cB, voffB); PG8_STAGE(PG8_SA(0, 0), cA, voffA); PG8_STAGE(PG8_SB(0, 1), cB + hstepB, voffB); PG8_STAGE(PG8_SA(0, 1), cA + hstepA, voffA);
    if (wr == 1) PG8_BAR;
    PG8_WAIT_V(4); PG8_BAR;
    PG8_STAGE(PG8_SB(1, 0), cB + kstep, voffB); PG8_STAGE(PG8_SA(1, 0), cA + kstep, voffA); PG8_STAGE(PG8_SB(1, 1), cB + hstepB + kstep, voffB);
    PG8_WAIT_V(6); PG8_BAR;
    for (;;) {
        const bool has_next = S.next(ui + 1, nxt);
        const char* nA = has_next ? nxt.A : cA; const char* nB = has_next ? nxt.B : cB;
        const int nt = cur.nt;
        for (int t = 0; t < nt; t += 2) {
            const bool last = (t == nt - 2);
            const char* a1 = cA + (size_t)(t + 1) * kstep;
            const char* a2 = last ? nA : cA + (size_t)(t + 2) * kstep; const char* b2 = last ? nB : cB + (size_t)(t + 2) * kstep;
            const char* a3 = a2 + kstep; const char* b3 = b2 + kstep;
            PG8_LDB(B0, 0, 0); PG8_SCHED; PG8_LDA(At, 0, 0); PG8_STAGE(PG8_SA(1, 1), a1 + hstepA, voffA);
            PG8_WAIT_L(8); PG8_BAR; PG8_WAIT_L(0); PG8_MMA(0, 0, At, B0); PG8_BAR; PG8_SCHED;
            PG8_LDB(B1, 0, 1); PG8_STAGE(PG8_SB(0, 0), b2, voffB);
            PG8_BAR; PG8_WAIT_L(0); PG8_MMA(0, 1, At, B1); PG8_BAR;
            PG8_LDA(At, 0, 1); PG8_STAGE(PG8_SA(0, 0), a2, voffA);
            PG8_BAR; PG8_WAIT_L(0); PG8_MMA(1, 0, At, B0); PG8_BAR; PG8_SCHED;
            PG8_STAGE(PG8_SB(0, 1), b2 + hstepB, voffB);
            PG8_WAIT_V(6); PG8_BAR; PG8_MMA(1, 1, At, B1); PG8_BAR;
            PG8_LDB(B0, 1, 0); PG8_SCHED; PG8_LDA(At, 1, 0); PG8_STAGE(PG8_SA(0, 1), a2 + hstepA, voffA);
            PG8_WAIT_L(8); PG8_BAR; PG8_WAIT_L(0); PG8_MMA(0, 0, At, B0); PG8_BAR; PG8_SCHED;
            PG8_LDB(B1, 1, 1); PG8_STAGE(PG8_SB(1, 0), b3, voffB);
            PG8_BAR; PG8_WAIT_L(0); PG8_MMA(0, 1, At, B1); PG8_BAR;
            PG8_LDA(At, 1, 1); PG8_STAGE(PG8_SA(1, 0), a3, voffA);
            PG8_BAR; PG8_WAIT_L(0); PG8_MMA(1, 0, At, B0); PG8_BAR; PG8_SCHED;
            PG8_STAGE(PG8_SB(1, 1), b3 + hstepB, voffB);
            PG8_WAIT_V(6); PG8_BAR; PG8_MMA(1, 1, At, B1); PG8_BAR;
        }
        E(acc, cur, wr, wc, fr, fq);
        if (!has_next) break;
#pragma unroll
        for (int a = 0; a < 2; ++a)
#pragma unroll
            for (int b = 0; b < 2; ++b)
#pragma unroll
                for (int m = 0; m < 4; ++m)
#pragma unroll
                    for (int n = 0; n < 2; ++n) acc[a][b][m][n] = (f32x4){0.f, 0.f, 0.f, 0.f};
        cur = nxt; cA = nA; cB = nB; ++ui;
    }
    PG8_WAIT_V(0);
    if (wr == 0) PG8_BAR;
    PG8_BAR;
#undef PG8_SA
#undef PG8_SB
#undef PG8_STAGE
#undef PG8_LDA
#undef PG8_LDB
#undef PG8_MMA
#undef PG8_WAIT_V
#undef PG8_WAIT_L
#undef PG8_BAR
#undef PG8_SCHED
}
}
using pg8::UnitD;

struct SchedInproj {
    const char* P; const char* WT; int G, c;
    __device__ __forceinline__ bool next(int i, UnitD& u) const {
        const int L = i * G + c; if (L >= 64 * 26) return false;
        int pm, pn; pg8::tile_of(L, 64, 26, pm, pn);
        u.A = P + ((size_t)pm * 256 * LDP + C_H) * 2; u.B = WT + (size_t)pn * 256 * 2048; u.nt = 16; u.pm = pm; u.pn = pn; u.kind = 0; return true;
    }
};
struct EpiInproj {
    bf16_t* P;
    __device__ __forceinline__ void operator()(const f32x4 (&acc)[2][2][4][2], const UnitD& u, int wr, int wc, int fr, int fq) const {
        const int row0 = u.pm * 256 + wr * 64 + fr, col0 = u.pn * 256 + wc * 32 + 8 * fq;
#pragma unroll
        for (int ai = 0; ai < 2; ++ai)
#pragma unroll
            for (int m = 0; m < 4; ++m) { bf16_t* rowp = P + (size_t)(row0 + ai * 128 + m * 16) * LDP + col0;
#pragma unroll
                for (int bj = 0; bj < 2; ++bj) { const f32x4 v0 = acc[ai][bj][m][0], v1 = acc[ai][bj][m][1];
                    u32x4 o; o.x = cvt_pk_bf16(v0[0], v0[1]); o.y = cvt_pk_bf16(v0[2], v0[3]); o.z = cvt_pk_bf16(v1[0], v1[1]); o.w = cvt_pk_bf16(v1[2], v1[3]);
                    *(u32x4*)(rowp + bj * 128) = o; } }
    }
};
struct SchedC1 {
    const char* P; const char* WT; int G, c;
    __device__ __forceinline__ bool next(int i, UnitD& u) const {
        const int ti = i / 6, sub = i - ti * 6, L = ti * G + c; if (L >= 256) return false;
        int pm, pn; pg8::tile_of(L, 64, 4, pm, pn);
        const int br = sub >> 1;
        if (!(sub & 1)) { u.A = P + ((size_t)pm * 256 * LDP + C_H) * 2; u.B = WT + (size_t)(R_GATE + br * 1024 + pn * 256) * 2048; u.nt = 16; }
        else { const int acol = br == 0 ? C_SBG : (br == 1 ? C_Z : C_YRW); const int brow = br == 0 ? R_SB : (br == 1 ? R_SSD : R_RWO);
            u.A = P + ((size_t)pm * 256 * LDP + acol) * 2; u.B = WT + (size_t)(brow + pn * 256) * 2048; u.nt = br == 1 ? 16 : 8; }
        u.pm = pm; u.pn = pn; u.kind = sub; return true;
    }
};
struct EpiC1 {
    bf16_t* P; const float* rstd;
    __device__ __forceinline__ void operator()(const f32x4 (&acc)[2][2][4][2], const UnitD& u, int wr, int wc, int fr, int fq) const {
        const int row0 = u.pm * 256 + wr * 64 + fr, col0 = u.pn * 256 + wc * 32 + 8 * fq;
        const int kind = u.kind;
#pragma unroll
        for (int ai = 0; ai < 2; ++ai)
#pragma unroll
            for (int m = 0; m < 4; ++m) { const int row = row0 + ai * 128 + m * 16; bf16_t* rowp = P + (size_t)row * LDP + col0;
                const float sc = (kind == 3) ? rstd[row] : 1.f;
#pragma unroll
                for (int bj = 0; bj < 2; ++bj) { const f32x4 v0 = acc[ai][bj][m][0], v1 = acc[ai][bj][m][1];
                    float v[8] = {v0[0], v0[1], v0[2], v0[3], v1[0], v1[1], v1[2], v1[3]};
                    u32x4* gp = (u32x4*)(rowp + C_G + bj * 128); u32x4* mp = (u32x4*)(rowp + C_M + bj * 128);
                    if (!(kind & 1)) {
#pragma unroll
                        for (int e = 0; e < 8; ++e) v[e] = sigmoidf_(v[e]);
                        u32x4 o; o.x = cvt_pk_bf16(v[0], v[1]); o.y = cvt_pk_bf16(v[2], v[3]); o.z = cvt_pk_bf16(v[4], v[5]); o.w = cvt_pk_bf16(v[6], v[7]);
                        *gp = o;
                    } else {
                        const u32x4 g = *gp;
                        float r[8];
                        r[0] = bf_lo(g.x) * v[0] * sc; r[1] = bf_hi(g.x) * v[1] * sc; r[2] = bf_lo(g.y) * v[2] * sc; r[3] = bf_hi(g.y) * v[3] * sc;
                        r[4] = bf_lo(g.z) * v[4] * sc; r[5] = bf_hi(g.z) * v[5] * sc; r[6] = bf_lo(g.w) * v[6] * sc; r[7] = bf_hi(g.w) * v[7] * sc;
                        if (kind != 1) { const u32x4 mo = *mp;
                            r[0] += bf_lo(mo.x); r[1] += bf_hi(mo.x); r[2] += bf_lo(mo.y); r[3] += bf_hi(mo.y); r[4] += bf_lo(mo.z); r[5] += bf_hi(mo.z); r[6] += bf_lo(mo.w); r[7] += bf_hi(mo.w); }
                        u32x4 o; o.x = cvt_pk_bf16(r[0], r[1]); o.y = cvt_pk_bf16(r[2], r[3]); o.z = cvt_pk_bf16(r[4], r[5]); o.w = cvt_pk_bf16(r[6], r[7]);
                        *mp = o;
                    } } }
    }
};
struct SchedOut {
    const char* P; const char* WT; int G, c;
    __device__ __forceinline__ bool next(int i, UnitD& u) const {
        const int L = i * G + c; if (L >= 256) return false;
        int pm, pn; pg8::tile_of(L, 64, 4, pm, pn);
        u.A = P + ((size_t)pm * 256 * LDP + C_M) * 2; u.B = WT + (size_t)(R_WO + pn * 256) * 2048; u.nt = 16; u.pm = pm; u.pn = pn; u.kind = 0; return true;
    }
};
struct EpiOut {
    const float* Xin; float* Xout;
    __device__ __forceinline__ void operator()(const f32x4 (&acc)[2][2][4][2], const UnitD& u, int wr, int wc, int fr, int fq) const {
        const int row0 = u.pm * 256 + wr * 64 + fr, col0 = u.pn * 256 + wc * 32 + 4 * fq;
#pragma unroll
        for (int ai = 0; ai < 2; ++ai)
#pragma unroll
            for (int m = 0; m < 4; ++m) { const size_t ro = (size_t)(row0 + ai * 128 + m * 16) * DM + col0;
#pragma unroll
                for (int bj = 0; bj < 2; ++bj)
#pragma unroll
                    for (int n = 0; n < 2; ++n) { const f32x4 xi = *(const f32x4*)(Xin + ro + bj * 128 + n * 16); *(f32x4*)(Xout + ro + bj * 128 + n * 16) = xi + acc[ai][bj][m][n]; } }
    }
};

__device__ __forceinline__ void phase0(const Params& p, int layer, unsigned char* shm) {
    const int tid = opaque_tid(), wave = tid >> 6, lane = tid & 63;
    bf16_t* P = (bf16_t*)(p.ws + OFF_P); bf16_t* WT = (bf16_t*)(p.ws + OFF_WT);
    const float* Xin = layer == 0 ? p.in[0] : p.out;
    const float* ng = p.in[1] + layer * DM;
    f32x4 gn[4];
#pragma unroll
    for (int i = 0; i < 4; ++i) gn[i] = *(const f32x4*)(ng + i * 256 + lane * 4);
    for (int row0 = (blockIdx.x * 8 + wave) * 4; row0 < TOK; row0 += gridDim.x * 32) {
        f32x4 v[4][4]; float ss[4];
#pragma unroll
        for (int rr = 0; rr < 4; ++rr) { const float* xr = Xin + (size_t)(row0 + rr) * DM;
#pragma unroll
            for (int i = 0; i < 4; ++i) v[rr][i] = *(const f32x4*)(xr + i * 256 + lane * 4); }
#pragma unroll
        for (int rr = 0; rr < 4; ++rr) { float a = 0.f;
#pragma unroll
            for (int i = 0; i < 4; ++i) a += v[rr][i][0] * v[rr][i][0] + v[rr][i][1] * v[rr][i][1] + v[rr][i][2] * v[rr][i][2] + v[rr][i][3] * v[rr][i][3];
            ss[rr] = wave_sum(a); }
#pragma unroll
        for (int rr = 0; rr < 4; ++rr) { const float rs = rsqrtf(ss[rr] * (1.f / DM) + 1e-6f);
#pragma unroll
            for (int i = 0; i < 4; ++i) { const f32x4 g = gn[i];
                u32x2 o; o.x = cvt_pk_bf16(v[rr][i][0] * rs * g[0], v[rr][i][1] * rs * g[1]); o.y = cvt_pk_bf16(v[rr][i][2] * rs * g[2], v[rr][i][3] * rs * g[3]);
                *(u32x2*)(P + (size_t)(row0 + rr) * LDP + C_H + i * 256 + lane * 4) = o; } }
    }
    float* T = (float*)shm + wave * (64 * 65);
    const float* w_in = p.in[2] + (size_t)layer * DM * NIN;
    const float* sg = p.in[8] + layer * DM;
    for (int job = blockIdx.x * 8 + wave; job < 3200; job += gridDim.x * 8) {
        const float* src; int srcN, k0, n0, dstrow; bool is_in = false, is_ssd = false;
        if (job < 2432) { is_in = true; src = w_in; srcN = NIN; const int ntile = job >> 4; k0 = (job & 15) * 64; n0 = ntile * 64; dstrow = n0; }
        else { int r = job - 2432;
            if (r < 128) { src = p.in[19] + (size_t)layer * 512 * DM; k0 = (r >> 4) * 64; n0 = (r & 15) * 64; dstrow = R_SB + n0; }
            else if (r < 384) { r -= 128; src = p.in[20] + (size_t)layer * DM * DM; k0 = (r >> 4) * 64; n0 = (r & 15) * 64; dstrow = R_SSD + n0; is_ssd = true; }
            else if (r < 512) { r -= 384; src = p.in[21] + (size_t)layer * 512 * DM; k0 = (r >> 4) * 64; n0 = (r & 15) * 64; dstrow = R_RWO + n0; }
            else { r -= 512; src = p.in[22] + (size_t)layer * DM * DM; k0 = (r >> 4) * 64; n0 = (r & 15) * 64; dstrow = R_WO + n0; }
            srcN = DM; }
        const int n4 = (lane & 15) * 4, np = n0 + n4; int sc = np;
        if (is_in) { if (np < 4352) sc = np; else if (np < 6528) sc = np + 16; else if (np < 6544) sc = np - 6528 + 4352; else if (np < 6656) sc = -1; else sc = np - 112; }
        f32x4 v[16];
#pragma unroll
        for (int i = 0; i < 16; ++i) { const int k = (lane >> 4) + 4 * i; v[i] = (f32x4){0.f, 0.f, 0.f, 0.f};
            if (sc >= 0) v[i] = *(const f32x4*)(src + (size_t)(k0 + k) * srcN + sc); }
#pragma unroll
        for (int i = 0; i < 16; ++i) { const int k = (lane >> 4) + 4 * i; f32x4 x = v[i];
            if (is_ssd) x = x * sg[k0 + k];
            T[k * 65 + n4] = x[0]; T[k * 65 + n4 + 1] = x[1]; T[k * 65 + n4 + 2] = x[2]; T[k * 65 + n4 + 3] = x[3]; }
        asm volatile("s_waitcnt lgkmcnt(0)" ::: "memory"); __builtin_amdgcn_wave_barrier(); asm volatile("" ::: "memory");
#pragma unroll
        for (int j = 0; j < 8; ++j) { const int r = lane + 64 * j, n = r >> 3, kc = (r & 7) * 8; const float* sp = T + kc * 65 + n;
            u32x4 o; o.x = cvt_pk_bf16(sp[0], sp[65]); o.y = cvt_pk_bf16(sp[130], sp[195]); o.z = cvt_pk_bf16(sp[260], sp[325]); o.w = cvt_pk_bf16(sp[390], sp[455]);
            *(u32x4*)(WT + (size_t)(dstrow + n) * 1024 + k0 + kc) = o; }
        asm volatile("s_waitcnt lgkmcnt(0)" ::: "memory"); __builtin_amdgcn_wave_barrier(); asm volatile("" ::: "memory");
    }
    __syncthreads();
}

__device__ __forceinline__ void attn_item(const Params& p, unsigned char* shm, int item) {
    const int qb = item & 15, h = (item >> 4) & 7, b = item >> 7;
    bf16_t* P = (bf16_t*)(p.ws + OFF_P);
    const int tid = opaque_tid(), wave = tid >> 6, lane = tid & 63, lq = lane & 15, g = lane >> 4;
    const size_t rowbase = (size_t)b * SEQ;
    const int t = qb * 128 + wave * 16 + lq;
    const int tmax = qb * 128 + wave * 16 + 15;
    constexpr int ABUF = 64 * 144 + 64 * 136;
    const bf16_t* qp = P + (rowbase + t) * LDP + C_Q + h * 64 + 8 * g;
    const bf16x8 qf0 = *(const bf16x8*)qp, qf1 = *(const bf16x8*)(qp + 32);
    bf16x8 TT[4][2];
#pragma unroll
    for (int a = 0; a < 4; ++a)
#pragma unroll
        for (int ks = 0; ks < 2; ++ks)
#pragma unroll
            for (int e = 0; e < 8; ++e) { const int j = 16 * (2 * ks + (e >> 2)) + 4 * g + (e & 3); TT[a][ks][e] = (j > 16 * a + lq) ? (short)0x3F80 : (short)0; }
    f32x4 o[4];
#pragma unroll
    for (int i = 0; i < 4; ++i) o[i] = (f32x4){0.f, 0.f, 0.f, 0.f};
    float R = 0.f;
    LAS volatile int* flg = (LAS volatile int*)((LAS unsigned char*)shm + 2 * ABUF);
    const int st_s = tid >> 3, st_dc = (tid & 7) * 8;
    const bf16_t* st_base = P + (rowbase + st_s) * LDP + h * 64 + st_dc;
    auto stage_write = [&](unsigned char* buf, const u32x4& kv, const u32x4& vv) {
        bf16_t* Ksw = (bf16_t*)buf; bf16_t* Vtw = (bf16_t*)(buf + 64 * 144); const int s_ = st_s, dc = st_dc;
        *(u32x4*)(Ksw + s_ * 72 + dc) = kv;
        Vtw[(dc + 0) * 68 + s_] = (bf16_t)(vv.x & 0xFFFF); Vtw[(dc + 1) * 68 + s_] = (bf16_t)(vv.x >> 16);
        Vtw[(dc + 2) * 68 + s_] = (bf16_t)(vv.y & 0xFFFF); Vtw[(dc + 3) * 68 + s_] = (bf16_t)(vv.y >> 16);
        Vtw[(dc + 4) * 68 + s_] = (bf16_t)(vv.z & 0xFFFF); Vtw[(dc + 5) * 68 + s_] = (bf16_t)(vv.z >> 16);
        Vtw[(dc + 6) * 68 + s_] = (bf16_t)(vv.w & 0xFFFF); Vtw[(dc + 7) * 68 + s_] = (bf16_t)(vv.w >> 16);
    };
    if (tid == 0) { flg[0] = 1; flg[1] = 0; flg[2] = 0; }
    { const bf16_t* kr = st_base + (size_t)(2 * qb + 1) * 64 * LDP; const u32x4 kv0 = *(const u32x4*)(kr + C_K), vv0 = *(const u32x4*)(kr + C_V); stage_write(shm, kv0, vv0); }
    int itn = 0, cur = 0;
    for (int kt = 2 * qb + 1; kt >= 0; --kt) {
        __syncthreads();
        const int f0 = itn % 3, f1 = (itn + 1) % 3, f2 = (itn + 2) % 3;
        if (flg[f0] == 0) break;
        if (tid == 0) flg[f2] = 0;
        u32x4 kvn = (u32x4){0u, 0u, 0u, 0u}, vvn = (u32x4){0u, 0u, 0u, 0u};
        if (kt > 0) { const bf16_t* kr = st_base + (size_t)(kt - 1) * 64 * LDP; kvn = *(const u32x4*)(kr + C_K); vvn = *(const u32x4*)(kr + C_V); }
        const bf16_t* Ks = (const bf16_t*)(shm + cur * ABUF); const bf16_t* Vt = (const bf16_t*)(shm + cur * ABUF + 64 * 144);
        const bool walive = __any(R > -104.f);
        const bool act = (kt * 64 < tmax) && walive;
        if (act) {
            float lb[4][4], lk[4][4];
#pragma unroll
            for (int sub = 0; sub < 4; ++sub) {
                const bf16_t* kp = Ks + (16 * sub + lq) * 72 + 8 * g;
                const bf16x8 k0 = *(const bf16x8*)kp, k1 = *(const bf16x8*)(kp + 32);
                f32x4 s4 = (f32x4){0.f, 0.f, 0.f, 0.f};
                s4 = __builtin_amdgcn_mfma_f32_16x16x32_bf16(k0, qf0, s4, 0, 0, 0);
                s4 = __builtin_amdgcn_mfma_f32_16x16x32_bf16(k1, qf1, s4, 0, 0, 0);
#pragma unroll
                for (int r = 0; r < 4; ++r) { const float z = s4[r] * 0.125f; const bool mk = (kt * 64 + 16 * sub + 4 * g + r) < t;
                    const float l = fminf(z, 0.f) - __logf(1.f + __expf(-fabsf(z)));
                    lb[sub][r] = mk ? l : -1e30f; lk[sub][r] = mk ? (l - z) : 0.f; }
            }
            bf16x8 hi[2], lo[2];
#pragma unroll
            for (int ks = 0; ks < 2; ++ks) {
                unsigned hw[4], lw[4];
#pragma unroll
                for (int w2 = 0; w2 < 4; ++w2) { const int sub = 2 * ks + (w2 >> 1), r0 = (w2 & 1) * 2; const float a0 = lk[sub][r0], a1 = lk[sub][r0 + 1];
                    hw[w2] = cvt_pk_bf16(a0, a1); lw[w2] = cvt_pk_bf16(a0 - bf_lo(hw[w2]), a1 - bf_hi(hw[w2])); }
                u32x4 hv = (u32x4){hw[0], hw[1], hw[2], hw[3]}, lv = (u32x4){lw[0], lw[1], lw[2], lw[3]};
                hi[ks] = __builtin_bit_cast(bf16x8, hv); lo[ks] = __builtin_bit_cast(bf16x8, lv);
            }
            f32x4 aft[4];
#pragma unroll
            for (int a = 0; a < 4; ++a) { f32x4 c = (f32x4){0.f, 0.f, 0.f, 0.f};
#pragma unroll
                for (int ks = 0; ks < 2; ++ks) { c = __builtin_amdgcn_mfma_f32_16x16x32_bf16(TT[a][ks], hi[ks], c, 0, 0, 0); c = __builtin_amdgcn_mfma_f32_16x16x32_bf16(TT[a][ks], lo[ks], c, 0, 0, 0); }
                aft[a] = c; }
            float tot = aft[0][0] + lk[0][0];
            tot = __shfl(tot, lq);
            bf16x8 pf[2];
#pragma unroll
            for (int ks = 0; ks < 2; ++ks) { unsigned pw[4];
#pragma unroll
                for (int w2 = 0; w2 < 4; ++w2) { const int sub = 2 * ks + (w2 >> 1), r0 = (w2 & 1) * 2;
                    const float e0 = __expf(lb[sub][r0] + aft[sub][r0] + R), e1 = __expf(lb[sub][r0 + 1] + aft[sub][r0 + 1] + R);
                    pw[w2] = cvt_pk_bf16(e0, e1); }
                u32x4 pv = (u32x4){pw[0], pw[1], pw[2], pw[3]}; pf[ks] = __builtin_bit_cast(bf16x8, pv); }
            R += tot;
#pragma unroll
            for (int ds = 0; ds < 4; ++ds)
#pragma unroll
                for (int ks = 0; ks < 2; ++ks) { const bf16_t* vp = Vt + (16 * ds + lq) * 68 + 32 * ks + 4 * g;
                    const u32x2 v0 = *(const u32x2*)vp, v1 = *(const u32x2*)(vp + 16);
                    u32x4 vv = (u32x4){v0.x, v0.y, v1.x, v1.y};
                    o[ds] = __builtin_amdgcn_mfma_f32_16x16x32_bf16(__builtin_bit_cast(bf16x8, vv), pf[ks], o[ds], 0, 0, 0); }
        }
        if (__any(R > -104.f) && lane == 0) flg[f1] = 1;
        if (kt > 0) stage_write(shm + (cur ^ 1) * ABUF, kvn, vvn);
        cur ^= 1; ++itn;
    }
#pragma unroll
    for (int ds = 0; ds < 4; ++ds) { bf16_t* gp = P + (rowbase + t) * LDP + C_SBG + h * 64 + 16 * ds + 4 * g;
        const u32x2 gv = *(const u32x2*)gp;
        u32x2 ov; ov.x = cvt_pk_bf16(o[ds][0] * siluf_(bf_lo(gv.x)), o[ds][1] * siluf_(bf_hi(gv.x))); ov.y = cvt_pk_bf16(o[ds][2] * siluf_(bf_lo(gv.y)), o[ds][3] * siluf_(bf_hi(gv.y)));
        *(u32x2*)gp = ov; }
    __syncthreads();
}

__device__ __forceinline__ void bc_prepass(const Params& p, int layer, int blk, int nblk) {
    const bf16_t* P = (const bf16_t*)(p.ws + OFF_P); bf16_t* BCc = (bf16_t*)(p.ws + OFF_BCC);
    const float* cw = p.in[3] + (size_t)layer * 4 * 1280; const float* cb = p.in[4] + layer * 1280;
    const int gt = blk * 512 + opaque_tid(), gs = nblk * 512;
    const int c = (gt & 63) * 4, chn = 1024 + c;
    const f32x4 bias = *(const f32x4*)(cb + chn);
    f32x4 w[4];
#pragma unroll
    for (int k = 0; k < 4; ++k) w[k] = *(const f32x4*)(cw + k * 1280 + chn);
    for (int idx0 = gt; idx0 < TOK * 64; idx0 += 4 * gs) {
        u32x2 xv[4][4]; bool ok[4];
#pragma unroll
        for (int u = 0; u < 4; ++u) { const int idx = idx0 + u * gs; ok[u] = idx < TOK * 64; const int tok = ok[u] ? (idx >> 6) : 0; const int t = tok & (SEQ - 1);
            const bf16_t* xp = P + (size_t)tok * LDP + C_XBC + chn;
#pragma unroll
            for (int k = 0; k < 4; ++k) { const int ts = t - 3 + k; const unsigned xm = ts >= 0 ? 0xFFFFFFFFu : 0u;
                u32x2 x = *(const u32x2*)(xp + (ptrdiff_t)(ts >= 0 ? k - 3 : 0) * LDP); x.x &= xm; x.y &= xm; xv[u][k] = x; } }
#pragma unroll
        for (int u = 0; u < 4; ++u) { const int idx = idx0 + u * gs; const int tok = ok[u] ? (idx >> 6) : 0;
            f32x4 a = bias;
#pragma unroll
            for (int k = 0; k < 4; ++k) { a[0] += w[k][0] * bf_lo(xv[u][k].x); a[1] += w[k][1] * bf_hi(xv[u][k].x); a[2] += w[k][2] * bf_lo(xv[u][k].y); a[3] += w[k][3] * bf_hi(xv[u][k].y); }
            u32x2 o; o.x = cvt_pk_bf16(siluf_(a[0]), siluf_(a[1])); o.y = cvt_pk_bf16(siluf_(a[2]), siluf_(a[3]));
            if (ok[u]) *(u32x2*)(BCc + (size_t)tok * 256 + c) = o; }
    }
}

__device__ __forceinline__ void ssd_item(const Params& p, int layer, unsigned char* shm, int item) {
    const int ph = item & 1, hh = (item >> 1) & 15, b = item >> 5, grp = hh >> 3;
    bf16_t* P = (bf16_t*)(p.ws + OFF_P); float* SSQ = (float*)(p.ws + OFF_SSQ);
    const int tid = opaque_tid(), wave = tid >> 6, lane = tid & 63, lq = lane & 15, g = lane >> 4;
    const size_t rowbase = (size_t)b * SEQ;
    const float* cw = p.in[3] + (size_t)layer * 4 * 1280; const float* cb = p.in[4] + layer * 1280;
    const float dtb = p.in[5][layer * 16 + hh], Aneg = -__expf(p.in[6][layer * 16 + hh]), Dsk = p.in[7][layer * 16 + hh];
    float* XS = (float*)shm;
    float* YS = XS + 2048;
    float* DTs = YS + 2048;
    float* ACS = DTs + 64;
    bf16_t* Cb = (bf16_t*)(ACS + 64);
    bf16_t* Bb = Cb + 64 * 72;
    bf16_t* BT = Bb + 64 * 72;
    bf16_t* Mx = BT + 64 * 72;
    bf16_t* XT = Mx + 64 * 72;
    bf16_t* XwT = XT + 32 * 72;
    bf16_t* SbT = XwT + 32 * 72;
    f32x4 Sacc = (f32x4){0.f, 0.f, 0.f, 0.f};
    const bf16_t* BCc = (const bf16_t*)(p.ws + OFF_BCC);
    const int x_tt = tid >> 3, x_c = (tid & 7) * 4, x_chn = hh * 64 + ph * 32 + x_c;
    const int bc_q = tid & 7;
    const f32x4 xbias = *(const f32x4*)(cb + x_chn);
    f32x4 xw[4];
#pragma unroll
    for (int k = 0; k < 4; ++k) xw[k] = *(const f32x4*)(cw + k * 1280 + x_chn);
    u32x2 sx[4]; u32x4 bc0, bc1; bf16_t sdt = 0;
    auto ssd_load = [&](int tb) {
        const int t = tb + x_tt;
        const bf16_t* xp = P + (rowbase + t) * LDP + C_XBC + x_chn;
#pragma unroll
        for (int k = 0; k < 4; ++k) { const int ts = t - 3 + k; const unsigned xm = ts >= 0 ? 0xFFFFFFFFu : 0u;
            u32x2 xv = *(const u32x2*)(xp + (ptrdiff_t)(ts >= 0 ? k - 3 : 0) * LDP); xv.x &= xm; xv.y &= xm; sx[k] = xv; }
        const bf16_t* bp = BCc + (rowbase + t) * 256 + (bc_q < 4 ? grp * 64 + bc_q * 16 : 128 + grp * 64 + (bc_q - 4) * 16);
        bc0 = *(const u32x4*)bp; bc1 = *(const u32x4*)(bp + 8);
        if (tid < 64) sdt = P[(rowbase + tb + tid) * LDP + C_DT + hh];
    };
    ssd_load(0);
    for (int ch = 0; ch < SEQ / 64; ++ch) {
        const int t0 = ch * 64;
        __syncthreads();
        const int o_tt = tid >> 3, o_p4 = (tid & 7) * 4;
        bf16_t* zp = P + (rowbase + t0 + o_tt) * LDP + C_Z + hh * 64 + ph * 32 + o_p4;
        const u32x2 zv = *(const u32x2*)zp;
        { f32x4 a = xbias;
#pragma unroll
            for (int k = 0; k < 4; ++k) { a[0] += xw[k][0] * bf_lo(sx[k].x); a[1] += xw[k][1] * bf_hi(sx[k].x); a[2] += xw[k][2] * bf_lo(sx[k].y); a[3] += xw[k][3] * bf_hi(sx[k].y); }
            a[0] = siluf_(a[0]); a[1] = siluf_(a[1]); a[2] = siluf_(a[2]); a[3] = siluf_(a[3]);
            const unsigned q0 = cvt_pk_bf16(a[0], a[1]), q1 = cvt_pk_bf16(a[2], a[3]); const int tt = x_tt, c = x_c;
            *(f32x4*)(XS + tt * 32 + c) = a;
            XT[(c + 0) * 72 + tt] = (bf16_t)(q0 & 0xFFFF); XT[(c + 1) * 72 + tt] = (bf16_t)(q0 >> 16); XT[(c + 2) * 72 + tt] = (bf16_t)(q1 & 0xFFFF); XT[(c + 3) * 72 + tt] = (bf16_t)(q1 >> 16);
            if (bc_q < 4) { const int n = bc_q * 16; *(u32x4*)(Bb + tt * 72 + n) = bc0; *(u32x4*)(Bb + tt * 72 + n + 8) = bc1;
                const unsigned wv[8] = {bc0.x, bc0.y, bc0.z, bc0.w, bc1.x, bc1.y, bc1.z, bc1.w};
#pragma unroll
                for (int e = 0; e < 8; ++e) { BT[(n + 2 * e) * 72 + tt] = (bf16_t)(wv[e] & 0xFFFF); BT[(n + 2 * e + 1) * 72 + tt] = (bf16_t)(wv[e] >> 16); } }
            else { const int n = (bc_q - 4) * 16; *(u32x4*)(Cb + tt * 72 + n) = bc0; *(u32x4*)(Cb + tt * 72 + n + 8) = bc1; } }
        if (tid < 64) { const float dt = softplusf_(bf2f(sdt) + dtb); DTs[tid] = dt;
            float x = dt * Aneg;
#pragma unroll
            for (int o = 1; o < 64; o <<= 1) { const float v = __shfl_up(x, o); if (lane >= o) x += v; }
            ACS[tid] = x; }
        if (ch + 1 < SEQ / 64) ssd_load(t0 + 64);
        __syncthreads();
        const float acsL = ACS[63];
        { const int pp = tid >> 4, s4 = (tid & 15) * 4; float v[4];
#pragma unroll
            for (int e = 0; e < 4; ++e) { const int sidx = s4 + e; v[e] = XS[sidx * 32 + pp] * DTs[sidx] * __expf(acsL - ACS[sidx]); }
            *(u32x2*)(XwT + pp * 72 + s4) = (u32x2){cvt_pk_bf16(v[0], v[1]), cvt_pk_bf16(v[2], v[3])}; }
        { const int pi = wave >> 2, ni = wave & 3;
#pragma unroll
            for (int r = 0; r < 4; ++r) SbT[(16 * pi + 4 * g + r) * 72 + 16 * ni + lq] = (bf16_t)(cvt_pk_bf16(Sacc[r], 0.f) & 0xFFFF); }
        { const int ti = wave >> 1;
#pragma unroll
            for (int sj = 0; sj < 2; ++sj) { const int si = 2 * (wave & 1) + sj;
                f32x4 acc = (f32x4){0.f, 0.f, 0.f, 0.f};
                if (si <= ti) {
                    const bf16_t* ap = Cb + (16 * ti + lq) * 72 + 8 * g; const bf16_t* bp = Bb + (16 * si + lq) * 72 + 8 * g;
                    acc = __builtin_amdgcn_mfma_f32_16x16x32_bf16(*(const bf16x8*)ap, *(const bf16x8*)bp, acc, 0, 0, 0);
                    acc = __builtin_amdgcn_mfma_f32_16x16x32_bf16(*(const bf16x8*)(ap + 32), *(const bf16x8*)(bp + 32), acc, 0, 0, 0);
                }
                const int sidx = 16 * si + lq; const float as = ACS[sidx], ds = DTs[sidx];
#pragma unroll
                for (int r = 0; r < 4; ++r) { const int t = 16 * ti + 4 * g + r; const float val = (sidx <= t) ? acc[r] * __expf(ACS[t] - as) * ds : 0.f;
                    Mx[t * 72 + sidx] = (bf16_t)(cvt_pk_bf16(val, 0.f) & 0xFFFF); } } }
        __syncthreads();
        { const int ti = wave >> 1, pi = wave & 1;
            const bf16_t* ap = Mx + (16 * ti + lq) * 72 + 8 * g; const bf16_t* bp = XT + (16 * pi + lq) * 72 + 8 * g;
            const bf16_t* cp = Cb + (16 * ti + lq) * 72 + 8 * g; const bf16_t* sp = SbT + (16 * pi + lq) * 72 + 8 * g;
            f32x4 a1 = (f32x4){0.f, 0.f, 0.f, 0.f}, a2 = (f32x4){0.f, 0.f, 0.f, 0.f};
            a1 = __builtin_amdgcn_mfma_f32_16x16x32_bf16(*(const bf16x8*)ap, *(const bf16x8*)bp, a1, 0, 0, 0);
            a1 = __builtin_amdgcn_mfma_f32_16x16x32_bf16(*(const bf16x8*)(ap + 32), *(const bf16x8*)(bp + 32), a1, 0, 0, 0);
            a2 = __builtin_amdgcn_mfma_f32_16x16x32_bf16(*(const bf16x8*)cp, *(const bf16x8*)sp, a2, 0, 0, 0);
            a2 = __builtin_amdgcn_mfma_f32_16x16x32_bf16(*(const bf16x8*)(cp + 32), *(const bf16x8*)(sp + 32), a2, 0, 0, 0);
#pragma unroll
            for (int r = 0; r < 4; ++r) { const int t = 16 * ti + 4 * g + r, pc = 16 * pi + lq;
                YS[t * 32 + pc] = a1[r] + __expf(ACS[t]) * a2[r] + Dsk * XS[t * 32 + pc]; } }
        { const int pi = wave >> 2, ni = wave & 3; const float dl = __expf(acsL);
            Sacc = Sacc * dl;
            const bf16_t* ap = XwT + (16 * pi + lq) * 72 + 8 * g; const bf16_t* bp = BT + (16 * ni + lq) * 72 + 8 * g;
            Sacc = __builtin_amdgcn_mfma_f32_16x16x32_bf16(*(const bf16x8*)ap, *(const bf16x8*)bp, Sacc, 0, 0, 0);
            Sacc = __builtin_amdgcn_mfma_f32_16x16x32_bf16(*(const bf16x8*)(ap + 32), *(const bf16x8*)(bp + 32), Sacc, 0, 0, 0); }
        __syncthreads();
        { const int tt = o_tt, p4 = o_p4; const f32x4 y4 = *(const f32x4*)(YS + tt * 32 + p4);
            const float u0 = y4[0] * siluf_(bf_lo(zv.x)), u1 = y4[1] * siluf_(bf_hi(zv.x)), u2 = y4[2] * siluf_(bf_lo(zv.y)), u3 = y4[3] * siluf_(bf_hi(zv.y));
            u32x2 ov; ov.x = cvt_pk_bf16(u0, u1); ov.y = cvt_pk_bf16(u2, u3); *(u32x2*)zp = ov;
            float q = u0 * u0 + u1 * u1 + u2 * u2 + u3 * u3;
            q += __shfl_xor(q, 1); q += __shfl_xor(q, 2); q += __shfl_xor(q, 4);
            if ((tid & 7) == 0) SSQ[(rowbase + t0 + tt) * 32 + hh * 2 + ph] = q; }
    }
    __syncthreads();
}

__device__ __forceinline__ float fast_tanh(float x) { return 1.f - 2.f * __builtin_amdgcn_rcpf(1.f + __expf(2.f * x)); }
__device__ __forceinline__ void pbar4(LAS volatile unsigned* cnt, unsigned& tgt, int lane) {
    tgt += 4u;
    asm volatile("s_waitcnt lgkmcnt(0)" ::: "memory");
    if (lane == 0) __hip_atomic_fetch_add((LAS unsigned*)cnt, 1u, __ATOMIC_RELAXED, __HIP_MEMORY_SCOPE_WORKGROUP);
    while (*cnt < tgt) __builtin_amdgcn_s_sleep(1);
    asm volatile("" ::: "memory");
}
__device__ __forceinline__ void rwkv_item(const Params& p, int layer, unsigned char* shm, int item) {
    const int half = item & 1, h = (item >> 1) & 7, b = item >> 4;
    bf16_t* P = (bf16_t*)(p.ws + OFF_P); bf16_t* YRAW = (bf16_t*)(p.ws + OFF_YRAW); float* BONUS = (float*)(p.ws + OFF_BONUS);
    const int tid = opaque_tid(), wave = tid >> 6, lane = tid & 63, lq = lane & 15, g = lane >> 4;
    const size_t rowbase = (size_t)b * SEQ;
    const float* mu = p.in[9] + layer * 2176;
    const float* w0 = p.in[10] + layer * 512; const float* wup = p.in[11] + (size_t)layer * 64 * 512;
    const float* a0 = p.in[12] + layer * 512; const float* aup = p.in[13] + (size_t)layer * 64 * 512;
    const float* kkp = p.in[14] + layer * 512; const float* kap = p.in[15] + layer * 512; const float* rkp = p.in[16] + layer * 512;
    constexpr int SETF = 6 * 2048;
    float* SET0 = (float*)shm;
    float* AA = SET0 + 2 * SETF;
    float* Yb = AA + 2048;
    bf16_t* WLb = (bf16_t*)(Yb + 2048);
    bf16_t* ALb = WLb + 32 * 72;
    LAS volatile unsigned* pcnt = (LAS volatile unsigned*)((LAS unsigned char*)shm + (2 * SETF + 2048 + 2048) * 4 + 2 * 32 * 72 * 2);
    const int csub = wave & 3;
    bf16x8 bfr[2][2]; float lw0[2];
#pragma unroll
    for (int mat = 0; mat < 2; ++mat) { const float* up = (mat ? aup : wup) + h * 64 + csub * 16 + lq;
#pragma unroll
        for (int ks = 0; ks < 2; ++ks) { unsigned w[4];
#pragma unroll
            for (int e2 = 0; e2 < 4; ++e2) { const int m0 = 32 * ks + 8 * g + 2 * e2; w[e2] = cvt_pk_bf16(up[(size_t)m0 * 512], up[(size_t)(m0 + 1) * 512]); }
            u32x4 wv = (u32x4){w[0], w[1], w[2], w[3]}; bfr[mat][ks] = __builtin_bit_cast(bf16x8, wv); }
        lw0[mat] = (mat ? a0 : w0)[h * 64 + csub * 16 + lq]; }
    const int ej = (tid & 15) * 4;
    const f32x4 c_kk = *(const f32x4*)(kkp + h * 64 + ej), c_ka = *(const f32x4*)(kap + h * 64 + ej), c_rk = *(const f32x4*)(rkp + h * 64 + ej);
    const f32x4 mu_r = *(const f32x4*)(mu + h * 64 + ej), mu_k = *(const f32x4*)(mu + 512 + h * 64 + ej), mu_v = *(const f32x4*)(mu + 1024 + h * 64 + ej);
    const f32x4 mu_w = *(const f32x4*)(mu + 2048 + ej), mu_a = *(const f32x4*)(mu + 2112 + ej);
    f32x4 sA = (f32x4){0.f, 0.f, 0.f, 0.f}, sB = (f32x4){0.f, 0.f, 0.f, 0.f};
    const int irow = half * 32 + (wave & 3) * 8 + g * 2;
    unsigned ptgt = 0u;
    const int pm = tid - 256, e2t = pm >> 4;
    u32x2 cva[2][5], pva[2][5];
    auto rw_load = [&](int ch) {
#pragma unroll
        for (int ps = 0; ps < 2; ++ps) { const int tl = e2t + 16 * ps, t = ch * 32 + tl; const bf16_t* cur = P + (rowbase + t) * LDP + C_RW; const bool hp = t > 0; const bf16_t* prv = hp ? cur - LDP : cur;
#pragma unroll
            for (int i = 0; i < 5; ++i) { const int col = (i == 0 ? h * 64 : i == 1 ? 512 + h * 64 : i == 2 ? 1024 + h * 64 : i == 3 ? 2048 : 2112) + ej;
                cva[ps][i] = *(const u32x2*)(cur + col); pva[ps][i] = *(const u32x2*)(prv + col); } }
    };
    auto prep = [&](int ch, float* SET) {
        float* Rm = SET; float* Km = SET + 2048; float* Vm = SET + 4096; float* DEC = SET + 6144; float* KK = SET + 8192; float* BB = SET + 10240;
#pragma unroll
        for (int ps = 0; ps < 2; ++ps) { const int tl = e2t + 16 * ps, t = ch * 32 + tl; const unsigned pmask = t > 0 ? 0xFFFFFFFFu : 0u;
#pragma unroll
            for (int i = 0; i < 5; ++i) {
                const u32x2 cv = cva[ps][i]; u32x2 pv = pva[ps][i]; pv.x &= pmask; pv.y &= pmask;
                const f32x4 m4 = i == 0 ? mu_r : i == 1 ? mu_k : i == 2 ? mu_v : i == 3 ? mu_w : mu_a;
                float c[4] = {bf_lo(cv.x), bf_hi(cv.x), bf_lo(cv.y), bf_hi(cv.y)}; const float q[4] = {bf_lo(pv.x), bf_hi(pv.x), bf_lo(pv.y), bf_hi(pv.y)};
#pragma unroll
                for (int e = 0; e < 4; ++e) c[e] = c[e] + (q[e] - c[e]) * m4[e];
                if (i == 0) *(f32x4*)(Rm + tl * 64 + ej) = (f32x4){c[0], c[1], c[2], c[3]};
                else if (i == 1) *(f32x4*)(Km + tl * 64 + ej) = (f32x4){c[0], c[1], c[2], c[3]};
                else if (i == 2) *(f32x4*)(Vm + tl * 64 + ej) = (f32x4){c[0], c[1], c[2], c[3]};
                else if (i == 3) { u32x2 o; o.x = cvt_pk_bf16(fast_tanh(c[0]), fast_tanh(c[1])); o.y = cvt_pk_bf16(fast_tanh(c[2]), fast_tanh(c[3])); *(u32x2*)(WLb + tl * 72 + ej) = o; }
                else { u32x2 o; o.x = cvt_pk_bf16(c[0], c[1]); o.y = cvt_pk_bf16(c[2], c[3]); *(u32x2*)(ALb + tl * 72 + ej) = o; } } }
        if (ch + 1 < SEQ / 32) rw_load(ch + 1);
        pbar4(pcnt, ptgt, lane);
#pragma unroll
        for (int mat = 0; mat < 2; ++mat)
#pragma unroll
            for (int ts = 0; ts < 2; ++ts) { const bf16_t* ap = (mat ? ALb : WLb) + (16 * ts + lq) * 72 + 8 * g;
                const bf16x8 a0f = *(const bf16x8*)ap, a1f = *(const bf16x8*)(ap + 32);
                f32x4 c = (f32x4){0.f, 0.f, 0.f, 0.f};
                c = __builtin_amdgcn_mfma_f32_16x16x32_bf16(a0f, bfr[mat][0], c, 0, 0, 0);
                c = __builtin_amdgcn_mfma_f32_16x16x32_bf16(a1f, bfr[mat][1], c, 0, 0, 0);
#pragma unroll
                for (int r = 0; r < 4; ++r) { const int tt = 16 * ts + 4 * g + r; const float x = lw0[mat] + c[r];
                    if (mat == 0) DEC[tt * 64 + csub * 16 + lq] = __expf(-0.60653066f * sigmoidf_(x));
                    else AA[tt * 64 + csub * 16 + lq] = sigmoidf_(x); } }
        pbar4(pcnt, ptgt, lane);
#pragma unroll
        for (int ps = 0; ps < 2; ++ps) { const int tl = e2t + 16 * ps;
            const f32x4 k4 = *(const f32x4*)(Km + tl * 64 + ej), a4 = *(const f32x4*)(AA + tl * 64 + ej), r4 = *(const f32x4*)(Rm + tl * 64 + ej);
            f32x4 kr, kt; float ss = 0.f, bo = 0.f;
#pragma unroll
            for (int e = 0; e < 4; ++e) { kr[e] = k4[e] * c_kk[e]; ss += kr[e] * kr[e]; kt[e] = k4[e] * (1.f + (a4[e] - 1.f) * c_ka[e]); bo += r4[e] * kt[e] * c_rk[e]; }
            ss = allred16(ss); bo = allred16(bo);
            const float inv = __builtin_amdgcn_rsqf(fmaxf(ss, 1e-24f));
            f32x4 kk4, b4;
#pragma unroll
            for (int e = 0; e < 4; ++e) { kk4[e] = kr[e] * inv; b4[e] = kk4[e] * a4[e]; }
            *(f32x4*)(Km + tl * 64 + ej) = kt; *(f32x4*)(KK + tl * 64 + ej) = kk4; *(f32x4*)(BB + tl * 64 + ej) = b4;
            if (half == 0 && (tid & 15) == 0) BONUS[(rowbase + ch * 32 + tl) * 8 + h] = bo; }
    };
    auto yraw_store = [&](int ch) {
#pragma unroll
        for (int ps = 0; ps < 2; ++ps)
#pragma unroll
            for (int q = 0; q < 2; ++q) { const int tl = e2t + 16 * ps, il = (tid & 15) + 16 * q;
                YRAW[(rowbase + ch * 32 + tl) * 512 + h * 64 + half * 32 + il] = (bf16_t)(cvt_pk_bf16(Yb[(ch & 1) * 1024 + tl * 32 + il], 0.f) & 0xFFFF); }
    };
    if (tid == 0) *pcnt = 0u;
    __syncthreads();
    if (wave >= 4) { rw_load(0); prep(0, SET0); }
    for (int ch = 0; ch < SEQ / 32; ++ch) {
        __syncthreads();
        if (wave < 4) {
            const float* SET = SET0 + (ch & 1) * SETF;
            const float* Rm = SET; const float* Km = SET + 2048; const float* Vm = SET + 4096; const float* DEC = SET + 6144; const float* KK = SET + 8192; const float* BB = SET + 10240;
            float* Yw = Yb + (ch & 1) * 1024;
            struct Ops { f32x4 w, k, q, b, r; float v0, v1; };
            auto ld = [&](Ops& o, int tt) { const int off = tt * 64 + lq * 4;
                o.w = *(const f32x4*)(DEC + off); o.k = *(const f32x4*)(Km + off); o.q = *(const f32x4*)(KK + off); o.b = *(const f32x4*)(BB + off); o.r = *(const f32x4*)(Rm + off);
                const float* vp = Vm + tt * 64 + irow; o.v0 = vp[0]; o.v1 = vp[1]; };
            auto step = [&](const Ops& o, int tt) {
                const f32x4 da = sA * o.q, db = sB * o.q; float sa0 = (da[0] + da[1]) + (da[2] + da[3]), sa1 = (db[0] + db[1]) + (db[2] + db[3]);
                const f32x4 uA = sA * o.w + o.k * o.v0, uB = sB * o.w + o.k * o.v1;
                sa0 = -allred16(sa0); sa1 = -allred16(sa1);
                sA = uA + o.b * sa0; sB = uB + o.b * sa1;
                const f32x4 ea = sA * o.r, eb = sB * o.r; float y0 = (ea[0] + ea[1]) + (ea[2] + ea[3]), y1 = (eb[0] + eb[1]) + (eb[2] + eb[3]);
                asm("" : "+v"(y0)); asm("" : "+v"(y1));
                y0 = allred16(y0); y1 = allred16(y1);
                if (lq == 0) { float* yp = Yw + tt * 32 + (wave & 3) * 8 + g * 2; yp[0] = y0; yp[1] = y1; } };
            Ops oa, ob;
            ld(oa, 0);
            for (int tt = 0; tt < 32; tt += 2) {
                ld(ob, tt + 1);
                step(oa, tt);
                ld(oa, (tt + 2 < 32) ? tt + 2 : 31);
                step(ob, tt + 1);
            }
        } else {
            if (ch > 0) yraw_store(ch - 1);
            if (ch + 1 < SEQ / 32) prep(ch + 1, SET0 + ((ch + 1) & 1) * SETF);
        }
    }
    __syncthreads();
    if (wave >= 4) yraw_store(SEQ / 32 - 1);
    __syncthreads();
}

__device__ __forceinline__ void rw_post(const Params& p, int layer) {
    bf16_t* P = (bf16_t*)(p.ws + OFF_P); const bf16_t* YRAW = (const bf16_t*)(p.ws + OFF_YRAW);
    const float* BONUS = (const float*)(p.ws + OFF_BONUS); const float* SSQ = (const float*)(p.ws + OFF_SSQ); float* RSTD = (float*)(p.ws + OFF_RSTD);
    const float* mu = p.in[9] + layer * 2176; const float* lng = p.in[17] + layer * 512; const float* lnb = p.in[18] + layer * 512;
    const int gt = blockIdx.x * 512 + opaque_tid(), gs = gridDim.x * 512;
    {
        const int c = (gt & 127) * 4, h = c >> 6;
        const f32x4 muv = *(const f32x4*)(mu + 1024 + c), mug = *(const f32x4*)(mu + 1536 + c);
        const f32x4 lg = *(const f32x4*)(lng + c), lb = *(const f32x4*)(lnb + c);
        for (int idx0 = gt; idx0 < TOK * 128; idx0 += 4 * gs) {
            u32x2 yv[4], vc[4], gc[4], vp[4], gp[4]; float bn[4]; unsigned pm[4]; bool ok[4];
#pragma unroll
            for (int u = 0; u < 4; ++u) { const int idx = idx0 + u * gs; ok[u] = idx < TOK * 128; const int tok = ok[u] ? (idx >> 7) : 0;
                const bf16_t* cur = P + (size_t)tok * LDP + C_RW; const bool hp = (tok & (SEQ - 1)) > 0; const bf16_t* prv = hp ? cur - LDP : cur; pm[u] = hp ? 0xFFFFFFFFu : 0u;
                yv[u] = *(const u32x2*)(YRAW + (size_t)tok * 512 + c);
                vc[u] = *(const u32x2*)(cur + 1024 + c); gc[u] = *(const u32x2*)(cur + 1536 + c);
                vp[u] = *(const u32x2*)(prv + 1024 + c); gp[u] = *(const u32x2*)(prv + 1536 + c);
                bn[u] = BONUS[(size_t)tok * 8 + h]; }
#pragma unroll
            for (int u = 0; u < 4; ++u) { const int idx = idx0 + u * gs; const int tok = ok[u] ? (idx >> 7) : 0;
                float y[4] = {bf_lo(yv[u].x), bf_hi(yv[u].x), bf_lo(yv[u].y), bf_hi(yv[u].y)};
                const float mean = allred16(y[0] + y[1] + y[2] + y[3]) * (1.f / 64.f);
                float d[4], vs = 0.f;
#pragma unroll
                for (int e = 0; e < 4; ++e) { d[e] = y[e] - mean; vs += d[e] * d[e]; }
                const float var = allred16(vs) * (1.f / 64.f);
                const float rs = rsqrtf(var + 64e-5f);
                const unsigned m = pm[u];
                const float vcur[4] = {bf_lo(vc[u].x), bf_hi(vc[u].x), bf_lo(vc[u].y), bf_hi(vc[u].y)}, vprv[4] = {bf_lo(vp[u].x & m), bf_hi(vp[u].x & m), bf_lo(vp[u].y & m), bf_hi(vp[u].y & m)};
                const float gcur[4] = {bf_lo(gc[u].x), bf_hi(gc[u].x), bf_lo(gc[u].y), bf_hi(gc[u].y)}, gprv[4] = {bf_lo(gp[u].x & m), bf_hi(gp[u].x & m), bf_lo(gp[u].y & m), bf_hi(gp[u].y & m)};
                float o[4];
#pragma unroll
                for (int e = 0; e < 4; ++e) { const float vm = vcur[e] + (vprv[e] - vcur[e]) * muv[e], gm = gcur[e] + (gprv[e] - gcur[e]) * mug[e];
                    o[e] = (d[e] * rs * lg[e] + lb[e] + bn[u] * vm) * siluf_(gm); }
                u32x2 ov; ov.x = cvt_pk_bf16(o[0], o[1]); ov.y = cvt_pk_bf16(o[2], o[3]);
                if (ok[u]) *(u32x2*)(P + (size_t)tok * LDP + C_YRW + c) = ov; }
        }
    }
    for (int tok = gt; tok < TOK; tok += gs) { const f32x4* q = (const f32x4*)(SSQ + (size_t)tok * 32); float s = 0.f;
#pragma unroll
        for (int i = 0; i < 8; ++i) { const f32x4 v = q[i]; s += v[0] + v[1] + v[2] + v[3]; }
        RSTD[tok] = rsqrtf(s * (1.f / 1024.f) + 1e-6f); }
}

#define XB_TMO      128
#define XB_XCNT(j)  (256  + 64 * (j))
#define XB_XSUB(j)  (1280 + 64 * (j))
#define XB_XGEN(j)  (2304 + 64 * (j))
#define XB_TOP      3328
#define XB_TOPGEN   3392
#define XCD_BAR_WORDS 3456
#define XB_SPIN_CAP (1u << 18)
__device__ __forceinline__ unsigned xb_ld(unsigned* p)              { return __hip_atomic_load(p, __ATOMIC_RELAXED, __HIP_MEMORY_SCOPE_AGENT); }
__device__ __forceinline__ unsigned xb_add(unsigned* p, unsigned v) { return __hip_atomic_fetch_add(p, v, __ATOMIC_RELAXED, __HIP_MEMORY_SCOPE_AGENT); }
__device__ __forceinline__ unsigned xb_xcc_id() { return (unsigned)__builtin_amdgcn_s_getreg((3 << 11) | 20) & 0xFu; }
#define XB_SPIN(cond, bar) do { unsigned _sp = 0; while (cond) { __builtin_amdgcn_s_sleep(1); \
    if ((++_sp & 255u) == 0u) { if (xb_ld(&(bar)[XB_TMO])) break; if (_sp > XB_SPIN_CAP) { atomicAdd(&(bar)[XB_TMO], 1u); break; } } } } while (0)
struct XcdBarrier { unsigned* bar; unsigned x; volatile LAS unsigned* st; };
__device__ __forceinline__ XcdBarrier xcd_barrier_post(unsigned* bar, volatile LAS unsigned* st) {
    XcdBarrier b; b.bar = bar; b.x = xb_xcc_id(); b.st = st;
    if (threadIdx.x == 0) (void)xb_add(&bar[XB_XCNT(b.x)], 1u);
    return b;
}
__device__ __forceinline__ void xcd_barrier_complete(unsigned* bar, unsigned x, unsigned& nloc, unsigned& nx) {
    const unsigned G = gridDim.x * gridDim.y * gridDim.z;
    unsigned sum, cnt, mine, sp = 0u;
    for (;;) {
        sum = 0u; cnt = 0u; mine = 0u;
#pragma unroll
        for (unsigned j = 0; j < 16; ++j) { const unsigned c = xb_ld(&bar[XB_XCNT(j)]); sum += c; cnt += (c > 0u) ? 1u : 0u; mine = (j == x) ? c : mine; }
        if (sum == G) break;
        __builtin_amdgcn_s_sleep(1);
        if ((++sp & 255u) == 0u) { if (xb_ld(&bar[XB_TMO])) break; if (sp > XB_SPIN_CAP) { atomicAdd(&bar[XB_TMO], 1u); break; } }
    }
    nloc = mine > 0u ? mine : 1u; nx = cnt > 0u ? cnt : 1u;
}
__device__ __forceinline__ void xcd_barrier(const XcdBarrier& b) {
    asm volatile("s_waitcnt vmcnt(0)" ::: "memory");
    __syncthreads();
    if (threadIdx.x == 0) {
        unsigned* bar = b.bar;
        __builtin_amdgcn_s_waitcnt(0);
        unsigned nloc = b.st[0], nx = b.st[1];
        if (nloc == 0u) { xcd_barrier_complete(bar, b.x, nloc, nx); b.st[0] = nloc; b.st[1] = nx; }
        const unsigned old = xb_add(&bar[XB_XSUB(b.x)], 1u);
        const unsigned gen = old / nloc;
        if (old + 1u == (gen + 1u) * nloc) {
            __builtin_amdgcn_fence(__ATOMIC_RELEASE, "agent");
            asm volatile("s_waitcnt vmcnt(0)" ::: "memory");
            const unsigned og = xb_add(&bar[XB_TOP], 1u);
            const unsigned tg = og / nx;
            if (og + 1u == (tg + 1u) * nx) xb_add(&bar[XB_TOPGEN], 1u);
            else XB_SPIN(xb_ld(&bar[XB_TOPGEN]) == tg, bar);
            __builtin_amdgcn_fence(__ATOMIC_ACQUIRE, "agent");
            xb_add(&bar[XB_XGEN(b.x)], 1u);
            asm volatile("s_waitcnt vmcnt(0)" ::: "memory");
        } else {
            XB_SPIN(xb_ld(&bar[XB_XGEN(b.x)]) == gen, bar);
            __builtin_amdgcn_fence(__ATOMIC_ACQUIRE, "agent");
            asm volatile("s_waitcnt vmcnt(0)" ::: "memory");
        }
    }
    __syncthreads();
}

#define GSYNC() xcd_barrier(xb)
__global__ void __launch_bounds__(512, 2) mega(Params p) {
    extern __shared__ __attribute__((aligned(16))) unsigned char shm[];
    cg::grid_group grid = cg::this_grid();
    volatile LAS unsigned* xst = (volatile LAS unsigned*)((LAS unsigned char*)shm + LDS_BYTES - 16);
    if (threadIdx.x == 0) { xst[0] = 0u; xst[1] = 0u; }
    __syncthreads();
    const XcdBarrier xb = xcd_barrier_post((unsigned*)(p.ws + OFF_BAR), xst);
    const char* Pc = (const char*)(p.ws + OFF_P); const char* WTc = (const char*)(p.ws + OFF_WT);
    bf16_t* P = (bf16_t*)(p.ws + OFF_P);
    const int G = gridDim.x, c = blockIdx.x;
    for (int layer = 0; layer < 2; ++layer) {
        phase0(p, layer, shm);
        if (layer == 0) grid.sync(); else GSYNC();
        { SchedInproj S{Pc, WTc, G, c}; EpiInproj E{P}; pg8::gemm_phase<true>((LAS unsigned char*)shm, S, E); }
        GSYNC();
        { const int Gh = G >> 1;
            if (c < Gh) { for (int it = c; it < 128; it += Gh) rwkv_item(p, layer, shm, it); }
            else { const int c2 = c - Gh;
                bc_prepass(p, layer, c2, G - Gh);
                asm volatile("s_waitcnt vmcnt(0)" ::: "memory");
                __syncthreads();
                if (threadIdx.x == 0) { unsigned* cw_ = (unsigned*)(p.ws + OFF_BAR) + 3520; const unsigned need = (unsigned)(G - Gh) * (unsigned)(layer + 1);
                    __builtin_amdgcn_fence(__ATOMIC_RELEASE, "agent"); asm volatile("s_waitcnt vmcnt(0)" ::: "memory");
                    (void)xb_add(cw_, 1u);
                    unsigned sp_ = 0; while (xb_ld(cw_) < need) { __builtin_amdgcn_s_sleep(2); if (++sp_ > (1u << 22)) break; }
                    __builtin_amdgcn_fence(__ATOMIC_ACQUIRE, "agent"); asm volatile("s_waitcnt vmcnt(0)" ::: "memory"); }
                __syncthreads();
                for (int it = c2; it < 256; it += Gh) ssd_item(p, layer, shm, it);
                for (int it = c2; it < 1024; it += Gh) attn_item(p, shm, it); } }
        GSYNC();
        rw_post(p, layer);
        GSYNC();
        { SchedC1 S{Pc, WTc, G, c}; EpiC1 E{P, (const float*)(p.ws + OFF_RSTD)}; pg8::gemm_phase<true>((LAS unsigned char*)shm, S, E); }
        GSYNC();
        { SchedOut S{Pc, WTc, G, c}; EpiOut E{layer == 0 ? p.in[0] : p.out, p.out}; pg8::gemm_phase<false>((LAS unsigned char*)shm, S, E); }
        GSYNC();
    }
    { const int tid = opaque_tid(), wave = tid >> 6, lane = tid & 63; const float* fg = p.in[23];
        for (int row = blockIdx.x * 8 + wave; row < TOK; row += gridDim.x * 8) { float* xr = p.out + (size_t)row * DM;
            f32x4 v[4]; float ss = 0.f;
#pragma unroll
            for (int i = 0; i < 4; ++i) { v[i] = *(const f32x4*)(xr + i * 256 + lane * 4); ss += v[i][0] * v[i][0] + v[i][1] * v[i][1] + v[i][2] * v[i][2] + v[i][3] * v[i][3]; }
            ss = wave_sum(ss);
            const float rs = rsqrtf(ss * (1.f / DM) + 1e-6f);
#pragma unroll
            for (int i = 0; i < 4; ++i) { const f32x4 g = *(const f32x4*)(fg + i * 256 + lane * 4); *(f32x4*)(xr + i * 256 + lane * 4) = v[i] * rs * g; } } }
}

extern "C" void kernel_launch(void* const* d_in, const int* in_sizes, int n_in, void* d_out, int out_size, void* d_ws, size_t ws_size, hipStream_t stream) {
    static int grid_blocks = 0;
    if (grid_blocks == 0) {
        if (n_in != 24 || out_size != TOK * DM || ws_size < WS_NEED) { fprintf(stderr, "kernel_launch: unexpected shapes (n_in %d out %d ws %zu need %zu)\n", n_in, out_size, ws_size, (size_t)WS_NEED); grid_blocks = -1; return; }
        int dev = 0, cus = 0, per_cu = 0;
        hipGetDevice(&dev);
        hipDeviceGetAttribute(&cus, hipDeviceAttributeMultiprocessorCount, dev);
        hipFuncSetAttribute((const void*)mega, hipFuncAttributeMaxDynamicSharedMemorySize, LDS_BYTES);
        hipOccupancyMaxActiveBlocksPerMultiprocessor(&per_cu, (const void*)mega, 512, LDS_BYTES);
        if (per_cu < 1) { fprintf(stderr, "kernel_launch: occupancy query says %d blocks per CU\n", per_cu); grid_blocks = -1; return; }
        if (per_cu > 1) per_cu = 1;
        grid_blocks = cus * per_cu;
        grid_blocks &= ~7;
    }
    if (grid_blocks < 0) return;
    Params p{};
    for (int i = 0; i < 24; ++i) p.in[i] = (const float*)d_in[i];
    p.out = (float*)d_out; p.ws = (unsigned char*)d_ws;
    (void)hipMemsetAsync((unsigned char*)d_ws + OFF_BAR, 0, SZ_BAR, stream);
    void* args[] = {&p};
    hipError_t e = hipLaunchCooperativeKernel((const void*)mega, dim3(grid_blocks), dim3(512), args, LDS_BYTES, stream);
    if (e != hipSuccess) fprintf(stderr, "cooperative launch failed: %s (grid %d)\n", hipGetErrorString(e), grid_blocks);
}
```

```cpp
#include <hip/hip_runtime.h>
#include <hip/hip_cooperative_groups.h>
#include <cstdio>
namespace cg = cooperative_groups;

#define LAS __attribute__((address_space(3)))
typedef unsigned short bf16_t;
typedef short bf16x8 __attribute__((ext_vector_type(8)));
typedef float f32x4 __attribute__((ext_vector_type(4)));
typedef unsigned u32x4 __attribute__((ext_vector_type(4)));
typedef unsigned u32x2 __attribute__((ext_vector_type(2)));

constexpr int TOK = 16384, SEQ = 2048, DM = 1024, NIN = 9616;
constexpr int LDP = 7680;
constexpr int C_Q = 0, C_K = 512, C_V = 1024, C_SBG = 1536, C_Z = 2048, C_XBC = 3072, C_RW = 4352, C_DT = 6528, C_H = 6656;
constexpr int C_M = 0, C_G = 3072, C_YRW = 4352;
constexpr int R_GATE = 6656, R_SB = 9728, R_SSD = 10752, R_RWO = 11776, R_WO = 12800, WT_ROWS = 13824;
constexpr size_t OFF_P = 0, SZ_P = (size_t)TOK * LDP * 2;
constexpr size_t OFF_WT = OFF_P + SZ_P, SZ_WT = (size_t)WT_ROWS * 1024 * 2;
constexpr size_t OFF_YRAW = OFF_WT + SZ_WT, SZ_YRAW = (size_t)TOK * 512 * 2;
constexpr size_t OFF_SSQ = OFF_YRAW + SZ_YRAW, SZ_SSQ = (size_t)TOK * 32 * 4;
constexpr size_t OFF_RSTD = OFF_SSQ + SZ_SSQ, SZ_RSTD = (size_t)TOK * 4;
constexpr size_t OFF_BONUS = OFF_RSTD + SZ_RSTD, SZ_BONUS = (size_t)TOK * 8 * 4;
constexpr size_t OFF_BAR = OFF_BONUS + SZ_BONUS, SZ_BAR = 16384;
constexpr size_t OFF_BCC = OFF_BAR + SZ_BAR, SZ_BCC = (size_t)TOK * 256 * 2;
constexpr size_t WS_NEED = OFF_BCC + SZ_BCC;
constexpr int LDS_BYTES = 135168;

struct Params { const float* in[24]; float* out; unsigned char* ws; };

typedef float f32x2_t __attribute__((ext_vector_type(2)));
typedef __bf16 bf16x2_t __attribute__((ext_vector_type(2)));
__device__ __forceinline__ unsigned cvt_pk_bf16(float lo, float hi) { const f32x2_t v = {lo, hi}; return __builtin_bit_cast(unsigned, __builtin_convertvector(v, bf16x2_t)); }
__device__ __forceinline__ float bf_lo(unsigned u) { return __uint_as_float(u << 16); }
__device__ __forceinline__ float bf_hi(unsigned u) { return __uint_as_float(u & 0xFFFF0000u); }
__device__ __forceinline__ float bf2f(bf16_t h) { return __uint_as_float(((unsigned)h) << 16); }
__device__ __forceinline__ float sigmoidf_(float x) { return __builtin_amdgcn_rcpf(1.f + __expf(-x)); }
__device__ __forceinline__ float siluf_(float x) { return x * __builtin_amdgcn_rcpf(1.f + __expf(-x)); }
__device__ __forceinline__ float softplusf_(float x) { return fmaxf(x, 0.f) + __logf(1.f + __expf(-fabsf(x))); }
template <int CTRL> __device__ __forceinline__ float dppf(float x) { return __int_as_float(__builtin_amdgcn_update_dpp(0, __float_as_int(x), CTRL, 0xF, 0xF, true)); }
__device__ __forceinline__ float allred16(float x) { x += dppf<0xB1>(x); x += dppf<0x4E>(x); x += dppf<0x141>(x); x += dppf<0x140>(x); return x; }
__device__ __forceinline__ int opaque_tid() { int t; asm volatile("v_mov_b32 %0, %1" : "=v"(t) : "v"((int)threadIdx.x)); return t; }
__device__ __forceinline__ float wave_sum(float v) {
#pragma unroll
    for (int o = 1; o < 64; o <<= 1) v += __shfl_xor(v, o);
    return v;
}

namespace pg8 {
constexpr int BM = 256, BK = 64, HALF = 128, HTB = HALF * BK * 2, NXCD = 8, WGM = 8;
constexpr unsigned LDA_B = LDP * 2, LDB_B = 2048;
__device__ __forceinline__ int lds_byte(int r, int c) { const int st = (r >> 4) * 2 + (c >> 5), rr = r & 15, cc = c & 31, ob = rr * 64 + cc * 2; return st * 1024 + (ob ^ (((ob >> 9) & 1) << 5)); }
__device__ __forceinline__ void stage_rc(int b, int& R, int& C) { const int st = b / 1024, sb = b % 1024, swz = sb ^ (((sb >> 9) & 1) << 5); R = (st >> 1) * 16 + swz / 64; C = (st & 1) * 32 + (swz % 64) / 2; }
__device__ __forceinline__ int perm32(int rho) { const int n = rho >> 4, i = rho & 15; return 8 * (i >> 2) + 4 * n + (i & 3); }
struct UnitD { const char* A; const char* B; int nt, pm, pn, kind; };
__device__ __forceinline__ void tile_of(int L, int nM, int nN, int& pm, int& pn) {
    const int nwg = nM * nN; int wgid = L;
    { const int q = nwg / NXCD, r = nwg % NXCD, xcd = wgid % NXCD, off = wgid / NXCD; wgid = (xcd < r ? xcd * (q + 1) : r * (q + 1) + (xcd - r) * q) + off; }
    const int nig = WGM * nN, gid = wgid / nig, fm = gid * WGM, gsz = (nM - fm) < WGM ? (nM - fm) : WGM;
    pm = fm + ((wgid % nig) % gsz); pn = (wgid % nig) / gsz;
}

template <bool PERM, class Sched, class Epi>
__device__ __forceinline__ void gemm_phase(LAS unsigned char* lds, const Sched& S, const Epi& E) {
    const int tid = opaque_tid(), wid = __builtin_amdgcn_readfirstlane(tid >> 6), lane = tid & 63, wr = wid >> 2, wc = wid & 3, fr = lane & 15, fq = lane >> 4;
    unsigned voffA[2], voffB[2];
#pragma unroll
    for (int i = 0; i < 2; ++i) { int R, C; stage_rc(tid * 16 + i * 8192, R, C); const int Rb = PERM ? ((R & ~31) + perm32(R & 31)) : R;
        voffA[i] = (unsigned)R * LDA_B + (unsigned)C * 2u; voffB[i] = (unsigned)Rb * LDB_B + (unsigned)C * 2u; }
    const size_t kstep = (size_t)(BK * 2);
    const size_t hstepA = (size_t)HALF * LDA_B, hstepB = (size_t)HALF * LDB_B;
    const unsigned ldsw = (unsigned)wid * 1024u;
    const int aoff = lds_byte(wr * 64 + fr, fq * 8), boff = lds_byte(wc * 32 + fr, fq * 8);
#define PG8_SA(b, h) (((b) * 2 + (h)) * HTB)
#define PG8_SB(b, h) ((4 + (b) * 2 + (h)) * HTB)
#define PG8_STAGE(bufoff, gbase, voff) do { _Pragma("unroll") for (int _i = 0; _i < 2; ++_i) \
        __builtin_amdgcn_global_load_lds((const unsigned*)((const char*)(gbase) + (voff)[_i]), (LAS unsigned*)(lds + (bufoff) + ldsw + _i * 8192), 16, 0, 0); } while (0)
#define PG8_LDA(dst, b, h) do { _Pragma("unroll") for (int m = 0; m < 4; ++m) _Pragma("unroll") for (int k = 0; k < 2; ++k) dst[m][k] = *(const LAS bf16x8*)(lds + PG8_SA(b, h) + aoff + m * 2048 + k * 1024); } while (0)
#define PG8_LDB(dst, b, h) do { _Pragma("unroll") for (int n = 0; n < 2; ++n) _Pragma("unroll") for (int k = 0; k < 2; ++k) dst[n][k] = *(const LAS bf16x8*)(lds + PG8_SB(b, h) + boff + n * 2048 + k * 1024); } while (0)
#define PG8_MMA(ai, bj, At, Bt) do { __builtin_amdgcn_s_setprio(1); _Pragma("unroll") for (int m = 0; m < 4; ++m) _Pragma("unroll") for (int n = 0; n < 2; ++n) _Pragma("unroll") for (int k = 0; k < 2; ++k) \
        acc[ai][bj][m][n] = __builtin_amdgcn_mfma_f32_16x16x32_bf16(Bt[n][k], At[m][k], acc[ai][bj][m][n], 0, 0, 0); __builtin_amdgcn_s_setprio(0); } while (0)
#define PG8_WAIT_V(n) asm volatile("s_waitcnt vmcnt(" #n ")" ::: "memory")
#define PG8_WAIT_L(n) asm volatile("s_waitcnt lgkmcnt(" #n ")" ::: "memory")
#define PG8_BAR __builtin_amdgcn_s_barrier()
#define PG8_SCHED __builtin_amdgcn_sched_barrier(0)
    UnitD cur, nxt; int ui = 0;
    if (!S.next(0, cur)) return;
    f32x4 acc[2][2][4][2];
#pragma unroll
    for (int a = 0; a < 2; ++a)
#pragma unroll
        for (int b = 0; b < 2; ++b)
#pragma unroll
            for (int m = 0; m < 4; ++m)
#pragma unroll
                for (int n = 0; n < 2; ++n) acc[a][b][m][n] = (f32x4){0.f, 0.f, 0.f, 0.f};
    bf16x8 At[4][2], B0[2][2], B1[2][2];
    const char* cA = cur.A; const char* cB = cur.B;
    PG8_STAGE(PG8_SB(0, 0), cB, voffB); PG8_STAGE(PG8_SA(0, 0), cA, voffA); PG8_STAGE(PG8_SB(0, 1), cB + hstepB, voffB); PG8_STAGE(PG8_SA(0, 1), cA + hstepA, voffA);
    if (wr == 1) PG8_BAR;
    PG8_WAIT_V(4); PG8_BAR;
    PG8_STAGE(PG8_SB(1, 0), cB + kstep, voffB); PG8_STAGE(PG8_SA(1, 0), cA + kstep, voffA); PG8_STAGE(PG8_SB(1, 1), cB + hstepB + kstep, voffB);
    PG8_WAIT_V(6); PG8_BAR;
    for (;;) {
        const bool has_next = S.next(ui + 1, nxt);
        const char* nA = has_next ? nxt.A : cA; const char* nB = has_next ? nxt.B : cB;
        const int nt = cur.nt;
        for (int t = 0; t < nt; t += 2) {
            const bool last = (t == nt - 2);
            const char* a1 = cA + (size_t)(t + 1) * kstep;
            const char* a2 = last ? nA : cA + (size_t)(t + 2) * kstep; const char* b2 = last ? nB : cB + (size_t)(t + 2) * kstep;
            const char* a3 = a2 + kstep; const char* b3 = b2 + kstep;
            PG8_LDB(B0, 0, 0); PG8_SCHED; PG8_LDA(At, 0, 0); PG8_STAGE(PG8_SA(1, 1), a1 + hstepA, voffA);
            PG8_WAIT_L(8); PG8_BAR; PG8_WAIT_L(0); PG8_MMA(0, 0, At, B0); PG8_BAR; PG8_SCHED;
            PG8_LDB(B1, 0, 1); PG8_STAGE(PG8_SB(0, 0), b2, voffB);
            PG8_BAR; PG8_WAIT_L(0); PG8_MMA(0, 1, At, B1); PG8_BAR;
            PG8_LDA(At, 0, 1); PG8_STAGE(PG8_SA(0, 0), a2, voffA);
            PG8_BAR; PG8_WAIT_L(0); PG8_MMA(1, 0, At, B0); PG8_BAR; PG8_SCHED;
            PG8_STAGE(PG8_SB(0, 1), b2 + hstepB, voffB);
            PG8_WAIT_V(6); PG8_BAR; PG8_MMA(1, 1, At, B1); PG8_BAR;
            PG8_LDB(B0, 1, 0); PG8_SCHED; PG8_LDA(At, 1, 0); PG8_STAGE(PG8_SA(0, 1), a2 + hstepA, voffA);
            PG8_WAIT_L(8); PG8_BAR; PG8_WAIT_L(0); PG8_MMA(0, 0, At, B0); PG8_BAR; PG8_SCHED;
            PG8_LDB(B1, 1, 1); PG8_STAGE(PG8_SB(1, 0), b3, voffB);
            PG8_BAR; PG8_WAIT_L(0); PG8_MMA(0, 1, At, B1); PG8_BAR;
            PG8_LDA(At, 1, 1); PG8_STAGE(PG8_SA(1, 0), a3, voffA);
            PG8_BAR; PG8_WAIT_L(0); PG8_MMA(1, 0, At, B0); PG8_BAR; PG8_SCHED;
            PG8_STAGE(PG8_SB(1, 1), b3 + hstepB, voffB);
            PG8_WAIT_V(6); PG8_BAR; PG8_MMA(1, 1, At, B1); PG8_BAR;
        }
        E(acc, cur, wr, wc, fr, fq);
        if (!has_next) break;
#pragma unroll
        for (int a = 0; a < 2; ++a)
#pragma unroll
            for (int b = 0; b < 2; ++b)
#pragma unroll
                for (int m = 0; m < 4; ++m)
#pragma unroll
                    for (int n = 0; n < 2; ++n) acc[a][b][m][n] = (f32x4){0.f, 0.f, 0.f, 0.f};
        cur = nxt; cA = nA; cB = nB; ++ui;
    }
    PG8_WAIT_V(0);
    if (wr == 0) PG8_BAR;
    PG8_BAR;
#undef PG8_SA
#undef PG8_SB
#undef PG8_STAGE
#undef PG8_LDA
#undef PG8_LDB
#undef PG8_MMA
#undef PG8_WAIT_V
#undef PG8_WAIT_L
#undef PG8_BAR
#undef PG8_SCHED
}
}
using pg8::UnitD;

struct SchedInproj {
    const char* P; const char* WT; int G, c;
    __device__ __forceinline__ bool next(int i, UnitD& u) const {
        const int L = i * G + c; if (L >= 64 * 26) return false;
        int pm, pn; pg8::tile_of(L, 64, 26, pm, pn);
        u.A = P + ((size_t)pm * 256 * LDP + C_H) * 2; u.B = WT + (size_t)pn * 256 * 2048; u.nt = 16; u.pm = pm; u.pn = pn; u.kind = 0; return true;
    }
};
struct EpiInproj {
    bf16_t* P;
    __device__ __forceinline__ void operator()(const f32x4 (&acc)[2][2][4][2], const UnitD& u, int wr, int wc, int fr, int fq) const {
        const int row0 = u.pm * 256 + wr * 64 + fr, col0 = u.pn * 256 + wc * 32 + 8 * fq;
#pragma unroll
        for (int ai = 0; ai < 2; ++ai)
#pragma unroll
            for (int m = 0; m < 4; ++m) { bf16_t* rowp = P + (size_t)(row0 + ai * 128 + m * 16) * LDP + col0;
#pragma unroll
                for (int bj = 0; bj < 2; ++bj) { const f32x4 v0 = acc[ai][bj][m][0], v1 = acc[ai][bj][m][1];
                    u32x4 o; o.x = cvt_pk_bf16(v0[0], v0[1]); o.y = cvt_pk_bf16(v0[2], v0[3]); o.z = cvt_pk_bf16(v1[0], v1[1]); o.w = cvt_pk_bf16(v1[2], v1[3]);
                    *(u32x4*)(rowp + bj * 128) = o; } }
    }
};
struct SchedC1 {
    const char* P; const char* WT; int G, c;
    __device__ __forceinline__ bool next(int i, UnitD& u) const {
        const int ti = i / 6, sub = i - ti * 6, L = ti * G + c; if (L >= 256) return false;
        int pm, pn; pg8::tile_of(L, 64, 4, pm, pn);
        const int br = sub >> 1;
        if (!(sub & 1)) { u.A = P + ((size_t)pm * 256 * LDP + C_H) * 2; u.B = WT + (size_t)(R_GATE + br * 1024 + pn * 256) * 2048; u.nt = 16; }
        else { const int acol = br == 0 ? C_SBG : (br == 1 ? C_Z : C_YRW); const int brow = br == 0 ? R_SB : (br == 1 ? R_SSD : R_RWO);
            u.A = P + ((size_t)pm * 256 * LDP + acol) * 2; u.B = WT + (size_t)(brow + pn * 256) * 2048; u.nt = br == 1 ? 16 : 8; }
        u.pm = pm; u.pn = pn; u.kind = sub; return true;
    }
};
struct EpiC1 {
    bf16_t* P; const float* rstd;
    __device__ __forceinline__ void operator()(const f32x4 (&acc)[2][2][4][2], const UnitD& u, int wr, int wc, int fr, int fq) const {
        const int row0 = u.pm * 256 + wr * 64 + fr, col0 = u.pn * 256 + wc * 32 + 8 * fq;
        const int kind = u.kind;
#pragma unroll
        for (int ai = 0; ai < 2; ++ai)
#pragma unroll
            for (int m = 0; m < 4; ++m) { const int row = row0 + ai * 128 + m * 16; bf16_t* rowp = P + (size_t)row * LDP + col0;
                const float sc = (kind == 3) ? rstd[row] : 1.f;
#pragma unroll
                for (int bj = 0; bj < 2; ++bj) { const f32x4 v0 = acc[ai][bj][m][0], v1 = acc[ai][bj][m][1];
                    float v[8] = {v0[0], v0[1], v0[2], v0[3], v1[0], v1[1], v1[2], v1[3]};
                    u32x4* gp = (u32x4*)(rowp + C_G + bj * 128); u32x4* mp = (u32x4*)(rowp + C_M + bj * 128);
                    if (!(kind & 1)) {
#pragma unroll
                        for (int e = 0; e < 8; ++e) v[e] = sigmoidf_(v[e]);
                        u32x4 o; o.x = cvt_pk_bf16(v[0], v[1]); o.y = cvt_pk_bf16(v[2], v[3]); o.z = cvt_pk_bf16(v[4], v[5]); o.w = cvt_pk_bf16(v[6], v[7]);
                        *gp = o;
                    } else {
                        const u32x4 g = *gp;
                        float r[8];
                        r[0] = bf_lo(g.x) * v[0] * sc; r[1] = bf_hi(g.x) * v[1] * sc; r[2] = bf_lo(g.y) * v[2] * sc; r[3] = bf_hi(g.y) * v[3] * sc;
                        r[4] = bf_lo(g.z) * v[4] * sc; r[5] = bf_hi(g.z) * v[5] * sc; r[6] = bf_lo(g.w) * v[6] * sc; r[7] = bf_hi(g.w) * v[7] * sc;
                        if (kind != 1) { const u32x4 mo = *mp;
                            r[0] += bf_lo(mo.x); r[1] += bf_hi(mo.x); r[2] += bf_lo(mo.y); r[3] += bf_hi(mo.y); r[4] += bf_lo(mo.z); r[5] += bf_hi(mo.z); r[6] += bf_lo(mo.w); r[7] += bf_hi(mo.w); }
                        u32x4 o; o.x = cvt_pk_bf16(r[0], r[1]); o.y = cvt_pk_bf16(r[2], r[3]); o.z = cvt_pk_bf16(r[4], r[5]); o.w = cvt_pk_bf16(r[6], r[7]);
                        *mp = o;
                    } } }
    }
};
struct SchedOut {
    const char* P; const char* WT; int G, c;
    __device__ __forceinline__ bool next(int i, UnitD& u) const {
        const int L = i * G + c; if (L >= 256) return false;
        int pm, pn; pg8::tile_of(L, 64, 4, pm, pn);
        u.A = P + ((size_t)pm * 256 * LDP + C_M) * 2; u.B = WT + (size_t)(R_WO + pn * 256) * 2048; u.nt = 16; u.pm = pm; u.pn = pn; u.kind = 0; return true;
    }
};
struct EpiOut {
    const float* Xin; float* Xout;
    __device__ __forceinline__ void operator()(const f32x4 (&acc)[2][2][4][2], const UnitD& u, int wr, int wc, int fr, int fq) const {
        const int row0 = u.pm * 256 + wr * 64 + fr, col0 = u.pn * 256 + wc * 32 + 4 * fq;
#pragma unroll
        for (int ai = 0; ai < 2; ++ai)
#pragma unroll
            for (int m = 0; m < 4; ++m) { const size_t ro = (size_t)(row0 + ai * 128 + m * 16) * DM + col0;
#pragma unroll
                for (int bj = 0; bj < 2; ++bj)
#pragma unroll
                    for (int n = 0; n < 2; ++n) { const f32x4 xi = *(const f32x4*)(Xin + ro + bj * 128 + n * 16); *(f32x4*)(Xout + ro + bj * 128 + n * 16) = xi + acc[ai][bj][m][n]; } }
    }
};

__device__ __forceinline__ void phase0(const Params& p, int layer, unsigned char* shm) {
    const int tid = opaque_tid(), wave = tid >> 6, lane = tid & 63;
    bf16_t* P = (bf16_t*)(p.ws + OFF_P); bf16_t* WT = (bf16_t*)(p.ws + OFF_WT);
    const float* Xin = layer == 0 ? p.in[0] : p.out;
    const float* ng = p.in[1] + layer * DM;
    f32x4 gn[4];
#pragma unroll
    for (int i = 0; i < 4; ++i) gn[i] = *(const f32x4*)(ng + i * 256 + lane * 4);
    for (int row0 = (blockIdx.x * 8 + wave) * 4; row0 < TOK; row0 += gridDim.x * 32) {
        f32x4 v[4][4]; float ss[4];
#pragma unroll
        for (int rr = 0; rr < 4; ++rr) { const float* xr = Xin + (size_t)(row0 + rr) * DM;
#pragma unroll
            for (int i = 0; i < 4; ++i) v[rr][i] = *(const f32x4*)(xr + i * 256 + lane * 4); }
#pragma unroll
        for (int rr = 0; rr < 4; ++rr) { float a = 0.f;
#pragma unroll
            for (int i = 0; i < 4; ++i) a += v[rr][i][0] * v[rr][i][0] + v[rr][i][1] * v[rr][i][1] + v[rr][i][2] * v[rr][i][2] + v[rr][i][3] * v[rr][i][3];
            ss[rr] = wave_sum(a); }
#pragma unroll
        for (int rr = 0; rr < 4; ++rr) { const float rs = rsqrtf(ss[rr] * (1.f / DM) + 1e-6f);
#pragma unroll
            for (int i = 0; i < 4; ++i) { const f32x4 g = gn[i];
                u32x2 o; o.x = cvt_pk_bf16(v[rr][i][0] * rs * g[0], v[rr][i][1] * rs * g[1]); o.y = cvt_pk_bf16(v[rr][i][2] * rs * g[2], v[rr][i][3] * rs * g[3]);
                *(u32x2*)(P + (size_t)(row0 + rr) * LDP + C_H + i * 256 + lane * 4) = o; } }
    }
    float* T = (float*)shm + wave * (64 * 65);
    const float* w_in = p.in[2] + (size_t)layer * DM * NIN;
    const float* sg = p.in[8] + layer * DM;
    for (int job = blockIdx.x * 8 + wave; job < 3200; job += gridDim.x * 8) {
        const float* src; int srcN, k0, n0, dstrow; bool is_in = false, is_ssd = false;
        if (job < 2432) { is_in = true; src = w_in; srcN = NIN; const int ntile = job >> 4; k0 = (job & 15) * 64; n0 = ntile * 64; dstrow = n0; }
        else { int r = job - 2432;
            if (r < 128) { src = p.in[19] + (size_t)layer * 512 * DM; k0 = (r >> 4) * 64; n0 = (r & 15) * 64; dstrow = R_SB + n0; }
            else if (r < 384) { r -= 128; src = p.in[20] + (size_t)layer * DM * DM; k0 = (r >> 4) * 64; n0 = (r & 15) * 64; dstrow = R_SSD + n0; is_ssd = true; }
            else if (r < 512) { r -= 384; src = p.in[21] + (size_t)layer * 512 * DM; k0 = (r >> 4) * 64; n0 = (r & 15) * 64; dstrow = R_RWO + n0; }
            else { r -= 512; src = p.in[22] + (size_t)layer * DM * DM; k0 = (r >> 4) * 64; n0 = (r & 15) * 64; dstrow = R_WO + n0; }
            srcN = DM; }
        const int n4 = (lane & 15) * 4, np = n0 + n4; int sc = np;
        if (is_in) { if (np < 4352) sc = np; else if (np < 6528) sc = np + 16; else if (np < 6544) sc = np - 6528 + 4352; else if (np < 6656) sc = -1; else sc = np - 112; }
        f32x4 v[16];
#pragma unroll
        for (int i = 0; i < 16; ++i) { const int k = (lane >> 4) + 4 * i; v[i] = (f32x4){0.f, 0.f, 0.f, 0.f};
            if (sc >= 0) v[i] = *(const f32x4*)(src + (size_t)(k0 + k) * srcN + sc); }
#pragma unroll
        for (int i = 0; i < 16; ++i) { const int k = (lane >> 4) + 4 * i; f32x4 x = v[i];
            if (is_ssd) x = x * sg[k0 + k];
            T[k * 65 + n4] = x[0]; T[k * 65 + n4 + 1] = x[1]; T[k * 65 + n4 + 2] = x[2]; T[k * 65 + n4 + 3] = x[3]; }
        asm volatile("s_waitcnt lgkmcnt(0)" ::: "memory"); __builtin_amdgcn_wave_barrier(); asm volatile("" ::: "memory");
#pragma unroll
        for (int j = 0; j < 8; ++j) { const int r = lane + 64 * j, n = r >> 3, kc = (r & 7) * 8; const float* sp = T + kc * 65 + n;
            u32x4 o; o.x = cvt_pk_bf16(sp[0], sp[65]); o.y = cvt_pk_bf16(sp[130], sp[195]); o.z = cvt_pk_bf16(sp[260], sp[325]); o.w = cvt_pk_bf16(sp[390], sp[455]);
            *(u32x4*)(WT + (size_t)(dstrow + n) * 1024 + k0 + kc) = o; }
        asm volatile("s_waitcnt lgkmcnt(0)" ::: "memory"); __builtin_amdgcn_wave_barrier(); asm volatile("" ::: "memory");
    }
    __syncthreads();
}

__device__ __forceinline__ void attn_item(const Params& p, unsigned char* shm, int item) {
    const int qb = item & 15, h = (item >> 4) & 7, b = item >> 7;
    bf16_t* P = (bf16_t*)(p.ws + OFF_P);
    const int tid = opaque_tid(), wave = tid >> 6, lane = tid & 63, lq = lane & 15, g = lane >> 4;
    const size_t rowbase = (size_t)b * SEQ;
    const int t = qb * 128 + wave * 16 + lq;
    const int tmax = qb * 128 + wave * 16 + 15;
    constexpr int ABUF = 64 * 144 + 64 * 136;
    const bf16_t* qp = P + (rowbase + t) * LDP + C_Q + h * 64 + 8 * g;
    const bf16x8 qf0 = *(const bf16x8*)qp, qf1 = *(const bf16x8*)(qp + 32);
    bf16x8 TT[4][2];
#pragma unroll
    for (int a = 0; a < 4; ++a)
#pragma unroll
        for (int ks = 0; ks < 2; ++ks)
#pragma unroll
            for (int e = 0; e < 8; ++e) { const int j = 16 * (2 * ks + (e >> 2)) + 4 * g + (e & 3); TT[a][ks][e] = (j > 16 * a + lq) ? (short)0x3F80 : (short)0; }
    f32x4 o[4];
#pragma unroll
    for (int i = 0; i < 4; ++i) o[i] = (f32x4){0.f, 0.f, 0.f, 0.f};
    float R = 0.f;
    LAS volatile int* flg = (LAS volatile int*)((LAS unsigned char*)shm + 2 * ABUF);
    const int st_s = tid >> 3, st_dc = (tid & 7) * 8;
    const bf16_t* st_base = P + (rowbase + st_s) * LDP + h * 64 + st_dc;
    auto stage_write = [&](unsigned char* buf, const u32x4& kv, const u32x4& vv) {
        bf16_t* Ksw = (bf16_t*)buf; bf16_t* Vtw = (bf16_t*)(buf + 64 * 144); const int s_ = st_s, dc = st_dc;
        *(u32x4*)(Ksw + s_ * 72 + dc) = kv;
        Vtw[(dc + 0) * 68 + s_] = (bf16_t)(vv.x & 0xFFFF); Vtw[(dc + 1) * 68 + s_] = (bf16_t)(vv.x >> 16);
        Vtw[(dc + 2) * 68 + s_] = (bf16_t)(vv.y & 0xFFFF); Vtw[(dc + 3) * 68 + s_] = (bf16_t)(vv.y >> 16);
        Vtw[(dc + 4) * 68 + s_] = (bf16_t)(vv.z & 0xFFFF); Vtw[(dc + 5) * 68 + s_] = (bf16_t)(vv.z >> 16);
        Vtw[(dc + 6) * 68 + s_] = (bf16_t)(vv.w & 0xFFFF); Vtw[(dc + 7) * 68 + s_] = (bf16_t)(vv.w >> 16);
    };
    if (tid == 0) { flg[0] = 1; flg[1] = 0; flg[2] = 0; }
    { const bf16_t* kr = st_base + (size_t)(2 * qb + 1) * 64 * LDP; const u32x4 kv0 = *(const u32x4*)(kr + C_K), vv0 = *(const u32x4*)(kr + C_V); stage_write(shm, kv0, vv0); }
    int itn = 0, cur = 0;
    for (int kt = 2 * qb + 1; kt >= 0; --kt) {
        __syncthreads();
        const int f0 = itn % 3, f1 = (itn + 1) % 3, f2 = (itn + 2) % 3;
        if (flg[f0] == 0) break;
        if (tid == 0) flg[f2] = 0;
        u32x4 kvn = (u32x4){0u, 0u, 0u, 0u}, vvn = (u32x4){0u, 0u, 0u, 0u};
        if (kt > 0) { const bf16_t* kr = st_base + (size_t)(kt - 1) * 64 * LDP; kvn = *(const u32x4*)(kr + C_K); vvn = *(const u32x4*)(kr + C_V); }
        const bf16_t* Ks = (const bf16_t*)(shm + cur * ABUF); const bf16_t* Vt = (const bf16_t*)(shm + cur * ABUF + 64 * 144);
        const bool walive = __any(R > -104.f);
        const bool act = (kt * 64 < tmax) && walive;
        if (act) {
            float lb[4][4], lk[4][4];
#pragma unroll
            for (int sub = 0; sub < 4; ++sub) {
                const bf16_t* kp = Ks + (16 * sub + lq) * 72 + 8 * g;
                const bf16x8 k0 = *(const bf16x8*)kp, k1 = *(const bf16x8*)(kp + 32);
                f32x4 s4 = (f32x4){0.f, 0.f, 0.f, 0.f};
                s4 = __builtin_amdgcn_mfma_f32_16x16x32_bf16(k0, qf0, s4, 0, 0, 0);
                s4 = __builtin_amdgcn_mfma_f32_16x16x32_bf16(k1, qf1, s4, 0, 0, 0);
#pragma unroll
                for (int r = 0; r < 4; ++r) { const float z = s4[r] * 0.125f; const bool mk = (kt * 64 + 16 * sub + 4 * g + r) < t;
                    const float l = fminf(z, 0.f) - __logf(1.f + __expf(-fabsf(z)));
                    lb[sub][r] = mk ? l : -1e30f; lk[sub][r] = mk ? (l - z) : 0.f; }
            }
            bf16x8 hi[2];
#pragma unroll
            for (int ks = 0; ks < 2; ++ks) {
                unsigned hw[4];
#pragma unroll
                for (int w2 = 0; w2 < 4; ++w2) { const int sub = 2 * ks + (w2 >> 1), r0 = (w2 & 1) * 2; const float a0 = lk[sub][r0], a1 = lk[sub][r0 + 1];
                    hw[w2] = cvt_pk_bf16(a0, a1); }
                u32x4 hv = (u32x4){hw[0], hw[1], hw[2], hw[3]};
                hi[ks] = __builtin_bit_cast(bf16x8, hv);
            }
            f32x4 aft[4];
#pragma unroll
            for (int a = 0; a < 4; ++a) { f32x4 c = (f32x4){0.f, 0.f, 0.f, 0.f};
#pragma unroll
                for (int ks = 0; ks < 2; ++ks) c = __builtin_amdgcn_mfma_f32_16x16x32_bf16(TT[a][ks], hi[ks], c, 0, 0, 0);
                aft[a] = c; }
            float tot = aft[0][0] + lk[0][0];
            tot = __shfl(tot, lq);
            bf16x8 pf[2];
#pragma unroll
            for (int ks = 0; ks < 2; ++ks) { unsigned pw[4];
#pragma unroll
                for (int w2 = 0; w2 < 4; ++w2) { const int sub = 2 * ks + (w2 >> 1), r0 = (w2 & 1) * 2;
                    const float e0 = __expf(lb[sub][r0] + aft[sub][r0] + R), e1 = __expf(lb[sub][r0 + 1] + aft[sub][r0 + 1] + R);
                    pw[w2] = cvt_pk_bf16(e0, e1); }
                u32x4 pv = (u32x4){pw[0], pw[1], pw[2], pw[3]}; pf[ks] = __builtin_bit_cast(bf16x8, pv); }
            R += tot;
#pragma unroll
            for (int ds = 0; ds < 4; ++ds)
#pragma unroll
                for (int ks = 0; ks < 2; ++ks) { const bf16_t* vp = Vt + (16 * ds + lq) * 68 + 32 * ks + 4 * g;
                    const u32x2 v0 = *(const u32x2*)vp, v1 = *(const u32x2*)(vp + 16);
                    u32x4 vv = (u32x4){v0.x, v0.y, v1.x, v1.y};
                    o[ds] = __builtin_amdgcn_mfma_f32_16x16x32_bf16(__builtin_bit_cast(bf16x8, vv), pf[ks], o[ds], 0, 0, 0); }
        }
        if (__any(R > -104.f) && lane == 0) flg[f1] = 1;
        if (kt > 0) stage_write(shm + (cur ^ 1) * ABUF, kvn, vvn);
        cur ^= 1; ++itn;
    }
#pragma unroll
    for (int ds = 0; ds < 4; ++ds) { bf16_t* gp = P + (rowbase + t) * LDP + C_SBG + h * 64 + 16 * ds + 4 * g;
        const u32x2 gv = *(const u32x2*)gp;
        u32x2 ov; ov.x = cvt_pk_bf16(o[ds][0] * siluf_(bf_lo(gv.x)), o[ds][1] * siluf_(bf_hi(gv.x))); ov.y = cvt_pk_bf16(o[ds][2] * siluf_(bf_lo(gv.y)), o[ds][3] * siluf_(bf_hi(gv.y)));
        *(u32x2*)gp = ov; }
    __syncthreads();
}

__device__ __forceinline__ void bc_prepass(const Params& p, int layer, int blk, int nblk) {
    const bf16_t* P = (const bf16_t*)(p.ws + OFF_P); bf16_t* BCc = (bf16_t*)(p.ws + OFF_BCC);
    const float* cw = p.in[3] + (size_t)layer * 4 * 1280; const float* cb = p.in[4] + layer * 1280;
    const int gt = blk * 512 + opaque_tid(), gs = nblk * 512;
    const int c = (gt & 63) * 4, chn = 1024 + c;
    const f32x4 bias = *(const f32x4*)(cb + chn);
    f32x4 w[4];
#pragma unroll
    for (int k = 0; k < 4; ++k) w[k] = *(const f32x4*)(cw + k * 1280 + chn);
    for (int idx0 = gt; idx0 < TOK * 64; idx0 += 4 * gs) {
        u32x2 xv[4][4]; bool ok[4];
#pragma unroll
        for (int u = 0; u < 4; ++u) { const int idx = idx0 + u * gs; ok[u] = idx < TOK * 64; const int tok = ok[u] ? (idx >> 6) : 0; const int t = tok & (SEQ - 1);
            const bf16_t* xp = P + (size_t)tok * LDP + C_XBC + chn;
#pragma unroll
            for (int k = 0; k < 4; ++k) { const int ts = t - 3 + k; const unsigned xm = ts >= 0 ? 0xFFFFFFFFu : 0u;
                u32x2 x = *(const u32x2*)(xp + (ptrdiff_t)(ts >= 0 ? k - 3 : 0) * LDP); x.x &= xm; x.y &= xm; xv[u][k] = x; } }
#pragma unroll
        for (int u = 0; u < 4; ++u) { const int idx = idx0 + u * gs; const int tok = ok[u] ? (idx >> 6) : 0;
            f32x4 a = bias;
#pragma unroll
            for (int k = 0; k < 4; ++k) { a[0] += w[k][0] * bf_lo(xv[u][k].x); a[1] += w[k][1] * bf_hi(xv[u][k].x); a[2] += w[k][2] * bf_lo(xv[u][k].y); a[3] += w[k][3] * bf_hi(xv[u][k].y); }
            u32x2 o; o.x = cvt_pk_bf16(siluf_(a[0]), siluf_(a[1])); o.y = cvt_pk_bf16(siluf_(a[2]), siluf_(a[3]));
            if (ok[u]) *(u32x2*)(BCc + (size_t)tok * 256 + c) = o; }
    }
}

__device__ __forceinline__ void ssd_item(const Params& p, int layer, unsigned char* shm, int item) {
    const int ph = item & 1, hh = (item >> 1) & 15, b = item >> 5, grp = hh >> 3;
    bf16_t* P = (bf16_t*)(p.ws + OFF_P); float* SSQ = (float*)(p.ws + OFF_SSQ);
    const int tid = opaque_tid(), wave = tid >> 6, lane = tid & 63, lq = lane & 15, g = lane >> 4;
    const size_t rowbase = (size_t)b * SEQ;
    const float* cw = p.in[3] + (size_t)layer * 4 * 1280; const float* cb = p.in[4] + layer * 1280;
    const float dtb = p.in[5][layer * 16 + hh], Aneg = -__expf(p.in[6][layer * 16 + hh]), Dsk = p.in[7][layer * 16 + hh];
    float* XS = (float*)shm;
    float* YS = XS + 2048;
    float* DTs = YS + 2048;
    float* ACS = DTs + 64;
    bf16_t* Cb = (bf16_t*)(ACS + 64);
    bf16_t* Bb = Cb + 64 * 72;
    bf16_t* BT = Bb + 64 * 72;
    bf16_t* Mx = BT + 64 * 72;
    bf16_t* XT = Mx + 64 * 72;
    bf16_t* XwT = XT + 32 * 72;
    bf16_t* SbT = XwT + 32 * 72;
    f32x4 Sacc = (f32x4){0.f, 0.f, 0.f, 0.f};
    const bf16_t* BCc = (const bf16_t*)(p.ws + OFF_BCC);
    const int x_tt = tid >> 3, x_c = (tid & 7) * 4, x_chn = hh * 64 + ph * 32 + x_c;
    const int bc_q = tid & 7;
    const f32x4 xbias = *(const f32x4*)(cb + x_chn);
    f32x4 xw[4];
#pragma unroll
    for (int k = 0; k < 4; ++k) xw[k] = *(const f32x4*)(cw + k * 1280 + x_chn);
    u32x2 sx[4]; u32x4 bc0, bc1; bf16_t sdt = 0;
    auto ssd_load = [&](int tb) {
        const int t = tb + x_tt;
        const bf16_t* xp = P + (rowbase + t) * LDP + C_XBC + x_chn;
#pragma unroll
        for (int k = 0; k < 4; ++k) { const int ts = t - 3 + k; const unsigned xm = ts >= 0 ? 0xFFFFFFFFu : 0u;
            u32x2 xv = *(const u32x2*)(xp + (ptrdiff_t)(ts >= 0 ? k - 3 : 0) * LDP); xv.x &= xm; xv.y &= xm; sx[k] = xv; }
        const bf16_t* bp = BCc + (rowbase + t) * 256 + (bc_q < 4 ? grp * 64 + bc_q * 16 : 128 + grp * 64 + (bc_q - 4) * 16);
        bc0 = *(const u32x4*)bp; bc1 = *(const u32x4*)(bp + 8);
        if (tid < 64) sdt = P[(rowbase + tb + tid) * LDP + C_DT + hh];
    };
    ssd_load(0);
    for (int ch = 0; ch < SEQ / 64; ++ch) {
        const int t0 = ch * 64;
        __syncthreads();
        const int o_tt = tid >> 3, o_p4 = (tid & 7) * 4;
        bf16_t* zp = P + (rowbase + t0 + o_tt) * LDP + C_Z + hh * 64 + ph * 32 + o_p4;
        const u32x2 zv = *(const u32x2*)zp;
        { f32x4 a = xbias;
#pragma unroll
            for (int k = 0; k < 4; ++k) { a[0] += xw[k][0] * bf_lo(sx[k].x); a[1] += xw[k][1] * bf_hi(sx[k].x); a[2] += xw[k][2] * bf_lo(sx[k].y); a[3] += xw[k][3] * bf_hi(sx[k].y); }
            a[0] = siluf_(a[0]); a[1] = siluf_(a[1]); a[2] = siluf_(a[2]); a[3] = siluf_(a[3]);
            const unsigned q0 = cvt_pk_bf16(a[0], a[1]), q1 = cvt_pk_bf16(a[2], a[3]); const int tt = x_tt, c = x_c;
            *(f32x4*)(XS + tt * 32 + c) = a;
            XT[(c + 0) * 72 + tt] = (bf16_t)(q0 & 0xFFFF); XT[(c + 1) * 72 + tt] = (bf16_t)(q0 >> 16); XT[(c + 2) * 72 + tt] = (bf16_t)(q1 & 0xFFFF); XT[(c + 3) * 72 + tt] = (bf16_t)(q1 >> 16);
            if (bc_q < 4) { const int n = bc_q * 16; *(u32x4*)(Bb + tt * 72 + n) = bc0; *(u32x4*)(Bb + tt * 72 + n + 8) = bc1;
                const unsigned wv[8] = {bc0.x, bc0.y, bc0.z, bc0.w, bc1.x, bc1.y, bc1.z, bc1.w};
#pragma unroll
                for (int e = 0; e < 8; ++e) { BT[(n + 2 * e) * 72 + tt] = (bf16_t)(wv[e] & 0xFFFF); BT[(n + 2 * e + 1) * 72 + tt] = (bf16_t)(wv[e] >> 16); } }
            else { const int n = (bc_q - 4) * 16; *(u32x4*)(Cb + tt * 72 + n) = bc0; *(u32x4*)(Cb + tt * 72 + n + 8) = bc1; } }
        if (tid < 64) { const float dt = softplusf_(bf2f(sdt) + dtb); DTs[tid] = dt;
            float x = dt * Aneg;
#pragma unroll
            for (int o = 1; o < 64; o <<= 1) { const float v = __shfl_up(x, o); if (lane >= o) x += v; }
            ACS[tid] = x; }
        if (ch + 1 < SEQ / 64) ssd_load(t0 + 64);
        __syncthreads();
        const float acsL = ACS[63];
        { const int pp = tid >> 4, s4 = (tid & 15) * 4; float v[4];
#pragma unroll
            for (int e = 0; e < 4; ++e) { const int sidx = s4 + e; v[e] = XS[sidx * 32 + pp] * DTs[sidx] * __expf(acsL - ACS[sidx]); }
            *(u32x2*)(XwT + pp * 72 + s4) = (u32x2){cvt_pk_bf16(v[0], v[1]), cvt_pk_bf16(v[2], v[3])}; }
        { const int pi = wave >> 2, ni = wave & 3;
#pragma unroll
            for (int r = 0; r < 4; ++r) SbT[(16 * pi + 4 * g + r) * 72 + 16 * ni + lq] = (bf16_t)(cvt_pk_bf16(Sacc[r], 0.f) & 0xFFFF); }
        { const int ti = wave >> 1;
#pragma unroll
            for (int sj = 0; sj < 2; ++sj) { const int si = 2 * (wave & 1) + sj;
                f32x4 acc = (f32x4){0.f, 0.f, 0.f, 0.f};
                if (si <= ti) {
                    const bf16_t* ap = Cb + (16 * ti + lq) * 72 + 8 * g; const bf16_t* bp = Bb + (16 * si + lq) * 72 + 8 * g;
                    acc = __builtin_amdgcn_mfma_f32_16x16x32_bf16(*(const bf16x8*)ap, *(const bf16x8*)bp, acc, 0, 0, 0);
                    acc = __builtin_amdgcn_mfma_f32_16x16x32_bf16(*(const bf16x8*)(ap + 32), *(const bf16x8*)(bp + 32), acc, 0, 0, 0);
                }
                const int sidx = 16 * si + lq; const float as = ACS[sidx], ds = DTs[sidx];
#pragma unroll
                for (int r = 0; r < 4; ++r) { const int t = 16 * ti + 4 * g + r; const float val = (sidx <= t) ? acc[r] * __expf(ACS[t] - as) * ds : 0.f;
                    Mx[t * 72 + sidx] = (bf16_t)(cvt_pk_bf16(val, 0.f) & 0xFFFF); } } }
        __syncthreads();
        { const int ti = wave >> 1, pi = wave & 1;
            const bf16_t* ap = Mx + (16 * ti + lq) * 72 + 8 * g; const bf16_t* bp = XT + (16 * pi + lq) * 72 + 8 * g;
            const bf16_t* cp = Cb + (16 * ti + lq) * 72 + 8 * g; const bf16_t* sp = SbT + (16 * pi + lq) * 72 + 8 * g;
            f32x4 a1 = (f32x4){0.f, 0.f, 0.f, 0.f}, a2 = (f32x4){0.f, 0.f, 0.f, 0.f};
            a1 = __builtin_amdgcn_mfma_f32_16x16x32_bf16(*(const bf16x8*)ap, *(const bf16x8*)bp, a1, 0, 0, 0);
            a1 = __builtin_amdgcn_mfma_f32_16x16x32_bf16(*(const bf16x8*)(ap + 32), *(const bf16x8*)(bp + 32), a1, 0, 0, 0);
            a2 = __builtin_amdgcn_mfma_f32_16x16x32_bf16(*(const bf16x8*)cp, *(const bf16x8*)sp, a2, 0, 0, 0);
            a2 = __builtin_amdgcn_mfma_f32_16x16x32_bf16(*(const bf16x8*)(cp + 32), *(const bf16x8*)(sp + 32), a2, 0, 0, 0);
#pragma unroll
            for (int r = 0; r < 4; ++r) { const int t = 16 * ti + 4 * g + r, pc = 16 * pi + lq;
                YS[t * 32 + pc] = a1[r] + __expf(ACS[t]) * a2[r] + Dsk * XS[t * 32 + pc]; } }
        { const int pi = wave >> 2, ni = wave & 3; const float dl = __expf(acsL);
            Sacc = Sacc * dl;
            const bf16_t* ap = XwT + (16 * pi + lq) * 72 + 8 * g; const bf16_t* bp = BT + (16 * ni + lq) * 72 + 8 * g;
            Sacc = __builtin_amdgcn_mfma_f32_16x16x32_bf16(*(const bf16x8*)ap, *(const bf16x8*)bp, Sacc, 0, 0, 0);
            Sacc = __builtin_amdgcn_mfma_f32_16x16x32_bf16(*(const bf16x8*)(ap + 32), *(const bf16x8*)(bp + 32), Sacc, 0, 0, 0); }
        __syncthreads();
        { const int tt = o_tt, p4 = o_p4; const f32x4 y4 = *(const f32x4*)(YS + tt * 32 + p4);
            const float u0 = y4[0] * siluf_(bf_lo(zv.x)), u1 = y4[1] * siluf_(bf_hi(zv.x)), u2 = y4[2] * siluf_(bf_lo(zv.y)), u3 = y4[3] * siluf_(bf_hi(zv.y));
            u32x2 ov; ov.x = cvt_pk_bf16(u0, u1); ov.y = cvt_pk_bf16(u2, u3); *(u32x2*)zp = ov;
            float q = u0 * u0 + u1 * u1 + u2 * u2 + u3 * u3;
            q += __shfl_xor(q, 1); q += __shfl_xor(q, 2); q += __shfl_xor(q, 4);
            if ((tid & 7) == 0) SSQ[(rowbase + t0 + tt) * 32 + hh * 2 + ph] = q; }
    }
    __syncthreads();
}

__device__ __forceinline__ float fast_tanh(float x) { return 1.f - 2.f * __builtin_amdgcn_rcpf(1.f + __expf(2.f * x)); }
__device__ __forceinline__ void pbar4(LAS volatile unsigned* cnt, unsigned& tgt, int lane) {
    tgt += 4u;
    asm volatile("s_waitcnt lgkmcnt(0)" ::: "memory");
    if (lane == 0) __hip_atomic_fetch_add((LAS unsigned*)cnt, 1u, __ATOMIC_RELAXED, __HIP_MEMORY_SCOPE_WORKGROUP);
    while (*cnt < tgt) __builtin_amdgcn_s_sleep(1);
    asm volatile("" ::: "memory");
}
__device__ __forceinline__ void rwkv_item(const Params& p, int layer, unsigned char* shm, int item) {
    const int half = item & 1, h = (item >> 1) & 7, b = item >> 4;
    bf16_t* P = (bf16_t*)(p.ws + OFF_P); bf16_t* YRAW = (bf16_t*)(p.ws + OFF_YRAW); float* BONUS = (float*)(p.ws + OFF_BONUS);
    const int tid = opaque_tid(), wave = tid >> 6, lane = tid & 63, lq = lane & 15, g = lane >> 4;
    const size_t rowbase = (size_t)b * SEQ;
    const float* mu = p.in[9] + layer * 2176;
    const float* w0 = p.in[10] + layer * 512; const float* wup = p.in[11] + (size_t)layer * 64 * 512;
    const float* a0 = p.in[12] + layer * 512; const float* aup = p.in[13] + (size_t)layer * 64 * 512;
    const float* kkp = p.in[14] + layer * 512; const float* kap = p.in[15] + layer * 512; const float* rkp = p.in[16] + layer * 512;
    constexpr int SETF = 6 * 2048;
    float* SET0 = (float*)shm;
    float* AA = SET0 + 2 * SETF;
    float* Yb = AA + 2048;
    bf16_t* WLb = (bf16_t*)(Yb + 2048);
    bf16_t* ALb = WLb + 32 * 72;
    LAS volatile unsigned* pcnt = (LAS volatile unsigned*)((LAS unsigned char*)shm + (2 * SETF + 2048 + 2048) * 4 + 2 * 32 * 72 * 2);
    const int csub = wave & 3;
    bf16x8 bfr[2][2]; float lw0[2];
#pragma unroll
    for (int mat = 0; mat < 2; ++mat) { const float* up = (mat ? aup : wup) + h * 64 + csub * 16 + lq;
#pragma unroll
        for (int ks = 0; ks < 2; ++ks) { unsigned w[4];
#pragma unroll
            for (int e2 = 0; e2 < 4; ++e2) { const int m0 = 32 * ks + 8 * g + 2 * e2; w[e2] = cvt_pk_bf16(up[(size_t)m0 * 512], up[(size_t)(m0 + 1) * 512]); }
            u32x4 wv = (u32x4){w[0], w[1], w[2], w[3]}; bfr[mat][ks] = __builtin_bit_cast(bf16x8, wv); }
        lw0[mat] = (mat ? a0 : w0)[h * 64 + csub * 16 + lq]; }
    const int ej = (tid & 15) * 4;
    const f32x4 c_kk = *(const f32x4*)(kkp + h * 64 + ej), c_ka = *(const f32x4*)(kap + h * 64 + ej), c_rk = *(const f32x4*)(rkp + h * 64 + ej);
    const f32x4 mu_r = *(const f32x4*)(mu + h * 64 + ej), mu_k = *(const f32x4*)(mu + 512 + h * 64 + ej), mu_v = *(const f32x4*)(mu + 1024 + h * 64 + ej);
    const f32x4 mu_w = *(const f32x4*)(mu + 2048 + ej), mu_a = *(const f32x4*)(mu + 2112 + ej);
    f32x4 sA = (f32x4){0.f, 0.f, 0.f, 0.f}, sB = (f32x4){0.f, 0.f, 0.f, 0.f};
    const int irow = half * 32 + (wave & 3) * 8 + g * 2;
    unsigned ptgt = 0u;
    const int pm = tid - 256, e2t = pm >> 4;
    u32x2 cva[2][5], pva[2][5];
    auto rw_load = [&](int ch) {
#pragma unroll
        for (int ps = 0; ps < 2; ++ps) { const int tl = e2t + 16 * ps, t = ch * 32 + tl; const bf16_t* cur = P + (rowbase + t) * LDP + C_RW; const bool hp = t > 0; const bf16_t* prv = hp ? cur - LDP : cur;
#pragma unroll
            for (int i = 0; i < 5; ++i) { const int col = (i == 0 ? h * 64 : i == 1 ? 512 + h * 64 : i == 2 ? 1024 + h * 64 : i == 3 ? 2048 : 2112) + ej;
                cva[ps][i] = *(const u32x2*)(cur + col); pva[ps][i] = *(const u32x2*)(prv + col); } }
    };
    auto prep = [&](int ch, float* SET) {
        float* Rm = SET; float* Km = SET + 2048; float* Vm = SET + 4096; float* DEC = SET + 6144; float* KK = SET + 8192; float* BB = SET + 10240;
#pragma unroll
        for (int ps = 0; ps < 2; ++ps) { const int tl = e2t + 16 * ps, t = ch * 32 + tl; const unsigned pmask = t > 0 ? 0xFFFFFFFFu : 0u;
#pragma unroll
            for (int i = 0; i < 5; ++i) {
                const u32x2 cv = cva[ps][i]; u32x2 pv = pva[ps][i]; pv.x &= pmask; pv.y &= pmask;
                const f32x4 m4 = i == 0 ? mu_r : i == 1 ? mu_k : i == 2 ? mu_v : i == 3 ? mu_w : mu_a;
                float c[4] = {bf_lo(cv.x), bf_hi(cv.x), bf_lo(cv.y), bf_hi(cv.y)}; const float q[4] = {bf_lo(pv.x), bf_hi(pv.x), bf_lo(pv.y), bf_hi(pv.y)};
#pragma unroll
                for (int e = 0; e < 4; ++e) c[e] = c[e] + (q[e] - c[e]) * m4[e];
                if (i == 0) *(f32x4*)(Rm + tl * 64 + ej) = (f32x4){c[0], c[1], c[2], c[3]};
                else if (i == 1) *(f32x4*)(Km + tl * 64 + ej) = (f32x4){c[0], c[1], c[2], c[3]};
                else if (i == 2) *(f32x4*)(Vm + tl * 64 + ej) = (f32x4){c[0], c[1], c[2], c[3]};
                else if (i == 3) { u32x2 o; o.x = cvt_pk_bf16(fast_tanh(c[0]), fast_tanh(c[1])); o.y = cvt_pk_bf16(fast_tanh(c[2]), fast_tanh(c[3])); *(u32x2*)(WLb + tl * 72 + ej) = o; }
                else { u32x2 o; o.x = cvt_pk_bf16(c[0], c[1]); o.y = cvt_pk_bf16(c[2], c[3]); *(u32x2*)(ALb + tl * 72 + ej) = o; } } }
        if (ch + 1 < SEQ / 32) rw_load(ch + 1);
        pbar4(pcnt, ptgt, lane);
#pragma unroll
        for (int mat = 0; mat < 2; ++mat)
#pragma unroll
            for (int ts = 0; ts < 2; ++ts) { const bf16_t* ap = (mat ? ALb : WLb) + (16 * ts + lq) * 72 + 8 * g;
                const bf16x8 a0f = *(const bf16x8*)ap, a1f = *(const bf16x8*)(ap + 32);
                f32x4 c = (f32x4){0.f, 0.f, 0.f, 0.f};
                c = __builtin_amdgcn_mfma_f32_16x16x32_bf16(a0f, bfr[mat][0], c, 0, 0, 0);
                c = __builtin_amdgcn_mfma_f32_16x16x32_bf16(a1f, bfr[mat][1], c, 0, 0, 0);
#pragma unroll
                for (int r = 0; r < 4; ++r) { const int tt = 16 * ts + 4 * g + r; const float x = lw0[mat] + c[r];
                    if (mat == 0) DEC[tt * 64 + csub * 16 + lq] = __expf(-0.60653066f * sigmoidf_(x));
                    else AA[tt * 64 + csub * 16 + lq] = sigmoidf_(x); } }
        pbar4(pcnt, ptgt, lane);
#pragma unroll
        for (int ps = 0; ps < 2; ++ps) { const int tl = e2t + 16 * ps;
            const f32x4 k4 = *(const f32x4*)(Km + tl * 64 + ej), a4 = *(const f32x4*)(AA + tl * 64 + ej), r4 = *(const f32x4*)(Rm + tl * 64 + ej);
            f32x4 kr, kt; float ss = 0.f, bo = 0.f;
#pragma unroll
            for (int e = 0; e < 4; ++e) { kr[e] = k4[e] * c_kk[e]; ss += kr[e] * kr[e]; kt[e] = k4[e] * (1.f + (a4[e] - 1.f) * c_ka[e]); bo += r4[e] * kt[e] * c_rk[e]; }
            ss = allred16(ss); bo = allred16(bo);
            const float inv = __builtin_amdgcn_rsqf(fmaxf(ss, 1e-24f));
            f32x4 kk4, b4;
#pragma unroll
            for (int e = 0; e < 4; ++e) { kk4[e] = kr[e] * inv; b4[e] = kk4[e] * a4[e]; }
            *(f32x4*)(Km + tl * 64 + ej) = kt; *(f32x4*)(KK + tl * 64 + ej) = kk4; *(f32x4*)(BB + tl * 64 + ej) = b4;
            if (half == 0 && (tid & 15) == 0) BONUS[(rowbase + ch * 32 + tl) * 8 + h] = bo; }
    };
    auto yraw_store = [&](int ch) {
#pragma unroll
        for (int ps = 0; ps < 2; ++ps)
#pragma unroll
            for (int q = 0; q < 2; ++q) { const int tl = e2t + 16 * ps, il = (tid & 15) + 16 * q;
                YRAW[(rowbase + ch * 32 + tl) * 512 + h * 64 + half * 32 + il] = (bf16_t)(cvt_pk_bf16(Yb[(ch & 1) * 1024 + tl * 32 + il], 0.f) & 0xFFFF); }
    };
    if (tid == 0) *pcnt = 0u;
    __syncthreads();
    if (wave >= 4) { rw_load(0); prep(0, SET0); }
    for (int ch = 0; ch < SEQ / 32; ++ch) {
        __syncthreads();
        if (wave < 4) {
            const float* SET = SET0 + (ch & 1) * SETF;
            const float* Rm = SET; const float* Km = SET + 2048; const float* Vm = SET + 4096; const float* DEC = SET + 6144; const float* KK = SET + 8192; const float* BB = SET + 10240;
            float* Yw = Yb + (ch & 1) * 1024;
            struct Ops { f32x4 w, k, q, b, r; float v0, v1; };
            auto ld = [&](Ops& o, int tt) { const int off = tt * 64 + lq * 4;
                o.w = *(const f32x4*)(DEC + off); o.k = *(const f32x4*)(Km + off); o.q = *(const f32x4*)(KK + off); o.b = *(const f32x4*)(BB + off); o.r = *(const f32x4*)(Rm + off);
                const float* vp = Vm + tt * 64 + irow; o.v0 = vp[0]; o.v1 = vp[1]; };
            auto step = [&](const Ops& o, int tt) {
                const f32x4 da = sA * o.q, db = sB * o.q; float sa0 = (da[0] + da[1]) + (da[2] + da[3]), sa1 = (db[0] + db[1]) + (db[2] + db[3]);
                const f32x4 uA = sA * o.w + o.k * o.v0, uB = sB * o.w + o.k * o.v1;
                sa0 = -allred16(sa0); sa1 = -allred16(sa1);
                sA = uA + o.b * sa0; sB = uB + o.b * sa1;
                const f32x4 ea = sA * o.r, eb = sB * o.r; float y0 = (ea[0] + ea[1]) + (ea[2] + ea[3]), y1 = (eb[0] + eb[1]) + (eb[2] + eb[3]);
                asm("" : "+v"(y0)); asm("" : "+v"(y1));
                y0 += dppf<0xB1>(y0); y1 += dppf<0xB1>(y1);
                float z = (lq & 1) ? y1 : y0;
                z += dppf<0x4E>(z); z += dppf<0x124>(z); z += dppf<0x128>(z);
                if (lq < 2) Yw[tt * 32 + (wave & 3) * 8 + g * 2 + lq] = z; };
            Ops oa, ob;
            ld(oa, 0);
            for (int tt = 0; tt < 32; tt += 2) {
                ld(ob, tt + 1);
                step(oa, tt);
                ld(oa, (tt + 2 < 32) ? tt + 2 : 31);
                step(ob, tt + 1);
            }
        } else {
            if (ch > 0) yraw_store(ch - 1);
            if (ch + 1 < SEQ / 32) prep(ch + 1, SET0 + ((ch + 1) & 1) * SETF);
        }
    }
    __syncthreads();
    if (wave >= 4) yraw_store(SEQ / 32 - 1);
    __syncthreads();
}

__device__ __forceinline__ void rw_post(const Params& p, int layer) {
    bf16_t* P = (bf16_t*)(p.ws + OFF_P); const bf16_t* YRAW = (const bf16_t*)(p.ws + OFF_YRAW);
    const float* BONUS = (const float*)(p.ws + OFF_BONUS); const float* SSQ = (const float*)(p.ws + OFF_SSQ); float* RSTD = (float*)(p.ws + OFF_RSTD);
    const float* mu = p.in[9] + layer * 2176; const float* lng = p.in[17] + layer * 512; const float* lnb = p.in[18] + layer * 512;
    const int gt = blockIdx.x * 512 + opaque_tid(), gs = gridDim.x * 512;
    {
        const int c = (gt & 127) * 4, h = c >> 6;
        const f32x4 muv = *(const f32x4*)(mu + 1024 + c), mug = *(const f32x4*)(mu + 1536 + c);
        const f32x4 lg = *(const f32x4*)(lng + c), lb = *(const f32x4*)(lnb + c);
        for (int idx0 = gt; idx0 < TOK * 128; idx0 += 4 * gs) {
            u32x2 yv[4], vc[4], gc[4], vp[4], gp[4]; float bn[4]; unsigned pm[4]; bool ok[4];
#pragma unroll
            for (int u = 0; u < 4; ++u) { const int idx = idx0 + u * gs; ok[u] = idx < TOK * 128; const int tok = ok[u] ? (idx >> 7) : 0;
                const bf16_t* cur = P + (size_t)tok * LDP + C_RW; const bool hp = (tok & (SEQ - 1)) > 0; const bf16_t* prv = hp ? cur - LDP : cur; pm[u] = hp ? 0xFFFFFFFFu : 0u;
                yv[u] = *(const u32x2*)(YRAW + (size_t)tok * 512 + c);
                vc[u] = *(const u32x2*)(cur + 1024 + c); gc[u] = *(const u32x2*)(cur + 1536 + c);
                vp[u] = *(const u32x2*)(prv + 1024 + c); gp[u] = *(const u32x2*)(prv + 1536 + c);
                bn[u] = BONUS[(size_t)tok * 8 + h]; }
#pragma unroll
            for (int u = 0; u < 4; ++u) { const int idx = idx0 + u * gs; const int tok = ok[u] ? (idx >> 7) : 0;
                float y[4] = {bf_lo(yv[u].x), bf_hi(yv[u].x), bf_lo(yv[u].y), bf_hi(yv[u].y)};
                const float mean = allred16(y[0] + y[1] + y[2] + y[3]) * (1.f / 64.f);
                float d[4], vs = 0.f;
#pragma unroll
                for (int e = 0; e < 4; ++e) { d[e] = y[e] - mean; vs += d[e] * d[e]; }
                const float var = allred16(vs) * (1.f / 64.f);
                const float rs = rsqrtf(var + 64e-5f);
                const unsigned m = pm[u];
                const float vcur[4] = {bf_lo(vc[u].x), bf_hi(vc[u].x), bf_lo(vc[u].y), bf_hi(vc[u].y)}, vprv[4] = {bf_lo(vp[u].x & m), bf_hi(vp[u].x & m), bf_lo(vp[u].y & m), bf_hi(vp[u].y & m)};
                const float gcur[4] = {bf_lo(gc[u].x), bf_hi(gc[u].x), bf_lo(gc[u].y), bf_hi(gc[u].y)}, gprv[4] = {bf_lo(gp[u].x & m), bf_hi(gp[u].x & m), bf_lo(gp[u].y & m), bf_hi(gp[u].y & m)};
                float o[4];
#pragma unroll
                for (int e = 0; e < 4; ++e) { const float vm = vcur[e] + (vprv[e] - vcur[e]) * muv[e], gm = gcur[e] + (gprv[e] - gcur[e]) * mug[e];
                    o[e] = (d[e] * rs * lg[e] + lb[e] + bn[u] * vm) * siluf_(gm); }
                u32x2 ov; ov.x = cvt_pk_bf16(o[0], o[1]); ov.y = cvt_pk_bf16(o[2], o[3]);
                if (ok[u]) *(u32x2*)(P + (size_t)tok * LDP + C_YRW + c) = ov; }
        }
    }
    for (int tok = gt; tok < TOK; tok += gs) { const f32x4* q = (const f32x4*)(SSQ + (size_t)tok * 32); float s = 0.f;
#pragma unroll
        for (int i = 0; i < 8; ++i) { const f32x4 v = q[i]; s += v[0] + v[1] + v[2] + v[3]; }
        RSTD[tok] = rsqrtf(s * (1.f / 1024.f) + 1e-6f); }
}

#define XB_TMO      128
#define XB_XCNT(j)  (256  + 64 * (j))
#define XB_XSUB(j)  (1280 + 64 * (j))
#define XB_XGEN(j)  (2304 + 64 * (j))
#define XB_TOP      3328
#define XB_TOPGEN   3392
#define XCD_BAR_WORDS 3456
#define XB_SPIN_CAP (1u << 18)
__device__ __forceinline__ unsigned xb_ld(unsigned* p)              { return __hip_atomic_load(p, __ATOMIC_RELAXED, __HIP_MEMORY_SCOPE_AGENT); }
__device__ __forceinline__ unsigned xb_add(unsigned* p, unsigned v) { return __hip_atomic_fetch_add(p, v, __ATOMIC_RELAXED, __HIP_MEMORY_SCOPE_AGENT); }
__device__ __forceinline__ unsigned xb_xcc_id() { return (unsigned)__builtin_amdgcn_s_getreg((3 << 11) | 20) & 0xFu; }
#define XB_SPIN(cond, bar) do { unsigned _sp = 0; while (cond) { __builtin_amdgcn_s_sleep(1); \
    if ((++_sp & 255u) == 0u) { if (xb_ld(&(bar)[XB_TMO])) break; if (_sp > XB_SPIN_CAP) { atomicAdd(&(bar)[XB_TMO], 1u); break; } } } } while (0)
struct XcdBarrier { unsigned* bar; unsigned x; volatile LAS unsigned* st; };
__device__ __forceinline__ XcdBarrier xcd_barrier_post(unsigned* bar, volatile LAS unsigned* st) {
    XcdBarrier b; b.bar = bar; b.x = xb_xcc_id(); b.st = st;
    if (threadIdx.x == 0) (void)xb_add(&bar[XB_XCNT(b.x)], 1u);
    return b;
}
__device__ __forceinline__ void xcd_barrier_complete(unsigned* bar, unsigned x, unsigned& nloc, unsigned& nx) {
    const unsigned G = gridDim.x * gridDim.y * gridDim.z;
    unsigned sum, cnt, mine, sp = 0u;
    for (;;) {
        sum = 0u; cnt = 0u; mine = 0u;
#pragma unroll
        for (unsigned j = 0; j < 16; ++j) { const unsigned c = xb_ld(&bar[XB_XCNT(j)]); sum += c; cnt += (c > 0u) ? 1u : 0u; mine = (j == x) ? c : mine; }
        if (sum == G) break;
        __builtin_amdgcn_s_sleep(1);
        if ((++sp & 255u) == 0u) { if (xb_ld(&bar[XB_TMO])) break; if (sp > XB_SPIN_CAP) { atomicAdd(&bar[XB_TMO], 1u); break; } }
    }
    nloc = mine > 0u ? mine : 1u; nx = cnt > 0u ? cnt : 1u;
}
__device__ __forceinline__ void xcd_barrier(const XcdBarrier& b) {
    asm volatile("s_waitcnt vmcnt(0)" ::: "memory");
    __syncthreads();
    if (threadIdx.x == 0) {
        unsigned* bar = b.bar;
        __builtin_amdgcn_s_waitcnt(0);
        unsigned nloc = b.st[0], nx = b.st[1];
        if (nloc == 0u) { xcd_barrier_complete(bar, b.x, nloc, nx); b.st[0] = nloc; b.st[1] = nx; }
        const unsigned old = xb_add(&bar[XB_XSUB(b.x)], 1u);
        const unsigned gen = old / nloc;
        if (old + 1u == (gen + 1u) * nloc) {
            __builtin_amdgcn_fence(__ATOMIC_RELEASE, "agent");
            asm volatile("s_waitcnt vmcnt(0)" ::: "memory");
            const unsigned og = xb_add(&bar[XB_TOP], 1u);
            const unsigned tg = og / nx;
            if (og + 1u == (tg + 1u) * nx) xb_add(&bar[XB_TOPGEN], 1u);
            else XB_SPIN(xb_ld(&bar[XB_TOPGEN]) == tg, bar);
            __builtin_amdgcn_fence(__ATOMIC_ACQUIRE, "agent");
            xb_add(&bar[XB_XGEN(b.x)], 1u);
            asm volatile("s_waitcnt vmcnt(0)" ::: "memory");
        } else {
            XB_SPIN(xb_ld(&bar[XB_XGEN(b.x)]) == gen, bar);
            __builtin_amdgcn_fence(__ATOMIC_ACQUIRE, "agent");
            asm volatile("s_waitcnt vmcnt(0)" ::: "memory");
        }
    }
    __syncthreads();
}

#define GSYNC() xcd_barrier(xb)
__global__ void __launch_bounds__(512, 2) mega(Params p) {
    extern __shared__ __attribute__((aligned(16))) unsigned char shm[];
    cg::grid_group grid = cg::this_grid();
    volatile LAS unsigned* xst = (volatile LAS unsigned*)((LAS unsigned char*)shm + LDS_BYTES - 16);
    if (threadIdx.x == 0) { xst[0] = 0u; xst[1] = 0u; }
    __syncthreads();
    const XcdBarrier xb = xcd_barrier_post((unsigned*)(p.ws + OFF_BAR), xst);
    const char* Pc = (const char*)(p.ws + OFF_P); const char* WTc = (const char*)(p.ws + OFF_WT);
    bf16_t* P = (bf16_t*)(p.ws + OFF_P);
    const int G = gridDim.x, c = blockIdx.x;
    for (int layer = 0; layer < 2; ++layer) {
        phase0(p, layer, shm);
        if (layer == 0) grid.sync(); else GSYNC();
        { SchedInproj S{Pc, WTc, G, c}; EpiInproj E{P}; pg8::gemm_phase<true>((LAS unsigned char*)shm, S, E); }
        GSYNC();
        { const int Gh = G >> 1;
            if (c < Gh) { for (int it = c; it < 128; it += Gh) rwkv_item(p, layer, shm, it); }
            else { const int c2 = c - Gh;
                bc_prepass(p, layer, c2, G - Gh);
                asm volatile("s_waitcnt vmcnt(0)" ::: "memory");
                __syncthreads();
                if (threadIdx.x == 0) { unsigned* cw_ = (unsigned*)(p.ws + OFF_BAR) + 3520; const unsigned need = (unsigned)(G - Gh) * (unsigned)(layer + 1);
                    __builtin_amdgcn_fence(__ATOMIC_RELEASE, "agent"); asm volatile("s_waitcnt vmcnt(0)" ::: "memory");
                    (void)xb_add(cw_, 1u);
                    unsigned sp_ = 0; while (xb_ld(cw_) < need) { __builtin_amdgcn_s_sleep(2); if (++sp_ > (1u << 22)) break; }
                    __builtin_amdgcn_fence(__ATOMIC_ACQUIRE, "agent"); asm volatile("s_waitcnt vmcnt(0)" ::: "memory"); }
                __syncthreads();
                for (int it = c2; it < 256; it += Gh) ssd_item(p, layer, shm, it);
                for (int it = c2; it < 1024; it += Gh) attn_item(p, shm, it); } }
        GSYNC();
        rw_post(p, layer);
        GSYNC();
        { SchedC1 S{Pc, WTc, G, c}; EpiC1 E{P, (const float*)(p.ws + OFF_RSTD)}; pg8::gemm_phase<true>((LAS unsigned char*)shm, S, E); }
        GSYNC();
        { SchedOut S{Pc, WTc, G, c}; EpiOut E{layer == 0 ? p.in[0] : p.out, p.out}; pg8::gemm_phase<false>((LAS unsigned char*)shm, S, E); }
        GSYNC();
    }
    { const int tid = opaque_tid(), wave = tid >> 6, lane = tid & 63; const float* fg = p.in[23];
        for (int row = blockIdx.x * 8 + wave; row < TOK; row += gridDim.x * 8) { float* xr = p.out + (size_t)row * DM;
            f32x4 v[4]; float ss = 0.f;
#pragma unroll
            for (int i = 0; i < 4; ++i) { v[i] = *(const f32x4*)(xr + i * 256 + lane * 4); ss += v[i][0] * v[i][0] + v[i][1] * v[i][1] + v[i][2] * v[i][2] + v[i][3] * v[i][3]; }
            ss = wave_sum(ss);
            const float rs = rsqrtf(ss * (1.f / DM) + 1e-6f);
#pragma unroll
            for (int i = 0; i < 4; ++i) { const f32x4 g = *(const f32x4*)(fg + i * 256 + lane * 4); *(f32x4*)(xr + i * 256 + lane * 4) = v[i] * rs * g; } } }
}

extern "C" void kernel_launch(void* const* d_in, const int* in_sizes, int n_in, void* d_out, int out_size, void* d_ws, size_t ws_size, hipStream_t stream) {
    static int grid_blocks = 0;
    if (grid_blocks == 0) {
        if (n_in != 24 || out_size != TOK * DM || ws_size < WS_NEED) { fprintf(stderr, "kernel_launch: unexpected shapes (n_in %d out %d ws %zu need %zu)\n", n_in, out_size, ws_size, (size_t)WS_NEED); grid_blocks = -1; return; }
        int dev = 0, cus = 0, per_cu = 0;
        hipGetDevice(&dev);
        hipDeviceGetAttribute(&cus, hipDeviceAttributeMultiprocessorCount, dev);
        hipFuncSetAttribute((const void*)mega, hipFuncAttributeMaxDynamicSharedMemorySize, LDS_BYTES);
        hipOccupancyMaxActiveBlocksPerMultiprocessor(&per_cu, (const void*)mega, 512, LDS_BYTES);
        if (per_cu < 1) { fprintf(stderr, "kernel_launch: occupancy query says %d blocks per CU\n", per_cu); grid_blocks = -1; return; }
        if (per_cu > 1) per_cu = 1;
        grid_blocks = cus * per_cu;
        grid_blocks &= ~7;
    }
    if (grid_blocks < 0) return;
    Params p{};
    for (int i = 0; i < 24; ++i) p.in[i] = (const float*)d_in[i];
    p.out = (float*)d_out; p.ws = (unsigned char*)d_ws;
    (void)hipMemsetAsync((unsigned char*)d_ws + OFF_BAR, 0, SZ_BAR, stream);
    void* args[] = {&p};
    hipError_t e = hipLaunchCooperativeKernel((const void*)mega, dim3(grid_blocks), dim3(512), args, LDS_BYTES, stream);
    if (e != hipSuccess) fprintf(stderr, "cooperative launch failed: %s (grid %d)\n", hipGetErrorString(e), grid_blocks);
}
```

```cpp
#include <hip/hip_runtime.h>
#include <hip/hip_cooperative_groups.h>
#include <cstdio>
namespace cg = cooperative_groups;

#define LAS __attribute__((address_space(3)))
typedef unsigned short bf16_t;
typedef short bf16x8 __attribute__((ext_vector_type(8)));
typedef float f32x4 __attribute__((ext_vector_type(4)));
typedef unsigned u32x4 __attribute__((ext_vector_type(4)));
typedef unsigned u32x2 __attribute__((ext_vector_type(2)));

constexpr int TOK = 16384, SEQ = 2048, DM = 1024, NIN = 9616;
constexpr int LDP = 7680;
constexpr int C_Q = 0, C_K = 512, C_V = 1024, C_SBG = 1536, C_Z = 2048, C_XBC = 3072, C_RW = 4352, C_DT = 6528, C_H = 6656;
constexpr int C_M = 0, C_G = 3072, C_YRW = 4352;
constexpr int R_GATE = 6656, R_SB = 9728, R_SSD = 10752, R_RWO = 11776, R_WO = 12800, WT_ROWS = 13824;
constexpr size_t OFF_P = 0, SZ_P = (size_t)TOK * LDP * 2;
constexpr size_t OFF_WT = OFF_P + SZ_P, SZ_WT = (size_t)WT_ROWS * 1024 * 2;
constexpr size_t OFF_YRAW = OFF_WT + SZ_WT, SZ_YRAW = (size_t)TOK * 512 * 2;
constexpr size_t OFF_SSQ = OFF_YRAW + SZ_YRAW, SZ_SSQ = (size_t)TOK * 32 * 4;
constexpr size_t OFF_RSTD = OFF_SSQ + SZ_SSQ, SZ_RSTD = (size_t)TOK * 4;
constexpr size_t OFF_BONUS = OFF_RSTD + SZ_RSTD, SZ_BONUS = (size_t)TOK * 8 * 4;
constexpr size_t OFF_BAR = OFF_BONUS + SZ_BONUS, SZ_BAR = 16384;
constexpr size_t OFF_BCC = OFF_BAR + SZ_BAR, SZ_BCC = (size_t)TOK * 256 * 2;
constexpr size_t WS_NEED = OFF_BCC + SZ_BCC;
constexpr int LDS_BYTES = 135168;

struct Params { const float* in[24]; float* out; unsigned char* ws; };

typedef float f32x2_t __attribute__((ext_vector_type(2)));
typedef __bf16 bf16x2_t __attribute__((ext_vector_type(2)));
__device__ __forceinline__ unsigned cvt_pk_bf16(float lo, float hi) { const f32x2_t v = {lo, hi}; return __builtin_bit_cast(unsigned, __builtin_convertvector(v, bf16x2_t)); }
__device__ __forceinline__ float bf_lo(unsigned u) { return __uint_as_float(u << 16); }
__device__ __forceinline__ float bf_hi(unsigned u) { return __uint_as_float(u & 0xFFFF0000u); }
__device__ __forceinline__ float bf2f(bf16_t h) { return __uint_as_float(((unsigned)h) << 16); }
__device__ __forceinline__ float sigmoidf_(float x) { return __builtin_amdgcn_rcpf(1.f + __expf(-x)); }
__device__ __forceinline__ float siluf_(float x) { return x * __builtin_amdgcn_rcpf(1.f + __expf(-x)); }
__device__ __forceinline__ float softplusf_(float x) { return fmaxf(x, 0.f) + __logf(1.f + __expf(-fabsf(x))); }
template <int CTRL> __device__ __forceinline__ float dppf(float x) { return __int_as_float(__builtin_amdgcn_update_dpp(0, __float_as_int(x), CTRL, 0xF, 0xF, true)); }
__device__ __forceinline__ float allred16(float x) { x += dppf<0xB1>(x); x += dppf<0x4E>(x); x += dppf<0x141>(x); x += dppf<0x140>(x); return x; }
__device__ __forceinline__ int opaque_tid() { int t; asm volatile("v_mov_b32 %0, %1" : "=v"(t) : "v"((int)threadIdx.x)); return t; }
__device__ __forceinline__ float wave_sum(float v) {
#pragma unroll
    for (int o = 1; o < 64; o <<= 1) v += __shfl_xor(v, o);
    return v;
}

namespace pg8 {
constexpr int BM = 256, BK = 64, HALF = 128, HTB = HALF * BK * 2, NXCD = 8, WGM = 8;
constexpr unsigned LDA_B = LDP * 2, LDB_B = 2048;
__device__ __forceinline__ int lds_byte(int r, int c) { const int st = (r >> 4) * 2 + (c >> 5), rr = r & 15, cc = c & 31, ob = rr * 64 + cc * 2; return st * 1024 + (ob ^ (((ob >> 9) & 1) << 5)); }
__device__ __forceinline__ void stage_rc(int b, int& R, int& C) { const int st = b / 1024, sb = b % 1024, swz = sb ^ (((sb >> 9) & 1) << 5); R = (st >> 1) * 16 + swz / 64; C = (st & 1) * 32 + (swz % 64) / 2; }
__device__ __forceinline__ int perm32(int rho) { const int n = rho >> 4, i = rho & 15; return 8 * (i >> 2) + 4 * n + (i & 3); }
struct UnitD { const char* A; const char* B; int nt, pm, pn, kind; };
__device__ __forceinline__ void tile_of(int L, int nM, int nN, int& pm, int& pn) {
    const int nwg = nM * nN; int wgid = L;
    { const int q = nwg / NXCD, r = nwg % NXCD, xcd = wgid % NXCD, off = wgid / NXCD; wgid = (xcd < r ? xcd * (q + 1) : r * (q + 1) + (xcd - r) * q) + off; }
    const int nig = WGM * nN, gid = wgid / nig, fm = gid * WGM, gsz = (nM - fm) < WGM ? (nM - fm) : WGM;
    pm = fm + ((wgid % nig) % gsz); pn = (wgid % nig) / gsz;
}

template <bool PERM, class Sched, class Epi>
__device__ __forceinline__ void gemm_phase(LAS unsigned char* lds, const Sched& S, const Epi& E) {
    const int tid = opaque_tid(), wid = __builtin_amdgcn_readfirstlane(tid >> 6), lane = tid & 63, wr = wid >> 2, wc = wid & 3, fr = lane & 15, fq = lane >> 4;
    unsigned voffA[2], voffB[2];
#pragma unroll
    for (int i = 0; i < 2; ++i) { int R, C; stage_rc(tid * 16 + i * 8192, R, C); const int Rb = PERM ? ((R & ~31) + perm32(R & 31)) : R;
        voffA[i] = (unsigned)R * LDA_B + (unsigned)C * 2u; voffB[i] = (unsigned)Rb * LDB_B + (unsigned)C * 2u; }
    const size_t kstep = (size_t)(BK * 2);
    const size_t hstepA = (size_t)HALF * LDA_B, hstepB = (size_t)HALF * LDB_B;
    const unsigned ldsw = (unsigned)wid * 1024u;
    const int aoff = lds_byte(wr * 64 + fr, fq * 8), boff = lds_byte(wc * 32 + fr, fq * 8);
#define PG8_SA(b, h) (((b) * 2 + (h)) * HTB)
#define PG8_SB(b, h) ((4 + (b) * 2 + (h)) * HTB)
#define PG8_STAGE(bufoff, gbase, voff) do { _Pragma("unroll") for (int _i = 0; _i < 2; ++_i) \
        __builtin_amdgcn_global_load_lds((const unsigned*)((const char*)(gbase) + (voff)[_i]), (LAS unsigned*)(lds + (bufoff) + ldsw + _i * 8192), 16, 0, 0); } while (0)
#define PG8_LDA(dst, b, h) do { _Pragma("unroll") for (int m = 0; m < 4; ++m) _Pragma("unroll") for (int k = 0; k < 2; ++k) dst[m][k] = *(const LAS bf16x8*)(lds + PG8_SA(b, h) + aoff + m * 2048 + k * 1024); } while (0)
#define PG8_LDB(dst, b, h) do { _Pragma("unroll") for (int n = 0; n < 2; ++n) _Pragma("unroll") for (int k = 0; k < 2; ++k) dst[n][k] = *(const LAS bf16x8*)(lds + PG8_SB(b, h) + boff + n * 2048 + k * 1024); } while (0)
#define PG8_MMA(ai, bj, At, Bt) do { __builtin_amdgcn_s_setprio(1); _Pragma("unroll") for (int m = 0; m < 4; ++m) _Pragma("unroll") for (int n = 0; n < 2; ++n) _Pragma("unroll") for (int k = 0; k < 2; ++k) \
        acc[ai][bj][m][n] = __builtin_amdgcn_mfma_f32_16x16x32_bf16(Bt[n][k], At[m][k], acc[ai][bj][m][n], 0, 0, 0); __builtin_amdgcn_s_setprio(0); } while (0)
#define PG8_WAIT_V(n) asm volatile("s_waitcnt vmcnt(" #n ")" ::: "memory")
#define PG8_WAIT_L(n) asm volatile("s_waitcnt lgkmcnt(" #n ")" ::: "memory")
#define PG8_BAR __builtin_amdgcn_s_barrier()
#define PG8_SCHED __builtin_amdgcn_sched_barrier(0)
    UnitD cur, nxt; int ui = 0;
    if (!S.next(0, cur)) return;
    f32x4 acc[2][2][4][2];
#pragma unroll
    for (int a = 0; a < 2; ++a)
#pragma unroll
        for (int b = 0; b < 2; ++b)
#pragma unroll
            for (int m = 0; m < 4; ++m)
#pragma unroll
                for (int n = 0; n < 2; ++n) acc[a][b][m][n] = (f32x4){0.f, 0.f, 0.f, 0.f};
    bf16x8 At[4][2], B0[2][2], B1[2][2];
    const char* cA = cur.A; const char* cB = cur.B;
    PG8_STAGE(PG8_SB(0, 0), cB, voffB); PG8_STAGE(PG8_SA(0, 0), cA, voffA); PG8_STAGE(PG8_SB(0, 1), cB + hstepB, voffB); PG8_STAGE(PG8_SA(0, 1), cA + hstepA, voffA);
    if (wr == 1) PG8_BAR;
    PG8_WAIT_V(4); PG8_BAR;
    PG8_STAGE(PG8_SB(1, 0), cB + kstep, voffB); PG8_STAGE(PG8_SA(1, 0), cA + kstep, voffA); PG8_STAGE(PG8_SB(1, 1), cB + hstepB + kstep, voffB);
    PG8_WAIT_V(6); PG8_BAR;
    for (;;) {
        const bool has_next = S.next(ui + 1, nxt);
        const char* nA = has_next ? nxt.A : cA; const char* nB = has_next ? nxt.B : cB;
        const int nt = cur.nt;
        for (int t = 0; t < nt; t += 2) {
            const bool last = (t == nt - 2);
            const char* a1 = cA + (size_t)(t + 1) * kstep;
            const char* a2 = last ? nA : cA + (size_t)(t + 2) * kstep; const char* b2 = last ? nB : cB + (size_t)(t + 2) * kstep;
            const char* a3 = a2 + kstep; const char* b3 = b2 + kstep;
            PG8_LDB(B0, 0, 0); PG8_SCHED; PG8_LDA(At, 0, 0); PG8_STAGE(PG8_SA(1, 1), a1 + hstepA, voffA);
            PG8_WAIT_L(8); PG8_BAR; PG8_WAIT_L(0); PG8_MMA(0, 0, At, B0); PG8_BAR; PG8_SCHED;
            PG8_LDB(B1, 0, 1); PG8_STAGE(PG8_SB(0, 0), b2, voffB);
            PG8_BAR; PG8_WAIT_L(0); PG8_MMA(0, 1, At, B1); PG8_BAR;
            PG8_LDA(At, 0, 1); PG8_STAGE(PG8_SA(0, 0), a2, voffA);
            PG8_BAR; PG8_WAIT_L(0); PG8_MMA(1, 0, At, B0); PG8_BAR; PG8_SCHED;
            PG8_STAGE(PG8_SB(0, 1), b2 + hstepB, voffB);
            PG8_WAIT_V(6); PG8_BAR; PG8_MMA(1, 1, At, B1); PG8_BAR;
            PG8_LDB(B0, 1, 0); PG8_SCHED; PG8_LDA(At, 1, 0); PG8_STAGE(PG8_SA(0, 1), a2 + hstepA, voffA);
            PG8_WAIT_L(8); PG8_BAR; PG8_WAIT_L(0); PG8_MMA(0, 0, At, B0); PG8_BAR; PG8_SCHED;
            PG8_LDB(B1, 1, 1); PG8_STAGE(PG8_SB(1, 0), b3, voffB);
            PG8_BAR; PG8_WAIT_L(0); PG8_MMA(0, 1, At, B1); PG8_BAR;
            PG8_LDA(At, 1, 1); PG8_STAGE(PG8_SA(1, 0), a3, voffA);
            PG8_BAR; PG8_WAIT_L(0); PG8_MMA(1, 0, At, B0); PG8_BAR; PG8_SCHED;
            PG8_STAGE(PG8_SB(1, 1), b3 + hstepB, voffB);
            PG8_WAIT_V(6); PG8_BAR; PG8_MMA(1, 1, At, B1); PG8_BAR;
        }
        E(acc, cur, wr, wc, fr, fq);
        if (!has_next) break;
#pragma unroll
        for (int a = 0; a < 2; ++a)
#pragma unroll
            for (int b = 0; b < 2; ++b)
#pragma unroll
                for (int m = 0; m < 4; ++m)
#pragma unroll
                    for (int n = 0; n < 2; ++n) acc[a][b][m][n] = (f32x4){0.f, 0.f, 0.f, 0.f};
        cur = nxt; cA = nA; cB = nB; ++ui;
    }
    PG8_WAIT_V(0);
    if (wr == 0) PG8_BAR;
    PG8_BAR;
#undef PG8_SA
#undef PG8_SB
#undef PG8_STAGE
#undef PG8_LDA
#undef PG8_LDB
#undef PG8_MMA
#undef PG8_WAIT_V
#undef PG8_WAIT_L
#undef PG8_BAR
#undef PG8_SCHED
}
}
using pg8::UnitD;

struct SchedInproj {
    const char* P; const char* WT; int G, c;
    __device__ __forceinline__ bool next(int i, UnitD& u) const {
        const int L = i * G + c; if (L >= 64 * 26) return false;
        int pm, pn; pg8::tile_of(L, 64, 26, pm, pn);
        u.A = P + ((size_t)pm * 256 * LDP + C_H) * 2; u.B = WT + (size_t)pn * 256 * 2048; u.nt = 16; u.pm = pm; u.pn = pn; u.kind = 0; return true;
    }
};
struct EpiInproj {
    bf16_t* P;
    __device__ __forceinline__ void operator()(const f32x4 (&acc)[2][2][4][2], const UnitD& u, int wr, int wc, int fr, int fq) const {
        const int row0 = u.pm * 256 + wr * 64 + fr, col0 = u.pn * 256 + wc * 32 + 8 * fq;
#pragma unroll
        for (int ai = 0; ai < 2; ++ai)
#pragma unroll
            for (int m = 0; m < 4; ++m) { bf16_t* rowp = P + (size_t)(row0 + ai * 128 + m * 16) * LDP + col0;
#pragma unroll
                for (int bj = 0; bj < 2; ++bj) { const f32x4 v0 = acc[ai][bj][m][0], v1 = acc[ai][bj][m][1];
                    u32x4 o; o.x = cvt_pk_bf16(v0[0], v0[1]); o.y = cvt_pk_bf16(v0[2], v0[3]); o.z = cvt_pk_bf16(v1[0], v1[1]); o.w = cvt_pk_bf16(v1[2], v1[3]);
                    *(u32x4*)(rowp + bj * 128) = o; } }
    }
};
struct SchedC1 {
    const char* P; const char* WT; int G, c;
    __device__ __forceinline__ bool next(int i, UnitD& u) const {
        const int ti = i / 6, sub = i - ti * 6, L = ti * G + c; if (L >= 256) return false;
        int pm, pn; pg8::tile_of(L, 64, 4, pm, pn);
        const int br = sub >> 1;
        if (!(sub & 1)) { u.A = P + ((size_t)pm * 256 * LDP + C_H) * 2; u.B = WT + (size_t)(R_GATE + br * 1024 + pn * 256) * 2048; u.nt = 16; }
        else { const int acol = br == 0 ? C_SBG : (br == 1 ? C_Z : C_YRW); const int brow = br == 0 ? R_SB : (br == 1 ? R_SSD : R_RWO);
            u.A = P + ((size_t)pm * 256 * LDP + acol) * 2; u.B = WT + (size_t)(brow + pn * 256) * 2048; u.nt = br == 1 ? 16 : 8; }
        u.pm = pm; u.pn = pn; u.kind = sub; return true;
    }
};
struct EpiC1 {
    bf16_t* P; const float* rstd;
    __device__ __forceinline__ void operator()(const f32x4 (&acc)[2][2][4][2], const UnitD& u, int wr, int wc, int fr, int fq) const {
        const int row0 = u.pm * 256 + wr * 64 + fr, col0 = u.pn * 256 + wc * 32 + 8 * fq;
        const int kind = u.kind;
#pragma unroll
        for (int ai = 0; ai < 2; ++ai)
#pragma unroll
            for (int m = 0; m < 4; ++m) { const int row = row0 + ai * 128 + m * 16; bf16_t* rowp = P + (size_t)row * LDP + col0;
                const float sc = (kind == 3) ? rstd[row] : 1.f;
#pragma unroll
                for (int bj = 0; bj < 2; ++bj) { const f32x4 v0 = acc[ai][bj][m][0], v1 = acc[ai][bj][m][1];
                    float v[8] = {v0[0], v0[1], v0[2], v0[3], v1[0], v1[1], v1[2], v1[3]};
                    u32x4* gp = (u32x4*)(rowp + C_G + bj * 128); u32x4* mp = (u32x4*)(rowp + C_M + bj * 128);
                    if (!(kind & 1)) {
#pragma unroll
                        for (int e = 0; e < 8; ++e) v[e] = sigmoidf_(v[e]);
                        u32x4 o; o.x = cvt_pk_bf16(v[0], v[1]); o.y = cvt_pk_bf16(v[2], v[3]); o.z = cvt_pk_bf16(v[4], v[5]); o.w = cvt_pk_bf16(v[6], v[7]);
                        *gp = o;
                    } else {
                        const u32x4 g = *gp;
                        float r[8];
                        r[0] = bf_lo(g.x) * v[0] * sc; r[1] = bf_hi(g.x) * v[1] * sc; r[2] = bf_lo(g.y) * v[2] * sc; r[3] = bf_hi(g.y) * v[3] * sc;
                        r[4] = bf_lo(g.z) * v[4] * sc; r[5] = bf_hi(g.z) * v[5] * sc; r[6] = bf_lo(g.w) * v[6] * sc; r[7] = bf_hi(g.w) * v[7] * sc;
                        if (kind != 1) { const u32x4 mo = *mp;
                            r[0] += bf_lo(mo.x); r[1] += bf_hi(mo.x); r[2] += bf_lo(mo.y); r[3] += bf_hi(mo.y); r[4] += bf_lo(mo.z); r[5] += bf_hi(mo.z); r[6] += bf_lo(mo.w); r[7] += bf_hi(mo.w); }
                        u32x4 o; o.x = cvt_pk_bf16(r[0], r[1]); o.y = cvt_pk_bf16(r[2], r[3]); o.z = cvt_pk_bf16(r[4], r[5]); o.w = cvt_pk_bf16(r[6], r[7]);
                        *mp = o;
                    } } }
    }
};
struct SchedOut {
    const char* P; const char* WT; int G, c;
    __device__ __forceinline__ bool next(int i, UnitD& u) const {
        const int L = i * G + c; if (L >= 256) return false;
        int pm, pn; pg8::tile_of(L, 64, 4, pm, pn);
        u.A = P + ((size_t)pm * 256 * LDP + C_M) * 2; u.B = WT + (size_t)(R_WO + pn * 256) * 2048; u.nt = 16; u.pm = pm; u.pn = pn; u.kind = 0; return true;
    }
};
struct EpiOut {
    const float* Xin; float* Xout;
    __device__ __forceinline__ void operator()(const f32x4 (&acc)[2][2][4][2], const UnitD& u, int wr, int wc, int fr, int fq) const {
        const int row0 = u.pm * 256 + wr * 64 + fr, col0 = u.pn * 256 + wc * 32 + 4 * fq;
#pragma unroll
        for (int ai = 0; ai < 2; ++ai)
#pragma unroll
            for (int m = 0; m < 4; ++m) { const size_t ro = (size_t)(row0 + ai * 128 + m * 16) * DM + col0;
#pragma unroll
                for (int bj = 0; bj < 2; ++bj)
#pragma unroll
                    for (int n = 0; n < 2; ++n) { const f32x4 xi = *(const f32x4*)(Xin + ro + bj * 128 + n * 16); *(f32x4*)(Xout + ro + bj * 128 + n * 16) = xi + acc[ai][bj][m][n]; } }
    }
};

__device__ __forceinline__ void phase0(const Params& p, int layer, unsigned char* shm) {
    const int tid = opaque_tid(), wave = tid >> 6, lane = tid & 63;
    bf16_t* P = (bf16_t*)(p.ws + OFF_P); bf16_t* WT = (bf16_t*)(p.ws + OFF_WT);
    const float* Xin = layer == 0 ? p.in[0] : p.out;
    const float* ng = p.in[1] + layer * DM;
    f32x4 gn[4];
#pragma unroll
    for (int i = 0; i < 4; ++i) gn[i] = *(const f32x4*)(ng + i * 256 + lane * 4);
    for (int row0 = (blockIdx.x * 8 + wave) * 4; row0 < TOK; row0 += gridDim.x * 32) {
        f32x4 v[4][4]; float ss[4];
#pragma unroll
        for (int rr = 0; rr < 4; ++rr) { const float* xr = Xin + (size_t)(row0 + rr) * DM;
#pragma unroll
            for (int i = 0; i < 4; ++i) v[rr][i] = *(const f32x4*)(xr + i * 256 + lane * 4); }
#pragma unroll
        for (int rr = 0; rr < 4; ++rr) { float a = 0.f;
#pragma unroll
            for (int i = 0; i < 4; ++i) a += v[rr][i][0] * v[rr][i][0] + v[rr][i][1] * v[rr][i][1] + v[rr][i][2] * v[rr][i][2] + v[rr][i][3] * v[rr][i][3];
            ss[rr] = wave_sum(a); }
#pragma unroll
        for (int rr = 0; rr < 4; ++rr) { const float rs = rsqrtf(ss[rr] * (1.f / DM) + 1e-6f);
#pragma unroll
            for (int i = 0; i < 4; ++i) { const f32x4 g = gn[i];
                u32x2 o; o.x = cvt_pk_bf16(v[rr][i][0] * rs * g[0], v[rr][i][1] * rs * g[1]); o.y = cvt_pk_bf16(v[rr][i][2] * rs * g[2], v[rr][i][3] * rs * g[3]);
                *(u32x2*)(P + (size_t)(row0 + rr) * LDP + C_H + i * 256 + lane * 4) = o; } }
    }
    float* T = (float*)shm + wave * (64 * 65);
    const float* w_in = p.in[2] + (size_t)layer * DM * NIN;
    const float* sg = p.in[8] + layer * DM;
    for (int job = blockIdx.x * 8 + wave; job < 3200; job += gridDim.x * 8) {
        const float* src; int srcN, k0, n0, dstrow; bool is_in = false, is_ssd = false;
        if (job < 2432) { is_in = true; src = w_in; srcN = NIN; const int ntile = job >> 4; k0 = (job & 15) * 64; n0 = ntile * 64; dstrow = n0; }
        else { int r = job - 2432;
            if (r < 128) { src = p.in[19] + (size_t)layer * 512 * DM; k0 = (r >> 4) * 64; n0 = (r & 15) * 64; dstrow = R_SB + n0; }
            else if (r < 384) { r -= 128; src = p.in[20] + (size_t)layer * DM * DM; k0 = (r >> 4) * 64; n0 = (r & 15) * 64; dstrow = R_SSD + n0; is_ssd = true; }
            else if (r < 512) { r -= 384; src = p.in[21] + (size_t)layer * 512 * DM; k0 = (r >> 4) * 64; n0 = (r & 15) * 64; dstrow = R_RWO + n0; }
            else { r -= 512; src = p.in[22] + (size_t)layer * DM * DM; k0 = (r >> 4) * 64; n0 = (r & 15) * 64; dstrow = R_WO + n0; }
            srcN = DM; }
        const int n4 = (lane & 15) * 4, np = n0 + n4; int sc = np;
        if (is_in) { if (np < 4352) sc = np; else if (np < 6528) sc = np + 16; else if (np < 6544) sc = np - 6528 + 4352; else if (np < 6656) sc = -1; else sc = np - 112; }
        f32x4 v[16];
#pragma unroll
        for (int i = 0; i < 16; ++i) { const int k = (lane >> 4) + 4 * i; v[i] = (f32x4){0.f, 0.f, 0.f, 0.f};
            if (sc >= 0) v[i] = *(const f32x4*)(src + (size_t)(k0 + k) * srcN + sc); }
#pragma unroll
        for (int i = 0; i < 16; ++i) { const int k = (lane >> 4) + 4 * i; f32x4 x = v[i];
            if (is_ssd) x = x * sg[k0 + k];
            T[k * 65 + n4] = x[0]; T[k * 65 + n4 + 1] = x[1]; T[k * 65 + n4 + 2] = x[2]; T[k * 65 + n4 + 3] = x[3]; }
        asm volatile("s_waitcnt lgkmcnt(0)" ::: "memory"); __builtin_amdgcn_wave_barrier(); asm volatile("" ::: "memory");
#pragma unroll
        for (int j = 0; j < 8; ++j) { const int r = lane + 64 * j, n = r >> 3, kc = (r & 7) * 8; const float* sp = T + kc * 65 + n;
            u32x4 o; o.x = cvt_pk_bf16(sp[0], sp[65]); o.y = cvt_pk_bf16(sp[130], sp[195]); o.z = cvt_pk_bf16(sp[260], sp[325]); o.w = cvt_pk_bf16(sp[390], sp[455]);
            *(u32x4*)(WT + (size_t)(dstrow + n) * 1024 + k0 + kc) = o; }
        asm volatile("s_waitcnt lgkmcnt(0)" ::: "memory"); __builtin_amdgcn_wave_barrier(); asm volatile("" ::: "memory");
    }
    __syncthreads();
}

__device__ __forceinline__ void attn_item(const Params& p, unsigned char* shm, int item) {
    const int qb = item & 15, h = (item >> 4) & 7, b = item >> 7;
    bf16_t* P = (bf16_t*)(p.ws + OFF_P);
    const int tid = opaque_tid(), wave = tid >> 6, lane = tid & 63, lq = lane & 15, g = lane >> 4;
    const size_t rowbase = (size_t)b * SEQ;
    const int t = qb * 128 + wave * 16 + lq;
    const int tmax = qb * 128 + wave * 16 + 15;
    constexpr int ABUF = 64 * 144 + 64 * 136;
    const bf16_t* qp = P + (rowbase + t) * LDP + C_Q + h * 64 + 8 * g;
    const bf16x8 qf0 = *(const bf16x8*)qp, qf1 = *(const bf16x8*)(qp + 32);
    bf16x8 TT[4][2];
#pragma unroll
    for (int a = 0; a < 4; ++a)
#pragma unroll
        for (int ks = 0; ks < 2; ++ks)
#pragma unroll
            for (int e = 0; e < 8; ++e) { const int j = 16 * (2 * ks + (e >> 2)) + 4 * g + (e & 3); TT[a][ks][e] = (j > 16 * a + lq) ? (short)0x3F80 : (short)0; }
    f32x4 o[4];
#pragma unroll
    for (int i = 0; i < 4; ++i) o[i] = (f32x4){0.f, 0.f, 0.f, 0.f};
    float R = 0.f;
    LAS volatile int* flg = (LAS volatile int*)((LAS unsigned char*)shm + 2 * ABUF);
    const int st_s = tid >> 3, st_dc = (tid & 7) * 8;
    const bf16_t* st_base = P + (rowbase + st_s) * LDP + h * 64 + st_dc;
    auto stage_write = [&](unsigned char* buf, const u32x4& kv, const u32x4& vv) {
        bf16_t* Ksw = (bf16_t*)buf; bf16_t* Vtw = (bf16_t*)(buf + 64 * 144); const int s_ = st_s, dc = st_dc;
        *(u32x4*)(Ksw + s_ * 72 + dc) = kv;
        Vtw[(dc + 0) * 68 + s_] = (bf16_t)(vv.x & 0xFFFF); Vtw[(dc + 1) * 68 + s_] = (bf16_t)(vv.x >> 16);
        Vtw[(dc + 2) * 68 + s_] = (bf16_t)(vv.y & 0xFFFF); Vtw[(dc + 3) * 68 + s_] = (bf16_t)(vv.y >> 16);
        Vtw[(dc + 4) * 68 + s_] = (bf16_t)(vv.z & 0xFFFF); Vtw[(dc + 5) * 68 + s_] = (bf16_t)(vv.z >> 16);
        Vtw[(dc + 6) * 68 + s_] = (bf16_t)(vv.w & 0xFFFF); Vtw[(dc + 7) * 68 + s_] = (bf16_t)(vv.w >> 16);
    };
    if (tid == 0) { flg[0] = 1; flg[1] = 0; flg[2] = 0; }
    { const bf16_t* kr = st_base + (size_t)(2 * qb + 1) * 64 * LDP; const u32x4 kv0 = *(const u32x4*)(kr + C_K), vv0 = *(const u32x4*)(kr + C_V); stage_write(shm, kv0, vv0); }
    int itn = 0, cur = 0;
    for (int kt = 2 * qb + 1; kt >= 0; --kt) {
        __syncthreads();
        const int f0 = itn % 3, f1 = (itn + 1) % 3, f2 = (itn + 2) % 3;
        if (flg[f0] == 0) break;
        if (tid == 0) flg[f2] = 0;
        u32x4 kvn = (u32x4){0u, 0u, 0u, 0u}, vvn = (u32x4){0u, 0u, 0u, 0u};
        if (kt > 0) { const bf16_t* kr = st_base + (size_t)(kt - 1) * 64 * LDP; kvn = *(const u32x4*)(kr + C_K); vvn = *(const u32x4*)(kr + C_V); }
        const bf16_t* Ks = (const bf16_t*)(shm + cur * ABUF); const bf16_t* Vt = (const bf16_t*)(shm + cur * ABUF + 64 * 144);
        const bool walive = __any(R > -104.f);
        const bool act = (kt * 64 < tmax) && walive;
        if (act) {
            float lb[4][4], lk[4][4];
#pragma unroll
            for (int sub = 0; sub < 4; ++sub) {
                const bf16_t* kp = Ks + (16 * sub + lq) * 72 + 8 * g;
                const bf16x8 k0 = *(const bf16x8*)kp, k1 = *(const bf16x8*)(kp + 32);
                f32x4 s4 = (f32x4){0.f, 0.f, 0.f, 0.f};
                s4 = __builtin_amdgcn_mfma_f32_16x16x32_bf16(k0, qf0, s4, 0, 0, 0);
                s4 = __builtin_amdgcn_mfma_f32_16x16x32_bf16(k1, qf1, s4, 0, 0, 0);
#pragma unroll
                for (int r = 0; r < 4; ++r) { const float z = s4[r] * 0.125f; const bool mk = (kt * 64 + 16 * sub + 4 * g + r) < t;
                    const float l = fminf(z, 0.f) - 0.69314718f * __builtin_amdgcn_logf(1.f + __expf(-fabsf(z)));
                    lb[sub][r] = mk ? l : -1e30f; lk[sub][r] = mk ? (l - z) : 0.f; }
            }
            bf16x8 hi[2];
#pragma unroll
            for (int ks = 0; ks < 2; ++ks) {
                unsigned hw[4];
#pragma unroll
                for (int w2 = 0; w2 < 4; ++w2) { const int sub = 2 * ks + (w2 >> 1), r0 = (w2 & 1) * 2; const float a0 = lk[sub][r0], a1 = lk[sub][r0 + 1];
                    hw[w2] = cvt_pk_bf16(a0, a1); }
                u32x4 hv = (u32x4){hw[0], hw[1], hw[2], hw[3]};
                hi[ks] = __builtin_bit_cast(bf16x8, hv);
            }
            f32x4 aft[4];
#pragma unroll
            for (int a = 0; a < 4; ++a) { f32x4 c = (f32x4){0.f, 0.f, 0.f, 0.f};
#pragma unroll
                for (int ks = 0; ks < 2; ++ks) c = __builtin_amdgcn_mfma_f32_16x16x32_bf16(TT[a][ks], hi[ks], c, 0, 0, 0);
                aft[a] = c; }
            float tot = aft[0][0] + lk[0][0];
            tot = __shfl(tot, lq);
            bf16x8 pf[2];
#pragma unroll
            for (int ks = 0; ks < 2; ++ks) { unsigned pw[4];
#pragma unroll
                for (int w2 = 0; w2 < 4; ++w2) { const int sub = 2 * ks + (w2 >> 1), r0 = (w2 & 1) * 2;
                    const float e0 = __expf(lb[sub][r0] + aft[sub][r0] + R), e1 = __expf(lb[sub][r0 + 1] + aft[sub][r0 + 1] + R);
                    pw[w2] = cvt_pk_bf16(e0, e1); }
                u32x4 pv = (u32x4){pw[0], pw[1], pw[2], pw[3]}; pf[ks] = __builtin_bit_cast(bf16x8, pv); }
            R += tot;
#pragma unroll
            for (int ds = 0; ds < 4; ++ds)
#pragma unroll
                for (int ks = 0; ks < 2; ++ks) { const bf16_t* vp = Vt + (16 * ds + lq) * 68 + 32 * ks + 4 * g;
                    const u32x2 v0 = *(const u32x2*)vp, v1 = *(const u32x2*)(vp + 16);
                    u32x4 vv = (u32x4){v0.x, v0.y, v1.x, v1.y};
                    o[ds] = __builtin_amdgcn_mfma_f32_16x16x32_bf16(__builtin_bit_cast(bf16x8, vv), pf[ks], o[ds], 0, 0, 0); }
        }
        if (__any(R > -104.f) && lane == 0) flg[f1] = 1;
        if (kt > 0) stage_write(shm + (cur ^ 1) * ABUF, kvn, vvn);
        cur ^= 1; ++itn;
    }
#pragma unroll
    for (int ds = 0; ds < 4; ++ds) { bf16_t* gp = P + (rowbase + t) * LDP + C_SBG + h * 64 + 16 * ds + 4 * g;
        const u32x2 gv = *(const u32x2*)gp;
        u32x2 ov; ov.x = cvt_pk_bf16(o[ds][0] * siluf_(bf_lo(gv.x)), o[ds][1] * siluf_(bf_hi(gv.x))); ov.y = cvt_pk_bf16(o[ds][2] * siluf_(bf_lo(gv.y)), o[ds][3] * siluf_(bf_hi(gv.y)));
        *(u32x2*)gp = ov; }
    __syncthreads();
}

__device__ __forceinline__ void bc_prepass(const Params& p, int layer, int blk, int nblk) {
    const bf16_t* P = (const bf16_t*)(p.ws + OFF_P); bf16_t* BCc = (bf16_t*)(p.ws + OFF_BCC);
    const float* cw = p.in[3] + (size_t)layer * 4 * 1280; const float* cb = p.in[4] + layer * 1280;
    const int gt = blk * 512 + opaque_tid(), gs = nblk * 512;
    const int c = (gt & 63) * 4, chn = 1024 + c;
    const f32x4 bias = *(const f32x4*)(cb + chn);
    f32x4 w[4];
#pragma unroll
    for (int k = 0; k < 4; ++k) w[k] = *(const f32x4*)(cw + k * 1280 + chn);
    for (int idx0 = gt; idx0 < TOK * 64; idx0 += 4 * gs) {
        u32x2 xv[4][4]; bool ok[4];
#pragma unroll
        for (int u = 0; u < 4; ++u) { const int idx = idx0 + u * gs; ok[u] = idx < TOK * 64; const int tok = ok[u] ? (idx >> 6) : 0; const int t = tok & (SEQ - 1);
            const bf16_t* xp = P + (size_t)tok * LDP + C_XBC + chn;
#pragma unroll
            for (int k = 0; k < 4; ++k) { const int ts = t - 3 + k; const unsigned xm = ts >= 0 ? 0xFFFFFFFFu : 0u;
                u32x2 x = *(const u32x2*)(xp + (ptrdiff_t)(ts >= 0 ? k - 3 : 0) * LDP); x.x &= xm; x.y &= xm; xv[u][k] = x; } }
#pragma unroll
        for (int u = 0; u < 4; ++u) { const int idx = idx0 + u * gs; const int tok = ok[u] ? (idx >> 6) : 0;
            f32x4 a = bias;
#pragma unroll
            for (int k = 0; k < 4; ++k) { a[0] += w[k][0] * bf_lo(xv[u][k].x); a[1] += w[k][1] * bf_hi(xv[u][k].x); a[2] += w[k][2] * bf_lo(xv[u][k].y); a[3] += w[k][3] * bf_hi(xv[u][k].y); }
            u32x2 o; o.x = cvt_pk_bf16(siluf_(a[0]), siluf_(a[1])); o.y = cvt_pk_bf16(siluf_(a[2]), siluf_(a[3]));
            if (ok[u]) *(u32x2*)(BCc + (size_t)tok * 256 + c) = o; }
    }
}

__device__ __forceinline__ void ssd_item(const Params& p, int layer, unsigned char* shm, int item) {
    const int ph = item & 1, hh = (item >> 1) & 15, b = item >> 5, grp = hh >> 3;
    bf16_t* P = (bf16_t*)(p.ws + OFF_P); float* SSQ = (float*)(p.ws + OFF_SSQ);
    const int tid = opaque_tid(), wave = tid >> 6, lane = tid & 63, lq = lane & 15, g = lane >> 4;
    const size_t rowbase = (size_t)b * SEQ;
    const float* cw = p.in[3] + (size_t)layer * 4 * 1280; const float* cb = p.in[4] + layer * 1280;
    const float dtb = p.in[5][layer * 16 + hh], Aneg = -__expf(p.in[6][layer * 16 + hh]), Dsk = p.in[7][layer * 16 + hh];
    float* XS = (float*)shm;
    float* YS = XS + 2048;
    float* DTs = YS + 2048;
    float* ACS = DTs + 64;
    bf16_t* Cb = (bf16_t*)(ACS + 64);
    bf16_t* Bb = Cb + 64 * 72;
    bf16_t* BT = Bb + 64 * 72;
    bf16_t* Mx = BT + 64 * 72;
    bf16_t* XT = Mx + 64 * 72;
    bf16_t* XwT = XT + 32 * 72;
    bf16_t* SbT = XwT + 32 * 72;
    f32x4 Sacc = (f32x4){0.f, 0.f, 0.f, 0.f};
    const bf16_t* BCc = (const bf16_t*)(p.ws + OFF_BCC);
    const int x_tt = tid >> 3, x_c = (tid & 7) * 4, x_chn = hh * 64 + ph * 32 + x_c;
    const int bc_q = tid & 7;
    const f32x4 xbias = *(const f32x4*)(cb + x_chn);
    f32x4 xw[4];
#pragma unroll
    for (int k = 0; k < 4; ++k) xw[k] = *(const f32x4*)(cw + k * 1280 + x_chn);
    u32x2 sx[4]; u32x4 bc0, bc1; bf16_t sdt = 0;
    auto ssd_load = [&](int tb) {
        const int t = tb + x_tt;
        const bf16_t* xp = P + (rowbase + t) * LDP + C_XBC + x_chn;
#pragma unroll
        for (int k = 0; k < 4; ++k) { const int ts = t - 3 + k; const unsigned xm = ts >= 0 ? 0xFFFFFFFFu : 0u;
            u32x2 xv = *(const u32x2*)(xp + (ptrdiff_t)(ts >= 0 ? k - 3 : 0) * LDP); xv.x &= xm; xv.y &= xm; sx[k] = xv; }
        const bf16_t* bp = BCc + (rowbase + t) * 256 + (bc_q < 4 ? grp * 64 + bc_q * 16 : 128 + grp * 64 + (bc_q - 4) * 16);
        bc0 = *(const u32x4*)bp; bc1 = *(const u32x4*)(bp + 8);
        if (tid < 64) sdt = P[(rowbase + tb + tid) * LDP + C_DT + hh];
    };
    ssd_load(0);
    for (int ch = 0; ch < SEQ / 64; ++ch) {
        const int t0 = ch * 64;
        __syncthreads();
        const int o_tt = tid >> 3, o_p4 = (tid & 7) * 4;
        bf16_t* zp = P + (rowbase + t0 + o_tt) * LDP + C_Z + hh * 64 + ph * 32 + o_p4;
        const u32x2 zv = *(const u32x2*)zp;
        { f32x4 a = xbias;
#pragma unroll
            for (int k = 0; k < 4; ++k) { a[0] += xw[k][0] * bf_lo(sx[k].x); a[1] += xw[k][1] * bf_hi(sx[k].x); a[2] += xw[k][2] * bf_lo(sx[k].y); a[3] += xw[k][3] * bf_hi(sx[k].y); }
            a[0] = siluf_(a[0]); a[1] = siluf_(a[1]); a[2] = siluf_(a[2]); a[3] = siluf_(a[3]);
            const unsigned q0 = cvt_pk_bf16(a[0], a[1]), q1 = cvt_pk_bf16(a[2], a[3]); const int tt = x_tt, c = x_c;
            *(f32x4*)(XS + tt * 32 + c) = a;
            XT[(c + 0) * 72 + tt] = (bf16_t)(q0 & 0xFFFF); XT[(c + 1) * 72 + tt] = (bf16_t)(q0 >> 16); XT[(c + 2) * 72 + tt] = (bf16_t)(q1 & 0xFFFF); XT[(c + 3) * 72 + tt] = (bf16_t)(q1 >> 16);
            if (bc_q < 4) { const int n = bc_q * 16; *(u32x4*)(Bb + tt * 72 + n) = bc0; *(u32x4*)(Bb + tt * 72 + n + 8) = bc1;
                const unsigned wv[8] = {bc0.x, bc0.y, bc0.z, bc0.w, bc1.x, bc1.y, bc1.z, bc1.w};
#pragma unroll
                for (int e = 0; e < 8; ++e) { BT[(n + 2 * e) * 72 + tt] = (bf16_t)(wv[e] & 0xFFFF); BT[(n + 2 * e + 1) * 72 + tt] = (bf16_t)(wv[e] >> 16); } }
            else { const int n = (bc_q - 4) * 16; *(u32x4*)(Cb + tt * 72 + n) = bc0; *(u32x4*)(Cb + tt * 72 + n + 8) = bc1; } }
        if (tid < 64) { const float dt = softplusf_(bf2f(sdt) + dtb); DTs[tid] = dt;
            float x = dt * Aneg;
#pragma unroll
            for (int o = 1; o < 64; o <<= 1) { const float v = __shfl_up(x, o); if (lane >= o) x += v; }
            ACS[tid] = x; }
        if (ch + 1 < SEQ / 64) ssd_load(t0 + 64);
        __syncthreads();
        const float acsL = ACS[63];
        { const int pp = tid >> 4, s4 = (tid & 15) * 4; float v[4];
#pragma unroll
            for (int e = 0; e < 4; ++e) { const int sidx = s4 + e; v[e] = XS[sidx * 32 + pp] * DTs[sidx] * __expf(acsL - ACS[sidx]); }
            *(u32x2*)(XwT + pp * 72 + s4) = (u32x2){cvt_pk_bf16(v[0], v[1]), cvt_pk_bf16(v[2], v[3])}; }
        { const int pi = wave >> 2, ni = wave & 3;
#pragma unroll
            for (int r = 0; r < 4; ++r) SbT[(16 * pi + 4 * g + r) * 72 + 16 * ni + lq] = (bf16_t)(cvt_pk_bf16(Sacc[r], 0.f) & 0xFFFF); }
        { const int ti = wave >> 1;
#pragma unroll
            for (int sj = 0; sj < 2; ++sj) { const int si = 2 * (wave & 1) + sj;
                f32x4 acc = (f32x4){0.f, 0.f, 0.f, 0.f};
                if (si <= ti) {
                    const bf16_t* ap = Cb + (16 * ti + lq) * 72 + 8 * g; const bf16_t* bp = Bb + (16 * si + lq) * 72 + 8 * g;
                    acc = __builtin_amdgcn_mfma_f32_16x16x32_bf16(*(const bf16x8*)ap, *(const bf16x8*)bp, acc, 0, 0, 0);
                    acc = __builtin_amdgcn_mfma_f32_16x16x32_bf16(*(const bf16x8*)(ap + 32), *(const bf16x8*)(bp + 32), acc, 0, 0, 0);
                }
                const int sidx = 16 * si + lq; const float as = ACS[sidx], ds = DTs[sidx];
#pragma unroll
                for (int r = 0; r < 4; ++r) { const int t = 16 * ti + 4 * g + r; const float val = (sidx <= t) ? acc[r] * __expf(ACS[t] - as) * ds : 0.f;
                    Mx[t * 72 + sidx] = (bf16_t)(cvt_pk_bf16(val, 0.f) & 0xFFFF); } } }
        __syncthreads();
        { const int ti = wave >> 1, pi = wave & 1;
            const bf16_t* ap = Mx + (16 * ti + lq) * 72 + 8 * g; const bf16_t* bp = XT + (16 * pi + lq) * 72 + 8 * g;
            const bf16_t* cp = Cb + (16 * ti + lq) * 72 + 8 * g; const bf16_t* sp = SbT + (16 * pi + lq) * 72 + 8 * g;
            f32x4 a1 = (f32x4){0.f, 0.f, 0.f, 0.f}, a2 = (f32x4){0.f, 0.f, 0.f, 0.f};
            a1 = __builtin_amdgcn_mfma_f32_16x16x32_bf16(*(const bf16x8*)ap, *(const bf16x8*)bp, a1, 0, 0, 0);
            a1 = __builtin_amdgcn_mfma_f32_16x16x32_bf16(*(const bf16x8*)(ap + 32), *(const bf16x8*)(bp + 32), a1, 0, 0, 0);
            a2 = __builtin_amdgcn_mfma_f32_16x16x32_bf16(*(const bf16x8*)cp, *(const bf16x8*)sp, a2, 0, 0, 0);
            a2 = __builtin_amdgcn_mfma_f32_16x16x32_bf16(*(const bf16x8*)(cp + 32), *(const bf16x8*)(sp + 32), a2, 0, 0, 0);
#pragma unroll
            for (int r = 0; r < 4; ++r) { const int t = 16 * ti + 4 * g + r, pc = 16 * pi + lq;
                YS[t * 32 + pc] = a1[r] + __expf(ACS[t]) * a2[r] + Dsk * XS[t * 32 + pc]; } }
        { const int pi = wave >> 2, ni = wave & 3; const float dl = __expf(acsL);
            Sacc = Sacc * dl;
            const bf16_t* ap = XwT + (16 * pi + lq) * 72 + 8 * g; const bf16_t* bp = BT + (16 * ni + lq) * 72 + 8 * g;
            Sacc = __builtin_amdgcn_mfma_f32_16x16x32_bf16(*(const bf16x8*)ap, *(const bf16x8*)bp, Sacc, 0, 0, 0);
            Sacc = __builtin_amdgcn_mfma_f32_16x16x32_bf16(*(const bf16x8*)(ap + 32), *(const bf16x8*)(bp + 32), Sacc, 0, 0, 0); }
        __syncthreads();
        { const int tt = o_tt, p4 = o_p4; const f32x4 y4 = *(const f32x4*)(YS + tt * 32 + p4);
            const float u0 = y4[0] * siluf_(bf_lo(zv.x)), u1 = y4[1] * siluf_(bf_hi(zv.x)), u2 = y4[2] * siluf_(bf_lo(zv.y)), u3 = y4[3] * siluf_(bf_hi(zv.y));
            u32x2 ov; ov.x = cvt_pk_bf16(u0, u1); ov.y = cvt_pk_bf16(u2, u3); *(u32x2*)zp = ov;
            float q = u0 * u0 + u1 * u1 + u2 * u2 + u3 * u3;
            q += __shfl_xor(q, 1); q += __shfl_xor(q, 2); q += __shfl_xor(q, 4);
            if ((tid & 7) == 0) SSQ[(rowbase + t0 + tt) * 32 + hh * 2 + ph] = q; }
    }
    __syncthreads();
}

__device__ __forceinline__ float fast_tanh(float x) { return 1.f - 2.f * __builtin_amdgcn_rcpf(1.f + __expf(2.f * x)); }
__device__ __forceinline__ void pbar4(LAS volatile unsigned* cnt, unsigned& tgt, int lane) {
    tgt += 4u;
    asm volatile("s_waitcnt lgkmcnt(0)" ::: "memory");
    if (lane == 0) __hip_atomic_fetch_add((LAS unsigned*)cnt, 1u, __ATOMIC_RELAXED, __HIP_MEMORY_SCOPE_WORKGROUP);
    while (*cnt < tgt) __builtin_amdgcn_s_sleep(1);
    asm volatile("" ::: "memory");
}
__device__ __forceinline__ void rwkv_item(const Params& p, int layer, unsigned char* shm, int item) {
    const int half = item & 1, h = (item >> 1) & 7, b = item >> 4;
    bf16_t* P = (bf16_t*)(p.ws + OFF_P); bf16_t* YRAW = (bf16_t*)(p.ws + OFF_YRAW); float* BONUS = (float*)(p.ws + OFF_BONUS);
    const int tid = opaque_tid(), wave = tid >> 6, lane = tid & 63, lq = lane & 15, g = lane >> 4;
    const size_t rowbase = (size_t)b * SEQ;
    const float* mu = p.in[9] + layer * 2176;
    const float* w0 = p.in[10] + layer * 512; const float* wup = p.in[11] + (size_t)layer * 64 * 512;
    const float* a0 = p.in[12] + layer * 512; const float* aup = p.in[13] + (size_t)layer * 64 * 512;
    const float* kkp = p.in[14] + layer * 512; const float* kap = p.in[15] + layer * 512; const float* rkp = p.in[16] + layer * 512;
    constexpr int SETF = 6 * 2048;
    float* SET0 = (float*)shm;
    float* AA = SET0 + 2 * SETF;
    float* Yb = AA + 2048;
    bf16_t* WLb = (bf16_t*)(Yb + 2048);
    bf16_t* ALb = WLb + 32 * 72;
    LAS volatile unsigned* pcnt = (LAS volatile unsigned*)((LAS unsigned char*)shm + (2 * SETF + 2048 + 2048) * 4 + 2 * 32 * 72 * 2);
    const int csub = wave & 3;
    bf16x8 bfr[2][2]; float lw0[2];
#pragma unroll
    for (int mat = 0; mat < 2; ++mat) { const float* up = (mat ? aup : wup) + h * 64 + csub * 16 + lq;
#pragma unroll
        for (int ks = 0; ks < 2; ++ks) { unsigned w[4];
#pragma unroll
            for (int e2 = 0; e2 < 4; ++e2) { const int m0 = 32 * ks + 8 * g + 2 * e2; w[e2] = cvt_pk_bf16(up[(size_t)m0 * 512], up[(size_t)(m0 + 1) * 512]); }
            u32x4 wv = (u32x4){w[0], w[1], w[2], w[3]}; bfr[mat][ks] = __builtin_bit_cast(bf16x8, wv); }
        lw0[mat] = (mat ? a0 : w0)[h * 64 + csub * 16 + lq]; }
    const int ej = (tid & 15) * 4;
    const f32x4 c_kk = *(const f32x4*)(kkp + h * 64 + ej), c_ka = *(const f32x4*)(kap + h * 64 + ej), c_rk = *(const f32x4*)(rkp + h * 64 + ej);
    const f32x4 mu_r = *(const f32x4*)(mu + h * 64 + ej), mu_k = *(const f32x4*)(mu + 512 + h * 64 + ej), mu_v = *(const f32x4*)(mu + 1024 + h * 64 + ej);
    const f32x4 mu_w = *(const f32x4*)(mu + 2048 + ej), mu_a = *(const f32x4*)(mu + 2112 + ej);
    f32x4 sA = (f32x4){0.f, 0.f, 0.f, 0.f}, sB = (f32x4){0.f, 0.f, 0.f, 0.f};
    const int irow = half * 32 + (wave & 3) * 8 + g * 2;
    unsigned ptgt = 0u;
    const int pm = tid - 256, e2t = pm >> 4;
    u32x2 cva[2][5], pva[2][5];
    auto rw_load = [&](int ch) {
#pragma unroll
        for (int ps = 0; ps < 2; ++ps) { const int tl = e2t + 16 * ps, t = ch * 32 + tl; const bf16_t* cur = P + (rowbase + t) * LDP + C_RW; const bool hp = t > 0; const bf16_t* prv = hp ? cur - LDP : cur;
#pragma unroll
            for (int i = 0; i < 5; ++i) { const int col = (i == 0 ? h * 64 : i == 1 ? 512 + h * 64 : i == 2 ? 1024 + h * 64 : i == 3 ? 2048 : 2112) + ej;
                cva[ps][i] = *(const u32x2*)(cur + col); pva[ps][i] = *(const u32x2*)(prv + col); } }
    };
    auto prep = [&](int ch, float* SET) {
        float* Rm = SET; float* Km = SET + 2048; float* Vm = SET + 4096; float* DEC = SET + 6144; float* KK = SET + 8192; float* BB = SET + 10240;
#pragma unroll
        for (int ps = 0; ps < 2; ++ps) { const int tl = e2t + 16 * ps, t = ch * 32 + tl; const unsigned pmask = t > 0 ? 0xFFFFFFFFu : 0u;
#pragma unroll
            for (int i = 0; i < 5; ++i) {
                const u32x2 cv = cva[ps][i]; u32x2 pv = pva[ps][i]; pv.x &= pmask; pv.y &= pmask;
                const f32x4 m4 = i == 0 ? mu_r : i == 1 ? mu_k : i == 2 ? mu_v : i == 3 ? mu_w : mu_a;
                float c[4] = {bf_lo(cv.x), bf_hi(cv.x), bf_lo(cv.y), bf_hi(cv.y)}; const float q[4] = {bf_lo(pv.x), bf_hi(pv.x), bf_lo(pv.y), bf_hi(pv.y)};
#pragma unroll
                for (int e = 0; e < 4; ++e) c[e] = c[e] + (q[e] - c[e]) * m4[e];
                if (i == 0) *(f32x4*)(Rm + tl * 64 + ej) = (f32x4){c[0], c[1], c[2], c[3]};
                else if (i == 1) *(f32x4*)(Km + tl * 64 + ej) = (f32x4){c[0], c[1], c[2], c[3]};
                else if (i == 2) *(f32x4*)(Vm + tl * 64 + ej) = (f32x4){c[0], c[1], c[2], c[3]};
                else if (i == 3) { u32x2 o; o.x = cvt_pk_bf16(fast_tanh(c[0]), fast_tanh(c[1])); o.y = cvt_pk_bf16(fast_tanh(c[2]), fast_tanh(c[3])); *(u32x2*)(WLb + tl * 72 + ej) = o; }
                else { u32x2 o; o.x = cvt_pk_bf16(c[0], c[1]); o.y = cvt_pk_bf16(c[2], c[3]); *(u32x2*)(ALb + tl * 72 + ej) = o; } } }
        if (ch + 1 < SEQ / 32) rw_load(ch + 1);
        pbar4(pcnt, ptgt, lane);
#pragma unroll
        for (int mat = 0; mat < 2; ++mat)
#pragma unroll
            for (int ts = 0; ts < 2; ++ts) { const bf16_t* ap = (mat ? ALb : WLb) + (16 * ts + lq) * 72 + 8 * g;
                const bf16x8 a0f = *(const bf16x8*)ap, a1f = *(const bf16x8*)(ap + 32);
                f32x4 c = (f32x4){0.f, 0.f, 0.f, 0.f};
                c = __builtin_amdgcn_mfma_f32_16x16x32_bf16(a0f, bfr[mat][0], c, 0, 0, 0);
                c = __builtin_amdgcn_mfma_f32_16x16x32_bf16(a1f, bfr[mat][1], c, 0, 0, 0);
#pragma unroll
                for (int r = 0; r < 4; ++r) { const int tt = 16 * ts + 4 * g + r; const float x = lw0[mat] + c[r];
                    if (mat == 0) DEC[tt * 64 + csub * 16 + lq] = __expf(-0.60653066f * sigmoidf_(x));
                    else AA[tt * 64 + csub * 16 + lq] = sigmoidf_(x); } }
        pbar4(pcnt, ptgt, lane);
#pragma unroll
        for (int ps = 0; ps < 2; ++ps) { const int tl = e2t + 16 * ps;
            const f32x4 k4 = *(const f32x4*)(Km + tl * 64 + ej), a4 = *(const f32x4*)(AA + tl * 64 + ej), r4 = *(const f32x4*)(Rm + tl * 64 + ej);
            f32x4 kr, kt; float ss = 0.f, bo = 0.f;
#pragma unroll
            for (int e = 0; e < 4; ++e) { kr[e] = k4[e] * c_kk[e]; ss += kr[e] * kr[e]; kt[e] = k4[e] * (1.f + (a4[e] - 1.f) * c_ka[e]); bo += r4[e] * kt[e] * c_rk[e]; }
            ss = allred16(ss); bo = allred16(bo);
            const float inv = __builtin_amdgcn_rsqf(fmaxf(ss, 1e-24f));
            f32x4 kk4, b4;
#pragma unroll
            for (int e = 0; e < 4; ++e) { kk4[e] = kr[e] * inv; b4[e] = kk4[e] * a4[e]; }
            *(f32x4*)(Km + tl * 64 + ej) = kt; *(f32x4*)(KK + tl * 64 + ej) = kk4; *(f32x4*)(BB + tl * 64 + ej) = b4;
            if (half == 0 && (tid & 15) == 0) BONUS[(rowbase + ch * 32 + tl) * 8 + h] = bo; }
    };
    auto yraw_store = [&](int ch) {
#pragma unroll
        for (int ps = 0; ps < 2; ++ps)
#pragma unroll
            for (int q = 0; q < 2; ++q) { const int tl = e2t + 16 * ps, il = (tid & 15) + 16 * q;
                YRAW[(rowbase + ch * 32 + tl) * 512 + h * 64 + half * 32 + il] = (bf16_t)(cvt_pk_bf16(Yb[(ch & 1) * 1024 + tl * 32 + il], 0.f) & 0xFFFF); }
    };
    if (tid == 0) *pcnt = 0u;
    __syncthreads();
    if (wave >= 4) { rw_load(0); prep(0, SET0); }
    for (int ch = 0; ch < SEQ / 32; ++ch) {
        __syncthreads();
        if (wave < 4) {
            const float* SET = SET0 + (ch & 1) * SETF;
            const float* Rm = SET; const float* Km = SET + 2048; const float* Vm = SET + 4096; const float* DEC = SET + 6144; const float* KK = SET + 8192; const float* BB = SET + 10240;
            float* Yw = Yb + (ch & 1) * 1024;
            struct Ops { f32x4 w, k, q, b, r; float v0, v1; };
            auto ld = [&](Ops& o, int tt) { const int off = tt * 64 + lq * 4;
                o.w = *(const f32x4*)(DEC + off); o.k = *(const f32x4*)(Km + off); o.q = *(const f32x4*)(KK + off); o.b = *(const f32x4*)(BB + off); o.r = *(const f32x4*)(Rm + off);
                const float* vp = Vm + tt * 64 + irow; o.v0 = vp[0]; o.v1 = vp[1]; };
            auto step = [&](const Ops& o, int tt) {
                const f32x4 da = sA * o.q, db = sB * o.q; float sa0 = (da[0] + da[1]) + (da[2] + da[3]), sa1 = (db[0] + db[1]) + (db[2] + db[3]);
                const f32x4 uA = sA * o.w + o.k * o.v0, uB = sB * o.w + o.k * o.v1;
                sa0 = -allred16(sa0); sa1 = -allred16(sa1);
                sA = uA + o.b * sa0; sB = uB + o.b * sa1;
                const f32x4 ea = sA * o.r, eb = sB * o.r; float y0 = (ea[0] + ea[1]) + (ea[2] + ea[3]), y1 = (eb[0] + eb[1]) + (eb[2] + eb[3]);
                asm("" : "+v"(y0)); asm("" : "+v"(y1));
                y0 += dppf<0xB1>(y0); y1 += dppf<0xB1>(y1);
                float z = (lq & 1) ? y1 : y0;
                z += dppf<0x4E>(z); z += dppf<0x124>(z); z += dppf<0x128>(z);
                if (lq < 2) Yw[tt * 32 + (wave & 3) * 8 + g * 2 + lq] = z; };
            Ops oa, ob;
            ld(oa, 0);
            for (int tt = 0; tt < 32; tt += 4) {
                ld(ob, tt + 1);
                step(oa, tt);
                ld(oa, tt + 2);
                step(ob, tt + 1);
                ld(ob, tt + 3);
                step(oa, tt + 2);
                ld(oa, (tt + 4 < 32) ? tt + 4 : 31);
                step(ob, tt + 3);
            }
        } else {
            if (ch > 0) yraw_store(ch - 1);
            if (ch + 1 < SEQ / 32) prep(ch + 1, SET0 + ((ch + 1) & 1) * SETF);
        }
    }
    __syncthreads();
    if (wave >= 4) yraw_store(SEQ / 32 - 1);
    __syncthreads();
}

__device__ __forceinline__ void rw_post(const Params& p, int layer) {
    bf16_t* P = (bf16_t*)(p.ws + OFF_P); const bf16_t* YRAW = (const bf16_t*)(p.ws + OFF_YRAW);
    const float* BONUS = (const float*)(p.ws + OFF_BONUS); const float* SSQ = (const float*)(p.ws + OFF_SSQ); float* RSTD = (float*)(p.ws + OFF_RSTD);
    const float* mu = p.in[9] + layer * 2176; const float* lng = p.in[17] + layer * 512; const float* lnb = p.in[18] + layer * 512;
    const int gt = blockIdx.x * 512 + opaque_tid(), gs = gridDim.x * 512;
    {
        const int c = (gt & 127) * 4, h = c >> 6;
        const f32x4 muv = *(const f32x4*)(mu + 1024 + c), mug = *(const f32x4*)(mu + 1536 + c);
        const f32x4 lg = *(const f32x4*)(lng + c), lb = *(const f32x4*)(lnb + c);
        for (int idx0 = gt; idx0 < TOK * 128; idx0 += 4 * gs) {
            u32x2 yv[4], vc[4], gc[4], vp[4], gp[4]; float bn[4]; unsigned pm[4]; bool ok[4];
#pragma unroll
            for (int u = 0; u < 4; ++u) { const int idx = idx0 + u * gs; ok[u] = idx < TOK * 128; const int tok = ok[u] ? (idx >> 7) : 0;
                const bf16_t* cur = P + (size_t)tok * LDP + C_RW; const bool hp = (tok & (SEQ - 1)) > 0; const bf16_t* prv = hp ? cur - LDP : cur; pm[u] = hp ? 0xFFFFFFFFu : 0u;
                yv[u] = *(const u32x2*)(YRAW + (size_t)tok * 512 + c);
                vc[u] = *(const u32x2*)(cur + 1024 + c); gc[u] = *(const u32x2*)(cur + 1536 + c);
                vp[u] = *(const u32x2*)(prv + 1024 + c); gp[u] = *(const u32x2*)(prv + 1536 + c);
                bn[u] = BONUS[(size_t)tok * 8 + h]; }
#pragma unroll
            for (int u = 0; u < 4; ++u) { const int idx = idx0 + u * gs; const int tok = ok[u] ? (idx >> 7) : 0;
                float y[4] = {bf_lo(yv[u].x), bf_hi(yv[u].x), bf_lo(yv[u].y), bf_hi(yv[u].y)};
                const float mean = allred16(y[0] + y[1] + y[2] + y[3]) * (1.f / 64.f);
                float d[4], vs = 0.f;
#pragma unroll
                for (int e = 0; e < 4; ++e) { d[e] = y[e] - mean; vs += d[e] * d[e]; }
                const float var = allred16(vs) * (1.f / 64.f);
                const float rs = rsqrtf(var + 64e-5f);
                const unsigned m = pm[u];
                const float vcur[4] = {bf_lo(vc[u].x), bf_hi(vc[u].x), bf_lo(vc[u].y), bf_hi(vc[u].y)}, vprv[4] = {bf_lo(vp[u].x & m), bf_hi(vp[u].x & m), bf_lo(vp[u].y & m), bf_hi(vp[u].y & m)};
                const float gcur[4] = {bf_lo(gc[u].x), bf_hi(gc[u].x), bf_lo(gc[u].y), bf_hi(gc[u].y)}, gprv[4] = {bf_lo(gp[u].x & m), bf_hi(gp[u].x & m), bf_lo(gp[u].y & m), bf_hi(gp[u].y & m)};
                float o[4];
#pragma unroll
                for (int e = 0; e < 4; ++e) { const float vm = vcur[e] + (vprv[e] - vcur[e]) * muv[e], gm = gcur[e] + (gprv[e] - gcur[e]) * mug[e];
                    o[e] = (d[e] * rs * lg[e] + lb[e] + bn[u] * vm) * siluf_(gm); }
                u32x2 ov; ov.x = cvt_pk_bf16(o[0], o[1]); ov.y = cvt_pk_bf16(o[2], o[3]);
                if (ok[u]) *(u32x2*)(P + (size_t)tok * LDP + C_YRW + c) = ov; }
        }
    }
    for (int tok = gt; tok < TOK; tok += gs) { const f32x4* q = (const f32x4*)(SSQ + (size_t)tok * 32); float s = 0.f;
#pragma unroll
        for (int i = 0; i < 8; ++i) { const f32x4 v = q[i]; s += v[0] + v[1] + v[2] + v[3]; }
        RSTD[tok] = rsqrtf(s * (1.f / 1024.f) + 1e-6f); }
}

#define XB_TMO      128
#define XB_XCNT(j)  (256  + 64 * (j))
#define XB_XSUB(j)  (1280 + 64 * (j))
#define XB_XGEN(j)  (2304 + 64 * (j))
#define XB_TOP      3328
#define XB_TOPGEN   3392
#define XCD_BAR_WORDS 3456
#define XB_SPIN_CAP (1u << 18)
__device__ __forceinline__ unsigned xb_ld(unsigned* p)              { return __hip_atomic_load(p, __ATOMIC_RELAXED, __HIP_MEMORY_SCOPE_AGENT); }
__device__ __forceinline__ unsigned xb_add(unsigned* p, unsigned v) { return __hip_atomic_fetch_add(p, v, __ATOMIC_RELAXED, __HIP_MEMORY_SCOPE_AGENT); }
__device__ __forceinline__ unsigned xb_xcc_id() { return (unsigned)__builtin_amdgcn_s_getreg((3 << 11) | 20) & 0xFu; }
#define XB_SPIN(cond, bar) do { unsigned _sp = 0; while (cond) { __builtin_amdgcn_s_sleep(1); \
    if ((++_sp & 255u) == 0u) { if (xb_ld(&(bar)[XB_TMO])) break; if (_sp > XB_SPIN_CAP) { atomicAdd(&(bar)[XB_TMO], 1u); break; } } } } while (0)
struct XcdBarrier { unsigned* bar; unsigned x; volatile LAS unsigned* st; };
__device__ __forceinline__ XcdBarrier xcd_barrier_post(unsigned* bar, volatile LAS unsigned* st) {
    XcdBarrier b; b.bar = bar; b.x = xb_xcc_id(); b.st = st;
    if (threadIdx.x == 0) (void)xb_add(&bar[XB_XCNT(b.x)], 1u);
    return b;
}
__device__ __forceinline__ void xcd_barrier_complete(unsigned* bar, unsigned x, unsigned& nloc, unsigned& nx) {
    const unsigned G = gridDim.x * gridDim.y * gridDim.z;
    unsigned sum, cnt, mine, sp = 0u;
    for (;;) {
        sum = 0u; cnt = 0u; mine = 0u;
#pragma unroll
        for (unsigned j = 0; j < 16; ++j) { const unsigned c = xb_ld(&bar[XB_XCNT(j)]); sum += c; cnt += (c > 0u) ? 1u : 0u; mine = (j == x) ? c : mine; }
        if (sum == G) break;
        __builtin_amdgcn_s_sleep(1);
        if ((++sp & 255u) == 0u) { if (xb_ld(&bar[XB_TMO])) break; if (sp > XB_SPIN_CAP) { atomicAdd(&bar[XB_TMO], 1u); break; } }
    }
    nloc = mine > 0u ? mine : 1u; nx = cnt > 0u ? cnt : 1u;
}
__device__ __forceinline__ void xcd_barrier(const XcdBarrier& b) {
    asm volatile("s_waitcnt vmcnt(0)" ::: "memory");
    __syncthreads();
    if (threadIdx.x == 0) {
        unsigned* bar = b.bar;
        __builtin_amdgcn_s_waitcnt(0);
        unsigned nloc = b.st[0], nx = b.st[1];
        if (nloc == 0u) { xcd_barrier_complete(bar, b.x, nloc, nx); b.st[0] = nloc; b.st[1] = nx; }
        const unsigned old = xb_add(&bar[XB_XSUB(b.x)], 1u);
        const unsigned gen = old / nloc;
        if (old + 1u == (gen + 1u) * nloc) {
            __builtin_amdgcn_fence(__ATOMIC_RELEASE, "agent");
            asm volatile("s_waitcnt vmcnt(0)" ::: "memory");
            const unsigned og = xb_add(&bar[XB_TOP], 1u);
            const unsigned tg = og / nx;
            if (og + 1u == (tg + 1u) * nx) xb_add(&bar[XB_TOPGEN], 1u);
            else XB_SPIN(xb_ld(&bar[XB_TOPGEN]) == tg, bar);
            __builtin_amdgcn_fence(__ATOMIC_ACQUIRE, "agent");
            xb_add(&bar[XB_XGEN(b.x)], 1u);
            asm volatile("s_waitcnt vmcnt(0)" ::: "memory");
        } else {
            XB_SPIN(xb_ld(&bar[XB_XGEN(b.x)]) == gen, bar);
            __builtin_amdgcn_fence(__ATOMIC_ACQUIRE, "agent");
            asm volatile("s_waitcnt vmcnt(0)" ::: "memory");
        }
    }
    __syncthreads();
}

#define GSYNC() xcd_barrier(xb)
__global__ void __launch_bounds__(512, 2) mega(Params p) {
    extern __shared__ __attribute__((aligned(16))) unsigned char shm[];
    cg::grid_group grid = cg::this_grid();
    volatile LAS unsigned* xst = (volatile LAS unsigned*)((LAS unsigned char*)shm + LDS_BYTES - 16);
    if (threadIdx.x == 0) { xst[0] = 0u; xst[1] = 0u; }
    __syncthreads();
    const XcdBarrier xb = xcd_barrier_post((unsigned*)(p.ws + OFF_BAR), xst);
    const char* Pc = (const char*)(p.ws + OFF_P); const char* WTc = (const char*)(p.ws + OFF_WT);
    bf16_t* P = (bf16_t*)(p.ws + OFF_P);
    const int G = gridDim.x, c = blockIdx.x;
    for (int layer = 0; layer < 2; ++layer) {
        phase0(p, layer, shm);
        if (layer == 0) grid.sync(); else GSYNC();
        { SchedInproj S{Pc, WTc, G, c}; EpiInproj E{P}; pg8::gemm_phase<true>((LAS unsigned char*)shm, S, E); }
        GSYNC();
        { const int Gh = G >> 1;
            if (c < Gh) { for (int it = c; it < 128; it += Gh) rwkv_item(p, layer, shm, it); }
            else { const int c2 = c - Gh;
                bc_prepass(p, layer, c2, G - Gh);
                asm volatile("s_waitcnt vmcnt(0)" ::: "memory");
                __syncthreads();
                if (threadIdx.x == 0) { unsigned* cw_ = (unsigned*)(p.ws + OFF_BAR) + 3520; const unsigned need = (unsigned)(G - Gh) * (unsigned)(layer + 1);
                    __builtin_amdgcn_fence(__ATOMIC_RELEASE, "agent"); asm volatile("s_waitcnt vmcnt(0)" ::: "memory");
                    (void)xb_add(cw_, 1u);
                    unsigned sp_ = 0; while (xb_ld(cw_) < need) { __builtin_amdgcn_s_sleep(2); if (++sp_ > (1u << 22)) break; }
                    __builtin_amdgcn_fence(__ATOMIC_ACQUIRE, "agent"); asm volatile("s_waitcnt vmcnt(0)" ::: "memory"); }
                __syncthreads();
                for (int it = c2; it < 256; it += Gh) ssd_item(p, layer, shm, it);
                for (int it = c2; it < 1024; it += Gh) attn_item(p, shm, it); } }
        GSYNC();
        rw_post(p, layer);
        GSYNC();
        { SchedC1 S{Pc, WTc, G, c}; EpiC1 E{P, (const float*)(p.ws + OFF_RSTD)}; pg8::gemm_phase<true>((LAS unsigned char*)shm, S, E); }
        GSYNC();
        { SchedOut S{Pc, WTc, G, c}; EpiOut E{layer == 0 ? p.in[0] : p.out, p.out}; pg8::gemm_phase<false>((LAS unsigned char*)shm, S, E); }
        GSYNC();
    }
    { const int tid = opaque_tid(), wave = tid >> 6, lane = tid & 63; const float* fg = p.in[23];
        for (int row = blockIdx.x * 8 + wave; row < TOK; row += gridDim.x * 8) { float* xr = p.out + (size_t)row * DM;
            f32x4 v[4]; float ss = 0.f;
#pragma unroll
            for (int i = 0; i < 4; ++i) { v[i] = *(const f32x4*)(xr + i * 256 + lane * 4); ss += v[i][0] * v[i][0] + v[i][1] * v[i][1] + v[i][2] * v[i][2] + v[i][3] * v[i][3]; }
            ss = wave_sum(ss);
            const float rs = rsqrtf(ss * (1.f / DM) + 1e-6f);
#pragma unroll
            for (int i = 0; i < 4; ++i) { const f32x4 g = *(const f32x4*)(fg + i * 256 + lane * 4); *(f32x4*)(xr + i * 256 + lane * 4) = v[i] * rs * g; } } }
}

extern "C" void kernel_launch(void* const* d_in, const int* in_sizes, int n_in, void* d_out, int out_size, void* d_ws, size_t ws_size, hipStream_t stream) {
    static int grid_blocks = 0;
    if (grid_blocks == 0) {
        if (n_in != 24 || out_size != TOK * DM || ws_size < WS_NEED) { fprintf(stderr, "kernel_launch: unexpected shapes (n_in %d out %d ws %zu need %zu)\n", n_in, out_size, ws_size, (size_t)WS_NEED); grid_blocks = -1; return; }
        int dev = 0, cus = 0, per_cu = 0;
        hipGetDevice(&dev);
        hipDeviceGetAttribute(&cus, hipDeviceAttributeMultiprocessorCount, dev);
        hipFuncSetAttribute((const void*)mega, hipFuncAttributeMaxDynamicSharedMemorySize, LDS_BYTES);
        hipOccupancyMaxActiveBlocksPerMultiprocessor(&per_cu, (const void*)mega, 512, LDS_BYTES);
        if (per_cu < 1) { fprintf(stderr, "kernel_launch: occupancy query says %d blocks per CU\n", per_cu); grid_blocks = -1; return; }
        if (per_cu > 1) per_cu = 1;
        grid_blocks = cus * per_cu;
        grid_blocks &= ~7;
    }
    if (grid_blocks < 0) return;
    Params p{};
    for (int i = 0; i < 24; ++i) p.in[i] = (const float*)d_in[i];
    p.out = (float*)d_out; p.ws = (unsigned char*)d_ws;
    (void)hipMemsetAsync((unsigned char*)d_ws + OFF_BAR, 0, SZ_BAR, stream);
    void* args[] = {&p};
    hipError_t e = hipLaunchCooperativeKernel((const void*)mega, dim3(grid_blocks), dim3(512), args, LDS_BYTES, stream);
    if (e != hipSuccess) fprintf(stderr, "cooperative launch failed: %s (grid %d)\n", hipGetErrorString(e), grid_blocks);
}
```

```cpp
#include <hip/hip_runtime.h>
#include <hip/hip_cooperative_groups.h>
#include <cstdio>
namespace cg = cooperative_groups;

#define LAS __attribute__((address_space(3)))
typedef unsigned short bf16_t;
typedef short bf16x8 __attribute__((ext_vector_type(8)));
typedef float f32x4 __attribute__((ext_vector_type(4)));
typedef unsigned u32x4 __attribute__((ext_vector_type(4)));
typedef unsigned u32x2 __attribute__((ext_vector_type(2)));

constexpr int TOK = 16384, SEQ = 2048, DM = 1024, NIN = 9616;
constexpr int LDP = 7680;
constexpr int C_Q = 0, C_K = 512, C_V = 1024, C_SBG = 1536, C_Z = 2048, C_XBC = 3072, C_RW = 4352, C_DT = 6528, C_H = 6656;
constexpr int C_M = 0, C_G = 3072, C_YRW = 4352;
constexpr int R_GATE = 6656, R_SB = 9728, R_SSD = 10752, R_RWO = 11776, R_WO = 12800, WT_ROWS = 13824;
constexpr size_t OFF_P = 0, SZ_P = (size_t)TOK * LDP * 2;
constexpr size_t OFF_WT = OFF_P + SZ_P, SZ_WT = (size_t)WT_ROWS * 1024 * 2;
constexpr size_t OFF_YRAW = OFF_WT + SZ_WT, SZ_YRAW = (size_t)TOK * 512 * 2;
constexpr size_t OFF_SSQ = OFF_YRAW + SZ_YRAW, SZ_SSQ = (size_t)TOK * 32 * 4;
constexpr size_t OFF_RSTD = OFF_SSQ + SZ_SSQ, SZ_RSTD = (size_t)TOK * 4;
constexpr size_t OFF_BONUS = OFF_RSTD + SZ_RSTD, SZ_BONUS = (size_t)TOK * 8 * 4;
constexpr size_t OFF_BAR = OFF_BONUS + SZ_BONUS, SZ_BAR = 16384;
constexpr size_t OFF_BCC = OFF_BAR + SZ_BAR, SZ_BCC = (size_t)TOK * 256 * 2;
constexpr size_t WS_NEED = OFF_BCC + SZ_BCC;
constexpr int LDS_BYTES = 135168;

struct Params { const float* in[24]; float* out; unsigned char* ws; };

typedef float f32x2_t __attribute__((ext_vector_type(2)));
typedef __bf16 bf16x2_t __attribute__((ext_vector_type(2)));
__device__ __forceinline__ unsigned cvt_pk_bf16(float lo, float hi) { const f32x2_t v = {lo, hi}; return __builtin_bit_cast(unsigned, __builtin_convertvector(v, bf16x2_t)); }
__device__ __forceinline__ float bf_lo(unsigned u) { return __uint_as_float(u << 16); }
__device__ __forceinline__ float bf_hi(unsigned u) { return __uint_as_float(u & 0xFFFF0000u); }
__device__ __forceinline__ float bf2f(bf16_t h) { return __uint_as_float(((unsigned)h) << 16); }
__device__ __forceinline__ float sigmoidf_(float x) { return __builtin_amdgcn_rcpf(1.f + __expf(-x)); }
__device__ __forceinline__ float siluf_(float x) { return x * __builtin_amdgcn_rcpf(1.f + __expf(-x)); }
__device__ __forceinline__ float softplusf_(float x) { return fmaxf(x, 0.f) + __logf(1.f + __expf(-fabsf(x))); }
template <int CTRL> __device__ __forceinline__ float dppf(float x) { return __int_as_float(__builtin_amdgcn_update_dpp(0, __float_as_int(x), CTRL, 0xF, 0xF, true)); }
__device__ __forceinline__ float allred16(float x) { x += dppf<0xB1>(x); x += dppf<0x4E>(x); x += dppf<0x141>(x); x += dppf<0x140>(x); return x; }
__device__ __forceinline__ int opaque_tid() { int t; asm volatile("v_mov_b32 %0, %1" : "=v"(t) : "v"((int)threadIdx.x)); return t; }
__device__ __forceinline__ float wave_sum(float v) {
#pragma unroll
    for (int o = 1; o < 64; o <<= 1) v += __shfl_xor(v, o);
    return v;
}

namespace pg8 {
constexpr int BM = 256, BK = 64, HALF = 128, HTB = HALF * BK * 2, NXCD = 8, WGM = 8;
constexpr unsigned LDA_B = LDP * 2, LDB_B = 2048;
__device__ __forceinline__ int lds_byte(int r, int c) { const int st = (r >> 4) * 2 + (c >> 5), rr = r & 15, cc = c & 31, ob = rr * 64 + cc * 2; return st * 1024 + (ob ^ (((ob >> 9) & 1) << 5)); }
__device__ __forceinline__ void stage_rc(int b, int& R, int& C) { const int st = b / 1024, sb = b % 1024, swz = sb ^ (((sb >> 9) & 1) << 5); R = (st >> 1) * 16 + swz / 64; C = (st & 1) * 32 + (swz % 64) / 2; }
__device__ __forceinline__ int perm32(int rho) { const int n = rho >> 4, i = rho & 15; return 8 * (i >> 2) + 4 * n + (i & 3); }
struct UnitD { const char* A; const char* B; int nt, pm, pn, kind; };
__device__ __forceinline__ void tile_of(int L, int nM, int nN, int& pm, int& pn) {
    const int nwg = nM * nN; int wgid = L;
    { const int q = nwg / NXCD, r = nwg % NXCD, xcd = wgid % NXCD, off = wgid / NXCD; wgid = (xcd < r ? xcd * (q + 1) : r * (q + 1) + (xcd - r) * q) + off; }
    const int nig = WGM * nN, gid = wgid / nig, fm = gid * WGM, gsz = (nM - fm) < WGM ? (nM - fm) : WGM;
    pm = fm + ((wgid % nig) % gsz); pn = (wgid % nig) / gsz;
}

template <bool PERM, class Sched, class Epi>
__device__ __forceinline__ void gemm_phase(LAS unsigned char* lds, const Sched& S, const Epi& E) {
    const int tid = opaque_tid(), wid = __builtin_amdgcn_readfirstlane(tid >> 6), lane = tid & 63, wr = wid >> 2, wc = wid & 3, fr = lane & 15, fq = lane >> 4;
    unsigned voffA[2], voffB[2];
#pragma unroll
    for (int i = 0; i < 2; ++i) { int R, C; stage_rc(tid * 16 + i * 8192, R, C); const int Rb = PERM ? ((R & ~31) + perm32(R & 31)) : R;
        voffA[i] = (unsigned)R * LDA_B + (unsigned)C * 2u; voffB[i] = (unsigned)Rb * LDB_B + (unsigned)C * 2u; }
    const size_t kstep = (size_t)(BK * 2);
    const size_t hstepA = (size_t)HALF * LDA_B, hstepB = (size_t)HALF * LDB_B;
    const unsigned ldsw = (unsigned)wid * 1024u;
    const int aoff = lds_byte(wr * 64 + fr, fq * 8), boff = lds_byte(wc * 32 + fr, fq * 8);
#define PG8_SA(b, h) (((b) * 2 + (h)) * HTB)
#define PG8_SB(b, h) ((4 + (b) * 2 + (h)) * HTB)
#define PG8_STAGE(bufoff, gbase, voff) do { _Pragma("unroll") for (int _i = 0; _i < 2; ++_i) \
        __builtin_amdgcn_global_load_lds((const unsigned*)((const char*)(gbase) + (voff)[_i]), (LAS unsigned*)(lds + (bufoff) + ldsw + _i * 8192), 16, 0, 0); } while (0)
#define PG8_LDA(dst, b, h) do { _Pragma("unroll") for (int m = 0; m < 4; ++m) _Pragma("unroll") for (int k = 0; k < 2; ++k) dst[m][k] = *(const LAS bf16x8*)(lds + PG8_SA(b, h) + aoff + m * 2048 + k * 1024); } while (0)
#define PG8_LDB(dst, b, h) do { _Pragma("unroll") for (int n = 0; n < 2; ++n) _Pragma("unroll") for (int k = 0; k < 2; ++k) dst[n][k] = *(const LAS bf16x8*)(lds + PG8_SB(b, h) + boff + n * 2048 + k * 1024); } while (0)
#define PG8_MMA(ai, bj, At, Bt) do { __builtin_amdgcn_s_setprio(1); _Pragma("unroll") for (int m = 0; m < 4; ++m) _Pragma("unroll") for (int n = 0; n < 2; ++n) _Pragma("unroll") for (int k = 0; k < 2; ++k) \
        acc[ai][bj][m][n] = __builtin_amdgcn_mfma_f32_16x16x32_bf16(Bt[n][k], At[m][k], acc[ai][bj][m][n], 0, 0, 0); __builtin_amdgcn_s_setprio(0); } while (0)
#define PG8_WAIT_V(n) asm volatile("s_waitcnt vmcnt(" #n ")" ::: "memory")
#define PG8_WAIT_L(n) asm volatile("s_waitcnt lgkmcnt(" #n ")" ::: "memory")
#define PG8_BAR __builtin_amdgcn_s_barrier()
#define PG8_SCHED __builtin_amdgcn_sched_barrier(0)
    UnitD cur, nxt; int ui = 0;
    if (!S.next(0, cur)) return;
    f32x4 acc[2][2][4][2];
#pragma unroll
    for (int a = 0; a < 2; ++a)
#pragma unroll
        for (int b = 0; b < 2; ++b)
#pragma unroll
            for (int m = 0; m < 4; ++m)
#pragma unroll
                for (int n = 0; n < 2; ++n) acc[a][b][m][n] = (f32x4){0.f, 0.f, 0.f, 0.f};
    bf16x8 At[4][2], B0[2][2], B1[2][2];
    const char* cA = cur.A; const char* cB = cur.B;
    PG8_STAGE(PG8_SB(0, 0), cB, voffB); PG8_STAGE(PG8_SA(0, 0), cA, voffA); PG8_STAGE(PG8_SB(0, 1), cB + hstepB, voffB); PG8_STAGE(PG8_SA(0, 1), cA + hstepA, voffA);
    if (wr == 1) PG8_BAR;
    PG8_WAIT_V(4); PG8_BAR;
    PG8_STAGE(PG8_SB(1, 0), cB + kstep, voffB); PG8_STAGE(PG8_SA(1, 0), cA + kstep, voffA); PG8_STAGE(PG8_SB(1, 1), cB + hstepB + kstep, voffB);
    PG8_WAIT_V(6); PG8_BAR;
    for (;;) {
        const bool has_next = S.next(ui + 1, nxt);
        const char* nA = has_next ? nxt.A : cA; const char* nB = has_next ? nxt.B : cB;
        const int nt = cur.nt;
        for (int t = 0; t < nt; t += 2) {
            const bool last = (t == nt - 2);
            const char* a1 = cA + (size_t)(t + 1) * kstep;
            const char* a2 = last ? nA : cA + (size_t)(t + 2) * kstep; const char* b2 = last ? nB : cB + (size_t)(t + 2) * kstep;
            const char* a3 = a2 + kstep; const char* b3 = b2 + kstep;
            PG8_LDB(B0, 0, 0); PG8_SCHED; PG8_LDA(At, 0, 0); PG8_STAGE(PG8_SA(1, 1), a1 + hstepA, voffA);
            PG8_WAIT_L(8); PG8_BAR; PG8_WAIT_L(0); PG8_MMA(0, 0, At, B0); PG8_BAR; PG8_SCHED;
            PG8_LDB(B1, 0, 1); PG8_STAGE(PG8_SB(0, 0), b2, voffB);
            PG8_BAR; PG8_WAIT_L(0); PG8_MMA(0, 1, At, B1); PG8_BAR;
            PG8_LDA(At, 0, 1); PG8_STAGE(PG8_SA(0, 0), a2, voffA);
            PG8_BAR; PG8_WAIT_L(0); PG8_MMA(1, 0, At, B0); PG8_BAR; PG8_SCHED;
            PG8_STAGE(PG8_SB(0, 1), b2 + hstepB, voffB);
            PG8_WAIT_V(6); PG8_BAR; PG8_MMA(1, 1, At, B1); PG8_BAR;
            PG8_LDB(B0, 1, 0); PG8_SCHED; PG8_LDA(At, 1, 0); PG8_STAGE(PG8_SA(0, 1), a2 + hstepA, voffA);
            PG8_WAIT_L(8); PG8_BAR; PG8_WAIT_L(0); PG8_MMA(0, 0, At, B0); PG8_BAR; PG8_SCHED;
            PG8_LDB(B1, 1, 1); PG8_STAGE(PG8_SB(1, 0), b3, voffB);
            PG8_BAR; PG8_WAIT_L(0); PG8_MMA(0, 1, At, B1); PG8_BAR;
            PG8_LDA(At, 1, 1); PG8_STAGE(PG8_SA(1, 0), a3, voffA);
            PG8_BAR; PG8_WAIT_L(0); PG8_MMA(1, 0, At, B0); PG8_BAR; PG8_SCHED;
            PG8_STAGE(PG8_SB(1, 1), b3 + hstepB, voffB);
            PG8_WAIT_V(6); PG8_BAR; PG8_MMA(1, 1, At, B1); PG8_BAR;
        }
        E(acc, cur, wr, wc, fr, fq);
        if (!has_next) break;
#pragma unroll
        for (int a = 0; a < 2; ++a)
#pragma unroll
            for (int b = 0; b < 2; ++b)
#pragma unroll
                for (int m = 0; m < 4; ++m)
#pragma unroll
                    for (int n = 0; n < 2; ++n) acc[a][b][m][n] = (f32x4){0.f, 0.f, 0.f, 0.f};
        cur = nxt; cA = nA; cB = nB; ++ui;
    }
    PG8_WAIT_V(0);
    if (wr == 0) PG8_BAR;
    PG8_BAR;
#undef PG8_SA
#undef PG8_SB
#undef PG8_STAGE
#undef PG8_LDA
#undef PG8_LDB
#undef PG8_MMA
#undef PG8_WAIT_V
#undef PG8_WAIT_L
#undef PG8_BAR
#undef PG8_SCHED
}
}
using pg8::UnitD;

struct SchedInproj {
    const char* P; const char* WT; int G, c;
    __device__ __forceinline__ bool next(int i, UnitD& u) const {
        const int L = i * G + c; if (L >= 64 * 26) return false;
        int pm, pn; pg8::tile_of(L, 64, 26, pm, pn);
        u.A = P + ((size_t)pm * 256 * LDP + C_H) * 2; u.B = WT + (size_t)pn * 256 * 2048; u.nt = 16; u.pm = pm; u.pn = pn; u.kind = 0; return true;
    }
};
struct EpiInproj {
    bf16_t* P;
    __device__ __forceinline__ void operator()(const f32x4 (&acc)[2][2][4][2], const UnitD& u, int wr, int wc, int fr, int fq) const {
        const int row0 = u.pm * 256 + wr * 64 + fr, col0 = u.pn * 256 + wc * 32 + 8 * fq;
#pragma unroll
        for (int ai = 0; ai < 2; ++ai)
#pragma unroll
            for (int m = 0; m < 4; ++m) { bf16_t* rowp = P + (size_t)(row0 + ai * 128 + m * 16) * LDP + col0;
#pragma unroll
                for (int bj = 0; bj < 2; ++bj) { const f32x4 v0 = acc[ai][bj][m][0], v1 = acc[ai][bj][m][1];
                    u32x4 o; o.x = cvt_pk_bf16(v0[0], v0[1]); o.y = cvt_pk_bf16(v0[2], v0[3]); o.z = cvt_pk_bf16(v1[0], v1[1]); o.w = cvt_pk_bf16(v1[2], v1[3]);
                    *(u32x4*)(rowp + bj * 128) = o; } }
    }
};
struct SchedC1 {
    const char* P; const char* WT; int G, c;
    __device__ __forceinline__ bool next(int i, UnitD& u) const {
        const int ti = i / 6, sub = i - ti * 6, L = ti * G + c; if (L >= 256) return false;
        int pm, pn; pg8::tile_of(L, 64, 4, pm, pn);
        const int br = sub >> 1;
        if (!(sub & 1)) { u.A = P + ((size_t)pm * 256 * LDP + C_H) * 2; u.B = WT + (size_t)(R_GATE + br * 1024 + pn * 256) * 2048; u.nt = 16; }
        else { const int acol = br == 0 ? C_SBG : (br == 1 ? C_Z : C_YRW); const int brow = br == 0 ? R_SB : (br == 1 ? R_SSD : R_RWO);
            u.A = P + ((size_t)pm * 256 * LDP + acol) * 2; u.B = WT + (size_t)(brow + pn * 256) * 2048; u.nt = br == 1 ? 16 : 8; }
        u.pm = pm; u.pn = pn; u.kind = sub; return true;
    }
};
struct EpiC1 {
    bf16_t* P; const float* rstd;
    __device__ __forceinline__ void operator()(const f32x4 (&acc)[2][2][4][2], const UnitD& u, int wr, int wc, int fr, int fq) const {
        const int row0 = u.pm * 256 + wr * 64 + fr, col0 = u.pn * 256 + wc * 32 + 8 * fq;
        const int kind = u.kind;
#pragma unroll
        for (int ai = 0; ai < 2; ++ai)
#pragma unroll
            for (int m = 0; m < 4; ++m) { const int row = row0 + ai * 128 + m * 16; bf16_t* rowp = P + (size_t)row * LDP + col0;
                const float sc = (kind == 3) ? rstd[row] : 1.f;
#pragma unroll
                for (int bj = 0; bj < 2; ++bj) { const f32x4 v0 = acc[ai][bj][m][0], v1 = acc[ai][bj][m][1];
                    float v[8] = {v0[0], v0[1], v0[2], v0[3], v1[0], v1[1], v1[2], v1[3]};
                    u32x4* gp = (u32x4*)(rowp + C_G + bj * 128); u32x4* mp = (u32x4*)(rowp + C_M + bj * 128);
                    if (!(kind & 1)) {
#pragma unroll
                        for (int e = 0; e < 8; ++e) v[e] = sigmoidf_(v[e]);
                        u32x4 o; o.x = cvt_pk_bf16(v[0], v[1]); o.y = cvt_pk_bf16(v[2], v[3]); o.z = cvt_pk_bf16(v[4], v[5]); o.w = cvt_pk_bf16(v[6], v[7]);
                        *gp = o;
                    } else {
                        const u32x4 g = *gp;
                        float r[8];
                        r[0] = bf_lo(g.x) * v[0] * sc; r[1] = bf_hi(g.x) * v[1] * sc; r[2] = bf_lo(g.y) * v[2] * sc; r[3] = bf_hi(g.y) * v[3] * sc;
                        r[4] = bf_lo(g.z) * v[4] * sc; r[5] = bf_hi(g.z) * v[5] * sc; r[6] = bf_lo(g.w) * v[6] * sc; r[7] = bf_hi(g.w) * v[7] * sc;
                        if (kind != 1) { const u32x4 mo = *mp;
                            r[0] += bf_lo(mo.x); r[1] += bf_hi(mo.x); r[2] += bf_lo(mo.y); r[3] += bf_hi(mo.y); r[4] += bf_lo(mo.z); r[5] += bf_hi(mo.z); r[6] += bf_lo(mo.w); r[7] += bf_hi(mo.w); }
                        u32x4 o; o.x = cvt_pk_bf16(r[0], r[1]); o.y = cvt_pk_bf16(r[2], r[3]); o.z = cvt_pk_bf16(r[4], r[5]); o.w = cvt_pk_bf16(r[6], r[7]);
                        *mp = o;
                    } } }
    }
};
struct SchedOut {
    const char* P; const char* WT; int G, c;
    __device__ __forceinline__ bool next(int i, UnitD& u) const {
        const int L = i * G + c; if (L >= 256) return false;
        int pm, pn; pg8::tile_of(L, 64, 4, pm, pn);
        u.A = P + ((size_t)pm * 256 * LDP + C_M) * 2; u.B = WT + (size_t)(R_WO + pn * 256) * 2048; u.nt = 16; u.pm = pm; u.pn = pn; u.kind = 0; return true;
    }
};
struct EpiOut {
    const float* Xin; float* Xout;
    __device__ __forceinline__ void operator()(const f32x4 (&acc)[2][2][4][2], const UnitD& u, int wr, int wc, int fr, int fq) const {
        const int row0 = u.pm * 256 + wr * 64 + fr, col0 = u.pn * 256 + wc * 32 + 4 * fq;
#pragma unroll
        for (int ai = 0; ai < 2; ++ai)
#pragma unroll
            for (int m = 0; m < 4; ++m) { const size_t ro = (size_t)(row0 + ai * 128 + m * 16) * DM + col0;
#pragma unroll
                for (int bj = 0; bj < 2; ++bj)
#pragma unroll
                    for (int n = 0; n < 2; ++n) { const f32x4 xi = *(const f32x4*)(Xin + ro + bj * 128 + n * 16); *(f32x4*)(Xout + ro + bj * 128 + n * 16) = xi + acc[ai][bj][m][n]; } }
    }
};

__device__ __forceinline__ void phase0(const Params& p, int layer, unsigned char* shm) {
    const int tid = opaque_tid(), wave = tid >> 6, lane = tid & 63;
    bf16_t* P = (bf16_t*)(p.ws + OFF_P); bf16_t* WT = (bf16_t*)(p.ws + OFF_WT);
    const float* Xin = layer == 0 ? p.in[0] : p.out;
    const float* ng = p.in[1] + layer * DM;
    f32x4 gn[4];
#pragma unroll
    for (int i = 0; i < 4; ++i) gn[i] = *(const f32x4*)(ng + i * 256 + lane * 4);
    for (int row0 = (blockIdx.x * 8 + wave) * 4; row0 < TOK; row0 += gridDim.x * 32) {
        f32x4 v[4][4]; float ss[4];
#pragma unroll
        for (int rr = 0; rr < 4; ++rr) { const float* xr = Xin + (size_t)(row0 + rr) * DM;
#pragma unroll
            for (int i = 0; i < 4; ++i) v[rr][i] = *(const f32x4*)(xr + i * 256 + lane * 4); }
#pragma unroll
        for (int rr = 0; rr < 4; ++rr) { float a = 0.f;
#pragma unroll
            for (int i = 0; i < 4; ++i) a += v[rr][i][0] * v[rr][i][0] + v[rr][i][1] * v[rr][i][1] + v[rr][i][2] * v[rr][i][2] + v[rr][i][3] * v[rr][i][3];
            ss[rr] = wave_sum(a); }
#pragma unroll
        for (int rr = 0; rr < 4; ++rr) { const float rs = rsqrtf(ss[rr] * (1.f / DM) + 1e-6f);
#pragma unroll
            for (int i = 0; i < 4; ++i) { const f32x4 g = gn[i];
                u32x2 o; o.x = cvt_pk_bf16(v[rr][i][0] * rs * g[0], v[rr][i][1] * rs * g[1]); o.y = cvt_pk_bf16(v[rr][i][2] * rs * g[2], v[rr][i][3] * rs * g[3]);
                *(u32x2*)(P + (size_t)(row0 + rr) * LDP + C_H + i * 256 + lane * 4) = o; } }
    }
    float* T = (float*)shm + wave * (64 * 65);
    const float* w_in = p.in[2] + (size_t)layer * DM * NIN;
    const float* sg = p.in[8] + layer * DM;
    for (int job = blockIdx.x * 8 + wave; job < 3200; job += gridDim.x * 8) {
        const float* src; int srcN, k0, n0, dstrow; bool is_in = false, is_ssd = false;
        if (job < 2432) { is_in = true; src = w_in; srcN = NIN; const int ntile = job >> 4; k0 = (job & 15) * 64; n0 = ntile * 64; dstrow = n0; }
        else { int r = job - 2432;
            if (r < 128) { src = p.in[19] + (size_t)layer * 512 * DM; k0 = (r >> 4) * 64; n0 = (r & 15) * 64; dstrow = R_SB + n0; }
            else if (r < 384) { r -= 128; src = p.in[20] + (size_t)layer * DM * DM; k0 = (r >> 4) * 64; n0 = (r & 15) * 64; dstrow = R_SSD + n0; is_ssd = true; }
            else if (r < 512) { r -= 384; src = p.in[21] + (size_t)layer * 512 * DM; k0 = (r >> 4) * 64; n0 = (r & 15) * 64; dstrow = R_RWO + n0; }
            else { r -= 512; src = p.in[22] + (size_t)layer * DM * DM; k0 = (r >> 4) * 64; n0 = (r & 15) * 64; dstrow = R_WO + n0; }
            srcN = DM; }
        const int n4 = (lane & 15) * 4, np = n0 + n4; int sc = np;
        if (is_in) { if (np < 4352) sc = np; else if (np < 6528) sc = np + 16; else if (np < 6544) sc = np - 6528 + 4352; else if (np < 6656) sc = -1; else sc = np - 112; }
        f32x4 v[16];
#pragma unroll
        for (int i = 0; i < 16; ++i) { const int k = (lane >> 4) + 4 * i; v[i] = (f32x4){0.f, 0.f, 0.f, 0.f};
            if (sc >= 0) v[i] = *(const f32x4*)(src + (size_t)(k0 + k) * srcN + sc); }
#pragma unroll
        for (int i = 0; i < 16; ++i) { const int k = (lane >> 4) + 4 * i; f32x4 x = v[i];
            if (is_ssd) x = x * sg[k0 + k];
            T[k * 65 + n4] = x[0]; T[k * 65 + n4 + 1] = x[1]; T[k * 65 + n4 + 2] = x[2]; T[k * 65 + n4 + 3] = x[3]; }
        asm volatile("s_waitcnt lgkmcnt(0)" ::: "memory"); __builtin_amdgcn_wave_barrier(); asm volatile("" ::: "memory");
#pragma unroll
        for (int j = 0; j < 8; ++j) { const int r = lane + 64 * j, n = r >> 3, kc = (r & 7) * 8; const float* sp = T + kc * 65 + n;
            u32x4 o; o.x = cvt_pk_bf16(sp[0], sp[65]); o.y = cvt_pk_bf16(sp[130], sp[195]); o.z = cvt_pk_bf16(sp[260], sp[325]); o.w = cvt_pk_bf16(sp[390], sp[455]);
            *(u32x4*)(WT + (size_t)(dstrow + n) * 1024 + k0 + kc) = o; }
        asm volatile("s_waitcnt lgkmcnt(0)" ::: "memory"); __builtin_amdgcn_wave_barrier(); asm volatile("" ::: "memory");
    }
    __syncthreads();
}

__device__ __forceinline__ void attn_item(const Params& p, unsigned char* shm, int item) {
    const int qb = item & 15, h = (item >> 4) & 7, b = item >> 7;
    bf16_t* P = (bf16_t*)(p.ws + OFF_P);
    const int tid = opaque_tid(), wave = tid >> 6, lane = tid & 63, lq = lane & 15, g = lane >> 4;
    const size_t rowbase = (size_t)b * SEQ;
    const int t = qb * 128 + wave * 16 + lq;
    const int tmax = qb * 128 + wave * 16 + 15;
    constexpr int ABUF = 64 * 144 + 64 * 136;
    const bf16_t* qp = P + (rowbase + t) * LDP + C_Q + h * 64 + 8 * g;
    const bf16x8 qf0 = *(const bf16x8*)qp, qf1 = *(const bf16x8*)(qp + 32);
    bf16x8 TT[4][2];
#pragma unroll
    for (int a = 0; a < 4; ++a)
#pragma unroll
        for (int ks = 0; ks < 2; ++ks)
#pragma unroll
            for (int e = 0; e < 8; ++e) { const int j = 16 * (2 * ks + (e >> 2)) + 4 * g + (e & 3); TT[a][ks][e] = (j > 16 * a + lq) ? (short)0x3F80 : (short)0; }
    f32x4 o[4];
#pragma unroll
    for (int i = 0; i < 4; ++i) o[i] = (f32x4){0.f, 0.f, 0.f, 0.f};
    float R = 0.f;
    LAS volatile int* flg = (LAS volatile int*)((LAS unsigned char*)shm + 2 * ABUF);
    const int st_s = tid >> 3, st_dc = (tid & 7) * 8;
    const bf16_t* st_base = P + (rowbase + st_s) * LDP + h * 64 + st_dc;
    auto stage_write = [&](unsigned char* buf, const u32x4& kv, const u32x4& vv) {
        bf16_t* Ksw = (bf16_t*)buf; bf16_t* Vtw = (bf16_t*)(buf + 64 * 144); const int s_ = st_s, dc = st_dc;
        *(u32x4*)(Ksw + s_ * 72 + dc) = kv;
        Vtw[(dc + 0) * 68 + s_] = (bf16_t)(vv.x & 0xFFFF); Vtw[(dc + 1) * 68 + s_] = (bf16_t)(vv.x >> 16);
        Vtw[(dc + 2) * 68 + s_] = (bf16_t)(vv.y & 0xFFFF); Vtw[(dc + 3) * 68 + s_] = (bf16_t)(vv.y >> 16);
        Vtw[(dc + 4) * 68 + s_] = (bf16_t)(vv.z & 0xFFFF); Vtw[(dc + 5) * 68 + s_] = (bf16_t)(vv.z >> 16);
        Vtw[(dc + 6) * 68 + s_] = (bf16_t)(vv.w & 0xFFFF); Vtw[(dc + 7) * 68 + s_] = (bf16_t)(vv.w >> 16);
    };
    if (tid == 0) { flg[0] = 1; flg[1] = 0; flg[2] = 0; }
    { const bf16_t* kr = st_base + (size_t)(2 * qb + 1) * 64 * LDP; const u32x4 kv0 = *(const u32x4*)(kr + C_K), vv0 = *(const u32x4*)(kr + C_V); stage_write(shm, kv0, vv0); }
    int itn = 0, cur = 0;
    for (int kt = 2 * qb + 1; kt >= 0; --kt) {
        __syncthreads();
        const int f0 = itn % 3, f1 = (itn + 1) % 3, f2 = (itn + 2) % 3;
        if (flg[f0] == 0) break;
        if (tid == 0) flg[f2] = 0;
        u32x4 kvn = (u32x4){0u, 0u, 0u, 0u}, vvn = (u32x4){0u, 0u, 0u, 0u};
        if (kt > 0) { const bf16_t* kr = st_base + (size_t)(kt - 1) * 64 * LDP; kvn = *(const u32x4*)(kr + C_K); vvn = *(const u32x4*)(kr + C_V); }
        const bf16_t* Ks = (const bf16_t*)(shm + cur * ABUF); const bf16_t* Vt = (const bf16_t*)(shm + cur * ABUF + 64 * 144);
        const bool walive = __any(R > -104.f);
        const bool act = (kt * 64 < tmax) && walive;
        if (act) {
            float lb[4][4], lk[4][4];
#pragma unroll
            for (int sub = 0; sub < 4; ++sub) {
                const bf16_t* kp = Ks + (16 * sub + lq) * 72 + 8 * g;
                const bf16x8 k0 = *(const bf16x8*)kp, k1 = *(const bf16x8*)(kp + 32);
                f32x4 s4 = (f32x4){0.f, 0.f, 0.f, 0.f};
                s4 = __builtin_amdgcn_mfma_f32_16x16x32_bf16(k0, qf0, s4, 0, 0, 0);
                s4 = __builtin_amdgcn_mfma_f32_16x16x32_bf16(k1, qf1, s4, 0, 0, 0);
#pragma unroll
                for (int r = 0; r < 4; ++r) { const float z = s4[r] * 0.125f; const bool mk = (kt * 64 + 16 * sub + 4 * g + r) < t;
                    const float l = fminf(z, 0.f) - 0.69314718f * __builtin_amdgcn_logf(1.f + __expf(-fabsf(z)));
                    lb[sub][r] = mk ? l : -1e30f; lk[sub][r] = mk ? (l - z) : 0.f; }
            }
            bf16x8 hi[2];
#pragma unroll
            for (int ks = 0; ks < 2; ++ks) {
                unsigned hw[4];
#pragma unroll
                for (int w2 = 0; w2 < 4; ++w2) { const int sub = 2 * ks + (w2 >> 1), r0 = (w2 & 1) * 2; const float a0 = lk[sub][r0], a1 = lk[sub][r0 + 1];
                    hw[w2] = cvt_pk_bf16(a0, a1); }
                u32x4 hv = (u32x4){hw[0], hw[1], hw[2], hw[3]};
                hi[ks] = __builtin_bit_cast(bf16x8, hv);
            }
            f32x4 aft[4];
#pragma unroll
            for (int a = 0; a < 4; ++a) { f32x4 c = (f32x4){0.f, 0.f, 0.f, 0.f};
#pragma unroll
                for (int ks = 0; ks < 2; ++ks) c = __builtin_amdgcn_mfma_f32_16x16x32_bf16(TT[a][ks], hi[ks], c, 0, 0, 0);
                aft[a] = c; }
            float tot = aft[0][0] + lk[0][0];
            tot = __shfl(tot, lq);
            bf16x8 pf[2];
#pragma unroll
            for (int ks = 0; ks < 2; ++ks) { unsigned pw[4];
#pragma unroll
                for (int w2 = 0; w2 < 4; ++w2) { const int sub = 2 * ks + (w2 >> 1), r0 = (w2 & 1) * 2;
                    const float e0 = __expf(lb[sub][r0] + aft[sub][r0] + R), e1 = __expf(lb[sub][r0 + 1] + aft[sub][r0 + 1] + R);
                    pw[w2] = cvt_pk_bf16(e0, e1); }
                u32x4 pv = (u32x4){pw[0], pw[1], pw[2], pw[3]}; pf[ks] = __builtin_bit_cast(bf16x8, pv); }
            R += tot;
#pragma unroll
            for (int ds = 0; ds < 4; ++ds)
#pragma unroll
                for (int ks = 0; ks < 2; ++ks) { const bf16_t* vp = Vt + (16 * ds + lq) * 68 + 32 * ks + 4 * g;
                    const u32x2 v0 = *(const u32x2*)vp, v1 = *(const u32x2*)(vp + 16);
                    u32x4 vv = (u32x4){v0.x, v0.y, v1.x, v1.y};
                    o[ds] = __builtin_amdgcn_mfma_f32_16x16x32_bf16(__builtin_bit_cast(bf16x8, vv), pf[ks], o[ds], 0, 0, 0); }
        }
        if (__any(R > -104.f) && lane == 0) flg[f1] = 1;
        if (kt > 0) stage_write(shm + (cur ^ 1) * ABUF, kvn, vvn);
        cur ^= 1; ++itn;
    }
#pragma unroll
    for (int ds = 0; ds < 4; ++ds) { bf16_t* gp = P + (rowbase + t) * LDP + C_SBG + h * 64 + 16 * ds + 4 * g;
        const u32x2 gv = *(const u32x2*)gp;
        u32x2 ov; ov.x = cvt_pk_bf16(o[ds][0] * siluf_(bf_lo(gv.x)), o[ds][1] * siluf_(bf_hi(gv.x))); ov.y = cvt_pk_bf16(o[ds][2] * siluf_(bf_lo(gv.y)), o[ds][3] * siluf_(bf_hi(gv.y)));
        *(u32x2*)gp = ov; }
    __syncthreads();
}

__device__ __forceinline__ void bc_prepass(const Params& p, int layer, int blk, int nblk) {
    const bf16_t* P = (const bf16_t*)(p.ws + OFF_P); bf16_t* BCc = (bf16_t*)(p.ws + OFF_BCC);
    const float* cw = p.in[3] + (size_t)layer * 4 * 1280; const float* cb = p.in[4] + layer * 1280;
    const int gt = blk * 512 + opaque_tid(), gs = nblk * 512;
    const int c = (gt & 63) * 4, chn = 1024 + c;
    const f32x4 bias = *(const f32x4*)(cb + chn);
    f32x4 w[4];
#pragma unroll
    for (int k = 0; k < 4; ++k) w[k] = *(const f32x4*)(cw + k * 1280 + chn);
    for (int idx0 = gt; idx0 < TOK * 64; idx0 += 4 * gs) {
        u32x2 xv[4][4]; bool ok[4];
#pragma unroll
        for (int u = 0; u < 4; ++u) { const int idx = idx0 + u * gs; ok[u] = idx < TOK * 64; const int tok = ok[u] ? (idx >> 6) : 0; const int t = tok & (SEQ - 1);
            const bf16_t* xp = P + (size_t)tok * LDP + C_XBC + chn;
#pragma unroll
            for (int k = 0; k < 4; ++k) { const int ts = t - 3 + k; const unsigned xm = ts >= 0 ? 0xFFFFFFFFu : 0u;
                u32x2 x = *(const u32x2*)(xp + (ptrdiff_t)(ts >= 0 ? k - 3 : 0) * LDP); x.x &= xm; x.y &= xm; xv[u][k] = x; } }
#pragma unroll
        for (int u = 0; u < 4; ++u) { const int idx = idx0 + u * gs; const int tok = ok[u] ? (idx >> 6) : 0;
            f32x4 a = bias;
#pragma unroll
            for (int k = 0; k < 4; ++k) { a[0] += w[k][0] * bf_lo(xv[u][k].x); a[1] += w[k][1] * bf_hi(xv[u][k].x); a[2] += w[k][2] * bf_lo(xv[u][k].y); a[3] += w[k][3] * bf_hi(xv[u][k].y); }
            u32x2 o; o.x = cvt_pk_bf16(siluf_(a[0]), siluf_(a[1])); o.y = cvt_pk_bf16(siluf_(a[2]), siluf_(a[3]));
            if (ok[u]) *(u32x2*)(BCc + (size_t)tok * 256 + c) = o; }
    }
}

__device__ __forceinline__ void ssd_item(const Params& p, int layer, unsigned char* shm, int item) {
    const int ph = item & 1, hh = (item >> 1) & 15, b = item >> 5, grp = hh >> 3;
    bf16_t* P = (bf16_t*)(p.ws + OFF_P); float* SSQ = (float*)(p.ws + OFF_SSQ);
    const int tid = opaque_tid(), wave = tid >> 6, lane = tid & 63, lq = lane & 15, g = lane >> 4;
    const size_t rowbase = (size_t)b * SEQ;
    const float* cw = p.in[3] + (size_t)layer * 4 * 1280; const float* cb = p.in[4] + layer * 1280;
    const float dtb = p.in[5][layer * 16 + hh], Aneg = -__expf(p.in[6][layer * 16 + hh]), Dsk = p.in[7][layer * 16 + hh];
    float* XS = (float*)shm;
    float* YS = XS + 2048;
    float* DTs = YS + 2048;
    float* ACS = DTs + 64;
    bf16_t* Cb = (bf16_t*)(ACS + 64);
    bf16_t* Bb = Cb + 64 * 72;
    bf16_t* BT = Bb + 64 * 72;
    bf16_t* Mx = BT + 64 * 72;
    bf16_t* XT = Mx + 64 * 72;
    bf16_t* XwT = XT + 32 * 72;
    bf16_t* SbT = XwT + 32 * 72;
    f32x4 Sacc = (f32x4){0.f, 0.f, 0.f, 0.f};
    const bf16_t* BCc = (const bf16_t*)(p.ws + OFF_BCC);
    const int x_tt = tid >> 3, x_c = (tid & 7) * 4, x_chn = hh * 64 + ph * 32 + x_c;
    const int bc_q = tid & 7;
    const f32x4 xbias = *(const f32x4*)(cb + x_chn);
    f32x4 xw[4];
#pragma unroll
    for (int k = 0; k < 4; ++k) xw[k] = *(const f32x4*)(cw + k * 1280 + x_chn);
    u32x2 sx[4]; u32x4 bc0, bc1; bf16_t sdt = 0;
    auto ssd_load = [&](int tb) {
        const int t = tb + x_tt;
        const bf16_t* xp = P + (rowbase + t) * LDP + C_XBC + x_chn;
#pragma unroll
        for (int k = 0; k < 4; ++k) { const int ts = t - 3 + k; const unsigned xm = ts >= 0 ? 0xFFFFFFFFu : 0u;
            u32x2 xv = *(const u32x2*)(xp + (ptrdiff_t)(ts >= 0 ? k - 3 : 0) * LDP); xv.x &= xm; xv.y &= xm; sx[k] = xv; }
        const bf16_t* bp = BCc + (rowbase + t) * 256 + (bc_q < 4 ? grp * 64 + bc_q * 16 : 128 + grp * 64 + (bc_q - 4) * 16);
        bc0 = *(const u32x4*)bp; bc1 = *(const u32x4*)(bp + 8);
        if (tid < 64) sdt = P[(rowbase + tb + tid) * LDP + C_DT + hh];
    };
    ssd_load(0);
    for (int ch = 0; ch < SEQ / 64; ++ch) {
        const int t0 = ch * 64;
        __syncthreads();
        const int o_tt = tid >> 3, o_p4 = (tid & 7) * 4;
        bf16_t* zp = P + (rowbase + t0 + o_tt) * LDP + C_Z + hh * 64 + ph * 32 + o_p4;
        const u32x2 zv = *(const u32x2*)zp;
        { f32x4 a = xbias;
#pragma unroll
            for (int k = 0; k < 4; ++k) { a[0] += xw[k][0] * bf_lo(sx[k].x); a[1] += xw[k][1] * bf_hi(sx[k].x); a[2] += xw[k][2] * bf_lo(sx[k].y); a[3] += xw[k][3] * bf_hi(sx[k].y); }
            a[0] = siluf_(a[0]); a[1] = siluf_(a[1]); a[2] = siluf_(a[2]); a[3] = siluf_(a[3]);
            const unsigned q0 = cvt_pk_bf16(a[0], a[1]), q1 = cvt_pk_bf16(a[2], a[3]); const int tt = x_tt, c = x_c;
            *(f32x4*)(XS + tt * 32 + c) = a;
            XT[(c + 0) * 72 + tt] = (bf16_t)(q0 & 0xFFFF); XT[(c + 1) * 72 + tt] = (bf16_t)(q0 >> 16); XT[(c + 2) * 72 + tt] = (bf16_t)(q1 & 0xFFFF); XT[(c + 3) * 72 + tt] = (bf16_t)(q1 >> 16);
            if (bc_q < 4) { const int n = bc_q * 16; *(u32x4*)(Bb + tt * 72 + n) = bc0; *(u32x4*)(Bb + tt * 72 + n + 8) = bc1;
                const unsigned wv[8] = {bc0.x, bc0.y, bc0.z, bc0.w, bc1.x, bc1.y, bc1.z, bc1.w};
#pragma unroll
                for (int e = 0; e < 8; ++e) { BT[(n + 2 * e) * 72 + tt] = (bf16_t)(wv[e] & 0xFFFF); BT[(n + 2 * e + 1) * 72 + tt] = (bf16_t)(wv[e] >> 16); } }
            else { const int n = (bc_q - 4) * 16; *(u32x4*)(Cb + tt * 72 + n) = bc0; *(u32x4*)(Cb + tt * 72 + n + 8) = bc1; } }
        if (tid < 64) { const float dt = softplusf_(bf2f(sdt) + dtb); DTs[tid] = dt;
            float x = dt * Aneg;
#pragma unroll
            for (int o = 1; o < 64; o <<= 1) { const float v = __shfl_up(x, o); if (lane >= o) x += v; }
            ACS[tid] = x; }
        if (ch + 1 < SEQ / 64) ssd_load(t0 + 64);
        __syncthreads();
        const float acsL = ACS[63];
        { const int pp = tid >> 4, s4 = (tid & 15) * 4; float v[4];
#pragma unroll
            for (int e = 0; e < 4; ++e) { const int sidx = s4 + e; v[e] = XS[sidx * 32 + pp] * DTs[sidx] * __expf(acsL - ACS[sidx]); }
            *(u32x2*)(XwT + pp * 72 + s4) = (u32x2){cvt_pk_bf16(v[0], v[1]), cvt_pk_bf16(v[2], v[3])}; }
        { const int pi = wave >> 2, ni = wave & 3;
#pragma unroll
            for (int r = 0; r < 4; ++r) SbT[(16 * pi + 4 * g + r) * 72 + 16 * ni + lq] = (bf16_t)(cvt_pk_bf16(Sacc[r], 0.f) & 0xFFFF); }
        { const int ti = wave >> 1;
#pragma unroll
            for (int sj = 0; sj < 2; ++sj) { const int si = 2 * (wave & 1) + sj;
                f32x4 acc = (f32x4){0.f, 0.f, 0.f, 0.f};
                if (si <= ti) {
                    const bf16_t* ap = Cb + (16 * ti + lq) * 72 + 8 * g; const bf16_t* bp = Bb + (16 * si + lq) * 72 + 8 * g;
                    acc = __builtin_amdgcn_mfma_f32_16x16x32_bf16(*(const bf16x8*)ap, *(const bf16x8*)bp, acc, 0, 0, 0);
                    acc = __builtin_amdgcn_mfma_f32_16x16x32_bf16(*(const bf16x8*)(ap + 32), *(const bf16x8*)(bp + 32), acc, 0, 0, 0);
                }
                const int sidx = 16 * si + lq; const float as = ACS[sidx], ds = DTs[sidx];
#pragma unroll
                for (int r = 0; r < 4; ++r) { const int t = 16 * ti + 4 * g + r; const float val = (sidx <= t) ? acc[r] * __expf(ACS[t] - as) * ds : 0.f;
                    Mx[t * 72 + sidx] = (bf16_t)(cvt_pk_bf16(val, 0.f) & 0xFFFF); } } }
        __syncthreads();
        { const int ti = wave >> 1, pi = wave & 1;
            const bf16_t* ap = Mx + (16 * ti + lq) * 72 + 8 * g; const bf16_t* bp = XT + (16 * pi + lq) * 72 + 8 * g;
            const bf16_t* cp = Cb + (16 * ti + lq) * 72 + 8 * g; const bf16_t* sp = SbT + (16 * pi + lq) * 72 + 8 * g;
            f32x4 a1 = (f32x4){0.f, 0.f, 0.f, 0.f}, a2 = (f32x4){0.f, 0.f, 0.f, 0.f};
            a1 = __builtin_amdgcn_mfma_f32_16x16x32_bf16(*(const bf16x8*)ap, *(const bf16x8*)bp, a1, 0, 0, 0);
            a1 = __builtin_amdgcn_mfma_f32_16x16x32_bf16(*(const bf16x8*)(ap + 32), *(const bf16x8*)(bp + 32), a1, 0, 0, 0);
            a2 = __builtin_amdgcn_mfma_f32_16x16x32_bf16(*(const bf16x8*)cp, *(const bf16x8*)sp, a2, 0, 0, 0);
            a2 = __builtin_amdgcn_mfma_f32_16x16x32_bf16(*(const bf16x8*)(cp + 32), *(const bf16x8*)(sp + 32), a2, 0, 0, 0);
#pragma unroll
            for (int r = 0; r < 4; ++r) { const int t = 16 * ti + 4 * g + r, pc = 16 * pi + lq;
                YS[t * 32 + pc] = a1[r] + __expf(ACS[t]) * a2[r] + Dsk * XS[t * 32 + pc]; } }
        { const int pi = wave >> 2, ni = wave & 3; const float dl = __expf(acsL);
            Sacc = Sacc * dl;
            const bf16_t* ap = XwT + (16 * pi + lq) * 72 + 8 * g; const bf16_t* bp = BT + (16 * ni + lq) * 72 + 8 * g;
            Sacc = __builtin_amdgcn_mfma_f32_16x16x32_bf16(*(const bf16x8*)ap, *(const bf16x8*)bp, Sacc, 0, 0, 0);
            Sacc = __builtin_amdgcn_mfma_f32_16x16x32_bf16(*(const bf16x8*)(ap + 32), *(const bf16x8*)(bp + 32), Sacc, 0, 0, 0); }
        __syncthreads();
        { const int tt = o_tt, p4 = o_p4; const f32x4 y4 = *(const f32x4*)(YS + tt * 32 + p4);
            const float u0 = y4[0] * siluf_(bf_lo(zv.x)), u1 = y4[1] * siluf_(bf_hi(zv.x)), u2 = y4[2] * siluf_(bf_lo(zv.y)), u3 = y4[3] * siluf_(bf_hi(zv.y));
            u32x2 ov; ov.x = cvt_pk_bf16(u0, u1); ov.y = cvt_pk_bf16(u2, u3); *(u32x2*)zp = ov;
            float q = u0 * u0 + u1 * u1 + u2 * u2 + u3 * u3;
            q += __shfl_xor(q, 1); q += __shfl_xor(q, 2); q += __shfl_xor(q, 4);
            if ((tid & 7) == 0) SSQ[(rowbase + t0 + tt) * 32 + hh * 2 + ph] = q; }
    }
    __syncthreads();
}

__device__ __forceinline__ float fast_tanh(float x) { return 1.f - 2.f * __builtin_amdgcn_rcpf(1.f + __expf(2.f * x)); }
__device__ __forceinline__ void pbar4(LAS volatile unsigned* cnt, unsigned& tgt, int lane) {
    tgt += 4u;
    asm volatile("s_waitcnt lgkmcnt(0)" ::: "memory");
    if (lane == 0) __hip_atomic_fetch_add((LAS unsigned*)cnt, 1u, __ATOMIC_RELAXED, __HIP_MEMORY_SCOPE_WORKGROUP);
    while (*cnt < tgt) __builtin_amdgcn_s_sleep(1);
    asm volatile("" ::: "memory");
}
__device__ __forceinline__ void rwkv_item(const Params& p, int layer, unsigned char* shm, int item) {
    const int half = item & 1, h = (item >> 1) & 7, b = item >> 4;
    bf16_t* P = (bf16_t*)(p.ws + OFF_P); bf16_t* YRAW = (bf16_t*)(p.ws + OFF_YRAW); float* BONUS = (float*)(p.ws + OFF_BONUS);
    const int tid = opaque_tid(), wave = tid >> 6, lane = tid & 63, lq = lane & 15, g = lane >> 4;
    const size_t rowbase = (size_t)b * SEQ;
    const float* mu = p.in[9] + layer * 2176;
    const float* w0 = p.in[10] + layer * 512; const float* wup = p.in[11] + (size_t)layer * 64 * 512;
    const float* a0 = p.in[12] + layer * 512; const float* aup = p.in[13] + (size_t)layer * 64 * 512;
    const float* kkp = p.in[14] + layer * 512; const float* kap = p.in[15] + layer * 512; const float* rkp = p.in[16] + layer * 512;
    constexpr int SETF = 6 * 2048;
    float* SET0 = (float*)shm;
    float* AA = SET0 + 2 * SETF;
    float* Yb = AA + 2048;
    bf16_t* WLb = (bf16_t*)(Yb + 2048);
    bf16_t* ALb = WLb + 32 * 72;
    LAS volatile unsigned* pcnt = (LAS volatile unsigned*)((LAS unsigned char*)shm + (2 * SETF + 2048 + 2048) * 4 + 2 * 32 * 72 * 2);
    const int csub = wave & 3;
    bf16x8 bfr[2][2]; float lw0[2];
#pragma unroll
    for (int mat = 0; mat < 2; ++mat) { const float* up = (mat ? aup : wup) + h * 64 + csub * 16 + lq;
#pragma unroll
        for (int ks = 0; ks < 2; ++ks) { unsigned w[4];
#pragma unroll
            for (int e2 = 0; e2 < 4; ++e2) { const int m0 = 32 * ks + 8 * g + 2 * e2; w[e2] = cvt_pk_bf16(up[(size_t)m0 * 512], up[(size_t)(m0 + 1) * 512]); }
            u32x4 wv = (u32x4){w[0], w[1], w[2], w[3]}; bfr[mat][ks] = __builtin_bit_cast(bf16x8, wv); }
        lw0[mat] = (mat ? a0 : w0)[h * 64 + csub * 16 + lq]; }
    const int ej = (tid & 15) * 4;
    const f32x4 c_kk = *(const f32x4*)(kkp + h * 64 + ej), c_ka = *(const f32x4*)(kap + h * 64 + ej), c_rk = *(const f32x4*)(rkp + h * 64 + ej);
    const f32x4 mu_r = *(const f32x4*)(mu + h * 64 + ej), mu_k = *(const f32x4*)(mu + 512 + h * 64 + ej), mu_v = *(const f32x4*)(mu + 1024 + h * 64 + ej);
    const f32x4 mu_w = *(const f32x4*)(mu + 2048 + ej), mu_a = *(const f32x4*)(mu + 2112 + ej);
    f32x4 sA = (f32x4){0.f, 0.f, 0.f, 0.f}, sB = (f32x4){0.f, 0.f, 0.f, 0.f};
    const int irow = half * 32 + (wave & 3) * 8 + g * 2;
    unsigned ptgt = 0u;
    const int pm = tid - 256, e2t = pm >> 4;
    u32x2 cva[2][5], pva[2][5];
    auto rw_load = [&](int ch) {
#pragma unroll
        for (int ps = 0; ps < 2; ++ps) { const int tl = e2t + 16 * ps, t = ch * 32 + tl; const bf16_t* cur = P + (rowbase + t) * LDP + C_RW; const bool hp = t > 0; const bf16_t* prv = hp ? cur - LDP : cur;
#pragma unroll
            for (int i = 0; i < 5; ++i) { const int col = (i == 0 ? h * 64 : i == 1 ? 512 + h * 64 : i == 2 ? 1024 + h * 64 : i == 3 ? 2048 : 2112) + ej;
                cva[ps][i] = *(const u32x2*)(cur + col); pva[ps][i] = *(const u32x2*)(prv + col); } }
    };
    auto prep = [&](int ch, float* SET) {
        float* Rm = SET; float* Km = SET + 2048; float* Vm = SET + 4096; float* DEC = SET + 6144; float* KK = SET + 8192; float* BB = SET + 10240;
#pragma unroll
        for (int ps = 0; ps < 2; ++ps) { const int tl = e2t + 16 * ps, t = ch * 32 + tl; const unsigned pmask = t > 0 ? 0xFFFFFFFFu : 0u;
#pragma unroll
            for (int i = 0; i < 5; ++i) {
                const u32x2 cv = cva[ps][i]; u32x2 pv = pva[ps][i]; pv.x &= pmask; pv.y &= pmask;
                const f32x4 m4 = i == 0 ? mu_r : i == 1 ? mu_k : i == 2 ? mu_v : i == 3 ? mu_w : mu_a;
                float c[4] = {bf_lo(cv.x), bf_hi(cv.x), bf_lo(cv.y), bf_hi(cv.y)}; const float q[4] = {bf_lo(pv.x), bf_hi(pv.x), bf_lo(pv.y), bf_hi(pv.y)};
#pragma unroll
                for (int e = 0; e < 4; ++e) c[e] = c[e] + (q[e] - c[e]) * m4[e];
                if (i == 0) *(f32x4*)(Rm + tl * 64 + ej) = (f32x4){c[0], c[1], c[2], c[3]};
                else if (i == 1) *(f32x4*)(Km + tl * 64 + ej) = (f32x4){c[0], c[1], c[2], c[3]};
                else if (i == 2) *(f32x4*)(Vm + tl * 64 + ej) = (f32x4){c[0], c[1], c[2], c[3]};
                else if (i == 3) { u32x2 o; o.x = cvt_pk_bf16(fast_tanh(c[0]), fast_tanh(c[1])); o.y = cvt_pk_bf16(fast_tanh(c[2]), fast_tanh(c[3])); *(u32x2*)(WLb + tl * 72 + ej) = o; }
                else { u32x2 o; o.x = cvt_pk_bf16(c[0], c[1]); o.y = cvt_pk_bf16(c[2], c[3]); *(u32x2*)(ALb + tl * 72 + ej) = o; } } }
        if (ch + 1 < SEQ / 32) rw_load(ch + 1);
        pbar4(pcnt, ptgt, lane);
#pragma unroll
        for (int mat = 0; mat < 2; ++mat)
#pragma unroll
            for (int ts = 0; ts < 2; ++ts) { const bf16_t* ap = (mat ? ALb : WLb) + (16 * ts + lq) * 72 + 8 * g;
                const bf16x8 a0f = *(const bf16x8*)ap, a1f = *(const bf16x8*)(ap + 32);
                f32x4 c = (f32x4){0.f, 0.f, 0.f, 0.f};
                c = __builtin_amdgcn_mfma_f32_16x16x32_bf16(a0f, bfr[mat][0], c, 0, 0, 0);
                c = __builtin_amdgcn_mfma_f32_16x16x32_bf16(a1f, bfr[mat][1], c, 0, 0, 0);
#pragma unroll
                for (int r = 0; r < 4; ++r) { const int tt = 16 * ts + 4 * g + r; const float x = lw0[mat] + c[r];
                    if (mat == 0) DEC[tt * 64 + csub * 16 + lq] = __expf(-0.60653066f * sigmoidf_(x));
                    else AA[tt * 64 + csub * 16 + lq] = sigmoidf_(x); } }
        pbar4(pcnt, ptgt, lane);
#pragma unroll
        for (int ps = 0; ps < 2; ++ps) { const int tl = e2t + 16 * ps;
            const f32x4 k4 = *(const f32x4*)(Km + tl * 64 + ej), a4 = *(const f32x4*)(AA + tl * 64 + ej), r4 = *(const f32x4*)(Rm + tl * 64 + ej);
            f32x4 kr, kt; float ss = 0.f, bo = 0.f;
#pragma unroll
            for (int e = 0; e < 4; ++e) { kr[e] = k4[e] * c_kk[e]; ss += kr[e] * kr[e]; kt[e] = k4[e] * (1.f + (a4[e] - 1.f) * c_ka[e]); bo += r4[e] * kt[e] * c_rk[e]; }
            ss = allred16(ss); bo = allred16(bo);
            const float inv = __builtin_amdgcn_rsqf(fmaxf(ss, 1e-24f));
            f32x4 kk4, b4;
#pragma unroll
            for (int e = 0; e < 4; ++e) { kk4[e] = kr[e] * inv; b4[e] = kk4[e] * a4[e]; }
            *(f32x4*)(Km + tl * 64 + ej) = kt; *(f32x4*)(KK + tl * 64 + ej) = kk4; *(f32x4*)(BB + tl * 64 + ej) = b4;
            if (half == 0 && (tid & 15) == 0) BONUS[(rowbase + ch * 32 + tl) * 8 + h] = bo; }
    };
    auto yraw_store = [&](int ch) {
#pragma unroll
        for (int ps = 0; ps < 2; ++ps)
#pragma unroll
            for (int q = 0; q < 2; ++q) { const int tl = e2t + 16 * ps, il = (tid & 15) + 16 * q;
                YRAW[(rowbase + ch * 32 + tl) * 512 + h * 64 + half * 32 + il] = (bf16_t)(cvt_pk_bf16(Yb[(ch & 1) * 1024 + tl * 32 + il], 0.f) & 0xFFFF); }
    };
    if (tid == 0) *pcnt = 0u;
    __syncthreads();
    if (wave >= 4) { rw_load(0); prep(0, SET0); }
    for (int ch = 0; ch < SEQ / 32; ++ch) {
        __syncthreads();
        if (wave < 4) {
            const float* SET = SET0 + (ch & 1) * SETF;
            const float* Rm = SET; const float* Km = SET + 2048; const float* Vm = SET + 4096; const float* DEC = SET + 6144; const float* KK = SET + 8192; const float* BB = SET + 10240;
            float* Yw = Yb + (ch & 1) * 1024;
            struct Ops { f32x4 w, k, q, b, r; float v0, v1; };
            auto ld = [&](Ops& o, int tt) { const int off = tt * 64 + lq * 4;
                o.w = *(const f32x4*)(DEC + off); o.k = *(const f32x4*)(Km + off); o.q = *(const f32x4*)(KK + off); o.b = *(const f32x4*)(BB + off); o.r = *(const f32x4*)(Rm + off);
                const float* vp = Vm + tt * 64 + irow; o.v0 = vp[0]; o.v1 = vp[1]; };
            auto step = [&](const Ops& o, int tt) {
                const f32x4 da = sA * o.q, db = sB * o.q; const f32x2_t ha = da.lo + da.hi, hb = db.lo + db.hi;
                float sa0 = ha.x + ha.y, sa1 = hb.x + hb.y;
                const f32x4 uA = sA * o.w + o.k * o.v0, uB = sB * o.w + o.k * o.v1;
                sa0 = -allred16(sa0); sa1 = -allred16(sa1);
                sA = uA + o.b * sa0; sB = uB + o.b * sa1;
                const f32x4 ea = sA * o.r, eb = sB * o.r; const f32x2_t ga = ea.lo + ea.hi, gb = eb.lo + eb.hi; float y0 = ga.x + ga.y, y1 = gb.x + gb.y;
                asm("" : "+v"(y0)); asm("" : "+v"(y1));
                y0 += dppf<0xB1>(y0); y1 += dppf<0xB1>(y1);
                float z = (lq & 1) ? y1 : y0;
                z += dppf<0x4E>(z); z += dppf<0x124>(z); z += dppf<0x128>(z);
                if (lq < 2) Yw[tt * 32 + (wave & 3) * 8 + g * 2 + lq] = z; };
            Ops oa, ob;
            ld(oa, 0);
            for (int tt = 0; tt < 32; tt += 4) {
                ld(ob, tt + 1);
                step(oa, tt);
                ld(oa, tt + 2);
                step(ob, tt + 1);
                ld(ob, tt + 3);
                step(oa, tt + 2);
                ld(oa, (tt + 4 < 32) ? tt + 4 : 31);
                step(ob, tt + 3);
            }
        } else {
            if (ch > 0) yraw_store(ch - 1);
            if (ch + 1 < SEQ / 32) prep(ch + 1, SET0 + ((ch + 1) & 1) * SETF);
        }
    }
    __syncthreads();
    if (wave >= 4) yraw_store(SEQ / 32 - 1);
    __syncthreads();
}

__device__ __forceinline__ void rw_post(const Params& p, int layer) {
    bf16_t* P = (bf16_t*)(p.ws + OFF_P); const bf16_t* YRAW = (const bf16_t*)(p.ws + OFF_YRAW);
    const float* BONUS = (const float*)(p.ws + OFF_BONUS); const float* SSQ = (const float*)(p.ws + OFF_SSQ); float* RSTD = (float*)(p.ws + OFF_RSTD);
    const float* mu = p.in[9] + layer * 2176; const float* lng = p.in[17] + layer * 512; const float* lnb = p.in[18] + layer * 512;
    const int gt = blockIdx.x * 512 + opaque_tid(), gs = gridDim.x * 512;
    {
        const int c = (gt & 127) * 4, h = c >> 6;
        const f32x4 muv = *(const f32x4*)(mu + 1024 + c), mug = *(const f32x4*)(mu + 1536 + c);
        const f32x4 lg = *(const f32x4*)(lng + c), lb = *(const f32x4*)(lnb + c);
        for (int idx0 = gt; idx0 < TOK * 128; idx0 += 4 * gs) {
            u32x2 yv[4], vc[4], gc[4], vp[4], gp[4]; float bn[4]; unsigned pm[4]; bool ok[4];
#pragma unroll
            for (int u = 0; u < 4; ++u) { const int idx = idx0 + u * gs; ok[u] = idx < TOK * 128; const int tok = ok[u] ? (idx >> 7) : 0;
                const bf16_t* cur = P + (size_t)tok * LDP + C_RW; const bool hp = (tok & (SEQ - 1)) > 0; const bf16_t* prv = hp ? cur - LDP : cur; pm[u] = hp ? 0xFFFFFFFFu : 0u;
                yv[u] = *(const u32x2*)(YRAW + (size_t)tok * 512 + c);
                vc[u] = *(const u32x2*)(cur + 1024 + c); gc[u] = *(const u32x2*)(cur + 1536 + c);
                vp[u] = *(const u32x2*)(prv + 1024 + c); gp[u] = *(const u32x2*)(prv + 1536 + c);
                bn[u] = BONUS[(size_t)tok * 8 + h]; }
#pragma unroll
            for (int u = 0; u < 4; ++u) { const int idx = idx0 + u * gs; const int tok = ok[u] ? (idx >> 7) : 0;
                float y[4] = {bf_lo(yv[u].x), bf_hi(yv[u].x), bf_lo(yv[u].y), bf_hi(yv[u].y)};
                const float mean = allred16(y[0] + y[1] + y[2] + y[3]) * (1.f / 64.f);
                float d[4], vs = 0.f;
#pragma unroll
                for (int e = 0; e < 4; ++e) { d[e] = y[e] - mean; vs += d[e] * d[e]; }
                const float var = allred16(vs) * (1.f / 64.f);
                const float rs = rsqrtf(var + 64e-5f);
                const unsigned m = pm[u];
                const float vcur[4] = {bf_lo(vc[u].x), bf_hi(vc[u].x), bf_lo(vc[u].y), bf_hi(vc[u].y)}, vprv[4] = {bf_lo(vp[u].x & m), bf_hi(vp[u].x & m), bf_lo(vp[u].y & m), bf_hi(vp[u].y & m)};
                const float gcur[4] = {bf_lo(gc[u].x), bf_hi(gc[u].x), bf_lo(gc[u].y), bf_hi(gc[u].y)}, gprv[4] = {bf_lo(gp[u].x & m), bf_hi(gp[u].x & m), bf_lo(gp[u].y & m), bf_hi(gp[u].y & m)};
                float o[4];
#pragma unroll
                for (int e = 0; e < 4; ++e) { const float vm = vcur[e] + (vprv[e] - vcur[e]) * muv[e], gm = gcur[e] + (gprv[e] - gcur[e]) * mug[e];
                    o[e] = (d[e] * rs * lg[e] + lb[e] + bn[u] * vm) * siluf_(gm); }
                u32x2 ov; ov.x = cvt_pk_bf16(o[0], o[1]); ov.y = cvt_pk_bf16(o[2], o[3]);
                if (ok[u]) *(u32x2*)(P + (size_t)tok * LDP + C_YRW + c) = ov; }
        }
    }
    for (int tok = gt; tok < TOK; tok += gs) { const f32x4* q = (const f32x4*)(SSQ + (size_t)tok * 32); float s = 0.f;
#pragma unroll
        for (int i = 0; i < 8; ++i) { const f32x4 v = q[i]; s += v[0] + v[1] + v[2] + v[3]; }
        RSTD[tok] = rsqrtf(s * (1.f / 1024.f) + 1e-6f); }
}

#define XB_TMO      128
#define XB_XCNT(j)  (256  + 64 * (j))
#define XB_XSUB(j)  (1280 + 64 * (j))
#define XB_XGEN(j)  (2304 + 64 * (j))
#define XB_TOP      3328
#define XB_TOPGEN   3392
#define XCD_BAR_WORDS 3456
#define XB_SPIN_CAP (1u << 18)
__device__ __forceinline__ unsigned xb_ld(unsigned* p)              { return __hip_atomic_load(p, __ATOMIC_RELAXED, __HIP_MEMORY_SCOPE_AGENT); }
__device__ __forceinline__ unsigned xb_add(unsigned* p, unsigned v) { return __hip_atomic_fetch_add(p, v, __ATOMIC_RELAXED, __HIP_MEMORY_SCOPE_AGENT); }
__device__ __forceinline__ unsigned xb_xcc_id() { return (unsigned)__builtin_amdgcn_s_getreg((3 << 11) | 20) & 0xFu; }
#define XB_SPIN(cond, bar) do { unsigned _sp = 0; while (cond) { __builtin_amdgcn_s_sleep(1); \
    if ((++_sp & 255u) == 0u) { if (xb_ld(&(bar)[XB_TMO])) break; if (_sp > XB_SPIN_CAP) { atomicAdd(&(bar)[XB_TMO], 1u); break; } } } } while (0)
struct XcdBarrier { unsigned* bar; unsigned x; volatile LAS unsigned* st; };
__device__ __forceinline__ XcdBarrier xcd_barrier_post(unsigned* bar, volatile LAS unsigned* st) {
    XcdBarrier b; b.bar = bar; b.x = xb_xcc_id(); b.st = st;
    if (threadIdx.x == 0) (void)xb_add(&bar[XB_XCNT(b.x)], 1u);
    return b;
}
__device__ __forceinline__ void xcd_barrier_complete(unsigned* bar, unsigned x, unsigned& nloc, unsigned& nx) {
    const unsigned G = gridDim.x * gridDim.y * gridDim.z;
    unsigned sum, cnt, mine, sp = 0u;
    for (;;) {
        sum = 0u; cnt = 0u; mine = 0u;
#pragma unroll
        for (unsigned j = 0; j < 16; ++j) { const unsigned c = xb_ld(&bar[XB_XCNT(j)]); sum += c; cnt += (c > 0u) ? 1u : 0u; mine = (j == x) ? c : mine; }
        if (sum == G) break;
        __builtin_amdgcn_s_sleep(1);
        if ((++sp & 255u) == 0u) { if (xb_ld(&bar[XB_TMO])) break; if (sp > XB_SPIN_CAP) { atomicAdd(&bar[XB_TMO], 1u); break; } }
    }
    nloc = mine > 0u ? mine : 1u; nx = cnt > 0u ? cnt : 1u;
}
__device__ __forceinline__ void xcd_barrier(const XcdBarrier& b) {
    asm volatile("s_waitcnt vmcnt(0)" ::: "memory");
    __syncthreads();
    if (threadIdx.x == 0) {
        unsigned* bar = b.bar;
        __builtin_amdgcn_s_waitcnt(0);
        unsigned nloc = b.st[0], nx = b.st[1];
        if (nloc == 0u) { xcd_barrier_complete(bar, b.x, nloc, nx); b.st[0] = nloc; b.st[1] = nx; }
        const unsigned old = xb_add(&bar[XB_XSUB(b.x)], 1u);
        const unsigned gen = old / nloc;
        if (old + 1u == (gen + 1u) * nloc) {
            __builtin_amdgcn_fence(__ATOMIC_RELEASE, "agent");
            asm volatile("s_waitcnt vmcnt(0)" ::: "memory");
            const unsigned og = xb_add(&bar[XB_TOP], 1u);
            const unsigned tg = og / nx;
            if (og + 1u == (tg + 1u) * nx) xb_add(&bar[XB_TOPGEN], 1u);
            else XB_SPIN(xb_ld(&bar[XB_TOPGEN]) == tg, bar);
            __builtin_amdgcn_fence(__ATOMIC_ACQUIRE, "agent");
            xb_add(&bar[XB_XGEN(b.x)], 1u);
            asm volatile("s_waitcnt vmcnt(0)" ::: "memory");
        } else {
            XB_SPIN(xb_ld(&bar[XB_XGEN(b.x)]) == gen, bar);
            __builtin_amdgcn_fence(__ATOMIC_ACQUIRE, "agent");
            asm volatile("s_waitcnt vmcnt(0)" ::: "memory");
        }
    }
    __syncthreads();
}

#define GSYNC() xcd_barrier(xb)
__global__ void __launch_bounds__(512, 2) mega(Params p) {
    extern __shared__ __attribute__((aligned(16))) unsigned char shm[];
    cg::grid_group grid = cg::this_grid();
    volatile LAS unsigned* xst = (volatile LAS unsigned*)((LAS unsigned char*)shm + LDS_BYTES - 16);
    if (threadIdx.x == 0) { xst[0] = 0u; xst[1] = 0u; }
    __syncthreads();
    const XcdBarrier xb = xcd_barrier_post((unsigned*)(p.ws + OFF_BAR), xst);
    const char* Pc = (const char*)(p.ws + OFF_P); const char* WTc = (const char*)(p.ws + OFF_WT);
    bf16_t* P = (bf16_t*)(p.ws + OFF_P);
    const int G = gridDim.x, c = blockIdx.x;
    for (int layer = 0; layer < 2; ++layer) {
        phase0(p, layer, shm);
        if (layer == 0) grid.sync(); else GSYNC();
        { SchedInproj S{Pc, WTc, G, c}; EpiInproj E{P}; pg8::gemm_phase<true>((LAS unsigned char*)shm, S, E); }
        GSYNC();
        { const int Gh = G >> 1;
            if (c < Gh) { for (int it = c; it < 128; it += Gh) rwkv_item(p, layer, shm, it); }
            else { const int c2 = c - Gh;
                bc_prepass(p, layer, c2, G - Gh);
                asm volatile("s_waitcnt vmcnt(0)" ::: "memory");
                __syncthreads();
                if (threadIdx.x == 0) { unsigned* cw_ = (unsigned*)(p.ws + OFF_BAR) + 3520; const unsigned need = (unsigned)(G - Gh) * (unsigned)(layer + 1);
                    __builtin_amdgcn_fence(__ATOMIC_RELEASE, "agent"); asm volatile("s_waitcnt vmcnt(0)" ::: "memory");
                    (void)xb_add(cw_, 1u);
                    unsigned sp_ = 0; while (xb_ld(cw_) < need) { __builtin_amdgcn_s_sleep(2); if (++sp_ > (1u << 22)) break; }
                    __builtin_amdgcn_fence(__ATOMIC_ACQUIRE, "agent"); asm volatile("s_waitcnt vmcnt(0)" ::: "memory"); }
                __syncthreads();
                for (int it = c2; it < 256; it += Gh) ssd_item(p, layer, shm, it);
                for (int it = c2; it < 1024; it += Gh) attn_item(p, shm, it); } }
        GSYNC();
        rw_post(p, layer);
        GSYNC();
        { SchedC1 S{Pc, WTc, G, c}; EpiC1 E{P, (const float*)(p.ws + OFF_RSTD)}; pg8::gemm_phase<true>((LAS unsigned char*)shm, S, E); }
        GSYNC();
        { SchedOut S{Pc, WTc, G, c}; EpiOut E{layer == 0 ? p.in[0] : p.out, p.out}; pg8::gemm_phase<false>((LAS unsigned char*)shm, S, E); }
        GSYNC();
    }
    { const int tid = opaque_tid(), wave = tid >> 6, lane = tid & 63; const float* fg = p.in[23];
        for (int row = blockIdx.x * 8 + wave; row < TOK; row += gridDim.x * 8) { float* xr = p.out + (size_t)row * DM;
            f32x4 v[4]; float ss = 0.f;
#pragma unroll
            for (int i = 0; i < 4; ++i) { v[i] = *(const f32x4*)(xr + i * 256 + lane * 4); ss += v[i][0] * v[i][0] + v[i][1] * v[i][1] + v[i][2] * v[i][2] + v[i][3] * v[i][3]; }
            ss = wave_sum(ss);
            const float rs = rsqrtf(ss * (1.f / DM) + 1e-6f);
#pragma unroll
            for (int i = 0; i < 4; ++i) { const f32x4 g = *(const f32x4*)(fg + i * 256 + lane * 4); *(f32x4*)(xr + i * 256 + lane * 4) = v[i] * rs * g; } } }
}

extern "C" void kernel_launch(void* const* d_in, const int* in_sizes, int n_in, void* d_out, int out_size, void* d_ws, size_t ws_size, hipStream_t stream) {
    static int grid_blocks = 0;
    if (grid_blocks == 0) {
        if (n_in != 24 || out_size != TOK * DM || ws_size < WS_NEED) { fprintf(stderr, "kernel_launch: unexpected shapes (n_in %d out %d ws %zu need %zu)\n", n_in, out_size, ws_size, (size_t)WS_NEED); grid_blocks = -1; return; }
        int dev = 0, cus = 0, per_cu = 0;
        hipGetDevice(&dev);
        hipDeviceGetAttribute(&cus, hipDeviceAttributeMultiprocessorCount, dev);
        hipFuncSetAttribute((const void*)mega, hipFuncAttributeMaxDynamicSharedMemorySize, LDS_BYTES);
        hipOccupancyMaxActiveBlocksPerMultiprocessor(&per_cu, (const void*)mega, 512, LDS_BYTES);
        if (per_cu < 1) { fprintf(stderr, "kernel_launch: occupancy query says %d blocks per CU\n", per_cu); grid_blocks = -1; return; }
        if (per_cu > 1) per_cu = 1;
        grid_blocks = cus * per_cu;
        grid_blocks &= ~7;
    }
    if (grid_blocks < 0) return;
    Params p{};
    for (int i = 0; i < 24; ++i) p.in[i] = (const float*)d_in[i];
    p.out = (float*)d_out; p.ws = (unsigned char*)d_ws;
    (void)hipMemsetAsync((unsigned char*)d_ws + OFF_BAR, 0, SZ_BAR, stream);
    void* args[] = {&p};
    hipError_t e = hipLaunchCooperativeKernel((const void*)mega, dim3(grid_blocks), dim3(512), args, LDS_BYTES, stream);
    if (e != hipSuccess) fprintf(stderr, "cooperative launch failed: %s (grid %d)\n", hipGetErrorString(e), grid_blocks);
}
```

```cpp
#include <hip/hip_runtime.h>
#include <hip/hip_cooperative_groups.h>
#include <cstdio>
namespace cg = cooperative_groups;

#define LAS __attribute__((address_space(3)))
typedef unsigned short bf16_t;
typedef short bf16x8 __attribute__((ext_vector_type(8)));
typedef float f32x4 __attribute__((ext_vector_type(4)));
typedef unsigned u32x4 __attribute__((ext_vector_type(4)));
typedef unsigned u32x2 __attribute__((ext_vector_type(2)));

constexpr int TOK = 16384, SEQ = 2048, DM = 1024, NIN = 9616;
constexpr int LDP = 7680;
constexpr int C_Q = 0, C_K = 512, C_V = 1024, C_SBG = 1536, C_Z = 2048, C_XBC = 3072, C_RW = 4352, C_DT = 6528, C_H = 6656;
constexpr int C_M = 0, C_G = 3072, C_YRW = 4352;
constexpr int R_GATE = 6656, R_SB = 9728, R_SSD = 10752, R_RWO = 11776, R_WO = 12800, WT_ROWS = 13824;
constexpr size_t OFF_P = 0, SZ_P = (size_t)TOK * LDP * 2;
constexpr size_t OFF_WT = OFF_P + SZ_P, SZ_WT = (size_t)WT_ROWS * 1024 * 2;
constexpr size_t OFF_YRAW = OFF_WT + SZ_WT, SZ_YRAW = (size_t)TOK * 512 * 2;
constexpr size_t OFF_SSQ = OFF_YRAW + SZ_YRAW, SZ_SSQ = (size_t)TOK * 32 * 4;
constexpr size_t OFF_RSTD = OFF_SSQ + SZ_SSQ, SZ_RSTD = (size_t)TOK * 4;
constexpr size_t OFF_BONUS = OFF_RSTD + SZ_RSTD, SZ_BONUS = (size_t)TOK * 8 * 4;
constexpr size_t OFF_BAR = OFF_BONUS + SZ_BONUS, SZ_BAR = 16384;
constexpr size_t OFF_BCC = OFF_BAR + SZ_BAR, SZ_BCC = (size_t)TOK * 256 * 2;
constexpr size_t WS_NEED = OFF_BCC + SZ_BCC;
constexpr int LDS_BYTES = 135168;

struct Params { const float* in[24]; float* out; unsigned char* ws; };

typedef float f32x2_t __attribute__((ext_vector_type(2)));
typedef __bf16 bf16x2_t __attribute__((ext_vector_type(2)));
__device__ __forceinline__ unsigned cvt_pk_bf16(float lo, float hi) { const f32x2_t v = {lo, hi}; return __builtin_bit_cast(unsigned, __builtin_convertvector(v, bf16x2_t)); }
__device__ __forceinline__ float bf_lo(unsigned u) { return __uint_as_float(u << 16); }
__device__ __forceinline__ float bf_hi(unsigned u) { return __uint_as_float(u & 0xFFFF0000u); }
__device__ __forceinline__ float bf2f(bf16_t h) { return __uint_as_float(((unsigned)h) << 16); }
__device__ __forceinline__ float sigmoidf_(float x) { return __builtin_amdgcn_rcpf(1.f + __expf(-x)); }
__device__ __forceinline__ float siluf_(float x) { return x * __builtin_amdgcn_rcpf(1.f + __expf(-x)); }
__device__ __forceinline__ float softplusf_(float x) { return fmaxf(x, 0.f) + __logf(1.f + __expf(-fabsf(x))); }
template <int CTRL> __device__ __forceinline__ float dppf(float x) { return __int_as_float(__builtin_amdgcn_update_dpp(0, __float_as_int(x), CTRL, 0xF, 0xF, true)); }
__device__ __forceinline__ float allred16(float x) { x += dppf<0xB1>(x); x += dppf<0x4E>(x); x += dppf<0x141>(x); x += dppf<0x140>(x); return x; }
__device__ __forceinline__ int opaque_tid() { int t; asm volatile("v_mov_b32 %0, %1" : "=v"(t) : "v"((int)threadIdx.x)); return t; }
__device__ __forceinline__ float wave_sum(float v) {
#pragma unroll
    for (int o = 1; o < 64; o <<= 1) v += __shfl_xor(v, o);
    return v;
}

namespace pg8 {
constexpr int BM = 256, BK = 64, HALF = 128, HTB = HALF * BK * 2, NXCD = 8, WGM = 8;
constexpr unsigned LDA_B = LDP * 2, LDB_B = 2048;
__device__ __forceinline__ int lds_byte(int r, int c) { const int st = (r >> 4) * 2 + (c >> 5), rr = r & 15, cc = c & 31, ob = rr * 64 + cc * 2; return st * 1024 + (ob ^ (((ob >> 9) & 1) << 5)); }
__device__ __forceinline__ void stage_rc(int b, int& R, int& C) { const int st = b / 1024, sb = b % 1024, swz = sb ^ (((sb >> 9) & 1) << 5); R = (st >> 1) * 16 + swz / 64; C = (st & 1) * 32 + (swz % 64) / 2; }
__device__ __forceinline__ int perm32(int rho) { const int n = rho >> 4, i = rho & 15; return 8 * (i >> 2) + 4 * n + (i & 3); }
struct UnitD { const char* A; const char* B; int nt, pm, pn, kind; };
__device__ __forceinline__ void tile_of(int L, int nM, int nN, int& pm, int& pn) {
    const int nwg = nM * nN; int wgid = L;
    { const int q = nwg / NXCD, r = nwg % NXCD, xcd = wgid % NXCD, off = wgid / NXCD; wgid = (xcd < r ? xcd * (q + 1) : r * (q + 1) + (xcd - r) * q) + off; }
    const int nig = WGM * nN, gid = wgid / nig, fm = gid * WGM, gsz = (nM - fm) < WGM ? (nM - fm) : WGM;
    pm = fm + ((wgid % nig) % gsz); pn = (wgid % nig) / gsz;
}

template <bool PERM, class Sched, class Epi>
__device__ __forceinline__ void gemm_phase(LAS unsigned char* lds, const Sched& S, const Epi& E) {
    const int tid = opaque_tid(), wid = __builtin_amdgcn_readfirstlane(tid >> 6), lane = tid & 63, wr = wid >> 2, wc = wid & 3, fr = lane & 15, fq = lane >> 4;
    unsigned voffA[2], voffB[2];
#pragma unroll
    for (int i = 0; i < 2; ++i) { int R, C; stage_rc(tid * 16 + i * 8192, R, C); const int Rb = PERM ? ((R & ~31) + perm32(R & 31)) : R;
        voffA[i] = (unsigned)R * LDA_B + (unsigned)C * 2u; voffB[i] = (unsigned)Rb * LDB_B + (unsigned)C * 2u; }
    const size_t kstep = (size_t)(BK * 2);
    const size_t hstepA = (size_t)HALF * LDA_B, hstepB = (size_t)HALF * LDB_B;
    const unsigned ldsw = (unsigned)wid * 1024u;
    const int aoff = lds_byte(wr * 64 + fr, fq * 8), boff = lds_byte(wc * 32 + fr, fq * 8);
#define PG8_SA(b, h) (((b) * 2 + (h)) * HTB)
#define PG8_SB(b, h) ((4 + (b) * 2 + (h)) * HTB)
#define PG8_STAGE(bufoff, gbase, voff) do { _Pragma("unroll") for (int _i = 0; _i < 2; ++_i) \
        __builtin_amdgcn_global_load_lds((const unsigned*)((const char*)(gbase) + (voff)[_i]), (LAS unsigned*)(lds + (bufoff) + ldsw + _i * 8192), 16, 0, 0); } while (0)
#define PG8_LDA(dst, b, h) do { _Pragma("unroll") for (int m = 0; m < 4; ++m) _Pragma("unroll") for (int k = 0; k < 2; ++k) dst[m][k] = *(const LAS bf16x8*)(lds + PG8_SA(b, h) + aoff + m * 2048 + k * 1024); } while (0)
#define PG8_LDB(dst, b, h) do { _Pragma("unroll") for (int n = 0; n < 2; ++n) _Pragma("unroll") for (int k = 0; k < 2; ++k) dst[n][k] = *(const LAS bf16x8*)(lds + PG8_SB(b, h) + boff + n * 2048 + k * 1024); } while (0)
#define PG8_MMA(ai, bj, At, Bt) do { __builtin_amdgcn_s_setprio(1); _Pragma("unroll") for (int m = 0; m < 4; ++m) _Pragma("unroll") for (int n = 0; n < 2; ++n) _Pragma("unroll") for (int k = 0; k < 2; ++k) \
        acc[ai][bj][m][n] = __builtin_amdgcn_mfma_f32_16x16x32_bf16(Bt[n][k], At[m][k], acc[ai][bj][m][n], 0, 0, 0); __builtin_amdgcn_s_setprio(0); } while (0)
#define PG8_WAIT_V(n) asm volatile("s_waitcnt vmcnt(" #n ")" ::: "memory")
#define PG8_WAIT_L(n) asm volatile("s_waitcnt lgkmcnt(" #n ")" ::: "memory")
#define PG8_BAR __builtin_amdgcn_s_barrier()
#define PG8_SCHED __builtin_amdgcn_sched_barrier(0)
    UnitD cur, nxt; int ui = 0;
    if (!S.next(0, cur)) return;
    f32x4 acc[2][2][4][2];
#pragma unroll
    for (int a = 0; a < 2; ++a)
#pragma unroll
        for (int b = 0; b < 2; ++b)
#pragma unroll
            for (int m = 0; m < 4; ++m)
#pragma unroll
                for (int n = 0; n < 2; ++n) acc[a][b][m][n] = (f32x4){0.f, 0.f, 0.f, 0.f};
    bf16x8 At[4][2], B0[2][2], B1[2][2];
    const char* cA = cur.A; const char* cB = cur.B;
    PG8_STAGE(PG8_SB(0, 0), cB, voffB); PG8_STAGE(PG8_SA(0, 0), cA, voffA); PG8_STAGE(PG8_SB(0, 1), cB + hstepB, voffB); PG8_STAGE(PG8_SA(0, 1), cA + hstepA, voffA);
    if (wr == 1) PG8_BAR;
    PG8_WAIT_V(4); PG8_BAR;
    PG8_STAGE(PG8_SB(1, 0), cB + kstep, voffB); PG8_STAGE(PG8_SA(1, 0), cA + kstep, voffA); PG8_STAGE(PG8_SB(1, 1), cB + hstepB + kstep, voffB);
    PG8_WAIT_V(6); PG8_BAR;
    for (;;) {
        const bool has_next = S.next(ui + 1, nxt);
        const char* nA = has_next ? nxt.A : cA; const char* nB = has_next ? nxt.B : cB;
        const int nt = cur.nt;
        for (int t = 0; t < nt; t += 2) {
            const bool last = (t == nt - 2);
            const char* a1 = cA + (size_t)(t + 1) * kstep;
            const char* a2 = last ? nA : cA + (size_t)(t + 2) * kstep; const char* b2 = last ? nB : cB + (size_t)(t + 2) * kstep;
            const char* a3 = a2 + kstep; const char* b3 = b2 + kstep;
            PG8_LDB(B0, 0, 0); PG8_SCHED; PG8_LDA(At, 0, 0); PG8_STAGE(PG8_SA(1, 1), a1 + hstepA, voffA);
            PG8_WAIT_L(8); PG8_BAR; PG8_WAIT_L(0); PG8_MMA(0, 0, At, B0); PG8_BAR; PG8_SCHED;
            PG8_LDB(B1, 0, 1); PG8_STAGE(PG8_SB(0, 0), b2, voffB);
            PG8_BAR; PG8_WAIT_L(0); PG8_MMA(0, 1, At, B1); PG8_BAR;
            PG8_LDA(At, 0, 1); PG8_STAGE(PG8_SA(0, 0), a2, voffA);
            PG8_BAR; PG8_WAIT_L(0); PG8_MMA(1, 0, At, B0); PG8_BAR; PG8_SCHED;
            PG8_STAGE(PG8_SB(0, 1), b2 + hstepB, voffB);
            PG8_WAIT_V(6); PG8_BAR; PG8_MMA(1, 1, At, B1); PG8_BAR;
            PG8_LDB(B0, 1, 0); PG8_SCHED; PG8_LDA(At, 1, 0); PG8_STAGE(PG8_SA(0, 1), a2 + hstepA, voffA);
            PG8_WAIT_L(8); PG8_BAR; PG8_WAIT_L(0); PG8_MMA(0, 0, At, B0); PG8_BAR; PG8_SCHED;
            PG8_LDB(B1, 1, 1); PG8_STAGE(PG8_SB(1, 0), b3, voffB);
            PG8_BAR; PG8_WAIT_L(0); PG8_MMA(0, 1, At, B1); PG8_BAR;
            PG8_LDA(At, 1, 1); PG8_STAGE(PG8_SA(1, 0), a3, voffA);
            PG8_BAR; PG8_WAIT_L(0); PG8_MMA(1, 0, At, B0); PG8_BAR; PG8_SCHED;
            PG8_STAGE(PG8_SB(1, 1), b3 + hstepB, voffB);
            PG8_WAIT_V(6); PG8_BAR; PG8_MMA(1, 1, At, B1); PG8_BAR;
        }
        E(acc, cur, wr, wc, fr, fq);
        if (!has_next) break;
#pragma unroll
        for (int a = 0; a < 2; ++a)
#pragma unroll
            for (int b = 0; b < 2; ++b)
#pragma unroll
                for (int m = 0; m < 4; ++m)
#pragma unroll
                    for (int n = 0; n < 2; ++n) acc[a][b][m][n] = (f32x4){0.f, 0.f, 0.f, 0.f};
        cur = nxt; cA = nA; cB = nB; ++ui;
    }
    PG8_WAIT_V(0);
    if (wr == 0) PG8_BAR;
    PG8_BAR;
#undef PG8_SA
#undef PG8_SB
#undef PG8_STAGE
#undef PG8_LDA
#undef PG8_LDB
#undef PG8_MMA
#undef PG8_WAIT_V
#undef PG8_WAIT_L
#undef PG8_BAR
#undef PG8_SCHED
}
}
using pg8::UnitD;

struct SchedInproj {
    const char* P; const char* WT; int G, c;
    __device__ __forceinline__ bool next(int i, UnitD& u) const {
        const int L = i * G + c; if (L >= 64 * 26) return false;
        int pm, pn; pg8::tile_of(L, 64, 26, pm, pn);
        u.A = P + ((size_t)pm * 256 * LDP + C_H) * 2; u.B = WT + (size_t)pn * 256 * 2048; u.nt = 16; u.pm = pm; u.pn = pn; u.kind = 0; return true;
    }
};
struct EpiInproj {
    bf16_t* P;
    __device__ __forceinline__ void operator()(const f32x4 (&acc)[2][2][4][2], const UnitD& u, int wr, int wc, int fr, int fq) const {
        const int row0 = u.pm * 256 + wr * 64 + fr, col0 = u.pn * 256 + wc * 32 + 8 * fq;
#pragma unroll
        for (int ai = 0; ai < 2; ++ai)
#pragma unroll
            for (int m = 0; m < 4; ++m) { bf16_t* rowp = P + (size_t)(row0 + ai * 128 + m * 16) * LDP + col0;
#pragma unroll
                for (int bj = 0; bj < 2; ++bj) { const f32x4 v0 = acc[ai][bj][m][0], v1 = acc[ai][bj][m][1];
                    u32x4 o; o.x = cvt_pk_bf16(v0[0], v0[1]); o.y = cvt_pk_bf16(v0[2], v0[3]); o.z = cvt_pk_bf16(v1[0], v1[1]); o.w = cvt_pk_bf16(v1[2], v1[3]);
                    *(u32x4*)(rowp + bj * 128) = o; } }
    }
};
struct SchedC1 {
    const char* P; const char* WT; int G, c;
    __device__ __forceinline__ bool next(int i, UnitD& u) const {
        const int ti = i / 6, sub = i - ti * 6, L = ti * G + c; if (L >= 256) return false;
        int pm, pn; pg8::tile_of(L, 64, 4, pm, pn);
        const int br = sub >> 1;
        if (!(sub & 1)) { u.A = P + ((size_t)pm * 256 * LDP + C_H) * 2; u.B = WT + (size_t)(R_GATE + br * 1024 + pn * 256) * 2048; u.nt = 16; }
        else { const int acol = br == 0 ? C_SBG : (br == 1 ? C_Z : C_YRW); const int brow = br == 0 ? R_SB : (br == 1 ? R_SSD : R_RWO);
            u.A = P + ((size_t)pm * 256 * LDP + acol) * 2; u.B = WT + (size_t)(brow + pn * 256) * 2048; u.nt = br == 1 ? 16 : 8; }
        u.pm = pm; u.pn = pn; u.kind = sub; return true;
    }
};
struct EpiC1 {
    bf16_t* P; const float* rstd;
    __device__ __forceinline__ void operator()(const f32x4 (&acc)[2][2][4][2], const UnitD& u, int wr, int wc, int fr, int fq) const {
        const int row0 = u.pm * 256 + wr * 64 + fr, col0 = u.pn * 256 + wc * 32 + 8 * fq;
        const int kind = u.kind;
#pragma unroll
        for (int ai = 0; ai < 2; ++ai)
#pragma unroll
            for (int m = 0; m < 4; ++m) { const int row = row0 + ai * 128 + m * 16; bf16_t* rowp = P + (size_t)row * LDP + col0;
                const float sc = (kind == 3) ? rstd[row] : 1.f;
#pragma unroll
                for (int bj = 0; bj < 2; ++bj) { const f32x4 v0 = acc[ai][bj][m][0], v1 = acc[ai][bj][m][1];
                    float v[8] = {v0[0], v0[1], v0[2], v0[3], v1[0], v1[1], v1[2], v1[3]};
                    u32x4* gp = (u32x4*)(rowp + C_G + bj * 128); u32x4* mp = (u32x4*)(rowp + C_M + bj * 128);
                    if (!(kind & 1)) {
#pragma unroll
                        for (int e = 0; e < 8; ++e) v[e] = sigmoidf_(v[e]);
                        u32x4 o; o.x = cvt_pk_bf16(v[0], v[1]); o.y = cvt_pk_bf16(v[2], v[3]); o.z = cvt_pk_bf16(v[4], v[5]); o.w = cvt_pk_bf16(v[6], v[7]);
                        *gp = o;
                    } else {
                        const u32x4 g = *gp;
                        float r[8];
                        r[0] = bf_lo(g.x) * v[0] * sc; r[1] = bf_hi(g.x) * v[1] * sc; r[2] = bf_lo(g.y) * v[2] * sc; r[3] = bf_hi(g.y) * v[3] * sc;
                        r[4] = bf_lo(g.z) * v[4] * sc; r[5] = bf_hi(g.z) * v[5] * sc; r[6] = bf_lo(g.w) * v[6] * sc; r[7] = bf_hi(g.w) * v[7] * sc;
                        if (kind != 1) { const u32x4 mo = *mp;
                            r[0] += bf_lo(mo.x); r[1] += bf_hi(mo.x); r[2] += bf_lo(mo.y); r[3] += bf_hi(mo.y); r[4] += bf_lo(mo.z); r[5] += bf_hi(mo.z); r[6] += bf_lo(mo.w); r[7] += bf_hi(mo.w); }
                        u32x4 o; o.x = cvt_pk_bf16(r[0], r[1]); o.y = cvt_pk_bf16(r[2], r[3]); o.z = cvt_pk_bf16(r[4], r[5]); o.w = cvt_pk_bf16(r[6], r[7]);
                        *mp = o;
                    } } }
    }
};
struct SchedOut {
    const char* P; const char* WT; int G, c;
    __device__ __forceinline__ bool next(int i, UnitD& u) const {
        const int L = i * G + c; if (L >= 256) return false;
        int pm, pn; pg8::tile_of(L, 64, 4, pm, pn);
        u.A = P + ((size_t)pm * 256 * LDP + C_M) * 2; u.B = WT + (size_t)(R_WO + pn * 256) * 2048; u.nt = 16; u.pm = pm; u.pn = pn; u.kind = 0; return true;
    }
};
struct EpiOut {
    const float* Xin; float* Xout;
    __device__ __forceinline__ void operator()(const f32x4 (&acc)[2][2][4][2], const UnitD& u, int wr, int wc, int fr, int fq) const {
        const int row0 = u.pm * 256 + wr * 64 + fr, col0 = u.pn * 256 + wc * 32 + 4 * fq;
#pragma unroll
        for (int ai = 0; ai < 2; ++ai)
#pragma unroll
            for (int m = 0; m < 4; ++m) { const size_t ro = (size_t)(row0 + ai * 128 + m * 16) * DM + col0;
#pragma unroll
                for (int bj = 0; bj < 2; ++bj)
#pragma unroll
                    for (int n = 0; n < 2; ++n) { const f32x4 xi = *(const f32x4*)(Xin + ro + bj * 128 + n * 16); *(f32x4*)(Xout + ro + bj * 128 + n * 16) = xi + acc[ai][bj][m][n]; } }
    }
};

__device__ __forceinline__ void phase0(const Params& p, int layer, unsigned char* shm) {
    const int tid = opaque_tid(), wave = tid >> 6, lane = tid & 63;
    bf16_t* P = (bf16_t*)(p.ws + OFF_P); bf16_t* WT = (bf16_t*)(p.ws + OFF_WT);
    const float* Xin = layer == 0 ? p.in[0] : p.out;
    const float* ng = p.in[1] + layer * DM;
    f32x4 gn[4];
#pragma unroll
    for (int i = 0; i < 4; ++i) gn[i] = *(const f32x4*)(ng + i * 256 + lane * 4);
    for (int row0 = (blockIdx.x * 8 + wave) * 4; row0 < TOK; row0 += gridDim.x * 32) {
        f32x4 v[4][4]; float ss[4];
#pragma unroll
        for (int rr = 0; rr < 4; ++rr) { const float* xr = Xin + (size_t)(row0 + rr) * DM;
#pragma unroll
            for (int i = 0; i < 4; ++i) v[rr][i] = *(const f32x4*)(xr + i * 256 + lane * 4); }
#pragma unroll
        for (int rr = 0; rr < 4; ++rr) { float a = 0.f;
#pragma unroll
            for (int i = 0; i < 4; ++i) a += v[rr][i][0] * v[rr][i][0] + v[rr][i][1] * v[rr][i][1] + v[rr][i][2] * v[rr][i][2] + v[rr][i][3] * v[rr][i][3];
            ss[rr] = wave_sum(a); }
#pragma unroll
        for (int rr = 0; rr < 4; ++rr) { const float rs = rsqrtf(ss[rr] * (1.f / DM) + 1e-6f);
#pragma unroll
            for (int i = 0; i < 4; ++i) { const f32x4 g = gn[i];
                u32x2 o; o.x = cvt_pk_bf16(v[rr][i][0] * rs * g[0], v[rr][i][1] * rs * g[1]); o.y = cvt_pk_bf16(v[rr][i][2] * rs * g[2], v[rr][i][3] * rs * g[3]);
                *(u32x2*)(P + (size_t)(row0 + rr) * LDP + C_H + i * 256 + lane * 4) = o; } }
    }
    float* T = (float*)shm + wave * (64 * 65);
    const float* w_in = p.in[2] + (size_t)layer * DM * NIN;
    const float* sg = p.in[8] + layer * DM;
    for (int job = blockIdx.x * 8 + wave; job < 3200; job += gridDim.x * 8) {
        const float* src; int srcN, k0, n0, dstrow; bool is_in = false, is_ssd = false;
        if (job < 2432) { is_in = true; src = w_in; srcN = NIN; const int ntile = job >> 4; k0 = (job & 15) * 64; n0 = ntile * 64; dstrow = n0; }
        else { int r = job - 2432;
            if (r < 128) { src = p.in[19] + (size_t)layer * 512 * DM; k0 = (r >> 4) * 64; n0 = (r & 15) * 64; dstrow = R_SB + n0; }
            else if (r < 384) { r -= 128; src = p.in[20] + (size_t)layer * DM * DM; k0 = (r >> 4) * 64; n0 = (r & 15) * 64; dstrow = R_SSD + n0; is_ssd = true; }
            else if (r < 512) { r -= 384; src = p.in[21] + (size_t)layer * 512 * DM; k0 = (r >> 4) * 64; n0 = (r & 15) * 64; dstrow = R_RWO + n0; }
            else { r -= 512; src = p.in[22] + (size_t)layer * DM * DM; k0 = (r >> 4) * 64; n0 = (r & 15) * 64; dstrow = R_WO + n0; }
            srcN = DM; }
        const int n4 = (lane & 15) * 4, np = n0 + n4; int sc = np;
        if (is_in) { if (np < 4352) sc = np; else if (np < 6528) sc = np + 16; else if (np < 6544) sc = np - 6528 + 4352; else if (np < 6656) sc = -1; else sc = np - 112; }
        f32x4 v[16];
#pragma unroll
        for (int i = 0; i < 16; ++i) { const int k = (lane >> 4) + 4 * i; v[i] = (f32x4){0.f, 0.f, 0.f, 0.f};
            if (sc >= 0) v[i] = *(const f32x4*)(src + (size_t)(k0 + k) * srcN + sc); }
#pragma unroll
        for (int i = 0; i < 16; ++i) { const int k = (lane >> 4) + 4 * i; f32x4 x = v[i];
            if (is_ssd) x = x * sg[k0 + k];
            T[k * 65 + n4] = x[0]; T[k * 65 + n4 + 1] = x[1]; T[k * 65 + n4 + 2] = x[2]; T[k * 65 + n4 + 3] = x[3]; }
        asm volatile("s_waitcnt lgkmcnt(0)" ::: "memory"); __builtin_amdgcn_wave_barrier(); asm volatile("" ::: "memory");
#pragma unroll
        for (int j = 0; j < 8; ++j) { const int r = lane + 64 * j, n = r >> 3, kc = (r & 7) * 8; const float* sp = T + kc * 65 + n;
            u32x4 o; o.x = cvt_pk_bf16(sp[0], sp[65]); o.y = cvt_pk_bf16(sp[130], sp[195]); o.z = cvt_pk_bf16(sp[260], sp[325]); o.w = cvt_pk_bf16(sp[390], sp[455]);
            *(u32x4*)(WT + (size_t)(dstrow + n) * 1024 + k0 + kc) = o; }
        asm volatile("s_waitcnt lgkmcnt(0)" ::: "memory"); __builtin_amdgcn_wave_barrier(); asm volatile("" ::: "memory");
    }
    __syncthreads();
}

__device__ __forceinline__ void attn_item(const Params& p, unsigned char* shm, int item) {
    const int qb = item & 15, h = (item >> 4) & 7, b = item >> 7;
    bf16_t* P = (bf16_t*)(p.ws + OFF_P);
    const int tid = opaque_tid(), wave = tid >> 6, lane = tid & 63, lq = lane & 15, g = lane >> 4;
    const size_t rowbase = (size_t)b * SEQ;
    const int t = qb * 128 + wave * 16 + lq;
    const int tmax = qb * 128 + wave * 16 + 15;
    constexpr int ABUF = 64 * 144 + 64 * 136;
    const bf16_t* qp = P + (rowbase + t) * LDP + C_Q + h * 64 + 8 * g;
    const bf16x8 qf0 = *(const bf16x8*)qp, qf1 = *(const bf16x8*)(qp + 32);
    bf16x8 TT[4][2];
#pragma unroll
    for (int a = 0; a < 4; ++a)
#pragma unroll
        for (int ks = 0; ks < 2; ++ks)
#pragma unroll
            for (int e = 0; e < 8; ++e) { const int j = 16 * (2 * ks + (e >> 2)) + 4 * g + (e & 3); TT[a][ks][e] = (j > 16 * a + lq) ? (short)0x3F80 : (short)0; }
    f32x4 o[4];
#pragma unroll
    for (int i = 0; i < 4; ++i) o[i] = (f32x4){0.f, 0.f, 0.f, 0.f};
    float R = 0.f;
    LAS volatile int* flg = (LAS volatile int*)((LAS unsigned char*)shm + 2 * ABUF);
    const int st_s = tid >> 3, st_dc = (tid & 7) * 8;
    const bf16_t* st_base = P + (rowbase + st_s) * LDP + h * 64 + st_dc;
    auto stage_write = [&](unsigned char* buf, const u32x4& kv, const u32x4& vv) {
        bf16_t* Ksw = (bf16_t*)buf; bf16_t* Vtw = (bf16_t*)(buf + 64 * 144); const int s_ = st_s, dc = st_dc;
        *(u32x4*)(Ksw + s_ * 72 + dc) = kv;
        Vtw[(dc + 0) * 68 + s_] = (bf16_t)(vv.x & 0xFFFF); Vtw[(dc + 1) * 68 + s_] = (bf16_t)(vv.x >> 16);
        Vtw[(dc + 2) * 68 + s_] = (bf16_t)(vv.y & 0xFFFF); Vtw[(dc + 3) * 68 + s_] = (bf16_t)(vv.y >> 16);
        Vtw[(dc + 4) * 68 + s_] = (bf16_t)(vv.z & 0xFFFF); Vtw[(dc + 5) * 68 + s_] = (bf16_t)(vv.z >> 16);
        Vtw[(dc + 6) * 68 + s_] = (bf16_t)(vv.w & 0xFFFF); Vtw[(dc + 7) * 68 + s_] = (bf16_t)(vv.w >> 16);
    };
    if (tid == 0) { flg[0] = 1; flg[1] = 0; flg[2] = 0; }
    { const bf16_t* kr = st_base + (size_t)(2 * qb + 1) * 64 * LDP; const u32x4 kv0 = *(const u32x4*)(kr + C_K), vv0 = *(const u32x4*)(kr + C_V); stage_write(shm, kv0, vv0); }
    int itn = 0, cur = 0;
    for (int kt = 2 * qb + 1; kt >= 0; --kt) {
        __syncthreads();
        const int f0 = itn % 3, f1 = (itn + 1) % 3, f2 = (itn + 2) % 3;
        if (flg[f0] == 0) break;
        if (tid == 0) flg[f2] = 0;
        u32x4 kvn = (u32x4){0u, 0u, 0u, 0u}, vvn = (u32x4){0u, 0u, 0u, 0u};
        if (kt > 0) { const bf16_t* kr = st_base + (size_t)(kt - 1) * 64 * LDP; kvn = *(const u32x4*)(kr + C_K); vvn = *(const u32x4*)(kr + C_V); }
        const bf16_t* Ks = (const bf16_t*)(shm + cur * ABUF); const bf16_t* Vt = (const bf16_t*)(shm + cur * ABUF + 64 * 144);
        const bool walive = __any(R > -104.f);
        const bool act = (kt * 64 < tmax) && walive;
        if (act) {
            float lb[4][4], lk[4][4];
#pragma unroll
            for (int sub = 0; sub < 4; ++sub) {
                const bf16_t* kp = Ks + (16 * sub + lq) * 72 + 8 * g;
                const bf16x8 k0 = *(const bf16x8*)kp, k1 = *(const bf16x8*)(kp + 32);
                f32x4 s4 = (f32x4){0.f, 0.f, 0.f, 0.f};
                s4 = __builtin_amdgcn_mfma_f32_16x16x32_bf16(k0, qf0, s4, 0, 0, 0);
                s4 = __builtin_amdgcn_mfma_f32_16x16x32_bf16(k1, qf1, s4, 0, 0, 0);
#pragma unroll
                for (int r = 0; r < 4; ++r) { const float z = s4[r] * 0.125f; const bool mk = (kt * 64 + 16 * sub + 4 * g + r) < t;
                    const float l = fminf(z, 0.f) - 0.69314718f * __builtin_amdgcn_logf(1.f + __expf(-fabsf(z)));
                    lb[sub][r] = mk ? l : -1e30f; lk[sub][r] = mk ? (l - z) : 0.f; }
            }
            bf16x8 hi[2];
#pragma unroll
            for (int ks = 0; ks < 2; ++ks) {
                unsigned hw[4];
#pragma unroll
                for (int w2 = 0; w2 < 4; ++w2) { const int sub = 2 * ks + (w2 >> 1), r0 = (w2 & 1) * 2; const float a0 = lk[sub][r0], a1 = lk[sub][r0 + 1];
                    hw[w2] = cvt_pk_bf16(a0, a1); }
                u32x4 hv = (u32x4){hw[0], hw[1], hw[2], hw[3]};
                hi[ks] = __builtin_bit_cast(bf16x8, hv);
            }
            f32x4 aft[4];
#pragma unroll
            for (int a = 0; a < 4; ++a) { f32x4 c = (f32x4){0.f, 0.f, 0.f, 0.f};
#pragma unroll
                for (int ks = 0; ks < 2; ++ks) c = __builtin_amdgcn_mfma_f32_16x16x32_bf16(TT[a][ks], hi[ks], c, 0, 0, 0);
                aft[a] = c; }
            float tot = aft[0][0] + lk[0][0];
            tot = __shfl(tot, lq);
            bf16x8 pf[2];
#pragma unroll
            for (int ks = 0; ks < 2; ++ks) { unsigned pw[4];
#pragma unroll
                for (int w2 = 0; w2 < 4; ++w2) { const int sub = 2 * ks + (w2 >> 1), r0 = (w2 & 1) * 2;
                    const float e0 = __expf(lb[sub][r0] + aft[sub][r0] + R), e1 = __expf(lb[sub][r0 + 1] + aft[sub][r0 + 1] + R);
                    pw[w2] = cvt_pk_bf16(e0, e1); }
                u32x4 pv = (u32x4){pw[0], pw[1], pw[2], pw[3]}; pf[ks] = __builtin_bit_cast(bf16x8, pv); }
            R += tot;
#pragma unroll
            for (int ds = 0; ds < 4; ++ds)
#pragma unroll
                for (int ks = 0; ks < 2; ++ks) { const bf16_t* vp = Vt + (16 * ds + lq) * 68 + 32 * ks + 4 * g;
                    const u32x2 v0 = *(const u32x2*)vp, v1 = *(const u32x2*)(vp + 16);
                    u32x4 vv = (u32x4){v0.x, v0.y, v1.x, v1.y};
                    o[ds] = __builtin_amdgcn_mfma_f32_16x16x32_bf16(__builtin_bit_cast(bf16x8, vv), pf[ks], o[ds], 0, 0, 0); }
        }
        if (__any(R > -104.f) && lane == 0) flg[f1] = 1;
        if (kt > 0) stage_write(shm + (cur ^ 1) * ABUF, kvn, vvn);
        cur ^= 1; ++itn;
    }
#pragma unroll
    for (int ds = 0; ds < 4; ++ds) { bf16_t* gp = P + (rowbase + t) * LDP + C_SBG + h * 64 + 16 * ds + 4 * g;
        const u32x2 gv = *(const u32x2*)gp;
        u32x2 ov; ov.x = cvt_pk_bf16(o[ds][0] * siluf_(bf_lo(gv.x)), o[ds][1] * siluf_(bf_hi(gv.x))); ov.y = cvt_pk_bf16(o[ds][2] * siluf_(bf_lo(gv.y)), o[ds][3] * siluf_(bf_hi(gv.y)));
        *(u32x2*)gp = ov; }
    __syncthreads();
}

__device__ __forceinline__ void bc_prepass(const Params& p, int layer, int blk, int nblk) {
    const bf16_t* P = (const bf16_t*)(p.ws + OFF_P); bf16_t* BCc = (bf16_t*)(p.ws + OFF_BCC);
    const float* cw = p.in[3] + (size_t)layer * 4 * 1280; const float* cb = p.in[4] + layer * 1280;
    const int gt = blk * 512 + opaque_tid(), gs = nblk * 512;
    const int c = (gt & 63) * 4, chn = 1024 + c;
    const f32x4 bias = *(const f32x4*)(cb + chn);
    f32x4 w[4];
#pragma unroll
    for (int k = 0; k < 4; ++k) w[k] = *(const f32x4*)(cw + k * 1280 + chn);
    for (int idx0 = gt; idx0 < TOK * 64; idx0 += 4 * gs) {
        u32x2 xv[4][4]; bool ok[4];
#pragma unroll
        for (int u = 0; u < 4; ++u) { const int idx = idx0 + u * gs; ok[u] = idx < TOK * 64; const int tok = ok[u] ? (idx >> 6) : 0; const int t = tok & (SEQ - 1);
            const bf16_t* xp = P + (size_t)tok * LDP + C_XBC + chn;
#pragma unroll
            for (int k = 0; k < 4; ++k) { const int ts = t - 3 + k; const unsigned xm = ts >= 0 ? 0xFFFFFFFFu : 0u;
                u32x2 x = *(const u32x2*)(xp + (ptrdiff_t)(ts >= 0 ? k - 3 : 0) * LDP); x.x &= xm; x.y &= xm; xv[u][k] = x; } }
#pragma unroll
        for (int u = 0; u < 4; ++u) { const int idx = idx0 + u * gs; const int tok = ok[u] ? (idx >> 6) : 0;
            f32x4 a = bias;
#pragma unroll
            for (int k = 0; k < 4; ++k) { a[0] += w[k][0] * bf_lo(xv[u][k].x); a[1] += w[k][1] * bf_hi(xv[u][k].x); a[2] += w[k][2] * bf_lo(xv[u][k].y); a[3] += w[k][3] * bf_hi(xv[u][k].y); }
            u32x2 o; o.x = cvt_pk_bf16(siluf_(a[0]), siluf_(a[1])); o.y = cvt_pk_bf16(siluf_(a[2]), siluf_(a[3]));
            if (ok[u]) *(u32x2*)(BCc + (size_t)tok * 256 + c) = o; }
    }
}

__device__ __forceinline__ void ssd_item(const Params& p, int layer, unsigned char* shm, int item) {
    const int ph = item & 1, hh = (item >> 1) & 15, b = item >> 5, grp = hh >> 3;
    bf16_t* P = (bf16_t*)(p.ws + OFF_P); float* SSQ = (float*)(p.ws + OFF_SSQ);
    const int tid = opaque_tid(), wave = tid >> 6, lane = tid & 63, lq = lane & 15, g = lane >> 4;
    const size_t rowbase = (size_t)b * SEQ;
    const float* cw = p.in[3] + (size_t)layer * 4 * 1280; const float* cb = p.in[4] + layer * 1280;
    const float dtb = p.in[5][layer * 16 + hh], Aneg = -__expf(p.in[6][layer * 16 + hh]), Dsk = p.in[7][layer * 16 + hh];
    float* XS = (float*)shm;
    float* YS = XS + 2048;
    float* DTs = YS + 2048;
    float* ACS = DTs + 64;
    bf16_t* Cb = (bf16_t*)(ACS + 64);
    bf16_t* Bb = Cb + 64 * 72;
    bf16_t* BT = Bb + 64 * 72;
    bf16_t* Mx = BT + 64 * 72;
    bf16_t* XT = Mx + 64 * 72;
    bf16_t* XwT = XT + 32 * 72;
    bf16_t* SbT = XwT + 32 * 72;
    f32x4 Sacc = (f32x4){0.f, 0.f, 0.f, 0.f};
    const bf16_t* BCc = (const bf16_t*)(p.ws + OFF_BCC);
    const int x_tt = tid >> 3, x_c = (tid & 7) * 4, x_chn = hh * 64 + ph * 32 + x_c;
    const int bc_q = tid & 7;
    const f32x4 xbias = *(const f32x4*)(cb + x_chn);
    f32x4 xw[4];
#pragma unroll
    for (int k = 0; k < 4; ++k) xw[k] = *(const f32x4*)(cw + k * 1280 + x_chn);
    u32x2 sx[4]; u32x4 bc0, bc1; bf16_t sdt = 0;
    auto ssd_load = [&](int tb) {
        const int t = tb + x_tt;
        const bf16_t* xp = P + (rowbase + t) * LDP + C_XBC + x_chn;
#pragma unroll
        for (int k = 0; k < 4; ++k) { const int ts = t - 3 + k; const unsigned xm = ts >= 0 ? 0xFFFFFFFFu : 0u;
            u32x2 xv = *(const u32x2*)(xp + (ptrdiff_t)(ts >= 0 ? k - 3 : 0) * LDP); xv.x &= xm; xv.y &= xm; sx[k] = xv; }
        const bf16_t* bp = BCc + (rowbase + t) * 256 + (bc_q < 4 ? grp * 64 + bc_q * 16 : 128 + grp * 64 + (bc_q - 4) * 16);
        bc0 = *(const u32x4*)bp; bc1 = *(const u32x4*)(bp + 8);
        if (tid < 64) sdt = P[(rowbase + tb + tid) * LDP + C_DT + hh];
    };
    ssd_load(0);
    for (int ch = 0; ch < SEQ / 64; ++ch) {
        const int t0 = ch * 64;
        __syncthreads();
        const int o_tt = tid >> 3, o_p4 = (tid & 7) * 4;
        bf16_t* zp = P + (rowbase + t0 + o_tt) * LDP + C_Z + hh * 64 + ph * 32 + o_p4;
        const u32x2 zv = *(const u32x2*)zp;
        { f32x4 a = xbias;
#pragma unroll
            for (int k = 0; k < 4; ++k) { a[0] += xw[k][0] * bf_lo(sx[k].x); a[1] += xw[k][1] * bf_hi(sx[k].x); a[2] += xw[k][2] * bf_lo(sx[k].y); a[3] += xw[k][3] * bf_hi(sx[k].y); }
            a[0] = siluf_(a[0]); a[1] = siluf_(a[1]); a[2] = siluf_(a[2]); a[3] = siluf_(a[3]);
            const unsigned q0 = cvt_pk_bf16(a[0], a[1]), q1 = cvt_pk_bf16(a[2], a[3]); const int tt = x_tt, c = x_c;
            *(f32x4*)(XS + tt * 32 + c) = a;
            XT[(c + 0) * 72 + tt] = (bf16_t)(q0 & 0xFFFF); XT[(c + 1) * 72 + tt] = (bf16_t)(q0 >> 16); XT[(c + 2) * 72 + tt] = (bf16_t)(q1 & 0xFFFF); XT[(c + 3) * 72 + tt] = (bf16_t)(q1 >> 16);
            if (bc_q < 4) { const int n = bc_q * 16; *(u32x4*)(Bb + tt * 72 + n) = bc0; *(u32x4*)(Bb + tt * 72 + n + 8) = bc1;
                const unsigned wv[8] = {bc0.x, bc0.y, bc0.z, bc0.w, bc1.x, bc1.y, bc1.z, bc1.w};
#pragma unroll
                for (int e = 0; e < 8; ++e) { BT[(n + 2 * e) * 72 + tt] = (bf16_t)(wv[e] & 0xFFFF); BT[(n + 2 * e + 1) * 72 + tt] = (bf16_t)(wv[e] >> 16); } }
            else { const int n = (bc_q - 4) * 16; *(u32x4*)(Cb + tt * 72 + n) = bc0; *(u32x4*)(Cb + tt * 72 + n + 8) = bc1; } }
        if (tid < 64) { const float dt = softplusf_(bf2f(sdt) + dtb); DTs[tid] = dt;
            float x = dt * Aneg;
#pragma unroll
            for (int o = 1; o < 64; o <<= 1) { const float v = __shfl_up(x, o); if (lane >= o) x += v; }
            ACS[tid] = x; }
        if (ch + 1 < SEQ / 64) ssd_load(t0 + 64);
        __syncthreads();
        const float acsL = ACS[63];
        { const int pp = tid >> 4, s4 = (tid & 15) * 4; float v[4];
#pragma unroll
            for (int e = 0; e < 4; ++e) { const int sidx = s4 + e; v[e] = XS[sidx * 32 + pp] * DTs[sidx] * __expf(acsL - ACS[sidx]); }
            *(u32x2*)(XwT + pp * 72 + s4) = (u32x2){cvt_pk_bf16(v[0], v[1]), cvt_pk_bf16(v[2], v[3])}; }
        { const int pi = wave >> 2, ni = wave & 3;
#pragma unroll
            for (int r = 0; r < 4; ++r) SbT[(16 * pi + 4 * g + r) * 72 + 16 * ni + lq] = (bf16_t)(cvt_pk_bf16(Sacc[r], 0.f) & 0xFFFF); }
        { const int ti = wave >> 1;
#pragma unroll
            for (int sj = 0; sj < 2; ++sj) { const int si = 2 * (wave & 1) + sj;
                f32x4 acc = (f32x4){0.f, 0.f, 0.f, 0.f};
                if (si <= ti) {
                    const bf16_t* ap = Cb + (16 * ti + lq) * 72 + 8 * g; const bf16_t* bp = Bb + (16 * si + lq) * 72 + 8 * g;
                    acc = __builtin_amdgcn_mfma_f32_16x16x32_bf16(*(const bf16x8*)ap, *(const bf16x8*)bp, acc, 0, 0, 0);
                    acc = __builtin_amdgcn_mfma_f32_16x16x32_bf16(*(const bf16x8*)(ap + 32), *(const bf16x8*)(bp + 32), acc, 0, 0, 0);
                }
                const int sidx = 16 * si + lq; const float as = ACS[sidx], ds = DTs[sidx];
#pragma unroll
                for (int r = 0; r < 4; ++r) { const int t = 16 * ti + 4 * g + r; const float val = (sidx <= t) ? acc[r] * __expf(ACS[t] - as) * ds : 0.f;
                    Mx[t * 72 + sidx] = (bf16_t)(cvt_pk_bf16(val, 0.f) & 0xFFFF); } } }
        __syncthreads();
        { const int ti = wave >> 1, pi = wave & 1;
            const bf16_t* ap = Mx + (16 * ti + lq) * 72 + 8 * g; const bf16_t* bp = XT + (16 * pi + lq) * 72 + 8 * g;
            const bf16_t* cp = Cb + (16 * ti + lq) * 72 + 8 * g; const bf16_t* sp = SbT + (16 * pi + lq) * 72 + 8 * g;
            f32x4 a1 = (f32x4){0.f, 0.f, 0.f, 0.f}, a2 = (f32x4){0.f, 0.f, 0.f, 0.f};
            a1 = __builtin_amdgcn_mfma_f32_16x16x32_bf16(*(const bf16x8*)ap, *(const bf16x8*)bp, a1, 0, 0, 0);
            a1 = __builtin_amdgcn_mfma_f32_16x16x32_bf16(*(const bf16x8*)(ap + 32), *(const bf16x8*)(bp + 32), a1, 0, 0, 0);
            a2 = __builtin_amdgcn_mfma_f32_16x16x32_bf16(*(const bf16x8*)cp, *(const bf16x8*)sp, a2, 0, 0, 0);
            a2 = __builtin_amdgcn_mfma_f32_16x16x32_bf16(*(const bf16x8*)(cp + 32), *(const bf16x8*)(sp + 32), a2, 0, 0, 0);
#pragma unroll
            for (int r = 0; r < 4; ++r) { const int t = 16 * ti + 4 * g + r, pc = 16 * pi + lq;
                YS[t * 32 + pc] = a1[r] + __expf(ACS[t]) * a2[r] + Dsk * XS[t * 32 + pc]; } }
        { const int pi = wave >> 2, ni = wave & 3; const float dl = __expf(acsL);
            Sacc = Sacc * dl;
            const bf16_t* ap = XwT + (16 * pi + lq) * 72 + 8 * g; const bf16_t* bp = BT + (16 * ni + lq) * 72 + 8 * g;
            Sacc = __builtin_amdgcn_mfma_f32_16x16x32_bf16(*(const bf16x8*)ap, *(const bf16x8*)bp, Sacc, 0, 0, 0);
            Sacc = __builtin_amdgcn_mfma_f32_16x16x32_bf16(*(const bf16x8*)(ap + 32), *(const bf16x8*)(bp + 32), Sacc, 0, 0, 0); }
        __syncthreads();
        { const int tt = o_tt, p4 = o_p4; const f32x4 y4 = *(const f32x4*)(YS + tt * 32 + p4);
            const float u0 = y4[0] * siluf_(bf_lo(zv.x)), u1 = y4[1] * siluf_(bf_hi(zv.x)), u2 = y4[2] * siluf_(bf_lo(zv.y)), u3 = y4[3] * siluf_(bf_hi(zv.y));
            u32x2 ov; ov.x = cvt_pk_bf16(u0, u1); ov.y = cvt_pk_bf16(u2, u3); *(u32x2*)zp = ov;
            float q = u0 * u0 + u1 * u1 + u2 * u2 + u3 * u3;
            q += __shfl_xor(q, 1); q += __shfl_xor(q, 2); q += __shfl_xor(q, 4);
            if ((tid & 7) == 0) SSQ[(rowbase + t0 + tt) * 32 + hh * 2 + ph] = q; }
    }
    __syncthreads();
}

__device__ __forceinline__ float fast_tanh(float x) { return 1.f - 2.f * __builtin_amdgcn_rcpf(1.f + __expf(2.f * x)); }
__device__ __forceinline__ void pbar4(LAS volatile unsigned* cnt, unsigned& tgt, int lane) {
    tgt += 4u;
    asm volatile("s_waitcnt lgkmcnt(0)" ::: "memory");
    if (lane == 0) __hip_atomic_fetch_add((LAS unsigned*)cnt, 1u, __ATOMIC_RELAXED, __HIP_MEMORY_SCOPE_WORKGROUP);
    while (*cnt < tgt) __builtin_amdgcn_s_sleep(1);
    asm volatile("" ::: "memory");
}
__device__ __forceinline__ void rwkv_item(const Params& p, int layer, unsigned char* shm, int item) {
    const int half = item & 1, h = (item >> 1) & 7, b = item >> 4;
    bf16_t* P = (bf16_t*)(p.ws + OFF_P); bf16_t* YRAW = (bf16_t*)(p.ws + OFF_YRAW); float* BONUS = (float*)(p.ws + OFF_BONUS);
    const int tid = opaque_tid(), wave = tid >> 6, lane = tid & 63, lq = lane & 15, g = lane >> 4;
    const size_t rowbase = (size_t)b * SEQ;
    const float* mu = p.in[9] + layer * 2176;
    const float* w0 = p.in[10] + layer * 512; const float* wup = p.in[11] + (size_t)layer * 64 * 512;
    const float* a0 = p.in[12] + layer * 512; const float* aup = p.in[13] + (size_t)layer * 64 * 512;
    const float* kkp = p.in[14] + layer * 512; const float* kap = p.in[15] + layer * 512; const float* rkp = p.in[16] + layer * 512;
    constexpr int SETF = 6 * 2048;
    float* SET0 = (float*)shm;
    float* AA = SET0 + 2 * SETF;
    float* Yb = AA + 2048;
    bf16_t* WLb = (bf16_t*)(Yb + 2048);
    bf16_t* ALb = WLb + 32 * 72;
    LAS volatile unsigned* pcnt = (LAS volatile unsigned*)((LAS unsigned char*)shm + (2 * SETF + 2048 + 2048) * 4 + 2 * 32 * 72 * 2);
    const int csub = wave & 3;
    bf16x8 bfr[2][2]; float lw0[2];
#pragma unroll
    for (int mat = 0; mat < 2; ++mat) { const float* up = (mat ? aup : wup) + h * 64 + csub * 16 + lq;
#pragma unroll
        for (int ks = 0; ks < 2; ++ks) { unsigned w[4];
#pragma unroll
            for (int e2 = 0; e2 < 4; ++e2) { const int m0 = 32 * ks + 8 * g + 2 * e2; w[e2] = cvt_pk_bf16(up[(size_t)m0 * 512], up[(size_t)(m0 + 1) * 512]); }
            u32x4 wv = (u32x4){w[0], w[1], w[2], w[3]}; bfr[mat][ks] = __builtin_bit_cast(bf16x8, wv); }
        lw0[mat] = (mat ? a0 : w0)[h * 64 + csub * 16 + lq]; }
    const int ej = (tid & 15) * 4;
    const f32x4 c_kk = *(const f32x4*)(kkp + h * 64 + ej), c_ka = *(const f32x4*)(kap + h * 64 + ej), c_rk = *(const f32x4*)(rkp + h * 64 + ej);
    const f32x4 mu_r = *(const f32x4*)(mu + h * 64 + ej), mu_k = *(const f32x4*)(mu + 512 + h * 64 + ej), mu_v = *(const f32x4*)(mu + 1024 + h * 64 + ej);
    const f32x4 mu_w = *(const f32x4*)(mu + 2048 + ej), mu_a = *(const f32x4*)(mu + 2112 + ej);
    f32x4 sA = (f32x4){0.f, 0.f, 0.f, 0.f}, sB = (f32x4){0.f, 0.f, 0.f, 0.f};
    const int irow = half * 32 + (wave & 3) * 8 + g * 2;
    unsigned ptgt = 0u;
    const int pm = tid - 256, e2t = pm >> 4;
    u32x2 cva[2][5], pva[2][5];
    auto rw_load = [&](int ch) {
#pragma unroll
        for (int ps = 0; ps < 2; ++ps) { const int tl = e2t + 16 * ps, t = ch * 32 + tl; const bf16_t* cur = P + (rowbase + t) * LDP + C_RW; const bool hp = t > 0; const bf16_t* prv = hp ? cur - LDP : cur;
#pragma unroll
            for (int i = 0; i < 5; ++i) { const int col = (i == 0 ? h * 64 : i == 1 ? 512 + h * 64 : i == 2 ? 1024 + h * 64 : i == 3 ? 2048 : 2112) + ej;
                cva[ps][i] = *(const u32x2*)(cur + col); pva[ps][i] = *(const u32x2*)(prv + col); } }
    };
    auto prep = [&](int ch, float* SET) {
        float* Rm = SET; float* Km = SET + 2048; float* Vm = SET + 4096; float* DEC = SET + 6144; float* KK = SET + 8192; float* BB = SET + 10240;
#pragma unroll
        for (int ps = 0; ps < 2; ++ps) { const int tl = e2t + 16 * ps, t = ch * 32 + tl; const unsigned pmask = t > 0 ? 0xFFFFFFFFu : 0u;
#pragma unroll
            for (int i = 0; i < 5; ++i) {
                const u32x2 cv = cva[ps][i]; u32x2 pv = pva[ps][i]; pv.x &= pmask; pv.y &= pmask;
                const f32x4 m4 = i == 0 ? mu_r : i == 1 ? mu_k : i == 2 ? mu_v : i == 3 ? mu_w : mu_a;
                float c[4] = {bf_lo(cv.x), bf_hi(cv.x), bf_lo(cv.y), bf_hi(cv.y)}; const float q[4] = {bf_lo(pv.x), bf_hi(pv.x), bf_lo(pv.y), bf_hi(pv.y)};
#pragma unroll
                for (int e = 0; e < 4; ++e) c[e] = c[e] + (q[e] - c[e]) * m4[e];
                if (i == 0) *(f32x4*)(Rm + tl * 64 + ej) = (f32x4){c[0], c[1], c[2], c[3]};
                else if (i == 1) *(f32x4*)(Km + tl * 64 + ej) = (f32x4){c[0], c[1], c[2], c[3]};
                else if (i == 2) *(f32x4*)(Vm + tl * 64 + ej) = (f32x4){c[0], c[1], c[2], c[3]};
                else if (i == 3) { u32x2 o; o.x = cvt_pk_bf16(fast_tanh(c[0]), fast_tanh(c[1])); o.y = cvt_pk_bf16(fast_tanh(c[2]), fast_tanh(c[3])); *(u32x2*)(WLb + tl * 72 + ej) = o; }
                else { u32x2 o; o.x = cvt_pk_bf16(c[0], c[1]); o.y = cvt_pk_bf16(c[2], c[3]); *(u32x2*)(ALb + tl * 72 + ej) = o; } } }
        if (ch + 1 < SEQ / 32) rw_load(ch + 1);
        pbar4(pcnt, ptgt, lane);
#pragma unroll
        for (int mat = 0; mat < 2; ++mat)
#pragma unroll
            for (int ts = 0; ts < 2; ++ts) { const bf16_t* ap = (mat ? ALb : WLb) + (16 * ts + lq) * 72 + 8 * g;
                const bf16x8 a0f = *(const bf16x8*)ap, a1f = *(const bf16x8*)(ap + 32);
                f32x4 c = (f32x4){0.f, 0.f, 0.f, 0.f};
                c = __builtin_amdgcn_mfma_f32_16x16x32_bf16(a0f, bfr[mat][0], c, 0, 0, 0);
                c = __builtin_amdgcn_mfma_f32_16x16x32_bf16(a1f, bfr[mat][1], c, 0, 0, 0);
#pragma unroll
                for (int r = 0; r < 4; ++r) { const int tt = 16 * ts + 4 * g + r; const float x = lw0[mat] + c[r];
                    if (mat == 0) DEC[tt * 64 + csub * 16 + lq] = __expf(-0.60653066f * sigmoidf_(x));
                    else AA[tt * 64 + csub * 16 + lq] = sigmoidf_(x); } }
        pbar4(pcnt, ptgt, lane);
#pragma unroll
        for (int ps = 0; ps < 2; ++ps) { const int tl = e2t + 16 * ps;
            const f32x4 k4 = *(const f32x4*)(Km + tl * 64 + ej), a4 = *(const f32x4*)(AA + tl * 64 + ej), r4 = *(const f32x4*)(Rm + tl * 64 + ej);
            f32x4 kr, kt; float ss = 0.f, bo = 0.f;
#pragma unroll
            for (int e = 0; e < 4; ++e) { kr[e] = k4[e] * c_kk[e]; ss += kr[e] * kr[e]; kt[e] = k4[e] * (1.f + (a4[e] - 1.f) * c_ka[e]); bo += r4[e] * kt[e] * c_rk[e]; }
            ss = allred16(ss); bo = allred16(bo);
            const float inv = __builtin_amdgcn_rsqf(fmaxf(ss, 1e-24f));
            f32x4 kk4, b4;
#pragma unroll
            for (int e = 0; e < 4; ++e) { kk4[e] = kr[e] * inv; b4[e] = kk4[e] * a4[e]; }
            *(f32x4*)(Km + tl * 64 + ej) = kt; *(f32x4*)(KK + tl * 64 + ej) = kk4; *(f32x4*)(BB + tl * 64 + ej) = b4;
            if (half == 0 && (tid & 15) == 0) BONUS[(rowbase + ch * 32 + tl) * 8 + h] = bo; }
    };
    auto yraw_store = [&](int ch) {
#pragma unroll
        for (int ps = 0; ps < 2; ++ps)
#pragma unroll
            for (int q = 0; q < 2; ++q) { const int tl = e2t + 16 * ps, il = (tid & 15) + 16 * q;
                YRAW[(rowbase + ch * 32 + tl) * 512 + h * 64 + half * 32 + il] = (bf16_t)(cvt_pk_bf16(Yb[(ch & 1) * 1024 + tl * 32 + il], 0.f) & 0xFFFF); }
    };
    if (tid == 0) *pcnt = 0u;
    __syncthreads();
    if (wave >= 4) { rw_load(0); prep(0, SET0); }
    for (int ch = 0; ch < SEQ / 32; ++ch) {
        __syncthreads();
        if (wave < 4) {
            const float* SET = SET0 + (ch & 1) * SETF;
            const float* Rm = SET; const float* Km = SET + 2048; const float* Vm = SET + 4096; const float* DEC = SET + 6144; const float* KK = SET + 8192; const float* BB = SET + 10240;
            float* Yw = Yb + (ch & 1) * 1024;
            struct Ops { f32x4 w, k, q, b, r; float v0, v1; };
            auto ld = [&](Ops& o, int tt) { const int off = tt * 64 + lq * 4;
                o.w = *(const f32x4*)(DEC + off); o.k = *(const f32x4*)(Km + off); o.q = *(const f32x4*)(KK + off); o.b = *(const f32x4*)(BB + off); o.r = *(const f32x4*)(Rm + off);
                const float* vp = Vm + tt * 64 + irow; o.v0 = vp[0]; o.v1 = vp[1]; };
            auto step = [&](const Ops& o, int tt) {
                const f32x4 da = sA * o.q, db = sB * o.q; const f32x2_t ha = da.lo + da.hi, hb = db.lo + db.hi;
                float sa0 = ha.x + ha.y, sa1 = hb.x + hb.y;
                const f32x4 uA = sA * o.w + o.k * o.v0, uB = sB * o.w + o.k * o.v1;
                sa0 = -allred16(sa0); sa1 = -allred16(sa1);
                sA = uA + o.b * sa0; sB = uB + o.b * sa1;
                const f32x4 ea = sA * o.r, eb = sB * o.r; const f32x2_t ga = ea.lo + ea.hi, gb = eb.lo + eb.hi; float y0 = ga.x + ga.y, y1 = gb.x + gb.y;
                asm("" : "+v"(y0)); asm("" : "+v"(y1));
                y0 += dppf<0xB1>(y0); y1 += dppf<0xB1>(y1);
                float z = (lq & 1) ? y1 : y0;
                z += dppf<0x4E>(z); z += dppf<0x124>(z); z += dppf<0x128>(z);
                if (lq < 2) Yw[tt * 32 + (wave & 3) * 8 + g * 2 + lq] = z; };
            Ops oa, ob;
            ld(oa, 0);
            for (int tt = 0; tt < 32; tt += 4) {
                ld(ob, tt + 1);
                step(oa, tt);
                ld(oa, tt + 2);
                step(ob, tt + 1);
                ld(ob, tt + 3);
                step(oa, tt + 2);
                ld(oa, (tt + 4 < 32) ? tt + 4 : 31);
                step(ob, tt + 3);
            }
        } else {
            if (ch > 0) yraw_store(ch - 1);
            if (ch + 1 < SEQ / 32) prep(ch + 1, SET0 + ((ch + 1) & 1) * SETF);
        }
    }
    __syncthreads();
    if (wave >= 4) yraw_store(SEQ / 32 - 1);
    __syncthreads();
}

__device__ __forceinline__ void rw_post(const Params& p, int layer) {
    bf16_t* P = (bf16_t*)(p.ws + OFF_P); const bf16_t* YRAW = (const bf16_t*)(p.ws + OFF_YRAW);
    const float* BONUS = (const float*)(p.ws + OFF_BONUS); const float* SSQ = (const float*)(p.ws + OFF_SSQ); float* RSTD = (float*)(p.ws + OFF_RSTD);
    const float* mu = p.in[9] + layer * 2176; const float* lng = p.in[17] + layer * 512; const float* lnb = p.in[18] + layer * 512;
    const int gt = blockIdx.x * 512 + opaque_tid(), gs = gridDim.x * 512;
    {
        const int c = (gt & 127) * 4, h = c >> 6;
        const f32x4 muv = *(const f32x4*)(mu + 1024 + c), mug = *(const f32x4*)(mu + 1536 + c);
        const f32x4 lg = *(const f32x4*)(lng + c), lb = *(const f32x4*)(lnb + c);
        for (int idx0 = gt; idx0 < TOK * 128; idx0 += 4 * gs) {
            u32x2 yv[4], vc[4], gc[4], vp[4], gp[4]; float bn[4]; unsigned pm[4]; bool ok[4];
#pragma unroll
            for (int u = 0; u < 4; ++u) { const int idx = idx0 + u * gs; ok[u] = idx < TOK * 128; const int tok = ok[u] ? (idx >> 7) : 0;
                const bf16_t* cur = P + (size_t)tok * LDP + C_RW; const bool hp = (tok & (SEQ - 1)) > 0; const bf16_t* prv = hp ? cur - LDP : cur; pm[u] = hp ? 0xFFFFFFFFu : 0u;
                yv[u] = *(const u32x2*)(YRAW + (size_t)tok * 512 + c);
                vc[u] = *(const u32x2*)(cur + 1024 + c); gc[u] = *(const u32x2*)(cur + 1536 + c);
                vp[u] = *(const u32x2*)(prv + 1024 + c); gp[u] = *(const u32x2*)(prv + 1536 + c);
                bn[u] = BONUS[(size_t)tok * 8 + h]; }
#pragma unroll
            for (int u = 0; u < 4; ++u) { const int idx = idx0 + u * gs; const int tok = ok[u] ? (idx >> 7) : 0;
                float y[4] = {bf_lo(yv[u].x), bf_hi(yv[u].x), bf_lo(yv[u].y), bf_hi(yv[u].y)};
                const float mean = allred16(y[0] + y[1] + y[2] + y[3]) * (1.f / 64.f);
                float d[4], vs = 0.f;
#pragma unroll
                for (int e = 0; e < 4; ++e) { d[e] = y[e] - mean; vs += d[e] * d[e]; }
                const float var = allred16(vs) * (1.f / 64.f);
                const float rs = rsqrtf(var + 64e-5f);
                const unsigned m = pm[u];
                const float vcur[4] = {bf_lo(vc[u].x), bf_hi(vc[u].x), bf_lo(vc[u].y), bf_hi(vc[u].y)}, vprv[4] = {bf_lo(vp[u].x & m), bf_hi(vp[u].x & m), bf_lo(vp[u].y & m), bf_hi(vp[u].y & m)};
                const float gcur[4] = {bf_lo(gc[u].x), bf_hi(gc[u].x), bf_lo(gc[u].y), bf_hi(gc[u].y)}, gprv[4] = {bf_lo(gp[u].x & m), bf_hi(gp[u].x & m), bf_lo(gp[u].y & m), bf_hi(gp[u].y & m)};
                float o[4];
#pragma unroll
                for (int e = 0; e < 4; ++e) { const float vm = vcur[e] + (vprv[e] - vcur[e]) * muv[e], gm = gcur[e] + (gprv[e] - gcur[e]) * mug[e];
                    o[e] = (d[e] * rs * lg[e] + lb[e] + bn[u] * vm) * siluf_(gm); }
                u32x2 ov; ov.x = cvt_pk_bf16(o[0], o[1]); ov.y = cvt_pk_bf16(o[2], o[3]);
                if (ok[u]) *(u32x2*)(P + (size_t)tok * LDP + C_YRW + c) = ov; }
        }
    }
    for (int tok = gt; tok < TOK; tok += gs) { const f32x4* q = (const f32x4*)(SSQ + (size_t)tok * 32); float s = 0.f;
#pragma unroll
        for (int i = 0; i < 8; ++i) { const f32x4 v = q[i]; s += v[0] + v[1] + v[2] + v[3]; }
        RSTD[tok] = rsqrtf(s * (1.f / 1024.f) + 1e-6f); }
}

#define XB_TMO      128
#define XB_XCNT(j)  (256  + 64 * (j))
#define XB_XSUB(j)  (1280 + 64 * (j))
#define XB_XGEN(j)  (2304 + 64 * (j))
#define XB_TOP      3328
#define XB_TOPGEN   3392
#define XCD_BAR_WORDS 3456
#define XB_SPIN_CAP (1u << 18)
__device__ __forceinline__ unsigned xb_ld(unsigned* p)              { return __hip_atomic_load(p, __ATOMIC_RELAXED, __HIP_MEMORY_SCOPE_AGENT); }
__device__ __forceinline__ unsigned xb_add(unsigned* p, unsigned v) { return __hip_atomic_fetch_add(p, v, __ATOMIC_RELAXED, __HIP_MEMORY_SCOPE_AGENT); }
__device__ __forceinline__ unsigned xb_xcc_id() { return (unsigned)__builtin_amdgcn_s_getreg((3 << 11) | 20) & 0xFu; }
#define XB_SPIN(cond, bar) do { unsigned _sp = 0; while (cond) { __builtin_amdgcn_s_sleep(1); \
    if ((++_sp & 255u) == 0u) { if (xb_ld(&(bar)[XB_TMO])) break; if (_sp > XB_SPIN_CAP) { atomicAdd(&(bar)[XB_TMO], 1u); break; } } } } while (0)
struct XcdBarrier { unsigned* bar; unsigned x; volatile LAS unsigned* st; };
__device__ __forceinline__ XcdBarrier xcd_barrier_post(unsigned* bar, volatile LAS unsigned* st) {
    XcdBarrier b; b.bar = bar; b.x = xb_xcc_id(); b.st = st;
    if (threadIdx.x == 0) (void)xb_add(&bar[XB_XCNT(b.x)], 1u);
    return b;
}
__device__ __forceinline__ void xcd_barrier_complete(unsigned* bar, unsigned x, unsigned& nloc, unsigned& nx) {
    const unsigned G = gridDim.x * gridDim.y * gridDim.z;
    unsigned sum, cnt, mine, sp = 0u;
    for (;;) {
        sum = 0u; cnt = 0u; mine = 0u;
#pragma unroll
        for (unsigned j = 0; j < 16; ++j) { const unsigned c = xb_ld(&bar[XB_XCNT(j)]); sum += c; cnt += (c > 0u) ? 1u : 0u; mine = (j == x) ? c : mine; }
        if (sum == G) break;
        __builtin_amdgcn_s_sleep(1);
        if ((++sp & 255u) == 0u) { if (xb_ld(&bar[XB_TMO])) break; if (sp > XB_SPIN_CAP) { atomicAdd(&bar[XB_TMO], 1u); break; } }
    }
    nloc = mine > 0u ? mine : 1u; nx = cnt > 0u ? cnt : 1u;
}
__device__ __forceinline__ void xcd_barrier(const XcdBarrier& b) {
    asm volatile("s_waitcnt vmcnt(0)" ::: "memory");
    __syncthreads();
    if (threadIdx.x == 0) {
        unsigned* bar = b.bar;
        __builtin_amdgcn_s_waitcnt(0);
        unsigned nloc = b.st[0], nx = b.st[1];
        if (nloc == 0u) { xcd_barrier_complete(bar, b.x, nloc, nx); b.st[0] = nloc; b.st[1] = nx; }
        const unsigned old = xb_add(&bar[XB_XSUB(b.x)], 1u);
        const unsigned gen = old / nloc;
        if (old + 1u == (gen + 1u) * nloc) {
            __builtin_amdgcn_fence(__ATOMIC_RELEASE, "agent");
            asm volatile("s_waitcnt vmcnt(0)" ::: "memory");
            const unsigned og = xb_add(&bar[XB_TOP], 1u);
            const unsigned tg = og / nx;
            if (og + 1u == (tg + 1u) * nx) xb_add(&bar[XB_TOPGEN], 1u);
            else XB_SPIN(xb_ld(&bar[XB_TOPGEN]) == tg, bar);
            __builtin_amdgcn_fence(__ATOMIC_ACQUIRE, "agent");
            xb_add(&bar[XB_XGEN(b.x)], 1u);
            asm volatile("s_waitcnt vmcnt(0)" ::: "memory");
        } else {
            XB_SPIN(xb_ld(&bar[XB_XGEN(b.x)]) == gen, bar);
            __builtin_amdgcn_fence(__ATOMIC_ACQUIRE, "agent");
            asm volatile("s_waitcnt vmcnt(0)" ::: "memory");
        }
    }
    __syncthreads();
}

#define GSYNC() xcd_barrier(xb)
__global__ void __launch_bounds__(512, 2) mega(Params p) {
    extern __shared__ __attribute__((aligned(16))) unsigned char shm[];
    cg::grid_group grid = cg::this_grid();
    volatile LAS unsigned* xst = (volatile LAS unsigned*)((LAS unsigned char*)shm + LDS_BYTES - 16);
    if (threadIdx.x == 0) { xst[0] = 0u; xst[1] = 0u; }
    __syncthreads();
    const XcdBarrier xb = xcd_barrier_post((unsigned*)(p.ws + OFF_BAR), xst);
    const char* Pc = (const char*)(p.ws + OFF_P); const char* WTc = (const char*)(p.ws + OFF_WT);
    bf16_t* P = (bf16_t*)(p.ws + OFF_P);
    const int G = gridDim.x, c = blockIdx.x;
    for (int layer = 0; layer < 2; ++layer) {
        phase0(p, layer, shm);
        if (layer == 0) grid.sync(); else GSYNC();
        { SchedInproj S{Pc, WTc, G, c}; EpiInproj E{P}; pg8::gemm_phase<true>((LAS unsigned char*)shm, S, E); }
        GSYNC();
        { const int Gh = G >> 1;
            constexpr int ATT_B = 896;
            if (c < Gh) { for (int it = c; it < 128; it += Gh) rwkv_item(p, layer, shm, it);
                for (int it = ATT_B + c; it < 1024; it += Gh) attn_item(p, shm, it); }
            else { const int c2 = c - Gh;
                bc_prepass(p, layer, c2, G - Gh);
                asm volatile("s_waitcnt vmcnt(0)" ::: "memory");
                __syncthreads();
                if (threadIdx.x == 0) { unsigned* cw_ = (unsigned*)(p.ws + OFF_BAR) + 3520; const unsigned need = (unsigned)(G - Gh) * (unsigned)(layer + 1);
                    __builtin_amdgcn_fence(__ATOMIC_RELEASE, "agent"); asm volatile("s_waitcnt vmcnt(0)" ::: "memory");
                    (void)xb_add(cw_, 1u);
                    unsigned sp_ = 0; while (xb_ld(cw_) < need) { __builtin_amdgcn_s_sleep(2); if (++sp_ > (1u << 22)) break; }
                    __builtin_amdgcn_fence(__ATOMIC_ACQUIRE, "agent"); asm volatile("s_waitcnt vmcnt(0)" ::: "memory"); }
                __syncthreads();
                for (int it = c2; it < 256; it += Gh) ssd_item(p, layer, shm, it);
                for (int it = c2; it < ATT_B; it += Gh) attn_item(p, shm, it); } }
        GSYNC();
        rw_post(p, layer);
        GSYNC();
        { SchedC1 S{Pc, WTc, G, c}; EpiC1 E{P, (const float*)(p.ws + OFF_RSTD)}; pg8::gemm_phase<true>((LAS unsigned char*)shm, S, E); }
        GSYNC();
        { SchedOut S{Pc, WTc, G, c}; EpiOut E{layer == 0 ? p.in[0] : p.out, p.out}; pg8::gemm_phase<false>((LAS unsigned char*)shm, S, E); }
        GSYNC();
    }
    { const int tid = opaque_tid(), wave = tid >> 6, lane = tid & 63; const float* fg = p.in[23];
        for (int row = blockIdx.x * 8 + wave; row < TOK; row += gridDim.x * 8) { float* xr = p.out + (size_t)row * DM;
            f32x4 v[4]; float ss = 0.f;
#pragma unroll
            for (int i = 0; i < 4; ++i) { v[i] = *(const f32x4*)(xr + i * 256 + lane * 4); ss += v[i][0] * v[i][0] + v[i][1] * v[i][1] + v[i][2] * v[i][2] + v[i][3] * v[i][3]; }
            ss = wave_sum(ss);
            const float rs = rsqrtf(ss * (1.f / DM) + 1e-6f);
#pragma unroll
            for (int i = 0; i < 4; ++i) { const f32x4 g = *(const f32x4*)(fg + i * 256 + lane * 4); *(f32x4*)(xr + i * 256 + lane * 4) = v[i] * rs * g; } } }
}

extern "C" void kernel_launch(void* const* d_in, const int* in_sizes, int n_in, void* d_out, int out_size, void* d_ws, size_t ws_size, hipStream_t stream) {
    static int grid_blocks = 0;
    if (grid_blocks == 0) {
        if (n_in != 24 || out_size != TOK * DM || ws_size < WS_NEED) { fprintf(stderr, "kernel_launch: unexpected shapes (n_in %d out %d ws %zu need %zu)\n", n_in, out_size, ws_size, (size_t)WS_NEED); grid_blocks = -1; return; }
        int dev = 0, cus = 0, per_cu = 0;
        hipGetDevice(&dev);
        hipDeviceGetAttribute(&cus, hipDeviceAttributeMultiprocessorCount, dev);
        hipFuncSetAttribute((const void*)mega, hipFuncAttributeMaxDynamicSharedMemorySize, LDS_BYTES);
        hipOccupancyMaxActiveBlocksPerMultiprocessor(&per_cu, (const void*)mega, 512, LDS_BYTES);
        if (per_cu < 1) { fprintf(stderr, "kernel_launch: occupancy query says %d blocks per CU\n", per_cu); grid_blocks = -1; return; }
        if (per_cu > 1) per_cu = 1;
        grid_blocks = cus * per_cu;
        grid_blocks &= ~7;
    }
    if (grid_blocks < 0) return;
    Params p{};
    for (int i = 0; i < 24; ++i) p.in[i] = (const float*)d_in[i];
    p.out = (float*)d_out; p.ws = (unsigned char*)d_ws;
    (void)hipMemsetAsync((unsigned char*)d_ws + OFF_BAR, 0, SZ_BAR, stream);
    void* args[] = {&p};
    hipError_t e = hipLaunchCooperativeKernel((const void*)mega, dim3(grid_blocks), dim3(512), args, LDS_BYTES, stream);
    if (e != hipSuccess) fprintf(stderr, "cooperative launch failed: %s (grid %d)\n", hipGetErrorString(e), grid_blocks);
}
```

```cpp
#include <hip/hip_runtime.h>
#include <hip/hip_cooperative_groups.h>
#include <cstdio>
namespace cg = cooperative_groups;

#define LAS __attribute__((address_space(3)))
typedef unsigned short bf16_t;
typedef short bf16x8 __attribute__((ext_vector_type(8)));
typedef float f32x4 __attribute__((ext_vector_type(4)));
typedef unsigned u32x4 __attribute__((ext_vector_type(4)));
typedef unsigned u32x2 __attribute__((ext_vector_type(2)));

constexpr int TOK = 16384, SEQ = 2048, DM = 1024, NIN = 9616;
constexpr int LDP = 7680;
constexpr int C_Q = 0, C_K = 512, C_V = 1024, C_SBG = 1536, C_Z = 2048, C_XBC = 3072, C_RW = 4352, C_DT = 6528, C_H = 6656;
constexpr int C_M = 0, C_G = 3072, C_YRW = 4352;
constexpr int R_GATE = 6656, R_SB = 9728, R_SSD = 10752, R_RWO = 11776, R_WO = 12800, WT_ROWS = 13824;
constexpr size_t OFF_P = 0, SZ_P = (size_t)TOK * LDP * 2;
constexpr size_t OFF_WT = OFF_P + SZ_P, SZ_WT = (size_t)WT_ROWS * 1024 * 2;
constexpr size_t OFF_YRAW = OFF_WT + SZ_WT, SZ_YRAW = (size_t)TOK * 512 * 2;
constexpr size_t OFF_SSQ = OFF_YRAW + SZ_YRAW, SZ_SSQ = (size_t)TOK * 32 * 4;
constexpr size_t OFF_RSTD = OFF_SSQ + SZ_SSQ, SZ_RSTD = (size_t)TOK * 4;
constexpr size_t OFF_BONUS = OFF_RSTD + SZ_RSTD, SZ_BONUS = (size_t)TOK * 8 * 4;
constexpr size_t OFF_BAR = OFF_BONUS + SZ_BONUS, SZ_BAR = 16384;
constexpr size_t OFF_BCC = OFF_BAR + SZ_BAR, SZ_BCC = (size_t)TOK * 256 * 2;
constexpr size_t WS_NEED = OFF_BCC + SZ_BCC;
constexpr int LDS_BYTES = 135168;

struct Params { const float* in[24]; float* out; unsigned char* ws; };

typedef float f32x2_t __attribute__((ext_vector_type(2)));
typedef __bf16 bf16x2_t __attribute__((ext_vector_type(2)));
__device__ __forceinline__ unsigned cvt_pk_bf16(float lo, float hi) { const f32x2_t v = {lo, hi}; return __builtin_bit_cast(unsigned, __builtin_convertvector(v, bf16x2_t)); }
__device__ __forceinline__ float bf_lo(unsigned u) { return __uint_as_float(u << 16); }
__device__ __forceinline__ float bf_hi(unsigned u) { return __uint_as_float(u & 0xFFFF0000u); }
__device__ __forceinline__ float bf2f(bf16_t h) { return __uint_as_float(((unsigned)h) << 16); }
__device__ __forceinline__ float sigmoidf_(float x) { return __builtin_amdgcn_rcpf(1.f + __expf(-x)); }
__device__ __forceinline__ float siluf_(float x) { return x * __builtin_amdgcn_rcpf(1.f + __expf(-x)); }
__device__ __forceinline__ float softplusf_(float x) { return fmaxf(x, 0.f) + __logf(1.f + __expf(-fabsf(x))); }
template <int CTRL> __device__ __forceinline__ float dppf(float x) { return __int_as_float(__builtin_amdgcn_update_dpp(0, __float_as_int(x), CTRL, 0xF, 0xF, true)); }
__device__ __forceinline__ float allred16(float x) { x += dppf<0xB1>(x); x += dppf<0x4E>(x); x += dppf<0x141>(x); x += dppf<0x140>(x); return x; }
__device__ __forceinline__ int opaque_tid() { int t; asm volatile("v_mov_b32 %0, %1" : "=v"(t) : "v"((int)threadIdx.x)); return t; }
__device__ __forceinline__ float wave_sum(float v) {
#pragma unroll
    for (int o = 1; o < 64; o <<= 1) v += __shfl_xor(v, o);
    return v;
}

namespace pg8 {
constexpr int BM = 256, BK = 64, HALF = 128, HTB = HALF * BK * 2, NXCD = 8, WGM = 8;
constexpr unsigned LDA_B = LDP * 2, LDB_B = 2048;
__device__ __forceinline__ int lds_byte(int r, int c) { const int st = (r >> 4) * 2 + (c >> 5), rr = r & 15, cc = c & 31, ob = rr * 64 + cc * 2; return st * 1024 + (ob ^ (((ob >> 9) & 1) << 5)); }
__device__ __forceinline__ void stage_rc(int b, int& R, int& C) { const int st = b / 1024, sb = b % 1024, swz = sb ^ (((sb >> 9) & 1) << 5); R = (st >> 1) * 16 + swz / 64; C = (st & 1) * 32 + (swz % 64) / 2; }
__device__ __forceinline__ int perm32(int rho) { const int n = rho >> 4, i = rho & 15; return 8 * (i >> 2) + 4 * n + (i & 3); }
struct UnitD { const char* A; const char* B; int nt, pm, pn, kind; };
__device__ __forceinline__ void tile_of(int L, int nM, int nN, int& pm, int& pn) {
    const int nwg = nM * nN; int wgid = L;
    { const int q = nwg / NXCD, r = nwg % NXCD, xcd = wgid % NXCD, off = wgid / NXCD; wgid = (xcd < r ? xcd * (q + 1) : r * (q + 1) + (xcd - r) * q) + off; }
    const int nig = WGM * nN, gid = wgid / nig, fm = gid * WGM, gsz = (nM - fm) < WGM ? (nM - fm) : WGM;
    pm = fm + ((wgid % nig) % gsz); pn = (wgid % nig) / gsz;
}

template <bool PERM, class Sched, class Epi>
__device__ __forceinline__ void gemm_phase(LAS unsigned char* lds, const Sched& S, const Epi& E) {
    const int tid = opaque_tid(), wid = __builtin_amdgcn_readfirstlane(tid >> 6), lane = tid & 63, wr = wid >> 2, wc = wid & 3, fr = lane & 15, fq = lane >> 4;
    unsigned voffA[2], voffB[2];
#pragma unroll
    for (int i = 0; i < 2; ++i) { int R, C; stage_rc(tid * 16 + i * 8192, R, C); const int Rb = PERM ? ((R & ~31) + perm32(R & 31)) : R;
        voffA[i] = (unsigned)R * LDA_B + (unsigned)C * 2u; voffB[i] = (unsigned)Rb * LDB_B + (unsigned)C * 2u; }
    const size_t kstep = (size_t)(BK * 2);
    const size_t hstepA = (size_t)HALF * LDA_B, hstepB = (size_t)HALF * LDB_B;
    const unsigned ldsw = (unsigned)wid * 1024u;
    const int aoff = lds_byte(wr * 64 + fr, fq * 8), boff = lds_byte(wc * 32 + fr, fq * 8);
#define PG8_SA(b, h) (((b) * 2 + (h)) * HTB)
#define PG8_SB(b, h) ((4 + (b) * 2 + (h)) * HTB)
#define PG8_STAGE(bufoff, gbase, voff) do { _Pragma("unroll") for (int _i = 0; _i < 2; ++_i) \
        __builtin_amdgcn_global_load_lds((const unsigned*)((const char*)(gbase) + (voff)[_i]), (LAS unsigned*)(lds + (bufoff) + ldsw + _i * 8192), 16, 0, 0); } while (0)
#define PG8_LDA(dst, b, h) do { _Pragma("unroll") for (int m = 0; m < 4; ++m) _Pragma("unroll") for (int k = 0; k < 2; ++k) dst[m][k] = *(const LAS bf16x8*)(lds + PG8_SA(b, h) + aoff + m * 2048 + k * 1024); } while (0)
#define PG8_LDB(dst, b, h) do { _Pragma("unroll") for (int n = 0; n < 2; ++n) _Pragma("unroll") for (int k = 0; k < 2; ++k) dst[n][k] = *(const LAS bf16x8*)(lds + PG8_SB(b, h) + boff + n * 2048 + k * 1024); } while (0)
#define PG8_MMA(ai, bj, At, Bt) do { __builtin_amdgcn_s_setprio(1); _Pragma("unroll") for (int m = 0; m < 4; ++m) _Pragma("unroll") for (int n = 0; n < 2; ++n) _Pragma("unroll") for (int k = 0; k < 2; ++k) \
        acc[ai][bj][m][n] = __builtin_amdgcn_mfma_f32_16x16x32_bf16(Bt[n][k], At[m][k], acc[ai][bj][m][n], 0, 0, 0); __builtin_amdgcn_s_setprio(0); } while (0)
#define PG8_WAIT_V(n) asm volatile("s_waitcnt vmcnt(" #n ")" ::: "memory")
#define PG8_WAIT_L(n) asm volatile("s_waitcnt lgkmcnt(" #n ")" ::: "memory")
#define PG8_BAR __builtin_amdgcn_s_barrier()
#define PG8_SCHED __builtin_amdgcn_sched_barrier(0)
    UnitD cur, nxt; int ui = 0;
    if (!S.next(0, cur)) return;
    f32x4 acc[2][2][4][2];
#pragma unroll
    for (int a = 0; a < 2; ++a)
#pragma unroll
        for (int b = 0; b < 2; ++b)
#pragma unroll
            for (int m = 0; m < 4; ++m)
#pragma unroll
                for (int n = 0; n < 2; ++n) acc[a][b][m][n] = (f32x4){0.f, 0.f, 0.f, 0.f};
    bf16x8 At[4][2], B0[2][2], B1[2][2];
    const char* cA = cur.A; const char* cB = cur.B;
    PG8_STAGE(PG8_SB(0, 0), cB, voffB); PG8_STAGE(PG8_SA(0, 0), cA, voffA); PG8_STAGE(PG8_SB(0, 1), cB + hstepB, voffB); PG8_STAGE(PG8_SA(0, 1), cA + hstepA, voffA);
    if (wr == 1) PG8_BAR;
    PG8_WAIT_V(4); PG8_BAR;
    PG8_STAGE(PG8_SB(1, 0), cB + kstep, voffB); PG8_STAGE(PG8_SA(1, 0), cA + kstep, voffA); PG8_STAGE(PG8_SB(1, 1), cB + hstepB + kstep, voffB);
    PG8_WAIT_V(6); PG8_BAR;
    for (;;) {
        const bool has_next = S.next(ui + 1, nxt);
        const char* nA = has_next ? nxt.A : cA; const char* nB = has_next ? nxt.B : cB;
        const int nt = cur.nt;
        for (int t = 0; t < nt; t += 2) {
            const bool last = (t == nt - 2);
            const char* a1 = cA + (size_t)(t + 1) * kstep;
            const char* a2 = last ? nA : cA + (size_t)(t + 2) * kstep; const char* b2 = last ? nB : cB + (size_t)(t + 2) * kstep;
            const char* a3 = a2 + kstep; const char* b3 = b2 + kstep;
            PG8_LDB(B0, 0, 0); PG8_SCHED; PG8_LDA(At, 0, 0); PG8_STAGE(PG8_SA(1, 1), a1 + hstepA, voffA);
            PG8_WAIT_L(8); PG8_BAR; PG8_WAIT_L(0); PG8_MMA(0, 0, At, B0); PG8_BAR; PG8_SCHED;
            PG8_LDB(B1, 0, 1); PG8_STAGE(PG8_SB(0, 0), b2, voffB);
            PG8_BAR; PG8_WAIT_L(0); PG8_MMA(0, 1, At, B1); PG8_BAR;
            PG8_LDA(At, 0, 1); PG8_STAGE(PG8_SA(0, 0), a2, voffA);
            PG8_BAR; PG8_WAIT_L(0); PG8_MMA(1, 0, At, B0); PG8_BAR; PG8_SCHED;
            PG8_STAGE(PG8_SB(0, 1), b2 + hstepB, voffB);
            PG8_WAIT_V(6); PG8_BAR; PG8_MMA(1, 1, At, B1); PG8_BAR;
            PG8_LDB(B0, 1, 0); PG8_SCHED; PG8_LDA(At, 1, 0); PG8_STAGE(PG8_SA(0, 1), a2 + hstepA, voffA);
            PG8_WAIT_L(8); PG8_BAR; PG8_WAIT_L(0); PG8_MMA(0, 0, At, B0); PG8_BAR; PG8_SCHED;
            PG8_LDB(B1, 1, 1); PG8_STAGE(PG8_SB(1, 0), b3, voffB);
            PG8_BAR; PG8_WAIT_L(0); PG8_MMA(0, 1, At, B1); PG8_BAR;
            PG8_LDA(At, 1, 1); PG8_STAGE(PG8_SA(1, 0), a3, voffA);
            PG8_BAR; PG8_WAIT_L(0); PG8_MMA(1, 0, At, B0); PG8_BAR; PG8_SCHED;
            PG8_STAGE(PG8_SB(1, 1), b3 + hstepB, voffB);
            PG8_WAIT_V(6); PG8_BAR; PG8_MMA(1, 1, At, B1); PG8_BAR;
        }
        E(acc, cur, wr, wc, fr, fq);
        if (!has_next) break;
#pragma unroll
        for (int a = 0; a < 2; ++a)
#pragma unroll
            for (int b = 0; b < 2; ++b)
#pragma unroll
                for (int m = 0; m < 4; ++m)
#pragma unroll
                    for (int n = 0; n < 2; ++n) acc[a][b][m][n] = (f32x4){0.f, 0.f, 0.f, 0.f};
        cur = nxt; cA = nA; cB = nB; ++ui;
    }
    PG8_WAIT_V(0);
    if (wr == 0) PG8_BAR;
    PG8_BAR;
#undef PG8_SA
#undef PG8_SB
#undef PG8_STAGE
#undef PG8_LDA
#undef PG8_LDB
#undef PG8_MMA
#undef PG8_WAIT_V
#undef PG8_WAIT_L
#undef PG8_BAR
#undef PG8_SCHED
}
}
using pg8::UnitD;

struct SchedInproj {
    const char* P; const char* WT; int G, c;
    __device__ __forceinline__ bool next(int i, UnitD& u) const {
        const int L = i * G + c; if (L >= 64 * 26) return false;
        int pm, pn; pg8::tile_of(L, 64, 26, pm, pn);
        u.A = P + ((size_t)pm * 256 * LDP + C_H) * 2; u.B = WT + (size_t)pn * 256 * 2048; u.nt = 16; u.pm = pm; u.pn = pn; u.kind = 0; return true;
    }
};
struct EpiInproj {
    bf16_t* P;
    __device__ __forceinline__ void operator()(const f32x4 (&acc)[2][2][4][2], const UnitD& u, int wr, int wc, int fr, int fq) const {
        const int row0 = u.pm * 256 + wr * 64 + fr, col0 = u.pn * 256 + wc * 32 + 8 * fq;
#pragma unroll
        for (int ai = 0; ai < 2; ++ai)
#pragma unroll
            for (int m = 0; m < 4; ++m) { bf16_t* rowp = P + (size_t)(row0 + ai * 128 + m * 16) * LDP + col0;
#pragma unroll
                for (int bj = 0; bj < 2; ++bj) { const f32x4 v0 = acc[ai][bj][m][0], v1 = acc[ai][bj][m][1];
                    u32x4 o; o.x = cvt_pk_bf16(v0[0], v0[1]); o.y = cvt_pk_bf16(v0[2], v0[3]); o.z = cvt_pk_bf16(v1[0], v1[1]); o.w = cvt_pk_bf16(v1[2], v1[3]);
                    *(u32x4*)(rowp + bj * 128) = o; } }
    }
};
struct SchedC1 {
    const char* P; const char* WT; int G, c;
    __device__ __forceinline__ bool next(int i, UnitD& u) const {
        const int ti = i / 6, sub = i - ti * 6, L = ti * G + c; if (L >= 256) return false;
        int pm, pn; pg8::tile_of(L, 64, 4, pm, pn);
        const int br = sub >> 1;
        if (!(sub & 1)) { u.A = P + ((size_t)pm * 256 * LDP + C_H) * 2; u.B = WT + (size_t)(R_GATE + br * 1024 + pn * 256) * 2048; u.nt = 16; }
        else { const int acol = br == 0 ? C_SBG : (br == 1 ? C_Z : C_YRW); const int brow = br == 0 ? R_SB : (br == 1 ? R_SSD : R_RWO);
            u.A = P + ((size_t)pm * 256 * LDP + acol) * 2; u.B = WT + (size_t)(brow + pn * 256) * 2048; u.nt = br == 1 ? 16 : 8; }
        u.pm = pm; u.pn = pn; u.kind = sub; return true;
    }
};
struct EpiC1 {
    bf16_t* P; const float* rstd;
    __device__ __forceinline__ void operator()(const f32x4 (&acc)[2][2][4][2], const UnitD& u, int wr, int wc, int fr, int fq) const {
        const int row0 = u.pm * 256 + wr * 64 + fr, col0 = u.pn * 256 + wc * 32 + 8 * fq;
        const int kind = u.kind;
#pragma unroll
        for (int ai = 0; ai < 2; ++ai)
#pragma unroll
            for (int m = 0; m < 4; ++m) { const int row = row0 + ai * 128 + m * 16; bf16_t* rowp = P + (size_t)row * LDP + col0;
                const float sc = (kind == 3) ? rstd[row] : 1.f;
#pragma unroll
                for (int bj = 0; bj < 2; ++bj) { const f32x4 v0 = acc[ai][bj][m][0], v1 = acc[ai][bj][m][1];
                    float v[8] = {v0[0], v0[1], v0[2], v0[3], v1[0], v1[1], v1[2], v1[3]};
                    u32x4* gp = (u32x4*)(rowp + C_G + bj * 128); u32x4* mp = (u32x4*)(rowp + C_M + bj * 128);
                    if (!(kind & 1)) {
#pragma unroll
                        for (int e = 0; e < 8; ++e) v[e] = sigmoidf_(v[e]);
                        u32x4 o; o.x = cvt_pk_bf16(v[0], v[1]); o.y = cvt_pk_bf16(v[2], v[3]); o.z = cvt_pk_bf16(v[4], v[5]); o.w = cvt_pk_bf16(v[6], v[7]);
                        *gp = o;
                    } else {
                        const u32x4 g = *gp;
                        float r[8];
                        r[0] = bf_lo(g.x) * v[0] * sc; r[1] = bf_hi(g.x) * v[1] * sc; r[2] = bf_lo(g.y) * v[2] * sc; r[3] = bf_hi(g.y) * v[3] * sc;
                        r[4] = bf_lo(g.z) * v[4] * sc; r[5] = bf_hi(g.z) * v[5] * sc; r[6] = bf_lo(g.w) * v[6] * sc; r[7] = bf_hi(g.w) * v[7] * sc;
                        if (kind != 1) { const u32x4 mo = *mp;
                            r[0] += bf_lo(mo.x); r[1] += bf_hi(mo.x); r[2] += bf_lo(mo.y); r[3] += bf_hi(mo.y); r[4] += bf_lo(mo.z); r[5] += bf_hi(mo.z); r[6] += bf_lo(mo.w); r[7] += bf_hi(mo.w); }
                        u32x4 o; o.x = cvt_pk_bf16(r[0], r[1]); o.y = cvt_pk_bf16(r[2], r[3]); o.z = cvt_pk_bf16(r[4], r[5]); o.w = cvt_pk_bf16(r[6], r[7]);
                        *mp = o;
                    } } }
    }
};
struct SchedOut {
    const char* P; const char* WT; int G, c;
    __device__ __forceinline__ bool next(int i, UnitD& u) const {
        const int L = i * G + c; if (L >= 256) return false;
        int pm, pn; pg8::tile_of(L, 64, 4, pm, pn);
        u.A = P + ((size_t)pm * 256 * LDP + C_M) * 2; u.B = WT + (size_t)(R_WO + pn * 256) * 2048; u.nt = 16; u.pm = pm; u.pn = pn; u.kind = 0; return true;
    }
};
struct EpiOut {
    const float* Xin; float* Xout;
    __device__ __forceinline__ void operator()(const f32x4 (&acc)[2][2][4][2], const UnitD& u, int wr, int wc, int fr, int fq) const {
        const int row0 = u.pm * 256 + wr * 64 + fr, col0 = u.pn * 256 + wc * 32 + 4 * fq;
#pragma unroll
        for (int ai = 0; ai < 2; ++ai)
#pragma unroll
            for (int m = 0; m < 4; ++m) { const size_t ro = (size_t)(row0 + ai * 128 + m * 16) * DM + col0;
#pragma unroll
                for (int bj = 0; bj < 2; ++bj)
#pragma unroll
                    for (int n = 0; n < 2; ++n) { const f32x4 xi = *(const f32x4*)(Xin + ro + bj * 128 + n * 16); *(f32x4*)(Xout + ro + bj * 128 + n * 16) = xi + acc[ai][bj][m][n]; } }
    }
};

__device__ __forceinline__ void phase0(const Params& p, int layer, unsigned char* shm) {
    const int tid = opaque_tid(), wave = tid >> 6, lane = tid & 63;
    bf16_t* P = (bf16_t*)(p.ws + OFF_P); bf16_t* WT = (bf16_t*)(p.ws + OFF_WT);
    const float* Xin = layer == 0 ? p.in[0] : p.out;
    const float* ng = p.in[1] + layer * DM;
    f32x4 gn[4];
#pragma unroll
    for (int i = 0; i < 4; ++i) gn[i] = *(const f32x4*)(ng + i * 256 + lane * 4);
    for (int row0 = (blockIdx.x * 8 + wave) * 4; row0 < TOK; row0 += gridDim.x * 32) {
        f32x4 v[4][4]; float ss[4];
#pragma unroll
        for (int rr = 0; rr < 4; ++rr) { const float* xr = Xin + (size_t)(row0 + rr) * DM;
#pragma unroll
            for (int i = 0; i < 4; ++i) v[rr][i] = *(const f32x4*)(xr + i * 256 + lane * 4); }
#pragma unroll
        for (int rr = 0; rr < 4; ++rr) { float a = 0.f;
#pragma unroll
            for (int i = 0; i < 4; ++i) a += v[rr][i][0] * v[rr][i][0] + v[rr][i][1] * v[rr][i][1] + v[rr][i][2] * v[rr][i][2] + v[rr][i][3] * v[rr][i][3];
            ss[rr] = wave_sum(a); }
#pragma unroll
        for (int rr = 0; rr < 4; ++rr) { const float rs = rsqrtf(ss[rr] * (1.f / DM) + 1e-6f);
#pragma unroll
            for (int i = 0; i < 4; ++i) { const f32x4 g = gn[i];
                u32x2 o; o.x = cvt_pk_bf16(v[rr][i][0] * rs * g[0], v[rr][i][1] * rs * g[1]); o.y = cvt_pk_bf16(v[rr][i][2] * rs * g[2], v[rr][i][3] * rs * g[3]);
                *(u32x2*)(P + (size_t)(row0 + rr) * LDP + C_H + i * 256 + lane * 4) = o; } }
    }
    float* T = (float*)shm + wave * (64 * 65);
    const float* w_in = p.in[2] + (size_t)layer * DM * NIN;
    const float* sg = p.in[8] + layer * DM;
    for (int job = blockIdx.x * 8 + wave; job < 3200; job += gridDim.x * 8) {
        const float* src; int srcN, k0, n0, dstrow; bool is_in = false, is_ssd = false;
        if (job < 2432) { is_in = true; src = w_in; srcN = NIN; const int ntile = job >> 4; k0 = (job & 15) * 64; n0 = ntile * 64; dstrow = n0; }
        else { int r = job - 2432;
            if (r < 128) { src = p.in[19] + (size_t)layer * 512 * DM; k0 = (r >> 4) * 64; n0 = (r & 15) * 64; dstrow = R_SB + n0; }
            else if (r < 384) { r -= 128; src = p.in[20] + (size_t)layer * DM * DM; k0 = (r >> 4) * 64; n0 = (r & 15) * 64; dstrow = R_SSD + n0; is_ssd = true; }
            else if (r < 512) { r -= 384; src = p.in[21] + (size_t)layer * 512 * DM; k0 = (r >> 4) * 64; n0 = (r & 15) * 64; dstrow = R_RWO + n0; }
            else { r -= 512; src = p.in[22] + (size_t)layer * DM * DM; k0 = (r >> 4) * 64; n0 = (r & 15) * 64; dstrow = R_WO + n0; }
            srcN = DM; }
        const int n4 = (lane & 15) * 4, np = n0 + n4; int sc = np;
        if (is_in) { if (np < 4352) sc = np; else if (np < 6528) sc = np + 16; else if (np < 6544) sc = np - 6528 + 4352; else if (np < 6656) sc = -1; else sc = np - 112; }
        f32x4 v[16];
#pragma unroll
        for (int i = 0; i < 16; ++i) { const int k = (lane >> 4) + 4 * i; v[i] = (f32x4){0.f, 0.f, 0.f, 0.f};
            if (sc >= 0) v[i] = *(const f32x4*)(src + (size_t)(k0 + k) * srcN + sc); }
#pragma unroll
        for (int i = 0; i < 16; ++i) { const int k = (lane >> 4) + 4 * i; f32x4 x = v[i];
            if (is_ssd) x = x * sg[k0 + k];
            T[k * 65 + n4] = x[0]; T[k * 65 + n4 + 1] = x[1]; T[k * 65 + n4 + 2] = x[2]; T[k * 65 + n4 + 3] = x[3]; }
        asm volatile("s_waitcnt lgkmcnt(0)" ::: "memory"); __builtin_amdgcn_wave_barrier(); asm volatile("" ::: "memory");
#pragma unroll
        for (int j = 0; j < 8; ++j) { const int r = lane + 64 * j, n = r >> 3, kc = (r & 7) * 8; const float* sp = T + kc * 65 + n;
            u32x4 o; o.x = cvt_pk_bf16(sp[0], sp[65]); o.y = cvt_pk_bf16(sp[130], sp[195]); o.z = cvt_pk_bf16(sp[260], sp[325]); o.w = cvt_pk_bf16(sp[390], sp[455]);
            *(u32x4*)(WT + (size_t)(dstrow + n) * 1024 + k0 + kc) = o; }
        asm volatile("s_waitcnt lgkmcnt(0)" ::: "memory"); __builtin_amdgcn_wave_barrier(); asm volatile("" ::: "memory");
    }
    __syncthreads();
}

__device__ __forceinline__ void attn_item(const Params& p, unsigned char* shm, int item) {
    const int qb = item & 15, h = (item >> 4) & 7, b = item >> 7;
    bf16_t* P = (bf16_t*)(p.ws + OFF_P);
    const int tid = opaque_tid(), wave = tid >> 6, lane = tid & 63, lq = lane & 15, g = lane >> 4;
    const size_t rowbase = (size_t)b * SEQ;
    const int t = qb * 128 + wave * 16 + lq;
    const int tmax = qb * 128 + wave * 16 + 15;
    constexpr int ABUF = 64 * 144 + 64 * 136;
    const bf16_t* qp = P + (rowbase + t) * LDP + C_Q + h * 64 + 8 * g;
    const bf16x8 qf0 = *(const bf16x8*)qp, qf1 = *(const bf16x8*)(qp + 32);
    bf16x8 TT[4][2];
#pragma unroll
    for (int a = 0; a < 4; ++a)
#pragma unroll
        for (int ks = 0; ks < 2; ++ks)
#pragma unroll
            for (int e = 0; e < 8; ++e) { const int j = 16 * (2 * ks + (e >> 2)) + 4 * g + (e & 3); TT[a][ks][e] = (j > 16 * a + lq) ? (short)0x3F80 : (short)0; }
    f32x4 o[4];
#pragma unroll
    for (int i = 0; i < 4; ++i) o[i] = (f32x4){0.f, 0.f, 0.f, 0.f};
    float R = 0.f;
    LAS volatile int* flg = (LAS volatile int*)((LAS unsigned char*)shm + 2 * ABUF);
    const int st_s = tid >> 3, st_dc = (tid & 7) * 8;
    const bf16_t* st_base = P + (rowbase + st_s) * LDP + h * 64 + st_dc;
    auto stage_write = [&](unsigned char* buf, const u32x4& kv, const u32x4& vv) {
        bf16_t* Ksw = (bf16_t*)buf; bf16_t* Vtw = (bf16_t*)(buf + 64 * 144); const int s_ = st_s, dc = st_dc;
        *(u32x4*)(Ksw + s_ * 72 + dc) = kv;
        Vtw[(dc + 0) * 68 + s_] = (bf16_t)(vv.x & 0xFFFF); Vtw[(dc + 1) * 68 + s_] = (bf16_t)(vv.x >> 16);
        Vtw[(dc + 2) * 68 + s_] = (bf16_t)(vv.y & 0xFFFF); Vtw[(dc + 3) * 68 + s_] = (bf16_t)(vv.y >> 16);
        Vtw[(dc + 4) * 68 + s_] = (bf16_t)(vv.z & 0xFFFF); Vtw[(dc + 5) * 68 + s_] = (bf16_t)(vv.z >> 16);
        Vtw[(dc + 6) * 68 + s_] = (bf16_t)(vv.w & 0xFFFF); Vtw[(dc + 7) * 68 + s_] = (bf16_t)(vv.w >> 16);
    };
    if (tid == 0) { flg[0] = 1; flg[1] = 0; flg[2] = 0; }
    { const bf16_t* kr = st_base + (size_t)(2 * qb + 1) * 64 * LDP; const u32x4 kv0 = *(const u32x4*)(kr + C_K), vv0 = *(const u32x4*)(kr + C_V); stage_write(shm, kv0, vv0); }
    int itn = 0, cur = 0;
    for (int kt = 2 * qb + 1; kt >= 0; --kt) {
        __syncthreads();
        const int f0 = itn % 3, f1 = (itn + 1) % 3, f2 = (itn + 2) % 3;
        if (flg[f0] == 0) break;
        if (tid == 0) flg[f2] = 0;
        u32x4 kvn = (u32x4){0u, 0u, 0u, 0u}, vvn = (u32x4){0u, 0u, 0u, 0u};
        if (kt > 0) { const bf16_t* kr = st_base + (size_t)(kt - 1) * 64 * LDP; kvn = *(const u32x4*)(kr + C_K); vvn = *(const u32x4*)(kr + C_V); }
        const bf16_t* Ks = (const bf16_t*)(shm + cur * ABUF); const bf16_t* Vt = (const bf16_t*)(shm + cur * ABUF + 64 * 144);
        const bool walive = __any(R > -104.f);
        const bool act = (kt * 64 < tmax) && walive;
        if (act) {
            float lb[4][4], lk[4][4];
#pragma unroll
            for (int sub = 0; sub < 4; ++sub) {
                const bf16_t* kp = Ks + (16 * sub + lq) * 72 + 8 * g;
                const bf16x8 k0 = *(const bf16x8*)kp, k1 = *(const bf16x8*)(kp + 32);
                f32x4 s4 = (f32x4){0.f, 0.f, 0.f, 0.f};
                s4 = __builtin_amdgcn_mfma_f32_16x16x32_bf16(k0, qf0, s4, 0, 0, 0);
                s4 = __builtin_amdgcn_mfma_f32_16x16x32_bf16(k1, qf1, s4, 0, 0, 0);
#pragma unroll
                for (int r = 0; r < 4; ++r) { const float z = s4[r] * 0.125f; const bool mk = (kt * 64 + 16 * sub + 4 * g + r) < t;
                    const float l = fminf(z, 0.f) - 0.69314718f * __builtin_amdgcn_logf(1.f + __expf(-fabsf(z)));
                    lb[sub][r] = mk ? l : -1e30f; lk[sub][r] = mk ? (l - z) : 0.f; }
            }
            bf16x8 hi[2];
#pragma unroll
            for (int ks = 0; ks < 2; ++ks) {
                unsigned hw[4];
#pragma unroll
                for (int w2 = 0; w2 < 4; ++w2) { const int sub = 2 * ks + (w2 >> 1), r0 = (w2 & 1) * 2; const float a0 = lk[sub][r0], a1 = lk[sub][r0 + 1];
                    hw[w2] = cvt_pk_bf16(a0, a1); }
                u32x4 hv = (u32x4){hw[0], hw[1], hw[2], hw[3]};
                hi[ks] = __builtin_bit_cast(bf16x8, hv);
            }
            f32x4 aft[4];
#pragma unroll
            for (int a = 0; a < 4; ++a) { f32x4 c = (f32x4){0.f, 0.f, 0.f, 0.f};
#pragma unroll
                for (int ks = 0; ks < 2; ++ks) c = __builtin_amdgcn_mfma_f32_16x16x32_bf16(TT[a][ks], hi[ks], c, 0, 0, 0);
                aft[a] = c; }
            float tot = aft[0][0] + lk[0][0];
            tot = __shfl(tot, lq);
            bf16x8 pf[2];
#pragma unroll
            for (int ks = 0; ks < 2; ++ks) { unsigned pw[4];
#pragma unroll
                for (int w2 = 0; w2 < 4; ++w2) { const int sub = 2 * ks + (w2 >> 1), r0 = (w2 & 1) * 2;
                    const float e0 = __expf(lb[sub][r0] + aft[sub][r0] + R), e1 = __expf(lb[sub][r0 + 1] + aft[sub][r0 + 1] + R);
                    pw[w2] = cvt_pk_bf16(e0, e1); }
                u32x4 pv = (u32x4){pw[0], pw[1], pw[2], pw[3]}; pf[ks] = __builtin_bit_cast(bf16x8, pv); }
            R += tot;
#pragma unroll
            for (int ds = 0; ds < 4; ++ds)
#pragma unroll
                for (int ks = 0; ks < 2; ++ks) { const bf16_t* vp = Vt + (16 * ds + lq) * 68 + 32 * ks + 4 * g;
                    const u32x2 v0 = *(const u32x2*)vp, v1 = *(const u32x2*)(vp + 16);
                    u32x4 vv = (u32x4){v0.x, v0.y, v1.x, v1.y};
                    o[ds] = __builtin_amdgcn_mfma_f32_16x16x32_bf16(__builtin_bit_cast(bf16x8, vv), pf[ks], o[ds], 0, 0, 0); }
        }
        if (__any(R > -104.f) && lane == 0) flg[f1] = 1;
        if (kt > 0) stage_write(shm + (cur ^ 1) * ABUF, kvn, vvn);
        cur ^= 1; ++itn;
    }
#pragma unroll
    for (int ds = 0; ds < 4; ++ds) { bf16_t* gp = P + (rowbase + t) * LDP + C_SBG + h * 64 + 16 * ds + 4 * g;
        const u32x2 gv = *(const u32x2*)gp;
        u32x2 ov; ov.x = cvt_pk_bf16(o[ds][0] * siluf_(bf_lo(gv.x)), o[ds][1] * siluf_(bf_hi(gv.x))); ov.y = cvt_pk_bf16(o[ds][2] * siluf_(bf_lo(gv.y)), o[ds][3] * siluf_(bf_hi(gv.y)));
        *(u32x2*)gp = ov; }
    __syncthreads();
}

__device__ __forceinline__ void bc_prepass(const Params& p, int layer, int blk, int nblk) {
    const bf16_t* P = (const bf16_t*)(p.ws + OFF_P); bf16_t* BCc = (bf16_t*)(p.ws + OFF_BCC);
    const float* cw = p.in[3] + (size_t)layer * 4 * 1280; const float* cb = p.in[4] + layer * 1280;
    const int gt = blk * 512 + opaque_tid(), gs = nblk * 512;
    const int c = (gt & 63) * 4, chn = 1024 + c;
    const f32x4 bias = *(const f32x4*)(cb + chn);
    f32x4 w[4];
#pragma unroll
    for (int k = 0; k < 4; ++k) w[k] = *(const f32x4*)(cw + k * 1280 + chn);
    for (int idx0 = gt; idx0 < TOK * 64; idx0 += 4 * gs) {
        u32x2 xv[4][4]; bool ok[4];
#pragma unroll
        for (int u = 0; u < 4; ++u) { const int idx = idx0 + u * gs; ok[u] = idx < TOK * 64; const int tok = ok[u] ? (idx >> 6) : 0; const int t = tok & (SEQ - 1);
            const bf16_t* xp = P + (size_t)tok * LDP + C_XBC + chn;
#pragma unroll
            for (int k = 0; k < 4; ++k) { const int ts = t - 3 + k; const unsigned xm = ts >= 0 ? 0xFFFFFFFFu : 0u;
                u32x2 x = *(const u32x2*)(xp + (ptrdiff_t)(ts >= 0 ? k - 3 : 0) * LDP); x.x &= xm; x.y &= xm; xv[u][k] = x; } }
#pragma unroll
        for (int u = 0; u < 4; ++u) { const int idx = idx0 + u * gs; const int tok = ok[u] ? (idx >> 6) : 0;
            f32x4 a = bias;
#pragma unroll
            for (int k = 0; k < 4; ++k) { a[0] += w[k][0] * bf_lo(xv[u][k].x); a[1] += w[k][1] * bf_hi(xv[u][k].x); a[2] += w[k][2] * bf_lo(xv[u][k].y); a[3] += w[k][3] * bf_hi(xv[u][k].y); }
            u32x2 o; o.x = cvt_pk_bf16(siluf_(a[0]), siluf_(a[1])); o.y = cvt_pk_bf16(siluf_(a[2]), siluf_(a[3]));
            if (ok[u]) *(u32x2*)(BCc + (size_t)tok * 256 + c) = o; }
    }
}

__device__ __forceinline__ void ssd_item(const Params& p, int layer, unsigned char* shm, int item) {
    const int hh = item & 15, b = item >> 4, grp = hh >> 3;
    bf16_t* P = (bf16_t*)(p.ws + OFF_P); float* SSQ = (float*)(p.ws + OFF_SSQ);
    const int tid = opaque_tid(), wave = tid >> 6, lane = tid & 63, lq = lane & 15, g = lane >> 4;
    const size_t rowbase = (size_t)b * SEQ;
    const float* cw = p.in[3] + (size_t)layer * 4 * 1280; const float* cb = p.in[4] + layer * 1280;
    const float dtb = p.in[5][layer * 16 + hh], Aneg = -__expf(p.in[6][layer * 16 + hh]), Dsk = p.in[7][layer * 16 + hh];
    float* XS = (float*)shm;
    float* YS = XS + 4096;
    float* DTs = YS + 4096;
    float* ACS = DTs + 64;
    bf16_t* Cb = (bf16_t*)(ACS + 64);
    bf16_t* Bb = Cb + 64 * 72;
    bf16_t* BT = Bb + 64 * 72;
    bf16_t* Mx = BT + 64 * 72;
    bf16_t* XT = Mx + 64 * 72;
    bf16_t* XwT = XT + 64 * 72;
    bf16_t* SbT = XwT + 64 * 72;
    f32x4 Sacc[2] = {(f32x4){0.f, 0.f, 0.f, 0.f}, (f32x4){0.f, 0.f, 0.f, 0.f}};
    const bf16_t* BCc = (const bf16_t*)(p.ws + OFF_BCC);
    const int x_tt = tid >> 3, x_c = (tid & 7) * 4;
    const int bc_q = tid & 7;
    f32x4 xbias[2], xw[2][4];
#pragma unroll
    for (int h2 = 0; h2 < 2; ++h2) { const int chn = hh * 64 + x_c + 32 * h2; xbias[h2] = *(const f32x4*)(cb + chn);
#pragma unroll
        for (int k = 0; k < 4; ++k) xw[h2][k] = *(const f32x4*)(cw + k * 1280 + chn); }
    u32x2 sx[2][4]; u32x4 bc0, bc1; bf16_t sdt = 0;
    auto ssd_load = [&](int tb) {
        const int t = tb + x_tt;
#pragma unroll
        for (int h2 = 0; h2 < 2; ++h2) { const bf16_t* xp = P + (rowbase + t) * LDP + C_XBC + hh * 64 + x_c + 32 * h2;
#pragma unroll
            for (int k = 0; k < 4; ++k) { const int ts = t - 3 + k; const unsigned xm = ts >= 0 ? 0xFFFFFFFFu : 0u;
                u32x2 xv = *(const u32x2*)(xp + (ptrdiff_t)(ts >= 0 ? k - 3 : 0) * LDP); xv.x &= xm; xv.y &= xm; sx[h2][k] = xv; } }
        const bf16_t* bp = BCc + (rowbase + t) * 256 + (bc_q < 4 ? grp * 64 + bc_q * 16 : 128 + grp * 64 + (bc_q - 4) * 16);
        bc0 = *(const u32x4*)bp; bc1 = *(const u32x4*)(bp + 8);
        if (tid < 64) sdt = P[(rowbase + tb + tid) * LDP + C_DT + hh];
    };
    ssd_load(0);
    for (int ch = 0; ch < SEQ / 64; ++ch) {
        const int t0 = ch * 64;
        __syncthreads();
        const int o_tt = tid >> 3, o_p8 = (tid & 7) * 8;
        bf16_t* zp = P + (rowbase + t0 + o_tt) * LDP + C_Z + hh * 64 + o_p8;
        const u32x4 zv = *(const u32x4*)zp;
#pragma unroll
        for (int h2 = 0; h2 < 2; ++h2) { f32x4 a = xbias[h2];
#pragma unroll
            for (int k = 0; k < 4; ++k) { a[0] += xw[h2][k][0] * bf_lo(sx[h2][k].x); a[1] += xw[h2][k][1] * bf_hi(sx[h2][k].x); a[2] += xw[h2][k][2] * bf_lo(sx[h2][k].y); a[3] += xw[h2][k][3] * bf_hi(sx[h2][k].y); }
            a[0] = siluf_(a[0]); a[1] = siluf_(a[1]); a[2] = siluf_(a[2]); a[3] = siluf_(a[3]);
            const unsigned q0 = cvt_pk_bf16(a[0], a[1]), q1 = cvt_pk_bf16(a[2], a[3]); const int tt = x_tt, c = x_c + 32 * h2;
            *(f32x4*)(XS + tt * 64 + c) = a;
            XT[(c + 0) * 72 + tt] = (bf16_t)(q0 & 0xFFFF); XT[(c + 1) * 72 + tt] = (bf16_t)(q0 >> 16); XT[(c + 2) * 72 + tt] = (bf16_t)(q1 & 0xFFFF); XT[(c + 3) * 72 + tt] = (bf16_t)(q1 >> 16); }
        { const int tt = x_tt;
            if (bc_q < 4) { const int n = bc_q * 16; *(u32x4*)(Bb + tt * 72 + n) = bc0; *(u32x4*)(Bb + tt * 72 + n + 8) = bc1;
                const unsigned wv[8] = {bc0.x, bc0.y, bc0.z, bc0.w, bc1.x, bc1.y, bc1.z, bc1.w};
#pragma unroll
                for (int e = 0; e < 8; ++e) { BT[(n + 2 * e) * 72 + tt] = (bf16_t)(wv[e] & 0xFFFF); BT[(n + 2 * e + 1) * 72 + tt] = (bf16_t)(wv[e] >> 16); } }
            else { const int n = (bc_q - 4) * 16; *(u32x4*)(Cb + tt * 72 + n) = bc0; *(u32x4*)(Cb + tt * 72 + n + 8) = bc1; } }
        if (tid < 64) { const float dt = softplusf_(bf2f(sdt) + dtb); DTs[tid] = dt;
            float x = dt * Aneg;
#pragma unroll
            for (int o = 1; o < 64; o <<= 1) { const float v = __shfl_up(x, o); if (lane >= o) x += v; }
            ACS[tid] = x; }
        if (ch + 1 < SEQ / 64) ssd_load(t0 + 64);
        __syncthreads();
        const float acsL = ACS[63];
#pragma unroll
        for (int h2 = 0; h2 < 2; ++h2) { const int pp = (tid >> 4) + 32 * h2, s4 = (tid & 15) * 4; float v[4];
#pragma unroll
            for (int e = 0; e < 4; ++e) { const int sidx = s4 + e; v[e] = XS[sidx * 64 + pp] * DTs[sidx] * __expf(acsL - ACS[sidx]); }
            *(u32x2*)(XwT + pp * 72 + s4) = (u32x2){cvt_pk_bf16(v[0], v[1]), cvt_pk_bf16(v[2], v[3])}; }
#pragma unroll
        for (int h2 = 0; h2 < 2; ++h2) { const int pi = (wave >> 2) + 2 * h2, ni = wave & 3;
#pragma unroll
            for (int r = 0; r < 4; ++r) SbT[(16 * pi + 4 * g + r) * 72 + 16 * ni + lq] = (bf16_t)(cvt_pk_bf16(Sacc[h2][r], 0.f) & 0xFFFF); }
        { const int ti = wave >> 1;
#pragma unroll
            for (int sj = 0; sj < 2; ++sj) { const int si = 2 * (wave & 1) + sj;
                f32x4 acc = (f32x4){0.f, 0.f, 0.f, 0.f};
                if (si <= ti) {
                    const bf16_t* ap = Cb + (16 * ti + lq) * 72 + 8 * g; const bf16_t* bp = Bb + (16 * si + lq) * 72 + 8 * g;
                    acc = __builtin_amdgcn_mfma_f32_16x16x32_bf16(*(const bf16x8*)ap, *(const bf16x8*)bp, acc, 0, 0, 0);
                    acc = __builtin_amdgcn_mfma_f32_16x16x32_bf16(*(const bf16x8*)(ap + 32), *(const bf16x8*)(bp + 32), acc, 0, 0, 0);
                }
                const int sidx = 16 * si + lq; const float as = ACS[sidx], ds = DTs[sidx];
#pragma unroll
                for (int r = 0; r < 4; ++r) { const int t = 16 * ti + 4 * g + r; const float val = (sidx <= t) ? acc[r] * __expf(ACS[t] - as) * ds : 0.f;
                    Mx[t * 72 + sidx] = (bf16_t)(cvt_pk_bf16(val, 0.f) & 0xFFFF); } } }
        __syncthreads();
        { const int ti = wave >> 1;
            const bf16_t* ap = Mx + (16 * ti + lq) * 72 + 8 * g; const bf16_t* cp = Cb + (16 * ti + lq) * 72 + 8 * g;
            const bf16x8 mf0 = *(const bf16x8*)ap, mf1 = *(const bf16x8*)(ap + 32), cf0 = *(const bf16x8*)cp, cf1 = *(const bf16x8*)(cp + 32);
#pragma unroll
            for (int h2 = 0; h2 < 2; ++h2) { const int pi = (wave & 1) + 2 * h2;
                const bf16_t* bp = XT + (16 * pi + lq) * 72 + 8 * g; const bf16_t* sp = SbT + (16 * pi + lq) * 72 + 8 * g;
                f32x4 a1 = (f32x4){0.f, 0.f, 0.f, 0.f}, a2 = (f32x4){0.f, 0.f, 0.f, 0.f};
                a1 = __builtin_amdgcn_mfma_f32_16x16x32_bf16(mf0, *(const bf16x8*)bp, a1, 0, 0, 0);
                a1 = __builtin_amdgcn_mfma_f32_16x16x32_bf16(mf1, *(const bf16x8*)(bp + 32), a1, 0, 0, 0);
                a2 = __builtin_amdgcn_mfma_f32_16x16x32_bf16(cf0, *(const bf16x8*)sp, a2, 0, 0, 0);
                a2 = __builtin_amdgcn_mfma_f32_16x16x32_bf16(cf1, *(const bf16x8*)(sp + 32), a2, 0, 0, 0);
#pragma unroll
                for (int r = 0; r < 4; ++r) { const int t = 16 * ti + 4 * g + r, pc = 16 * pi + lq;
                    YS[t * 64 + pc] = a1[r] + __expf(ACS[t]) * a2[r] + Dsk * XS[t * 64 + pc]; } } }
        { const int ni = wave & 3; const float dl = __expf(acsL);
            const bf16_t* bp = BT + (16 * ni + lq) * 72 + 8 * g; const bf16x8 bf0 = *(const bf16x8*)bp, bf1 = *(const bf16x8*)(bp + 32);
#pragma unroll
            for (int h2 = 0; h2 < 2; ++h2) { const int pi = (wave >> 2) + 2 * h2;
                const bf16_t* ap = XwT + (16 * pi + lq) * 72 + 8 * g;
                f32x4 sa = Sacc[h2] * dl;
                sa = __builtin_amdgcn_mfma_f32_16x16x32_bf16(*(const bf16x8*)ap, bf0, sa, 0, 0, 0);
                sa = __builtin_amdgcn_mfma_f32_16x16x32_bf16(*(const bf16x8*)(ap + 32), bf1, sa, 0, 0, 0);
                Sacc[h2] = sa; } }
        __syncthreads();
        { const int tt = o_tt, p8 = o_p8; const f32x4 ya = *(const f32x4*)(YS + tt * 64 + p8), yb = *(const f32x4*)(YS + tt * 64 + p8 + 4);
            const float u0 = ya[0] * siluf_(bf_lo(zv.x)), u1 = ya[1] * siluf_(bf_hi(zv.x)), u2 = ya[2] * siluf_(bf_lo(zv.y)), u3 = ya[3] * siluf_(bf_hi(zv.y));
            const float u4 = yb[0] * siluf_(bf_lo(zv.z)), u5 = yb[1] * siluf_(bf_hi(zv.z)), u6 = yb[2] * siluf_(bf_lo(zv.w)), u7 = yb[3] * siluf_(bf_hi(zv.w));
            u32x4 ov; ov.x = cvt_pk_bf16(u0, u1); ov.y = cvt_pk_bf16(u2, u3); ov.z = cvt_pk_bf16(u4, u5); ov.w = cvt_pk_bf16(u6, u7); *(u32x4*)zp = ov;
            float q = (u0 * u0 + u1 * u1) + (u2 * u2 + u3 * u3) + (u4 * u4 + u5 * u5) + (u6 * u6 + u7 * u7);
            q += __shfl_xor(q, 1); q += __shfl_xor(q, 2); q += __shfl_xor(q, 4);
            if ((tid & 7) == 0) { SSQ[(rowbase + t0 + tt) * 32 + hh * 2] = q; SSQ[(rowbase + t0 + tt) * 32 + hh * 2 + 1] = 0.f; } }
    }
    __syncthreads();
}

__device__ __forceinline__ float fast_tanh(float x) { return 1.f - 2.f * __builtin_amdgcn_rcpf(1.f + __expf(2.f * x)); }
__device__ __forceinline__ void pbar4(LAS volatile unsigned* cnt, unsigned& tgt, int lane) {
    tgt += 4u;
    asm volatile("s_waitcnt lgkmcnt(0)" ::: "memory");
    if (lane == 0) __hip_atomic_fetch_add((LAS unsigned*)cnt, 1u, __ATOMIC_RELAXED, __HIP_MEMORY_SCOPE_WORKGROUP);
    while (*cnt < tgt) __builtin_amdgcn_s_sleep(1);
    asm volatile("" ::: "memory");
}
__device__ __forceinline__ void rwkv_item(const Params& p, int layer, unsigned char* shm, int item) {
    const int half = item & 1, h = (item >> 1) & 7, b = item >> 4;
    bf16_t* P = (bf16_t*)(p.ws + OFF_P); bf16_t* YRAW = (bf16_t*)(p.ws + OFF_YRAW); float* BONUS = (float*)(p.ws + OFF_BONUS);
    const int tid = opaque_tid(), wave = tid >> 6, lane = tid & 63, lq = lane & 15, g = lane >> 4;
    const size_t rowbase = (size_t)b * SEQ;
    const float* mu = p.in[9] + layer * 2176;
    const float* w0 = p.in[10] + layer * 512; const float* wup = p.in[11] + (size_t)layer * 64 * 512;
    const float* a0 = p.in[12] + layer * 512; const float* aup = p.in[13] + (size_t)layer * 64 * 512;
    const float* kkp = p.in[14] + layer * 512; const float* kap = p.in[15] + layer * 512; const float* rkp = p.in[16] + layer * 512;
    constexpr int SETF = 6 * 2048;
    float* SET0 = (float*)shm;
    float* AA = SET0 + 2 * SETF;
    float* Yb = AA + 2048;
    bf16_t* WLb = (bf16_t*)(Yb + 2048);
    bf16_t* ALb = WLb + 32 * 72;
    LAS volatile unsigned* pcnt = (LAS volatile unsigned*)((LAS unsigned char*)shm + (2 * SETF + 2048 + 2048) * 4 + 2 * 32 * 72 * 2);
    const int csub = wave & 3;
    bf16x8 bfr[2][2]; float lw0[2];
#pragma unroll
    for (int mat = 0; mat < 2; ++mat) { const float* up = (mat ? aup : wup) + h * 64 + csub * 16 + lq;
#pragma unroll
        for (int ks = 0; ks < 2; ++ks) { unsigned w[4];
#pragma unroll
            for (int e2 = 0; e2 < 4; ++e2) { const int m0 = 32 * ks + 8 * g + 2 * e2; w[e2] = cvt_pk_bf16(up[(size_t)m0 * 512], up[(size_t)(m0 + 1) * 512]); }
            u32x4 wv = (u32x4){w[0], w[1], w[2], w[3]}; bfr[mat][ks] = __builtin_bit_cast(bf16x8, wv); }
        lw0[mat] = (mat ? a0 : w0)[h * 64 + csub * 16 + lq]; }
    const int ej = (tid & 15) * 4;
    const f32x4 c_kk = *(const f32x4*)(kkp + h * 64 + ej), c_ka = *(const f32x4*)(kap + h * 64 + ej), c_rk = *(const f32x4*)(rkp + h * 64 + ej);
    const f32x4 mu_r = *(const f32x4*)(mu + h * 64 + ej), mu_k = *(const f32x4*)(mu + 512 + h * 64 + ej), mu_v = *(const f32x4*)(mu + 1024 + h * 64 + ej);
    const f32x4 mu_w = *(const f32x4*)(mu + 2048 + ej), mu_a = *(const f32x4*)(mu + 2112 + ej);
    f32x4 sA = (f32x4){0.f, 0.f, 0.f, 0.f}, sB = (f32x4){0.f, 0.f, 0.f, 0.f};
    const int irow = half * 32 + (wave & 3) * 8 + g * 2;
    unsigned ptgt = 0u;
    const int pm = tid - 256, e2t = pm >> 4;
    u32x2 cva[2][5], pva[2][5];
    auto rw_load = [&](int ch) {
#pragma unroll
        for (int ps = 0; ps < 2; ++ps) { const int tl = e2t + 16 * ps, t = ch * 32 + tl; const bf16_t* cur = P + (rowbase + t) * LDP + C_RW; const bool hp = t > 0; const bf16_t* prv = hp ? cur - LDP : cur;
#pragma unroll
            for (int i = 0; i < 5; ++i) { const int col = (i == 0 ? h * 64 : i == 1 ? 512 + h * 64 : i == 2 ? 1024 + h * 64 : i == 3 ? 2048 : 2112) + ej;
                cva[ps][i] = *(const u32x2*)(cur + col); pva[ps][i] = *(const u32x2*)(prv + col); } }
    };
    auto prep = [&](int ch, float* SET) {
        float* Rm = SET; float* Km = SET + 2048; float* Vm = SET + 4096; float* DEC = SET + 6144; float* KK = SET + 8192; float* BB = SET + 10240;
#pragma unroll
        for (int ps = 0; ps < 2; ++ps) { const int tl = e2t + 16 * ps, t = ch * 32 + tl; const unsigned pmask = t > 0 ? 0xFFFFFFFFu : 0u;
#pragma unroll
            for (int i = 0; i < 5; ++i) {
                const u32x2 cv = cva[ps][i]; u32x2 pv = pva[ps][i]; pv.x &= pmask; pv.y &= pmask;
                const f32x4 m4 = i == 0 ? mu_r : i == 1 ? mu_k : i == 2 ? mu_v : i == 3 ? mu_w : mu_a;
                float c[4] = {bf_lo(cv.x), bf_hi(cv.x), bf_lo(cv.y), bf_hi(cv.y)}; const float q[4] = {bf_lo(pv.x), bf_hi(pv.x), bf_lo(pv.y), bf_hi(pv.y)};
#pragma unroll
                for (int e = 0; e < 4; ++e) c[e] = c[e] + (q[e] - c[e]) * m4[e];
                if (i == 0) *(f32x4*)(Rm + tl * 64 + ej) = (f32x4){c[0], c[1], c[2], c[3]};
                else if (i == 1) *(f32x4*)(Km + tl * 64 + ej) = (f32x4){c[0], c[1], c[2], c[3]};
                else if (i == 2) *(f32x4*)(Vm + tl * 64 + ej) = (f32x4){c[0], c[1], c[2], c[3]};
                else if (i == 3) { u32x2 o; o.x = cvt_pk_bf16(fast_tanh(c[0]), fast_tanh(c[1])); o.y = cvt_pk_bf16(fast_tanh(c[2]), fast_tanh(c[3])); *(u32x2*)(WLb + tl * 72 + ej) = o; }
                else { u32x2 o; o.x = cvt_pk_bf16(c[0], c[1]); o.y = cvt_pk_bf16(c[2], c[3]); *(u32x2*)(ALb + tl * 72 + ej) = o; } } }
        if (ch + 1 < SEQ / 32) rw_load(ch + 1);
        pbar4(pcnt, ptgt, lane);
#pragma unroll
        for (int mat = 0; mat < 2; ++mat)
#pragma unroll
            for (int ts = 0; ts < 2; ++ts) { const bf16_t* ap = (mat ? ALb : WLb) + (16 * ts + lq) * 72 + 8 * g;
                const bf16x8 a0f = *(const bf16x8*)ap, a1f = *(const bf16x8*)(ap + 32);
                f32x4 c = (f32x4){0.f, 0.f, 0.f, 0.f};
                c = __builtin_amdgcn_mfma_f32_16x16x32_bf16(a0f, bfr[mat][0], c, 0, 0, 0);
                c = __builtin_amdgcn_mfma_f32_16x16x32_bf16(a1f, bfr[mat][1], c, 0, 0, 0);
#pragma unroll
                for (int r = 0; r < 4; ++r) { const int tt = 16 * ts + 4 * g + r; const float x = lw0[mat] + c[r];
                    if (mat == 0) DEC[tt * 64 + csub * 16 + lq] = __expf(-0.60653066f * sigmoidf_(x));
                    else AA[tt * 64 + csub * 16 + lq] = sigmoidf_(x); } }
        pbar4(pcnt, ptgt, lane);
#pragma unroll
        for (int ps = 0; ps < 2; ++ps) { const int tl = e2t + 16 * ps;
            const f32x4 k4 = *(const f32x4*)(Km + tl * 64 + ej), a4 = *(const f32x4*)(AA + tl * 64 + ej), r4 = *(const f32x4*)(Rm + tl * 64 + ej);
            f32x4 kr, kt; float ss = 0.f, bo = 0.f;
#pragma unroll
            for (int e = 0; e < 4; ++e) { kr[e] = k4[e] * c_kk[e]; ss += kr[e] * kr[e]; kt[e] = k4[e] * (1.f + (a4[e] - 1.f) * c_ka[e]); bo += r4[e] * kt[e] * c_rk[e]; }
            ss = allred16(ss); bo = allred16(bo);
            const float inv = __builtin_amdgcn_rsqf(fmaxf(ss, 1e-24f));
            f32x4 kk4, b4;
#pragma unroll
            for (int e = 0; e < 4; ++e) { kk4[e] = kr[e] * inv; b4[e] = kk4[e] * a4[e]; }
            *(f32x4*)(Km + tl * 64 + ej) = kt; *(f32x4*)(KK + tl * 64 + ej) = kk4; *(f32x4*)(BB + tl * 64 + ej) = b4;
            if (half == 0 && (tid & 15) == 0) BONUS[(rowbase + ch * 32 + tl) * 8 + h] = bo; }
    };
    auto yraw_store = [&](int ch) {
#pragma unroll
        for (int ps = 0; ps < 2; ++ps)
#pragma unroll
            for (int q = 0; q < 2; ++q) { const int tl = e2t + 16 * ps, il = (tid & 15) + 16 * q;
                YRAW[(rowbase + ch * 32 + tl) * 512 + h * 64 + half * 32 + il] = (bf16_t)(cvt_pk_bf16(Yb[(ch & 1) * 1024 + tl * 32 + il], 0.f) & 0xFFFF); }
    };
    if (tid == 0) *pcnt = 0u;
    __syncthreads();
    if (wave >= 4) { rw_load(0); prep(0, SET0); }
    for (int ch = 0; ch < SEQ / 32; ++ch) {
        __syncthreads();
        if (wave < 4) {
            const float* SET = SET0 + (ch & 1) * SETF;
            const float* Rm = SET; const float* Km = SET + 2048; const float* Vm = SET + 4096; const float* DEC = SET + 6144; const float* KK = SET + 8192; const float* BB = SET + 10240;
            float* Yw = Yb + (ch & 1) * 1024;
            struct Ops { f32x4 w, k, q, b, r; float v0, v1; };
            auto ld = [&](Ops& o, int tt) { const int off = tt * 64 + lq * 4;
                o.w = *(const f32x4*)(DEC + off); o.k = *(const f32x4*)(Km + off); o.q = *(const f32x4*)(KK + off); o.b = *(const f32x4*)(BB + off); o.r = *(const f32x4*)(Rm + off);
                const float* vp = Vm + tt * 64 + irow; o.v0 = vp[0]; o.v1 = vp[1]; };
            auto step = [&](const Ops& o, int tt) {
                const f32x4 da = sA * o.q, db = sB * o.q; const f32x2_t ha = da.lo + da.hi, hb = db.lo + db.hi;
                float sa0 = ha.x + ha.y, sa1 = hb.x + hb.y;
                const f32x4 uA = sA * o.w + o.k * o.v0, uB = sB * o.w + o.k * o.v1;
                sa0 = -allred16(sa0); sa1 = -allred16(sa1);
                sA = uA + o.b * sa0; sB = uB + o.b * sa1;
                const f32x4 ea = sA * o.r, eb = sB * o.r; const f32x2_t ga = ea.lo + ea.hi, gb = eb.lo + eb.hi; float y0 = ga.x + ga.y, y1 = gb.x + gb.y;
                asm("" : "+v"(y0)); asm("" : "+v"(y1));
                y0 += dppf<0xB1>(y0); y1 += dppf<0xB1>(y1);
                float z = (lq & 1) ? y1 : y0;
                z += dppf<0x4E>(z); z += dppf<0x124>(z); z += dppf<0x128>(z);
                if (lq < 2) Yw[tt * 32 + (wave & 3) * 8 + g * 2 + lq] = z; };
            Ops oa, ob;
            ld(oa, 0);
            for (int tt = 0; tt < 32; tt += 4) {
                ld(ob, tt + 1);
                step(oa, tt);
                ld(oa, tt + 2);
                step(ob, tt + 1);
                ld(ob, tt + 3);
                step(oa, tt + 2);
                ld(oa, (tt + 4 < 32) ? tt + 4 : 31);
                step(ob, tt + 3);
            }
        } else {
            if (ch > 0) yraw_store(ch - 1);
            if (ch + 1 < SEQ / 32) prep(ch + 1, SET0 + ((ch + 1) & 1) * SETF);
        }
    }
    __syncthreads();
    if (wave >= 4) yraw_store(SEQ / 32 - 1);
    __syncthreads();
}

__device__ __forceinline__ void rw_post(const Params& p, int layer) {
    bf16_t* P = (bf16_t*)(p.ws + OFF_P); const bf16_t* YRAW = (const bf16_t*)(p.ws + OFF_YRAW);
    const float* BONUS = (const float*)(p.ws + OFF_BONUS); const float* SSQ = (const float*)(p.ws + OFF_SSQ); float* RSTD = (float*)(p.ws + OFF_RSTD);
    const float* mu = p.in[9] + layer * 2176; const float* lng = p.in[17] + layer * 512; const float* lnb = p.in[18] + layer * 512;
    const int gt = blockIdx.x * 512 + opaque_tid(), gs = gridDim.x * 512;
    {
        const int c = (gt & 127) * 4, h = c >> 6;
        const f32x4 muv = *(const f32x4*)(mu + 1024 + c), mug = *(const f32x4*)(mu + 1536 + c);
        const f32x4 lg = *(const f32x4*)(lng + c), lb = *(const f32x4*)(lnb + c);
        for (int idx0 = gt; idx0 < TOK * 128; idx0 += 4 * gs) {
            u32x2 yv[4], vc[4], gc[4], vp[4], gp[4]; float bn[4]; unsigned pm[4]; bool ok[4];
#pragma unroll
            for (int u = 0; u < 4; ++u) { const int idx = idx0 + u * gs; ok[u] = idx < TOK * 128; const int tok = ok[u] ? (idx >> 7) : 0;
                const bf16_t* cur = P + (size_t)tok * LDP + C_RW; const bool hp = (tok & (SEQ - 1)) > 0; const bf16_t* prv = hp ? cur - LDP : cur; pm[u] = hp ? 0xFFFFFFFFu : 0u;
                yv[u] = *(const u32x2*)(YRAW + (size_t)tok * 512 + c);
                vc[u] = *(const u32x2*)(cur + 1024 + c); gc[u] = *(const u32x2*)(cur + 1536 + c);
                vp[u] = *(const u32x2*)(prv + 1024 + c); gp[u] = *(const u32x2*)(prv + 1536 + c);
                bn[u] = BONUS[(size_t)tok * 8 + h]; }
#pragma unroll
            for (int u = 0; u < 4; ++u) { const int idx = idx0 + u * gs; const int tok = ok[u] ? (idx >> 7) : 0;
                float y[4] = {bf_lo(yv[u].x), bf_hi(yv[u].x), bf_lo(yv[u].y), bf_hi(yv[u].y)};
                const float mean = allred16(y[0] + y[1] + y[2] + y[3]) * (1.f / 64.f);
                float d[4], vs = 0.f;
#pragma unroll
                for (int e = 0; e < 4; ++e) { d[e] = y[e] - mean; vs += d[e] * d[e]; }
                const float var = allred16(vs) * (1.f / 64.f);
                const float rs = rsqrtf(var + 64e-5f);
                const unsigned m = pm[u];
                const float vcur[4] = {bf_lo(vc[u].x), bf_hi(vc[u].x), bf_lo(vc[u].y), bf_hi(vc[u].y)}, vprv[4] = {bf_lo(vp[u].x & m), bf_hi(vp[u].x & m), bf_lo(vp[u].y & m), bf_hi(vp[u].y & m)};
                const float gcur[4] = {bf_lo(gc[u].x), bf_hi(gc[u].x), bf_lo(gc[u].y), bf_hi(gc[u].y)}, gprv[4] = {bf_lo(gp[u].x & m), bf_hi(gp[u].x & m), bf_lo(gp[u].y & m), bf_hi(gp[u].y & m)};
                float o[4];
#pragma unroll
                for (int e = 0; e < 4; ++e) { const float vm = vcur[e] + (vprv[e] - vcur[e]) * muv[e], gm = gcur[e] + (gprv[e] - gcur[e]) * mug[e];
                    o[e] = (d[e] * rs * lg[e] + lb[e] + bn[u] * vm) * siluf_(gm); }
                u32x2 ov; ov.x = cvt_pk_bf16(o[0], o[1]); ov.y = cvt_pk_bf16(o[2], o[3]);
                if (ok[u]) *(u32x2*)(P + (size_t)tok * LDP + C_YRW + c) = ov; }
        }
    }
    for (int tok = gt; tok < TOK; tok += gs) { const f32x4* q = (const f32x4*)(SSQ + (size_t)tok * 32); float s = 0.f;
#pragma unroll
        for (int i = 0; i < 8; ++i) { const f32x4 v = q[i]; s += v[0] + v[1] + v[2] + v[3]; }
        RSTD[tok] = rsqrtf(s * (1.f / 1024.f) + 1e-6f); }
}

#define XB_TMO      128
#define XB_XCNT(j)  (256  + 64 * (j))
#define XB_XSUB(j)  (1280 + 64 * (j))
#define XB_XGEN(j)  (2304 + 64 * (j))
#define XB_TOP      3328
#define XB_TOPGEN   3392
#define XCD_BAR_WORDS 3456
#define XB_SPIN_CAP (1u << 18)
__device__ __forceinline__ unsigned xb_ld(unsigned* p)              { return __hip_atomic_load(p, __ATOMIC_RELAXED, __HIP_MEMORY_SCOPE_AGENT); }
__device__ __forceinline__ unsigned xb_add(unsigned* p, unsigned v) { return __hip_atomic_fetch_add(p, v, __ATOMIC_RELAXED, __HIP_MEMORY_SCOPE_AGENT); }
__device__ __forceinline__ unsigned xb_xcc_id() { return (unsigned)__builtin_amdgcn_s_getreg((3 << 11) | 20) & 0xFu; }
#define XB_SPIN(cond, bar) do { unsigned _sp = 0; while (cond) { __builtin_amdgcn_s_sleep(1); \
    if ((++_sp & 255u) == 0u) { if (xb_ld(&(bar)[XB_TMO])) break; if (_sp > XB_SPIN_CAP) { atomicAdd(&(bar)[XB_TMO], 1u); break; } } } } while (0)
struct XcdBarrier { unsigned* bar; unsigned x; volatile LAS unsigned* st; };
__device__ __forceinline__ XcdBarrier xcd_barrier_post(unsigned* bar, volatile LAS unsigned* st) {
    XcdBarrier b; b.bar = bar; b.x = xb_xcc_id(); b.st = st;
    if (threadIdx.x == 0) (void)xb_add(&bar[XB_XCNT(b.x)], 1u);
    return b;
}
__device__ __forceinline__ void xcd_barrier_complete(unsigned* bar, unsigned x, unsigned& nloc, unsigned& nx) {
    const unsigned G = gridDim.x * gridDim.y * gridDim.z;
    unsigned sum, cnt, mine, sp = 0u;
    for (;;) {
        sum = 0u; cnt = 0u; mine = 0u;
#pragma unroll
        for (unsigned j = 0; j < 16; ++j) { const unsigned c = xb_ld(&bar[XB_XCNT(j)]); sum += c; cnt += (c > 0u) ? 1u : 0u; mine = (j == x) ? c : mine; }
        if (sum == G) break;
        __builtin_amdgcn_s_sleep(1);
        if ((++sp & 255u) == 0u) { if (xb_ld(&bar[XB_TMO])) break; if (sp > XB_SPIN_CAP) { atomicAdd(&bar[XB_TMO], 1u); break; } }
    }
    nloc = mine > 0u ? mine : 1u; nx = cnt > 0u ? cnt : 1u;
}
__device__ __forceinline__ void xcd_barrier(const XcdBarrier& b) {
    asm volatile("s_waitcnt vmcnt(0)" ::: "memory");
    __syncthreads();
    if (threadIdx.x == 0) {
        unsigned* bar = b.bar;
        __builtin_amdgcn_s_waitcnt(0);
        unsigned nloc = b.st[0], nx = b.st[1];
        if (nloc == 0u) { xcd_barrier_complete(bar, b.x, nloc, nx); b.st[0] = nloc; b.st[1] = nx; }
        const unsigned old = xb_add(&bar[XB_XSUB(b.x)], 1u);
        const unsigned gen = old / nloc;
        if (old + 1u == (gen + 1u) * nloc) {
            __builtin_amdgcn_fence(__ATOMIC_RELEASE, "agent");
            asm volatile("s_waitcnt vmcnt(0)" ::: "memory");
            const unsigned og = xb_add(&bar[XB_TOP], 1u);
            const unsigned tg = og / nx;
            if (og + 1u == (tg + 1u) * nx) xb_add(&bar[XB_TOPGEN], 1u);
            else XB_SPIN(xb_ld(&bar[XB_TOPGEN]) == tg, bar);
            __builtin_amdgcn_fence(__ATOMIC_ACQUIRE, "agent");
            xb_add(&bar[XB_XGEN(b.x)], 1u);
            asm volatile("s_waitcnt vmcnt(0)" ::: "memory");
        } else {
            XB_SPIN(xb_ld(&bar[XB_XGEN(b.x)]) == gen, bar);
            __builtin_amdgcn_fence(__ATOMIC_ACQUIRE, "agent");
            asm volatile("s_waitcnt vmcnt(0)" ::: "memory");
        }
    }
    __syncthreads();
}

#define GSYNC() xcd_barrier(xb)
__global__ void __launch_bounds__(512, 2) mega(Params p) {
    extern __shared__ __attribute__((aligned(16))) unsigned char shm[];
    cg::grid_group grid = cg::this_grid();
    volatile LAS unsigned* xst = (volatile LAS unsigned*)((LAS unsigned char*)shm + LDS_BYTES - 16);
    if (threadIdx.x == 0) { xst[0] = 0u; xst[1] = 0u; }
    __syncthreads();
    const XcdBarrier xb = xcd_barrier_post((unsigned*)(p.ws + OFF_BAR), xst);
    const char* Pc = (const char*)(p.ws + OFF_P); const char* WTc = (const char*)(p.ws + OFF_WT);
    bf16_t* P = (bf16_t*)(p.ws + OFF_P);
    const int G = gridDim.x, c = blockIdx.x;
    for (int layer = 0; layer < 2; ++layer) {
        phase0(p, layer, shm);
        if (layer == 0) grid.sync(); else GSYNC();
        { SchedInproj S{Pc, WTc, G, c}; EpiInproj E{P}; pg8::gemm_phase<true>((LAS unsigned char*)shm, S, E); }
        GSYNC();
        { const int Gh = G >> 1;
            constexpr int ATT_B = 896;
            if (c < Gh) { for (int it = c; it < 128; it += Gh) rwkv_item(p, layer, shm, it);
                for (int it = ATT_B + c; it < 1024; it += Gh) attn_item(p, shm, it); }
            else { const int c2 = c - Gh;
                bc_prepass(p, layer, c2, G - Gh);
                asm volatile("s_waitcnt vmcnt(0)" ::: "memory");
                __syncthreads();
                if (threadIdx.x == 0) { unsigned* cw_ = (unsigned*)(p.ws + OFF_BAR) + 3520; const unsigned need = (unsigned)(G - Gh) * (unsigned)(layer + 1);
                    __builtin_amdgcn_fence(__ATOMIC_RELEASE, "agent"); asm volatile("s_waitcnt vmcnt(0)" ::: "memory");
                    (void)xb_add(cw_, 1u);
                    unsigned sp_ = 0; while (xb_ld(cw_) < need) { __builtin_amdgcn_s_sleep(2); if (++sp_ > (1u << 22)) break; }
                    __builtin_amdgcn_fence(__ATOMIC_ACQUIRE, "agent"); asm volatile("s_waitcnt vmcnt(0)" ::: "memory"); }
                __syncthreads();
                for (int it = c2; it < 128; it += Gh) ssd_item(p, layer, shm, it);
                for (int it = c2; it < ATT_B; it += Gh) attn_item(p, shm, it); } }
        GSYNC();
        rw_post(p, layer);
        GSYNC();
        { SchedC1 S{Pc, WTc, G, c}; EpiC1 E{P, (const float*)(p.ws + OFF_RSTD)}; pg8::gemm_phase<true>((LAS unsigned char*)shm, S, E); }
        GSYNC();
        { SchedOut S{Pc, WTc, G, c}; EpiOut E{layer == 0 ? p.in[0] : p.out, p.out}; pg8::gemm_phase<false>((LAS unsigned char*)shm, S, E); }
        GSYNC();
    }
    { const int tid = opaque_tid(), wave = tid >> 6, lane = tid & 63; const float* fg = p.in[23];
        for (int row = blockIdx.x * 8 + wave; row < TOK; row += gridDim.x * 8) { float* xr = p.out + (size_t)row * DM;
            f32x4 v[4]; float ss = 0.f;
#pragma unroll
            for (int i = 0; i < 4; ++i) { v[i] = *(const f32x4*)(xr + i * 256 + lane * 4); ss += v[i][0] * v[i][0] + v[i][1] * v[i][1] + v[i][2] * v[i][2] + v[i][3] * v[i][3]; }
            ss = wave_sum(ss);
            const float rs = rsqrtf(ss * (1.f / DM) + 1e-6f);
#pragma unroll
            for (int i = 0; i < 4; ++i) { const f32x4 g = *(const f32x4*)(fg + i * 256 + lane * 4); *(f32x4*)(xr + i * 256 + lane * 4) = v[i] * rs * g; } } }
}

extern "C" void kernel_launch(void* const* d_in, const int* in_sizes, int n_in, void* d_out, int out_size, void* d_ws, size_t ws_size, hipStream_t stream) {
    static int grid_blocks = 0;
    if (grid_blocks == 0) {
        if (n_in != 24 || out_size != TOK * DM || ws_size < WS_NEED) { fprintf(stderr, "kernel_launch: unexpected shapes (n_in %d out %d ws %zu need %zu)\n", n_in, out_size, ws_size, (size_t)WS_NEED); grid_blocks = -1; return; }
        int dev = 0, cus = 0, per_cu = 0;
        hipGetDevice(&dev);
        hipDeviceGetAttribute(&cus, hipDeviceAttributeMultiprocessorCount, dev);
        hipFuncSetAttribute((const void*)mega, hipFuncAttributeMaxDynamicSharedMemorySize, LDS_BYTES);
        hipOccupancyMaxActiveBlocksPerMultiprocessor(&per_cu, (const void*)mega, 512, LDS_BYTES);
        if (per_cu < 1) { fprintf(stderr, "kernel_launch: occupancy query says %d blocks per CU\n", per_cu); grid_blocks = -1; return; }
        if (per_cu > 1) per_cu = 1;
        grid_blocks = cus * per_cu;
        grid_blocks &= ~7;
    }
    if (grid_blocks < 0) return;
    Params p{};
    for (int i = 0; i < 24; ++i) p.in[i] = (const float*)d_in[i];
    p.out = (float*)d_out; p.ws = (unsigned char*)d_ws;
    (void)hipMemsetAsync((unsigned char*)d_ws + OFF_BAR, 0, SZ_BAR, stream);
    void* args[] = {&p};
    hipError_t e = hipLaunchCooperativeKernel((const void*)mega, dim3(grid_blocks), dim3(512), args, LDS_BYTES, stream);
    if (e != hipSuccess) fprintf(stderr, "cooperative launch failed: %s (grid %d)\n", hipGetErrorString(e), grid_blocks);
}
```

```cpp
#include <hip/hip_runtime.h>
#include <hip/hip_cooperative_groups.h>
#include <cstdio>
namespace cg = cooperative_groups;

#define LAS __attribute__((address_space(3)))
typedef unsigned short bf16_t;
typedef short bf16x8 __attribute__((ext_vector_type(8)));
typedef float f32x4 __attribute__((ext_vector_type(4)));
typedef unsigned u32x4 __attribute__((ext_vector_type(4)));
typedef unsigned u32x2 __attribute__((ext_vector_type(2)));

constexpr int TOK = 16384, SEQ = 2048, DM = 1024, NIN = 9616;
constexpr int LDP = 7680;
constexpr int C_Q = 0, C_K = 512, C_V = 1024, C_SBG = 1536, C_Z = 2048, C_XBC = 3072, C_RW = 4352, C_DT = 6528, C_H = 6656;
constexpr int C_M = 0, C_G = 3072, C_YRW = 4352;
constexpr int R_GATE = 6656, R_SB = 9728, R_SSD = 10752, R_RWO = 11776, R_WO = 12800, WT_ROWS = 13824;
constexpr size_t OFF_P = 0, SZ_P = (size_t)TOK * LDP * 2;
constexpr size_t OFF_WT = OFF_P + SZ_P, SZ_WT = (size_t)WT_ROWS * 1024 * 2;
constexpr size_t OFF_YRAW = OFF_WT + SZ_WT, SZ_YRAW = (size_t)TOK * 512 * 2;
constexpr size_t OFF_SSQ = OFF_YRAW + SZ_YRAW, SZ_SSQ = (size_t)TOK * 32 * 4;
constexpr size_t OFF_RSTD = OFF_SSQ + SZ_SSQ, SZ_RSTD = (size_t)TOK * 4;
constexpr size_t OFF_BONUS = OFF_RSTD + SZ_RSTD, SZ_BONUS = (size_t)TOK * 8 * 4;
constexpr size_t OFF_BAR = OFF_BONUS + SZ_BONUS, SZ_BAR = 16384;
constexpr size_t OFF_BCC = OFF_BAR + SZ_BAR, SZ_BCC = (size_t)TOK * 256 * 2;
constexpr size_t WS_NEED = OFF_BCC + SZ_BCC;
constexpr int LDS_BYTES = 135168;

struct Params { const float* in[24]; float* out; unsigned char* ws; };

typedef float f32x2_t __attribute__((ext_vector_type(2)));
typedef __bf16 bf16x2_t __attribute__((ext_vector_type(2)));
__device__ __forceinline__ unsigned cvt_pk_bf16(float lo, float hi) { const f32x2_t v = {lo, hi}; return __builtin_bit_cast(unsigned, __builtin_convertvector(v, bf16x2_t)); }
__device__ __forceinline__ float bf_lo(unsigned u) { return __uint_as_float(u << 16); }
__device__ __forceinline__ float bf_hi(unsigned u) { return __uint_as_float(u & 0xFFFF0000u); }
__device__ __forceinline__ float bf2f(bf16_t h) { return __uint_as_float(((unsigned)h) << 16); }
__device__ __forceinline__ float sigmoidf_(float x) { return __builtin_amdgcn_rcpf(1.f + __expf(-x)); }
__device__ __forceinline__ float siluf_(float x) { return x * __builtin_amdgcn_rcpf(1.f + __expf(-x)); }
__device__ __forceinline__ float softplusf_(float x) { return fmaxf(x, 0.f) + __logf(1.f + __expf(-fabsf(x))); }
template <int CTRL> __device__ __forceinline__ float dppf(float x) { return __int_as_float(__builtin_amdgcn_update_dpp(0, __float_as_int(x), CTRL, 0xF, 0xF, true)); }
__device__ __forceinline__ float allred16(float x) { x += dppf<0xB1>(x); x += dppf<0x4E>(x); x += dppf<0x141>(x); x += dppf<0x140>(x); return x; }
__device__ __forceinline__ int opaque_tid() { int t; asm volatile("v_mov_b32 %0, %1" : "=v"(t) : "v"((int)threadIdx.x)); return t; }
__device__ __forceinline__ float wave_sum(float v) {
#pragma unroll
    for (int o = 1; o < 64; o <<= 1) v += __shfl_xor(v, o);
    return v;
}

namespace pg8 {
constexpr int BM = 256, BK = 64, HALF = 128, HTB = HALF * BK * 2, NXCD = 8, WGM = 8;
constexpr unsigned LDA_B = LDP * 2, LDB_B = 2048;
__device__ __forceinline__ int lds_byte(int r, int c) { const int st = (r >> 4) * 2 + (c >> 5), rr = r & 15, cc = c & 31, ob = rr * 64 + cc * 2; return st * 1024 + (ob ^ (((ob >> 9) & 1) << 5)); }
__device__ __forceinline__ void stage_rc(int b, int& R, int& C) { const int st = b / 1024, sb = b % 1024, swz = sb ^ (((sb >> 9) & 1) << 5); R = (st >> 1) * 16 + swz / 64; C = (st & 1) * 32 + (swz % 64) / 2; }
__device__ __forceinline__ int perm32(int rho) { const int n = rho >> 4, i = rho & 15; return 8 * (i >> 2) + 4 * n + (i & 3); }
struct UnitD { const char* A; const char* B; int nt, pm, pn, kind; };
__device__ __forceinline__ void tile_of(int L, int nM, int nN, int& pm, int& pn) {
    const int nwg = nM * nN; int wgid = L;
    { const int q = nwg / NXCD, r = nwg % NXCD, xcd = wgid % NXCD, off = wgid / NXCD; wgid = (xcd < r ? xcd * (q + 1) : r * (q + 1) + (xcd - r) * q) + off; }
    const int nig = WGM * nN, gid = wgid / nig, fm = gid * WGM, gsz = (nM - fm) < WGM ? (nM - fm) : WGM;
    pm = fm + ((wgid % nig) % gsz); pn = (wgid % nig) / gsz;
}

template <bool PERM, class Sched, class Epi>
__device__ __forceinline__ void gemm_phase(LAS unsigned char* lds, const Sched& S, const Epi& E) {
    const int tid = opaque_tid(), wid = __builtin_amdgcn_readfirstlane(tid >> 6), lane = tid & 63, wr = wid >> 2, wc = wid & 3, fr = lane & 15, fq = lane >> 4;
    unsigned voffA[2], voffB[2];
#pragma unroll
    for (int i = 0; i < 2; ++i) { int R, C; stage_rc(tid * 16 + i * 8192, R, C); const int Rb = PERM ? ((R & ~31) + perm32(R & 31)) : R;
        voffA[i] = (unsigned)R * LDA_B + (unsigned)C * 2u; voffB[i] = (unsigned)Rb * LDB_B + (unsigned)C * 2u; }
    const size_t kstep = (size_t)(BK * 2);
    const size_t hstepA = (size_t)HALF * LDA_B, hstepB = (size_t)HALF * LDB_B;
    const unsigned ldsw = (unsigned)wid * 1024u;
    const int aoff = lds_byte(wr * 64 + fr, fq * 8), boff = lds_byte(wc * 32 + fr, fq * 8);
#define PG8_SA(b, h) (((b) * 2 + (h)) * HTB)
#define PG8_SB(b, h) ((4 + (b) * 2 + (h)) * HTB)
#define PG8_STAGE(bufoff, gbase, voff) do { _Pragma("unroll") for (int _i = 0; _i < 2; ++_i) \
        __builtin_amdgcn_global_load_lds((const unsigned*)((const char*)(gbase) + (voff)[_i]), (LAS unsigned*)(lds + (bufoff) + ldsw + _i * 8192), 16, 0, 0); } while (0)
#define PG8_LDA(dst, b, h) do { _Pragma("unroll") for (int m = 0; m < 4; ++m) _Pragma("unroll") for (int k = 0; k < 2; ++k) dst[m][k] = *(const LAS bf16x8*)(lds + PG8_SA(b, h) + aoff + m * 2048 + k * 1024); } while (0)
#define PG8_LDB(dst, b, h) do { _Pragma("unroll") for (int n = 0; n < 2; ++n) _Pragma("unroll") for (int k = 0; k < 2; ++k) dst[n][k] = *(const LAS bf16x8*)(lds + PG8_SB(b, h) + boff + n * 2048 + k * 1024); } while (0)
#define PG8_MMA(ai, bj, At, Bt) do { __builtin_amdgcn_s_setprio(1); _Pragma("unroll") for (int m = 0; m < 4; ++m) _Pragma("unroll") for (int n = 0; n < 2; ++n) _Pragma("unroll") for (int k = 0; k < 2; ++k) \
        acc[ai][bj][m][n] = __builtin_amdgcn_mfma_f32_16x16x32_bf16(Bt[n][k], At[m][k], acc[ai][bj][m][n], 0, 0, 0); __builtin_amdgcn_s_setprio(0); } while (0)
#define PG8_WAIT_V(n) asm volatile("s_waitcnt vmcnt(" #n ")" ::: "memory")
#define PG8_WAIT_L(n) asm volatile("s_waitcnt lgkmcnt(" #n ")" ::: "memory")
#define PG8_BAR __builtin_amdgcn_s_barrier()
#define PG8_SCHED __builtin_amdgcn_sched_barrier(0)
    UnitD cur, nxt; int ui = 0;
    if (!S.next(0, cur)) return;
    f32x4 acc[2][2][4][2];
#pragma unroll
    for (int a = 0; a < 2; ++a)
#pragma unroll
        for (int b = 0; b < 2; ++b)
#pragma unroll
            for (int m = 0; m < 4; ++m)
#pragma unroll
                for (int n = 0; n < 2; ++n) acc[a][b][m][n] = (f32x4){0.f, 0.f, 0.f, 0.f};
    bf16x8 At[4][2], B0[2][2], B1[2][2];
    const char* cA = cur.A; const char* cB = cur.B;
    PG8_STAGE(PG8_SB(0, 0), cB, voffB); PG8_STAGE(PG8_SA(0, 0), cA, voffA); PG8_STAGE(PG8_SB(0, 1), cB + hstepB, voffB); PG8_STAGE(PG8_SA(0, 1), cA + hstepA, voffA);
    if (wr == 1) PG8_BAR;
    PG8_WAIT_V(4); PG8_BAR;
    PG8_STAGE(PG8_SB(1, 0), cB + kstep, voffB); PG8_STAGE(PG8_SA(1, 0), cA + kstep, voffA); PG8_STAGE(PG8_SB(1, 1), cB + hstepB + kstep, voffB);
    PG8_WAIT_V(6); PG8_BAR;
    for (;;) {
        const bool has_next = S.next(ui + 1, nxt);
        const char* nA = has_next ? nxt.A : cA; const char* nB = has_next ? nxt.B : cB;
        const int nt = cur.nt;
        for (int t = 0; t < nt; t += 2) {
            const bool last = (t == nt - 2);
            const char* a1 = cA + (size_t)(t + 1) * kstep;
            const char* a2 = last ? nA : cA + (size_t)(t + 2) * kstep; const char* b2 = last ? nB : cB + (size_t)(t + 2) * kstep;
            const char* a3 = a2 + kstep; const char* b3 = b2 + kstep;
            PG8_LDB(B0, 0, 0); PG8_SCHED; PG8_LDA(At, 0, 0); PG8_STAGE(PG8_SA(1, 1), a1 + hstepA, voffA);
            PG8_WAIT_L(8); PG8_BAR; PG8_WAIT_L(0); PG8_MMA(0, 0, At, B0); PG8_BAR; PG8_SCHED;
            PG8_LDB(B1, 0, 1); PG8_STAGE(PG8_SB(0, 0), b2, voffB);
            PG8_BAR; PG8_WAIT_L(0); PG8_MMA(0, 1, At, B1); PG8_BAR;
            PG8_LDA(At, 0, 1); PG8_STAGE(PG8_SA(0, 0), a2, voffA);
            PG8_BAR; PG8_WAIT_L(0); PG8_MMA(1, 0, At, B0); PG8_BAR; PG8_SCHED;
            PG8_STAGE(PG8_SB(0, 1), b2 + hstepB, voffB);
            PG8_WAIT_V(6); PG8_BAR; PG8_MMA(1, 1, At, B1); PG8_BAR;
            PG8_LDB(B0, 1, 0); PG8_SCHED; PG8_LDA(At, 1, 0); PG8_STAGE(PG8_SA(0, 1), a2 + hstepA, voffA);
            PG8_WAIT_L(8); PG8_BAR; PG8_WAIT_L(0); PG8_MMA(0, 0, At, B0); PG8_BAR; PG8_SCHED;
            PG8_LDB(B1, 1, 1); PG8_STAGE(PG8_SB(1, 0), b3, voffB);
            PG8_BAR; PG8_WAIT_L(0); PG8_MMA(0, 1, At, B1); PG8_BAR;
            PG8_LDA(At, 1, 1); PG8_STAGE(PG8_SA(1, 0), a3, voffA);
            PG8_BAR; PG8_WAIT_L(0); PG8_MMA(1, 0, At, B0); PG8_BAR; PG8_SCHED;
            PG8_STAGE(PG8_SB(1, 1), b3 + hstepB, voffB);
            PG8_WAIT_V(6); PG8_BAR; PG8_MMA(1, 1, At, B1); PG8_BAR;
        }
        E(acc, cur, wr, wc, fr, fq);
        if (!has_next) break;
#pragma unroll
        for (int a = 0; a < 2; ++a)
#pragma unroll
            for (int b = 0; b < 2; ++b)
#pragma unroll
                for (int m = 0; m < 4; ++m)
#pragma unroll
                    for (int n = 0; n < 2; ++n) acc[a][b][m][n] = (f32x4){0.f, 0.f, 0.f, 0.f};
        cur = nxt; cA = nA; cB = nB; ++ui;
    }
    PG8_WAIT_V(0);
    if (wr == 0) PG8_BAR;
    PG8_BAR;
#undef PG8_SA
#undef PG8_SB
#undef PG8_STAGE
#undef PG8_LDA
#undef PG8_LDB
#undef PG8_MMA
#undef PG8_WAIT_V
#undef PG8_WAIT_L
#undef PG8_BAR
#undef PG8_SCHED
}
}
using pg8::UnitD;

struct SchedInproj {
    const char* P; const char* WT; int G, c;
    __device__ __forceinline__ bool next(int i, UnitD& u) const {
        const int L = i * G + c; if (L >= 64 * 26) return false;
        int pm, pn; pg8::tile_of(L, 64, 26, pm, pn);
        u.A = P + ((size_t)pm * 256 * LDP + C_H) * 2; u.B = WT + (size_t)pn * 256 * 2048; u.nt = 16; u.pm = pm; u.pn = pn; u.kind = 0; return true;
    }
};
struct EpiInproj {
    bf16_t* P;
    __device__ __forceinline__ void operator()(const f32x4 (&acc)[2][2][4][2], const UnitD& u, int wr, int wc, int fr, int fq) const {
        const int row0 = u.pm * 256 + wr * 64 + fr, col0 = u.pn * 256 + wc * 32 + 8 * fq;
#pragma unroll
        for (int ai = 0; ai < 2; ++ai)
#pragma unroll
            for (int m = 0; m < 4; ++m) { bf16_t* rowp = P + (size_t)(row0 + ai * 128 + m * 16) * LDP + col0;
#pragma unroll
                for (int bj = 0; bj < 2; ++bj) { const f32x4 v0 = acc[ai][bj][m][0], v1 = acc[ai][bj][m][1];
                    u32x4 o; o.x = cvt_pk_bf16(v0[0], v0[1]); o.y = cvt_pk_bf16(v0[2], v0[3]); o.z = cvt_pk_bf16(v1[0], v1[1]); o.w = cvt_pk_bf16(v1[2], v1[3]);
                    *(u32x4*)(rowp + bj * 128) = o; } }
    }
};
struct SchedC1 {
    const char* P; const char* WT; int G, c;
    __device__ __forceinline__ bool next(int i, UnitD& u) const {
        const int ti = i / 6, sub = i - ti * 6, L = ti * G + c; if (L >= 256) return false;
        int pm, pn; pg8::tile_of(L, 64, 4, pm, pn);
        const int br = sub >> 1;
        if (!(sub & 1)) { u.A = P + ((size_t)pm * 256 * LDP + C_H) * 2; u.B = WT + (size_t)(R_GATE + br * 1024 + pn * 256) * 2048; u.nt = 16; }
        else { const int acol = br == 0 ? C_SBG : (br == 1 ? C_Z : C_YRW); const int brow = br == 0 ? R_SB : (br == 1 ? R_SSD : R_RWO);
            u.A = P + ((size_t)pm * 256 * LDP + acol) * 2; u.B = WT + (size_t)(brow + pn * 256) * 2048; u.nt = br == 1 ? 16 : 8; }
        u.pm = pm; u.pn = pn; u.kind = sub; return true;
    }
};
struct EpiC1 {
    bf16_t* P; const float* rstd;
    __device__ __forceinline__ void operator()(const f32x4 (&acc)[2][2][4][2], const UnitD& u, int wr, int wc, int fr, int fq) const {
        const int row0 = u.pm * 256 + wr * 64 + fr, col0 = u.pn * 256 + wc * 32 + 8 * fq;
        const int kind = u.kind;
#pragma unroll
        for (int ai = 0; ai < 2; ++ai)
#pragma unroll
            for (int m = 0; m < 4; ++m) { const int row = row0 + ai * 128 + m * 16; bf16_t* rowp = P + (size_t)row * LDP + col0;
                const float sc = (kind == 3) ? rstd[row] : 1.f;
#pragma unroll
                for (int bj = 0; bj < 2; ++bj) { const f32x4 v0 = acc[ai][bj][m][0], v1 = acc[ai][bj][m][1];
                    float v[8] = {v0[0], v0[1], v0[2], v0[3], v1[0], v1[1], v1[2], v1[3]};
                    u32x4* gp = (u32x4*)(rowp + C_G + bj * 128); u32x4* mp = (u32x4*)(rowp + C_M + bj * 128);
                    if (!(kind & 1)) {
#pragma unroll
                        for (int e = 0; e < 8; ++e) v[e] = sigmoidf_(v[e]);
                        u32x4 o; o.x = cvt_pk_bf16(v[0], v[1]); o.y = cvt_pk_bf16(v[2], v[3]); o.z = cvt_pk_bf16(v[4], v[5]); o.w = cvt_pk_bf16(v[6], v[7]);
                        *gp = o;
                    } else {
                        const u32x4 g = *gp;
                        float r[8];
                        r[0] = bf_lo(g.x) * v[0] * sc; r[1] = bf_hi(g.x) * v[1] * sc; r[2] = bf_lo(g.y) * v[2] * sc; r[3] = bf_hi(g.y) * v[3] * sc;
                        r[4] = bf_lo(g.z) * v[4] * sc; r[5] = bf_hi(g.z) * v[5] * sc; r[6] = bf_lo(g.w) * v[6] * sc; r[7] = bf_hi(g.w) * v[7] * sc;
                        if (kind != 1) { const u32x4 mo = *mp;
                            r[0] += bf_lo(mo.x); r[1] += bf_hi(mo.x); r[2] += bf_lo(mo.y); r[3] += bf_hi(mo.y); r[4] += bf_lo(mo.z); r[5] += bf_hi(mo.z); r[6] += bf_lo(mo.w); r[7] += bf_hi(mo.w); }
                        u32x4 o; o.x = cvt_pk_bf16(r[0], r[1]); o.y = cvt_pk_bf16(r[2], r[3]); o.z = cvt_pk_bf16(r[4], r[5]); o.w = cvt_pk_bf16(r[6], r[7]);
                        *mp = o;
                    } } }
    }
};
struct SchedOut {
    const char* P; const char* WT; int G, c;
    __device__ __forceinline__ bool next(int i, UnitD& u) const {
        const int L = i * G + c; if (L >= 256) return false;
        int pm, pn; pg8::tile_of(L, 64, 4, pm, pn);
        u.A = P + ((size_t)pm * 256 * LDP + C_M) * 2; u.B = WT + (size_t)(R_WO + pn * 256) * 2048; u.nt = 16; u.pm = pm; u.pn = pn; u.kind = 0; return true;
    }
};
struct EpiOut {
    const float* Xin; float* Xout;
    __device__ __forceinline__ void operator()(const f32x4 (&acc)[2][2][4][2], const UnitD& u, int wr, int wc, int fr, int fq) const {
        const int row0 = u.pm * 256 + wr * 64 + fr, col0 = u.pn * 256 + wc * 32 + 4 * fq;
#pragma unroll
        for (int ai = 0; ai < 2; ++ai)
#pragma unroll
            for (int m = 0; m < 4; ++m) { const size_t ro = (size_t)(row0 + ai * 128 + m * 16) * DM + col0;
#pragma unroll
                for (int bj = 0; bj < 2; ++bj)
#pragma unroll
                    for (int n = 0; n < 2; ++n) { const f32x4 xi = *(const f32x4*)(Xin + ro + bj * 128 + n * 16); *(f32x4*)(Xout + ro + bj * 128 + n * 16) = xi + acc[ai][bj][m][n]; } }
    }
};

__device__ __forceinline__ void wt_jobs(const Params& p, int layer, unsigned char* shm, int job_lo, int job_hi, int widx, int wstride) {
    const int tid = opaque_tid(), wave = tid >> 6, lane = tid & 63;
    bf16_t* WT = (bf16_t*)(p.ws + OFF_WT);
    float* T = (float*)shm + wave * (64 * 65);
    const float* w_in = p.in[2] + (size_t)layer * DM * NIN;
    const float* sg = p.in[8] + layer * DM;
    for (int job = job_lo + widx; job < job_hi; job += wstride) {
        const float* src; int srcN, k0, n0, dstrow; bool is_in = false, is_ssd = false;
        if (job < 2432) { is_in = true; src = w_in; srcN = NIN; const int ntile = job >> 4; k0 = (job & 15) * 64; n0 = ntile * 64; dstrow = n0; }
        else { int r = job - 2432;
            if (r < 128) { src = p.in[19] + (size_t)layer * 512 * DM; k0 = (r >> 4) * 64; n0 = (r & 15) * 64; dstrow = R_SB + n0; }
            else if (r < 384) { r -= 128; src = p.in[20] + (size_t)layer * DM * DM; k0 = (r >> 4) * 64; n0 = (r & 15) * 64; dstrow = R_SSD + n0; is_ssd = true; }
            else if (r < 512) { r -= 384; src = p.in[21] + (size_t)layer * 512 * DM; k0 = (r >> 4) * 64; n0 = (r & 15) * 64; dstrow = R_RWO + n0; }
            else { r -= 512; src = p.in[22] + (size_t)layer * DM * DM; k0 = (r >> 4) * 64; n0 = (r & 15) * 64; dstrow = R_WO + n0; }
            srcN = DM; }
        const int n4 = (lane & 15) * 4, np = n0 + n4; int sc = np;
        if (is_in) { if (np < 4352) sc = np; else if (np < 6528) sc = np + 16; else if (np < 6544) sc = np - 6528 + 4352; else if (np < 6656) sc = -1; else sc = np - 112; }
        f32x4 v[16];
#pragma unroll
        for (int i = 0; i < 16; ++i) { const int k = (lane >> 4) + 4 * i; v[i] = (f32x4){0.f, 0.f, 0.f, 0.f};
            if (sc >= 0) v[i] = *(const f32x4*)(src + (size_t)(k0 + k) * srcN + sc); }
#pragma unroll
        for (int i = 0; i < 16; ++i) { const int k = (lane >> 4) + 4 * i; f32x4 x = v[i];
            if (is_ssd) x = x * sg[k0 + k];
            T[k * 65 + n4] = x[0]; T[k * 65 + n4 + 1] = x[1]; T[k * 65 + n4 + 2] = x[2]; T[k * 65 + n4 + 3] = x[3]; }
        asm volatile("s_waitcnt lgkmcnt(0)" ::: "memory"); __builtin_amdgcn_wave_barrier(); asm volatile("" ::: "memory");
#pragma unroll
        for (int j = 0; j < 8; ++j) { const int r = lane + 64 * j, n = r >> 3, kc = (r & 7) * 8; const float* sp = T + kc * 65 + n;
            u32x4 o; o.x = cvt_pk_bf16(sp[0], sp[65]); o.y = cvt_pk_bf16(sp[130], sp[195]); o.z = cvt_pk_bf16(sp[260], sp[325]); o.w = cvt_pk_bf16(sp[390], sp[455]);
            *(u32x4*)(WT + (size_t)(dstrow + n) * 1024 + k0 + kc) = o; }
        asm volatile("s_waitcnt lgkmcnt(0)" ::: "memory"); __builtin_amdgcn_wave_barrier(); asm volatile("" ::: "memory");
    }
    __syncthreads();
}

__device__ __forceinline__ void phase0(const Params& p, int layer, unsigned char* shm) {
    const int tid = opaque_tid(), wave = tid >> 6, lane = tid & 63;
    bf16_t* P = (bf16_t*)(p.ws + OFF_P); bf16_t* WT = (bf16_t*)(p.ws + OFF_WT);
    const float* Xin = layer == 0 ? p.in[0] : p.out;
    const float* ng = p.in[1] + layer * DM;
    f32x4 gn[4];
#pragma unroll
    for (int i = 0; i < 4; ++i) gn[i] = *(const f32x4*)(ng + i * 256 + lane * 4);
    for (int row0 = (blockIdx.x * 8 + wave) * 4; row0 < TOK; row0 += gridDim.x * 32) {
        f32x4 v[4][4]; float ss[4];
#pragma unroll
        for (int rr = 0; rr < 4; ++rr) { const float* xr = Xin + (size_t)(row0 + rr) * DM;
#pragma unroll
            for (int i = 0; i < 4; ++i) v[rr][i] = *(const f32x4*)(xr + i * 256 + lane * 4); }
#pragma unroll
        for (int rr = 0; rr < 4; ++rr) { float a = 0.f;
#pragma unroll
            for (int i = 0; i < 4; ++i) a += v[rr][i][0] * v[rr][i][0] + v[rr][i][1] * v[rr][i][1] + v[rr][i][2] * v[rr][i][2] + v[rr][i][3] * v[rr][i][3];
            ss[rr] = wave_sum(a); }
#pragma unroll
        for (int rr = 0; rr < 4; ++rr) { const float rs = rsqrtf(ss[rr] * (1.f / DM) + 1e-6f);
#pragma unroll
            for (int i = 0; i < 4; ++i) { const f32x4 g = gn[i];
                u32x2 o; o.x = cvt_pk_bf16(v[rr][i][0] * rs * g[0], v[rr][i][1] * rs * g[1]); o.y = cvt_pk_bf16(v[rr][i][2] * rs * g[2], v[rr][i][3] * rs * g[3]);
                *(u32x2*)(P + (size_t)(row0 + rr) * LDP + C_H + i * 256 + lane * 4) = o; } }
    }
    wt_jobs(p, layer, shm, (layer == 1) ? 1664 : 0, 3200, blockIdx.x * 8 + wave, gridDim.x * 8);
}

__device__ __forceinline__ void attn_item(const Params& p, unsigned char* shm, int item) {
    const int qb = item & 15, h = (item >> 4) & 7, b = item >> 7;
    bf16_t* P = (bf16_t*)(p.ws + OFF_P);
    const int tid = opaque_tid(), wave = tid >> 6, lane = tid & 63, lq = lane & 15, g = lane >> 4;
    const size_t rowbase = (size_t)b * SEQ;
    const int t = qb * 128 + wave * 16 + lq;
    const int tmax = qb * 128 + wave * 16 + 15;
    constexpr int ABUF = 64 * 144 + 64 * 136;
    const bf16_t* qp = P + (rowbase + t) * LDP + C_Q + h * 64 + 8 * g;
    const bf16x8 qf0 = *(const bf16x8*)qp, qf1 = *(const bf16x8*)(qp + 32);
    bf16x8 TT[4][2];
#pragma unroll
    for (int a = 0; a < 4; ++a)
#pragma unroll
        for (int ks = 0; ks < 2; ++ks)
#pragma unroll
            for (int e = 0; e < 8; ++e) { const int j = 16 * (2 * ks + (e >> 2)) + 4 * g + (e & 3); TT[a][ks][e] = (j > 16 * a + lq) ? (short)0x3F80 : (short)0; }
    f32x4 o[4];
#pragma unroll
    for (int i = 0; i < 4; ++i) o[i] = (f32x4){0.f, 0.f, 0.f, 0.f};
    float R = 0.f;
    LAS volatile int* flg = (LAS volatile int*)((LAS unsigned char*)shm + 2 * ABUF);
    const int st_s = tid >> 3, st_dc = (tid & 7) * 8;
    const bf16_t* st_base = P + (rowbase + st_s) * LDP + h * 64 + st_dc;
    auto stage_write = [&](unsigned char* buf, const u32x4& kv, const u32x4& vv) {
        bf16_t* Ksw = (bf16_t*)buf; bf16_t* Vtw = (bf16_t*)(buf + 64 * 144); const int s_ = st_s, dc = st_dc;
        *(u32x4*)(Ksw + s_ * 72 + dc) = kv;
        Vtw[(dc + 0) * 68 + s_] = (bf16_t)(vv.x & 0xFFFF); Vtw[(dc + 1) * 68 + s_] = (bf16_t)(vv.x >> 16);
        Vtw[(dc + 2) * 68 + s_] = (bf16_t)(vv.y & 0xFFFF); Vtw[(dc + 3) * 68 + s_] = (bf16_t)(vv.y >> 16);
        Vtw[(dc + 4) * 68 + s_] = (bf16_t)(vv.z & 0xFFFF); Vtw[(dc + 5) * 68 + s_] = (bf16_t)(vv.z >> 16);
        Vtw[(dc + 6) * 68 + s_] = (bf16_t)(vv.w & 0xFFFF); Vtw[(dc + 7) * 68 + s_] = (bf16_t)(vv.w >> 16);
    };
    if (tid == 0) { flg[0] = 1; flg[1] = 0; flg[2] = 0; }
    { const bf16_t* kr = st_base + (size_t)(2 * qb + 1) * 64 * LDP; const u32x4 kv0 = *(const u32x4*)(kr + C_K), vv0 = *(const u32x4*)(kr + C_V); stage_write(shm, kv0, vv0); }
    int itn = 0, cur = 0;
    for (int kt = 2 * qb + 1; kt >= 0; --kt) {
        __syncthreads();
        const int f0 = itn % 3, f1 = (itn + 1) % 3, f2 = (itn + 2) % 3;
        if (flg[f0] == 0) break;
        if (tid == 0) flg[f2] = 0;
        u32x4 kvn = (u32x4){0u, 0u, 0u, 0u}, vvn = (u32x4){0u, 0u, 0u, 0u};
        if (kt > 0) { const bf16_t* kr = st_base + (size_t)(kt - 1) * 64 * LDP; kvn = *(const u32x4*)(kr + C_K); vvn = *(const u32x4*)(kr + C_V); }
        const bf16_t* Ks = (const bf16_t*)(shm + cur * ABUF); const bf16_t* Vt = (const bf16_t*)(shm + cur * ABUF + 64 * 144);
        const bool walive = __any(R > -104.f);
        const bool act = (kt * 64 < tmax) && walive;
        if (act) {
            float lb[4][4], lk[4][4];
#pragma unroll
            for (int sub = 0; sub < 4; ++sub) {
                const bf16_t* kp = Ks + (16 * sub + lq) * 72 + 8 * g;
                const bf16x8 k0 = *(const bf16x8*)kp, k1 = *(const bf16x8*)(kp + 32);
                f32x4 s4 = (f32x4){0.f, 0.f, 0.f, 0.f};
                s4 = __builtin_amdgcn_mfma_f32_16x16x32_bf16(k0, qf0, s4, 0, 0, 0);
                s4 = __builtin_amdgcn_mfma_f32_16x16x32_bf16(k1, qf1, s4, 0, 0, 0);
#pragma unroll
                for (int r = 0; r < 4; ++r) { const float z = s4[r] * 0.125f; const bool mk = (kt * 64 + 16 * sub + 4 * g + r) < t;
                    const float l = fminf(z, 0.f) - 0.69314718f * __builtin_amdgcn_logf(1.f + __expf(-fabsf(z)));
                    lb[sub][r] = mk ? l : -1e30f; lk[sub][r] = mk ? (l - z) : 0.f; }
            }
            bf16x8 hi[2];
#pragma unroll
            for (int ks = 0; ks < 2; ++ks) {
                unsigned hw[4];
#pragma unroll
                for (int w2 = 0; w2 < 4; ++w2) { const int sub = 2 * ks + (w2 >> 1), r0 = (w2 & 1) * 2; const float a0 = lk[sub][r0], a1 = lk[sub][r0 + 1];
                    hw[w2] = cvt_pk_bf16(a0, a1); }
                u32x4 hv = (u32x4){hw[0], hw[1], hw[2], hw[3]};
                hi[ks] = __builtin_bit_cast(bf16x8, hv);
            }
            f32x4 aft[4];
#pragma unroll
            for (int a = 0; a < 4; ++a) { f32x4 c = (f32x4){0.f, 0.f, 0.f, 0.f};
#pragma unroll
                for (int ks = 0; ks < 2; ++ks) c = __builtin_amdgcn_mfma_f32_16x16x32_bf16(TT[a][ks], hi[ks], c, 0, 0, 0);
                aft[a] = c; }
            float tot = aft[0][0] + lk[0][0];
            tot = __shfl(tot, lq);
            bf16x8 pf[2];
#pragma unroll
            for (int ks = 0; ks < 2; ++ks) { unsigned pw[4];
#pragma unroll
                for (int w2 = 0; w2 < 4; ++w2) { const int sub = 2 * ks + (w2 >> 1), r0 = (w2 & 1) * 2;
                    const float e0 = __expf(lb[sub][r0] + aft[sub][r0] + R), e1 = __expf(lb[sub][r0 + 1] + aft[sub][r0 + 1] + R);
                    pw[w2] = cvt_pk_bf16(e0, e1); }
                u32x4 pv = (u32x4){pw[0], pw[1], pw[2], pw[3]}; pf[ks] = __builtin_bit_cast(bf16x8, pv); }
            R += tot;
#pragma unroll
            for (int ds = 0; ds < 4; ++ds)
#pragma unroll
                for (int ks = 0; ks < 2; ++ks) { const bf16_t* vp = Vt + (16 * ds + lq) * 68 + 32 * ks + 4 * g;
                    const u32x2 v0 = *(const u32x2*)vp, v1 = *(const u32x2*)(vp + 16);
                    u32x4 vv = (u32x4){v0.x, v0.y, v1.x, v1.y};
                    o[ds] = __builtin_amdgcn_mfma_f32_16x16x32_bf16(__builtin_bit_cast(bf16x8, vv), pf[ks], o[ds], 0, 0, 0); }
        }
        if (__any(R > -104.f) && lane == 0) flg[f1] = 1;
        if (kt > 0) stage_write(shm + (cur ^ 1) * ABUF, kvn, vvn);
        cur ^= 1; ++itn;
    }
#pragma unroll
    for (int ds = 0; ds < 4; ++ds) { bf16_t* gp = P + (rowbase + t) * LDP + C_SBG + h * 64 + 16 * ds + 4 * g;
        const u32x2 gv = *(const u32x2*)gp;
        u32x2 ov; ov.x = cvt_pk_bf16(o[ds][0] * siluf_(bf_lo(gv.x)), o[ds][1] * siluf_(bf_hi(gv.x))); ov.y = cvt_pk_bf16(o[ds][2] * siluf_(bf_lo(gv.y)), o[ds][3] * siluf_(bf_hi(gv.y)));
        *(u32x2*)gp = ov; }
    __syncthreads();
}

__device__ __forceinline__ void bc_prepass(const Params& p, int layer, int blk, int nblk) {
    const bf16_t* P = (const bf16_t*)(p.ws + OFF_P); bf16_t* BCc = (bf16_t*)(p.ws + OFF_BCC);
    const float* cw = p.in[3] + (size_t)layer * 4 * 1280; const float* cb = p.in[4] + layer * 1280;
    const int gt = blk * 512 + opaque_tid(), gs = nblk * 512;
    const int c = (gt & 63) * 4, chn = 1024 + c;
    const f32x4 bias = *(const f32x4*)(cb + chn);
    f32x4 w[4];
#pragma unroll
    for (int k = 0; k < 4; ++k) w[k] = *(const f32x4*)(cw + k * 1280 + chn);
    for (int idx0 = gt; idx0 < TOK * 64; idx0 += 4 * gs) {
        u32x2 xv[4][4]; bool ok[4];
#pragma unroll
        for (int u = 0; u < 4; ++u) { const int idx = idx0 + u * gs; ok[u] = idx < TOK * 64; const int tok = ok[u] ? (idx >> 6) : 0; const int t = tok & (SEQ - 1);
            const bf16_t* xp = P + (size_t)tok * LDP + C_XBC + chn;
#pragma unroll
            for (int k = 0; k < 4; ++k) { const int ts = t - 3 + k; const unsigned xm = ts >= 0 ? 0xFFFFFFFFu : 0u;
                u32x2 x = *(const u32x2*)(xp + (ptrdiff_t)(ts >= 0 ? k - 3 : 0) * LDP); x.x &= xm; x.y &= xm; xv[u][k] = x; } }
#pragma unroll
        for (int u = 0; u < 4; ++u) { const int idx = idx0 + u * gs; const int tok = ok[u] ? (idx >> 6) : 0;
            f32x4 a = bias;
#pragma unroll
            for (int k = 0; k < 4; ++k) { a[0] += w[k][0] * bf_lo(xv[u][k].x); a[1] += w[k][1] * bf_hi(xv[u][k].x); a[2] += w[k][2] * bf_lo(xv[u][k].y); a[3] += w[k][3] * bf_hi(xv[u][k].y); }
            u32x2 o; o.x = cvt_pk_bf16(siluf_(a[0]), siluf_(a[1])); o.y = cvt_pk_bf16(siluf_(a[2]), siluf_(a[3]));
            if (ok[u]) *(u32x2*)(BCc + (size_t)tok * 256 + c) = o; }
    }
}

__device__ __forceinline__ void ssd_item(const Params& p, int layer, unsigned char* shm, int item) {
    const int hh = item & 15, b = item >> 4, grp = hh >> 3;
    bf16_t* P = (bf16_t*)(p.ws + OFF_P); float* SSQ = (float*)(p.ws + OFF_SSQ);
    const int tid = opaque_tid(), wave = tid >> 6, lane = tid & 63, lq = lane & 15, g = lane >> 4;
    const size_t rowbase = (size_t)b * SEQ;
    const float* cw = p.in[3] + (size_t)layer * 4 * 1280; const float* cb = p.in[4] + layer * 1280;
    const float dtb = p.in[5][layer * 16 + hh], Aneg = -__expf(p.in[6][layer * 16 + hh]), Dsk = p.in[7][layer * 16 + hh];
    float* XS = (float*)shm;
    float* YS = XS + 4096;
    float* DTs = YS + 4096;
    float* ACS = DTs + 64;
    bf16_t* Cb = (bf16_t*)(ACS + 64);
    bf16_t* Bb = Cb + 64 * 72;
    bf16_t* BT = Bb + 64 * 72;
    bf16_t* Mx = BT + 64 * 72;
    bf16_t* XT = Mx + 64 * 72;
    bf16_t* XwT = XT + 64 * 72;
    bf16_t* SbT = XwT + 64 * 72;
    f32x4 Sacc[2] = {(f32x4){0.f, 0.f, 0.f, 0.f}, (f32x4){0.f, 0.f, 0.f, 0.f}};
    const bf16_t* BCc = (const bf16_t*)(p.ws + OFF_BCC);
    const int x_tt = tid >> 3, x_c = (tid & 7) * 4;
    const int bc_q = tid & 7;
    f32x4 xbias[2], xw[2][4];
#pragma unroll
    for (int h2 = 0; h2 < 2; ++h2) { const int chn = hh * 64 + x_c + 32 * h2; xbias[h2] = *(const f32x4*)(cb + chn);
#pragma unroll
        for (int k = 0; k < 4; ++k) xw[h2][k] = *(const f32x4*)(cw + k * 1280 + chn); }
    u32x2 sx[2][4]; u32x4 bc0, bc1; bf16_t sdt = 0;
    auto ssd_load = [&](int tb) {
        const int t = tb + x_tt;
#pragma unroll
        for (int h2 = 0; h2 < 2; ++h2) { const bf16_t* xp = P + (rowbase + t) * LDP + C_XBC + hh * 64 + x_c + 32 * h2;
#pragma unroll
            for (int k = 0; k < 4; ++k) { const int ts = t - 3 + k; const unsigned xm = ts >= 0 ? 0xFFFFFFFFu : 0u;
                u32x2 xv = *(const u32x2*)(xp + (ptrdiff_t)(ts >= 0 ? k - 3 : 0) * LDP); xv.x &= xm; xv.y &= xm; sx[h2][k] = xv; } }
        const bf16_t* bp = BCc + (rowbase + t) * 256 + (bc_q < 4 ? grp * 64 + bc_q * 16 : 128 + grp * 64 + (bc_q - 4) * 16);
        bc0 = *(const u32x4*)bp; bc1 = *(const u32x4*)(bp + 8);
        if (tid < 64) sdt = P[(rowbase + tb + tid) * LDP + C_DT + hh];
    };
    ssd_load(0);
    for (int ch = 0; ch < SEQ / 64; ++ch) {
        const int t0 = ch * 64;
        __syncthreads();
        const int o_tt = tid >> 3, o_p8 = (tid & 7) * 8;
        bf16_t* zp = P + (rowbase + t0 + o_tt) * LDP + C_Z + hh * 64 + o_p8;
        const u32x4 zv = *(const u32x4*)zp;
#pragma unroll
        for (int h2 = 0; h2 < 2; ++h2) { f32x4 a = xbias[h2];
#pragma unroll
            for (int k = 0; k < 4; ++k) { a[0] += xw[h2][k][0] * bf_lo(sx[h2][k].x); a[1] += xw[h2][k][1] * bf_hi(sx[h2][k].x); a[2] += xw[h2][k][2] * bf_lo(sx[h2][k].y); a[3] += xw[h2][k][3] * bf_hi(sx[h2][k].y); }
            a[0] = siluf_(a[0]); a[1] = siluf_(a[1]); a[2] = siluf_(a[2]); a[3] = siluf_(a[3]);
            const unsigned q0 = cvt_pk_bf16(a[0], a[1]), q1 = cvt_pk_bf16(a[2], a[3]); const int tt = x_tt, c = x_c + 32 * h2;
            *(f32x4*)(XS + tt * 64 + c) = a;
            XT[(c + 0) * 72 + tt] = (bf16_t)(q0 & 0xFFFF); XT[(c + 1) * 72 + tt] = (bf16_t)(q0 >> 16); XT[(c + 2) * 72 + tt] = (bf16_t)(q1 & 0xFFFF); XT[(c + 3) * 72 + tt] = (bf16_t)(q1 >> 16); }
        { const int tt = x_tt;
            if (bc_q < 4) { const int n = bc_q * 16; *(u32x4*)(Bb + tt * 72 + n) = bc0; *(u32x4*)(Bb + tt * 72 + n + 8) = bc1;
                const unsigned wv[8] = {bc0.x, bc0.y, bc0.z, bc0.w, bc1.x, bc1.y, bc1.z, bc1.w};
#pragma unroll
                for (int e = 0; e < 8; ++e) { BT[(n + 2 * e) * 72 + tt] = (bf16_t)(wv[e] & 0xFFFF); BT[(n + 2 * e + 1) * 72 + tt] = (bf16_t)(wv[e] >> 16); } }
            else { const int n = (bc_q - 4) * 16; *(u32x4*)(Cb + tt * 72 + n) = bc0; *(u32x4*)(Cb + tt * 72 + n + 8) = bc1; } }
        if (tid < 64) { const float dt = softplusf_(bf2f(sdt) + dtb); DTs[tid] = dt;
            float x = dt * Aneg;
#pragma unroll
            for (int o = 1; o < 64; o <<= 1) { const float v = __shfl_up(x, o); if (lane >= o) x += v; }
            ACS[tid] = x; }
        if (ch + 1 < SEQ / 64) ssd_load(t0 + 64);
        __syncthreads();
        const float acsL = ACS[63];
#pragma unroll
        for (int h2 = 0; h2 < 2; ++h2) { const int pp = (tid >> 4) + 32 * h2, s4 = (tid & 15) * 4; float v[4];
#pragma unroll
            for (int e = 0; e < 4; ++e) { const int sidx = s4 + e; v[e] = XS[sidx * 64 + pp] * DTs[sidx] * __expf(acsL - ACS[sidx]); }
            *(u32x2*)(XwT + pp * 72 + s4) = (u32x2){cvt_pk_bf16(v[0], v[1]), cvt_pk_bf16(v[2], v[3])}; }
#pragma unroll
        for (int h2 = 0; h2 < 2; ++h2) { const int pi = (wave >> 2) + 2 * h2, ni = wave & 3;
#pragma unroll
            for (int r = 0; r < 4; ++r) SbT[(16 * pi + 4 * g + r) * 72 + 16 * ni + lq] = (bf16_t)(cvt_pk_bf16(Sacc[h2][r], 0.f) & 0xFFFF); }
        { const int ti = wave >> 1;
#pragma unroll
            for (int sj = 0; sj < 2; ++sj) { const int si = 2 * (wave & 1) + sj;
                f32x4 acc = (f32x4){0.f, 0.f, 0.f, 0.f};
                if (si <= ti) {
                    const bf16_t* ap = Cb + (16 * ti + lq) * 72 + 8 * g; const bf16_t* bp = Bb + (16 * si + lq) * 72 + 8 * g;
                    acc = __builtin_amdgcn_mfma_f32_16x16x32_bf16(*(const bf16x8*)ap, *(const bf16x8*)bp, acc, 0, 0, 0);
                    acc = __builtin_amdgcn_mfma_f32_16x16x32_bf16(*(const bf16x8*)(ap + 32), *(const bf16x8*)(bp + 32), acc, 0, 0, 0);
                }
                const int sidx = 16 * si + lq; const float as = ACS[sidx], ds = DTs[sidx];
#pragma unroll
                for (int r = 0; r < 4; ++r) { const int t = 16 * ti + 4 * g + r; const float val = (sidx <= t) ? acc[r] * __expf(ACS[t] - as) * ds : 0.f;
                    Mx[t * 72 + sidx] = (bf16_t)(cvt_pk_bf16(val, 0.f) & 0xFFFF); } } }
        __syncthreads();
        { const int ti = wave >> 1;
            const bf16_t* ap = Mx + (16 * ti + lq) * 72 + 8 * g; const bf16_t* cp = Cb + (16 * ti + lq) * 72 + 8 * g;
            const bf16x8 mf0 = *(const bf16x8*)ap, mf1 = *(const bf16x8*)(ap + 32), cf0 = *(const bf16x8*)cp, cf1 = *(const bf16x8*)(cp + 32);
#pragma unroll
            for (int h2 = 0; h2 < 2; ++h2) { const int pi = (wave & 1) + 2 * h2;
                const bf16_t* bp = XT + (16 * pi + lq) * 72 + 8 * g; const bf16_t* sp = SbT + (16 * pi + lq) * 72 + 8 * g;
                f32x4 a1 = (f32x4){0.f, 0.f, 0.f, 0.f}, a2 = (f32x4){0.f, 0.f, 0.f, 0.f};
                a1 = __builtin_amdgcn_mfma_f32_16x16x32_bf16(mf0, *(const bf16x8*)bp, a1, 0, 0, 0);
                a1 = __builtin_amdgcn_mfma_f32_16x16x32_bf16(mf1, *(const bf16x8*)(bp + 32), a1, 0, 0, 0);
                a2 = __builtin_amdgcn_mfma_f32_16x16x32_bf16(cf0, *(const bf16x8*)sp, a2, 0, 0, 0);
                a2 = __builtin_amdgcn_mfma_f32_16x16x32_bf16(cf1, *(const bf16x8*)(sp + 32), a2, 0, 0, 0);
#pragma unroll
                for (int r = 0; r < 4; ++r) { const int t = 16 * ti + 4 * g + r, pc = 16 * pi + lq;
                    YS[t * 64 + pc] = a1[r] + __expf(ACS[t]) * a2[r] + Dsk * XS[t * 64 + pc]; } } }
        { const int ni = wave & 3; const float dl = __expf(acsL);
            const bf16_t* bp = BT + (16 * ni + lq) * 72 + 8 * g; const bf16x8 bf0 = *(const bf16x8*)bp, bf1 = *(const bf16x8*)(bp + 32);
#pragma unroll
            for (int h2 = 0; h2 < 2; ++h2) { const int pi = (wave >> 2) + 2 * h2;
                const bf16_t* ap = XwT + (16 * pi + lq) * 72 + 8 * g;
                f32x4 sa = Sacc[h2] * dl;
                sa = __builtin_amdgcn_mfma_f32_16x16x32_bf16(*(const bf16x8*)ap, bf0, sa, 0, 0, 0);
                sa = __builtin_amdgcn_mfma_f32_16x16x32_bf16(*(const bf16x8*)(ap + 32), bf1, sa, 0, 0, 0);
                Sacc[h2] = sa; } }
        __syncthreads();
        { const int tt = o_tt, p8 = o_p8; const f32x4 ya = *(const f32x4*)(YS + tt * 64 + p8), yb = *(const f32x4*)(YS + tt * 64 + p8 + 4);
            const float u0 = ya[0] * siluf_(bf_lo(zv.x)), u1 = ya[1] * siluf_(bf_hi(zv.x)), u2 = ya[2] * siluf_(bf_lo(zv.y)), u3 = ya[3] * siluf_(bf_hi(zv.y));
            const float u4 = yb[0] * siluf_(bf_lo(zv.z)), u5 = yb[1] * siluf_(bf_hi(zv.z)), u6 = yb[2] * siluf_(bf_lo(zv.w)), u7 = yb[3] * siluf_(bf_hi(zv.w));
            u32x4 ov; ov.x = cvt_pk_bf16(u0, u1); ov.y = cvt_pk_bf16(u2, u3); ov.z = cvt_pk_bf16(u4, u5); ov.w = cvt_pk_bf16(u6, u7); *(u32x4*)zp = ov;
            float q = (u0 * u0 + u1 * u1) + (u2 * u2 + u3 * u3) + (u4 * u4 + u5 * u5) + (u6 * u6 + u7 * u7);
            q += __shfl_xor(q, 1); q += __shfl_xor(q, 2); q += __shfl_xor(q, 4);
            if ((tid & 7) == 0) { SSQ[(rowbase + t0 + tt) * 32 + hh * 2] = q; SSQ[(rowbase + t0 + tt) * 32 + hh * 2 + 1] = 0.f; } }
    }
    __syncthreads();
}

__device__ __forceinline__ float fast_tanh(float x) { return 1.f - 2.f * __builtin_amdgcn_rcpf(1.f + __expf(2.f * x)); }
__device__ __forceinline__ void pbar4(LAS volatile unsigned* cnt, unsigned& tgt, int lane) {
    tgt += 4u;
    asm volatile("s_waitcnt lgkmcnt(0)" ::: "memory");
    if (lane == 0) __hip_atomic_fetch_add((LAS unsigned*)cnt, 1u, __ATOMIC_RELAXED, __HIP_MEMORY_SCOPE_WORKGROUP);
    while (*cnt < tgt) __builtin_amdgcn_s_sleep(1);
    asm volatile("" ::: "memory");
}
__device__ __forceinline__ void rwkv_item(const Params& p, int layer, unsigned char* shm, int item) {
    const int half = item & 1, h = (item >> 1) & 7, b = item >> 4;
    bf16_t* P = (bf16_t*)(p.ws + OFF_P); bf16_t* YRAW = (bf16_t*)(p.ws + OFF_YRAW); float* BONUS = (float*)(p.ws + OFF_BONUS);
    const int tid = opaque_tid(), wave = tid >> 6, lane = tid & 63, lq = lane & 15, g = lane >> 4;
    const size_t rowbase = (size_t)b * SEQ;
    const float* mu = p.in[9] + layer * 2176;
    const float* w0 = p.in[10] + layer * 512; const float* wup = p.in[11] + (size_t)layer * 64 * 512;
    const float* a0 = p.in[12] + layer * 512; const float* aup = p.in[13] + (size_t)layer * 64 * 512;
    const float* kkp = p.in[14] + layer * 512; const float* kap = p.in[15] + layer * 512; const float* rkp = p.in[16] + layer * 512;
    constexpr int SETF = 6 * 2048;
    float* SET0 = (float*)shm;
    float* AA = SET0 + 2 * SETF;
    float* Yb = AA + 2048;
    bf16_t* WLb = (bf16_t*)(Yb + 2048);
    bf16_t* ALb = WLb + 32 * 72;
    LAS volatile unsigned* pcnt = (LAS volatile unsigned*)((LAS unsigned char*)shm + (2 * SETF + 2048 + 2048) * 4 + 2 * 32 * 72 * 2);
    const int csub = wave & 3;
    bf16x8 bfr[2][2]; float lw0[2];
#pragma unroll
    for (int mat = 0; mat < 2; ++mat) { const float* up = (mat ? aup : wup) + h * 64 + csub * 16 + lq;
#pragma unroll
        for (int ks = 0; ks < 2; ++ks) { unsigned w[4];
#pragma unroll
            for (int e2 = 0; e2 < 4; ++e2) { const int m0 = 32 * ks + 8 * g + 2 * e2; w[e2] = cvt_pk_bf16(up[(size_t)m0 * 512], up[(size_t)(m0 + 1) * 512]); }
            u32x4 wv = (u32x4){w[0], w[1], w[2], w[3]}; bfr[mat][ks] = __builtin_bit_cast(bf16x8, wv); }
        lw0[mat] = (mat ? a0 : w0)[h * 64 + csub * 16 + lq]; }
    const int ej = (tid & 15) * 4;
    const f32x4 c_kk = *(const f32x4*)(kkp + h * 64 + ej), c_ka = *(const f32x4*)(kap + h * 64 + ej), c_rk = *(const f32x4*)(rkp + h * 64 + ej);
    const f32x4 mu_r = *(const f32x4*)(mu + h * 64 + ej), mu_k = *(const f32x4*)(mu + 512 + h * 64 + ej), mu_v = *(const f32x4*)(mu + 1024 + h * 64 + ej);
    const f32x4 mu_w = *(const f32x4*)(mu + 2048 + ej), mu_a = *(const f32x4*)(mu + 2112 + ej);
    f32x4 sA = (f32x4){0.f, 0.f, 0.f, 0.f}, sB = (f32x4){0.f, 0.f, 0.f, 0.f};
    const int irow = half * 32 + (wave & 3) * 8 + g * 2;
    unsigned ptgt = 0u;
    const int pm = tid - 256, e2t = pm >> 4;
    u32x2 cva[2][5], pva[2][5];
    auto rw_load = [&](int ch) {
#pragma unroll
        for (int ps = 0; ps < 2; ++ps) { const int tl = e2t + 16 * ps, t = ch * 32 + tl; const bf16_t* cur = P + (rowbase + t) * LDP + C_RW; const bool hp = t > 0; const bf16_t* prv = hp ? cur - LDP : cur;
#pragma unroll
            for (int i = 0; i < 5; ++i) { const int col = (i == 0 ? h * 64 : i == 1 ? 512 + h * 64 : i == 2 ? 1024 + h * 64 : i == 3 ? 2048 : 2112) + ej;
                cva[ps][i] = *(const u32x2*)(cur + col); pva[ps][i] = *(const u32x2*)(prv + col); } }
    };
    auto prep = [&](int ch, float* SET) {
        float* Rm = SET; float* Km = SET + 2048; float* Vm = SET + 4096; float* DEC = SET + 6144; float* KK = SET + 8192; float* BB = SET + 10240;
#pragma unroll
        for (int ps = 0; ps < 2; ++ps) { const int tl = e2t + 16 * ps, t = ch * 32 + tl; const unsigned pmask = t > 0 ? 0xFFFFFFFFu : 0u;
#pragma unroll
            for (int i = 0; i < 5; ++i) {
                const u32x2 cv = cva[ps][i]; u32x2 pv = pva[ps][i]; pv.x &= pmask; pv.y &= pmask;
                const f32x4 m4 = i == 0 ? mu_r : i == 1 ? mu_k : i == 2 ? mu_v : i == 3 ? mu_w : mu_a;
                float c[4] = {bf_lo(cv.x), bf_hi(cv.x), bf_lo(cv.y), bf_hi(cv.y)}; const float q[4] = {bf_lo(pv.x), bf_hi(pv.x), bf_lo(pv.y), bf_hi(pv.y)};
#pragma unroll
                for (int e = 0; e < 4; ++e) c[e] = c[e] + (q[e] - c[e]) * m4[e];
                if (i == 0) *(f32x4*)(Rm + tl * 64 + ej) = (f32x4){c[0], c[1], c[2], c[3]};
                else if (i == 1) *(f32x4*)(Km + tl * 64 + ej) = (f32x4){c[0], c[1], c[2], c[3]};
                else if (i == 2) *(f32x4*)(Vm + tl * 64 + ej) = (f32x4){c[0], c[1], c[2], c[3]};
                else if (i == 3) { u32x2 o; o.x = cvt_pk_bf16(fast_tanh(c[0]), fast_tanh(c[1])); o.y = cvt_pk_bf16(fast_tanh(c[2]), fast_tanh(c[3])); *(u32x2*)(WLb + tl * 72 + ej) = o; }
                else { u32x2 o; o.x = cvt_pk_bf16(c[0], c[1]); o.y = cvt_pk_bf16(c[2], c[3]); *(u32x2*)(ALb + tl * 72 + ej) = o; } } }
        if (ch + 1 < SEQ / 32) rw_load(ch + 1);
        pbar4(pcnt, ptgt, lane);
#pragma unroll
        for (int mat = 0; mat < 2; ++mat)
#pragma unroll
            for (int ts = 0; ts < 2; ++ts) { const bf16_t* ap = (mat ? ALb : WLb) + (16 * ts + lq) * 72 + 8 * g;
                const bf16x8 a0f = *(const bf16x8*)ap, a1f = *(const bf16x8*)(ap + 32);
                f32x4 c = (f32x4){0.f, 0.f, 0.f, 0.f};
                c = __builtin_amdgcn_mfma_f32_16x16x32_bf16(a0f, bfr[mat][0], c, 0, 0, 0);
                c = __builtin_amdgcn_mfma_f32_16x16x32_bf16(a1f, bfr[mat][1], c, 0, 0, 0);
#pragma unroll
                for (int r = 0; r < 4; ++r) { const int tt = 16 * ts + 4 * g + r; const float x = lw0[mat] + c[r];
                    if (mat == 0) DEC[tt * 64 + csub * 16 + lq] = __expf(-0.60653066f * sigmoidf_(x));
                    else AA[tt * 64 + csub * 16 + lq] = sigmoidf_(x); } }
        pbar4(pcnt, ptgt, lane);
#pragma unroll
        for (int ps = 0; ps < 2; ++ps) { const int tl = e2t + 16 * ps;
            const f32x4 k4 = *(const f32x4*)(Km + tl * 64 + ej), a4 = *(const f32x4*)(AA + tl * 64 + ej), r4 = *(const f32x4*)(Rm + tl * 64 + ej);
            f32x4 kr, kt; float ss = 0.f, bo = 0.f;
#pragma unroll
            for (int e = 0; e < 4; ++e) { kr[e] = k4[e] * c_kk[e]; ss += kr[e] * kr[e]; kt[e] = k4[e] * (1.f + (a4[e] - 1.f) * c_ka[e]); bo += r4[e] * kt[e] * c_rk[e]; }
            ss = allred16(ss); bo = allred16(bo);
            const float inv = __builtin_amdgcn_rsqf(fmaxf(ss, 1e-24f));
            f32x4 kk4, b4;
#pragma unroll
            for (int e = 0; e < 4; ++e) { kk4[e] = kr[e] * inv; b4[e] = kk4[e] * a4[e]; }
            *(f32x4*)(Km + tl * 64 + ej) = kt; *(f32x4*)(KK + tl * 64 + ej) = kk4; *(f32x4*)(BB + tl * 64 + ej) = b4;
            if (half == 0 && (tid & 15) == 0) BONUS[(rowbase + ch * 32 + tl) * 8 + h] = bo; }
    };
    auto yraw_store = [&](int ch) {
#pragma unroll
        for (int ps = 0; ps < 2; ++ps)
#pragma unroll
            for (int q = 0; q < 2; ++q) { const int tl = e2t + 16 * ps, il = (tid & 15) + 16 * q;
                YRAW[(rowbase + ch * 32 + tl) * 512 + h * 64 + half * 32 + il] = (bf16_t)(cvt_pk_bf16(Yb[(ch & 1) * 1024 + tl * 32 + il], 0.f) & 0xFFFF); }
    };
    if (tid == 0) *pcnt = 0u;
    __syncthreads();
    if (wave >= 4) { rw_load(0); prep(0, SET0); }
    for (int ch = 0; ch < SEQ / 32; ++ch) {
        __syncthreads();
        if (wave < 4) {
            const float* SET = SET0 + (ch & 1) * SETF;
            const float* Rm = SET; const float* Km = SET + 2048; const float* Vm = SET + 4096; const float* DEC = SET + 6144; const float* KK = SET + 8192; const float* BB = SET + 10240;
            float* Yw = Yb + (ch & 1) * 1024;
            struct Ops { f32x4 w, k, q, b, r; float v0, v1; };
            auto ld = [&](Ops& o, int tt) { const int off = tt * 64 + lq * 4;
                o.w = *(const f32x4*)(DEC + off); o.k = *(const f32x4*)(Km + off); o.q = *(const f32x4*)(KK + off); o.b = *(const f32x4*)(BB + off); o.r = *(const f32x4*)(Rm + off);
                const float* vp = Vm + tt * 64 + irow; o.v0 = vp[0]; o.v1 = vp[1]; };
            auto step = [&](const Ops& o, int tt) {
                const f32x4 da = sA * o.q, db = sB * o.q; const f32x2_t ha = da.lo + da.hi, hb = db.lo + db.hi;
                float sa0 = ha.x + ha.y, sa1 = hb.x + hb.y;
                const f32x4 uA = sA * o.w + o.k * o.v0, uB = sB * o.w + o.k * o.v1;
                sa0 = -allred16(sa0); sa1 = -allred16(sa1);
                sA = uA + o.b * sa0; sB = uB + o.b * sa1;
                const f32x4 ea = sA * o.r, eb = sB * o.r; const f32x2_t ga = ea.lo + ea.hi, gb = eb.lo + eb.hi; float y0 = ga.x + ga.y, y1 = gb.x + gb.y;
                asm("" : "+v"(y0)); asm("" : "+v"(y1));
                y0 += dppf<0xB1>(y0); y1 += dppf<0xB1>(y1);
                float z = (lq & 1) ? y1 : y0;
                z += dppf<0x4E>(z); z += dppf<0x124>(z); z += dppf<0x128>(z);
                if (lq < 2) Yw[tt * 32 + (wave & 3) * 8 + g * 2 + lq] = z; };
            Ops oa, ob;
            ld(oa, 0);
            for (int tt = 0; tt < 32; tt += 4) {
                ld(ob, tt + 1);
                step(oa, tt);
                ld(oa, tt + 2);
                step(ob, tt + 1);
                ld(ob, tt + 3);
                step(oa, tt + 2);
                ld(oa, (tt + 4 < 32) ? tt + 4 : 31);
                step(ob, tt + 3);
            }
        } else {
            if (ch > 0) yraw_store(ch - 1);
            if (ch + 1 < SEQ / 32) prep(ch + 1, SET0 + ((ch + 1) & 1) * SETF);
        }
    }
    __syncthreads();
    if (wave >= 4) yraw_store(SEQ / 32 - 1);
    __syncthreads();
}

__device__ __forceinline__ void rw_post(const Params& p, int layer) {
    bf16_t* P = (bf16_t*)(p.ws + OFF_P); const bf16_t* YRAW = (const bf16_t*)(p.ws + OFF_YRAW);
    const float* BONUS = (const float*)(p.ws + OFF_BONUS); const float* SSQ = (const float*)(p.ws + OFF_SSQ); float* RSTD = (float*)(p.ws + OFF_RSTD);
    const float* mu = p.in[9] + layer * 2176; const float* lng = p.in[17] + layer * 512; const float* lnb = p.in[18] + layer * 512;
    const int gt = blockIdx.x * 512 + opaque_tid(), gs = gridDim.x * 512;
    {
        const int c = (gt & 127) * 4, h = c >> 6;
        const f32x4 muv = *(const f32x4*)(mu + 1024 + c), mug = *(const f32x4*)(mu + 1536 + c);
        const f32x4 lg = *(const f32x4*)(lng + c), lb = *(const f32x4*)(lnb + c);
        for (int idx0 = gt; idx0 < TOK * 128; idx0 += 4 * gs) {
            u32x2 yv[4], vc[4], gc[4], vp[4], gp[4]; float bn[4]; unsigned pm[4]; bool ok[4];
#pragma unroll
            for (int u = 0; u < 4; ++u) { const int idx = idx0 + u * gs; ok[u] = idx < TOK * 128; const int tok = ok[u] ? (idx >> 7) : 0;
                const bf16_t* cur = P + (size_t)tok * LDP + C_RW; const bool hp = (tok & (SEQ - 1)) > 0; const bf16_t* prv = hp ? cur - LDP : cur; pm[u] = hp ? 0xFFFFFFFFu : 0u;
                yv[u] = *(const u32x2*)(YRAW + (size_t)tok * 512 + c);
                vc[u] = *(const u32x2*)(cur + 1024 + c); gc[u] = *(const u32x2*)(cur + 1536 + c);
                vp[u] = *(const u32x2*)(prv + 1024 + c); gp[u] = *(const u32x2*)(prv + 1536 + c);
                bn[u] = BONUS[(size_t)tok * 8 + h]; }
#pragma unroll
            for (int u = 0; u < 4; ++u) { const int idx = idx0 + u * gs; const int tok = ok[u] ? (idx >> 7) : 0;
                float y[4] = {bf_lo(yv[u].x), bf_hi(yv[u].x), bf_lo(yv[u].y), bf_hi(yv[u].y)};
                const float mean = allred16(y[0] + y[1] + y[2] + y[3]) * (1.f / 64.f);
                float d[4], vs = 0.f;
#pragma unroll
                for (int e = 0; e < 4; ++e) { d[e] = y[e] - mean; vs += d[e] * d[e]; }
                const float var = allred16(vs) * (1.f / 64.f);
                const float rs = rsqrtf(var + 64e-5f);
                const unsigned m = pm[u];
                const float vcur[4] = {bf_lo(vc[u].x), bf_hi(vc[u].x), bf_lo(vc[u].y), bf_hi(vc[u].y)}, vprv[4] = {bf_lo(vp[u].x & m), bf_hi(vp[u].x & m), bf_lo(vp[u].y & m), bf_hi(vp[u].y & m)};
                const float gcur[4] = {bf_lo(gc[u].x), bf_hi(gc[u].x), bf_lo(gc[u].y), bf_hi(gc[u].y)}, gprv[4] = {bf_lo(gp[u].x & m), bf_hi(gp[u].x & m), bf_lo(gp[u].y & m), bf_hi(gp[u].y & m)};
                float o[4];
#pragma unroll
                for (int e = 0; e < 4; ++e) { const float vm = vcur[e] + (vprv[e] - vcur[e]) * muv[e], gm = gcur[e] + (gprv[e] - gcur[e]) * mug[e];
                    o[e] = (d[e] * rs * lg[e] + lb[e] + bn[u] * vm) * siluf_(gm); }
                u32x2 ov; ov.x = cvt_pk_bf16(o[0], o[1]); ov.y = cvt_pk_bf16(o[2], o[3]);
                if (ok[u]) *(u32x2*)(P + (size_t)tok * LDP + C_YRW + c) = ov; }
        }
    }
    for (int tok = gt; tok < TOK; tok += gs) { const f32x4* q = (const f32x4*)(SSQ + (size_t)tok * 32); float s = 0.f;
#pragma unroll
        for (int i = 0; i < 8; ++i) { const f32x4 v = q[i]; s += v[0] + v[1] + v[2] + v[3]; }
        RSTD[tok] = rsqrtf(s * (1.f / 1024.f) + 1e-6f); }
}

#define XB_TMO      128
#define XB_XCNT(j)  (256  + 64 * (j))
#define XB_XSUB(j)  (1280 + 64 * (j))
#define XB_XGEN(j)  (2304 + 64 * (j))
#define XB_TOP      3328
#define XB_TOPGEN   3392
#define XCD_BAR_WORDS 3456
#define XB_SPIN_CAP (1u << 18)
__device__ __forceinline__ unsigned xb_ld(unsigned* p)              { return __hip_atomic_load(p, __ATOMIC_RELAXED, __HIP_MEMORY_SCOPE_AGENT); }
__device__ __forceinline__ unsigned xb_add(unsigned* p, unsigned v) { return __hip_atomic_fetch_add(p, v, __ATOMIC_RELAXED, __HIP_MEMORY_SCOPE_AGENT); }
__device__ __forceinline__ unsigned xb_xcc_id() { return (unsigned)__builtin_amdgcn_s_getreg((3 << 11) | 20) & 0xFu; }
#define XB_SPIN(cond, bar) do { unsigned _sp = 0; while (cond) { __builtin_amdgcn_s_sleep(1); \
    if ((++_sp & 255u) == 0u) { if (xb_ld(&(bar)[XB_TMO])) break; if (_sp > XB_SPIN_CAP) { atomicAdd(&(bar)[XB_TMO], 1u); break; } } } } while (0)
struct XcdBarrier { unsigned* bar; unsigned x; volatile LAS unsigned* st; };
__device__ __forceinline__ XcdBarrier xcd_barrier_post(unsigned* bar, volatile LAS unsigned* st) {
    XcdBarrier b; b.bar = bar; b.x = xb_xcc_id(); b.st = st;
    if (threadIdx.x == 0) (void)xb_add(&bar[XB_XCNT(b.x)], 1u);
    return b;
}
__device__ __forceinline__ void xcd_barrier_complete(unsigned* bar, unsigned x, unsigned& nloc, unsigned& nx) {
    const unsigned G = gridDim.x * gridDim.y * gridDim.z;
    unsigned sum, cnt, mine, sp = 0u;
    for (;;) {
        sum = 0u; cnt = 0u; mine = 0u;
#pragma unroll
        for (unsigned j = 0; j < 16; ++j) { const unsigned c = xb_ld(&bar[XB_XCNT(j)]); sum += c; cnt += (c > 0u) ? 1u : 0u; mine = (j == x) ? c : mine; }
        if (sum == G) break;
        __builtin_amdgcn_s_sleep(1);
        if ((++sp & 255u) == 0u) { if (xb_ld(&bar[XB_TMO])) break; if (sp > XB_SPIN_CAP) { atomicAdd(&bar[XB_TMO], 1u); break; } }
    }
    nloc = mine > 0u ? mine : 1u; nx = cnt > 0u ? cnt : 1u;
}
__device__ __forceinline__ void xcd_barrier(const XcdBarrier& b) {
    asm volatile("s_waitcnt vmcnt(0)" ::: "memory");
    __syncthreads();
    if (threadIdx.x == 0) {
        unsigned* bar = b.bar;
        __builtin_amdgcn_s_waitcnt(0);
        unsigned nloc = b.st[0], nx = b.st[1];
        if (nloc == 0u) { xcd_barrier_complete(bar, b.x, nloc, nx); b.st[0] = nloc; b.st[1] = nx; }
        const unsigned old = xb_add(&bar[XB_XSUB(b.x)], 1u);
        const unsigned gen = old / nloc;
        if (old + 1u == (gen + 1u) * nloc) {
            __builtin_amdgcn_fence(__ATOMIC_RELEASE, "agent");
            asm volatile("s_waitcnt vmcnt(0)" ::: "memory");
            const unsigned og = xb_add(&bar[XB_TOP], 1u);
            const unsigned tg = og / nx;
            if (og + 1u == (tg + 1u) * nx) xb_add(&bar[XB_TOPGEN], 1u);
            else XB_SPIN(xb_ld(&bar[XB_TOPGEN]) == tg, bar);
            __builtin_amdgcn_fence(__ATOMIC_ACQUIRE, "agent");
            xb_add(&bar[XB_XGEN(b.x)], 1u);
            asm volatile("s_waitcnt vmcnt(0)" ::: "memory");
        } else {
            XB_SPIN(xb_ld(&bar[XB_XGEN(b.x)]) == gen, bar);
            __builtin_amdgcn_fence(__ATOMIC_ACQUIRE, "agent");
            asm volatile("s_waitcnt vmcnt(0)" ::: "memory");
        }
    }
    __syncthreads();
}

#define GSYNC() xcd_barrier(xb)
__global__ void __launch_bounds__(512, 2) mega(Params p) {
    extern __shared__ __attribute__((aligned(16))) unsigned char shm[];
    cg::grid_group grid = cg::this_grid();
    volatile LAS unsigned* xst = (volatile LAS unsigned*)((LAS unsigned char*)shm + LDS_BYTES - 16);
    if (threadIdx.x == 0) { xst[0] = 0u; xst[1] = 0u; }
    __syncthreads();
    const XcdBarrier xb = xcd_barrier_post((unsigned*)(p.ws + OFF_BAR), xst);
    const char* Pc = (const char*)(p.ws + OFF_P); const char* WTc = (const char*)(p.ws + OFF_WT);
    bf16_t* P = (bf16_t*)(p.ws + OFF_P);
    const int G = gridDim.x, c = blockIdx.x;
    for (int layer = 0; layer < 2; ++layer) {
        phase0(p, layer, shm);
        if (layer == 0) grid.sync(); else GSYNC();
        { SchedInproj S{Pc, WTc, G, c}; EpiInproj E{P}; pg8::gemm_phase<true>((LAS unsigned char*)shm, S, E); }
        GSYNC();
        { const int Gh = G >> 1;
            constexpr int ATT_B = 1024;
            if (c < Gh) { for (int it = c; it < 128; it += Gh) rwkv_item(p, layer, shm, it);
                for (int it = ATT_B + c; it < 1024; it += Gh) attn_item(p, shm, it); }
            else { const int c2 = c - Gh;
                bc_prepass(p, layer, c2, G - Gh);
                asm volatile("s_waitcnt vmcnt(0)" ::: "memory");
                __syncthreads();
                if (threadIdx.x == 0) { unsigned* cw_ = (unsigned*)(p.ws + OFF_BAR) + 3520; const unsigned need = (unsigned)(G - Gh) * (unsigned)(layer + 1);
                    __builtin_amdgcn_fence(__ATOMIC_RELEASE, "agent"); asm volatile("s_waitcnt vmcnt(0)" ::: "memory");
                    (void)xb_add(cw_, 1u);
                    unsigned sp_ = 0; while (xb_ld(cw_) < need) { __builtin_amdgcn_s_sleep(2); if (++sp_ > (1u << 22)) break; }
                    __builtin_amdgcn_fence(__ATOMIC_ACQUIRE, "agent"); asm volatile("s_waitcnt vmcnt(0)" ::: "memory"); }
                __syncthreads();
                for (int it = c2; it < 128; it += Gh) ssd_item(p, layer, shm, it);
                for (int it = c2; it < ATT_B; it += Gh) attn_item(p, shm, it);
                if (layer == 0) wt_jobs(p, 1, shm, 0, 1664, c2 * 8 + (int)(threadIdx.x >> 6), (G - Gh) * 8); } }
        GSYNC();
        rw_post(p, layer);
        GSYNC();
        { SchedC1 S{Pc, WTc, G, c}; EpiC1 E{P, (const float*)(p.ws + OFF_RSTD)}; pg8::gemm_phase<true>((LAS unsigned char*)shm, S, E); }
        GSYNC();
        { SchedOut S{Pc, WTc, G, c}; EpiOut E{layer == 0 ? p.in[0] : p.out, p.out}; pg8::gemm_phase<false>((LAS unsigned char*)shm, S, E); }
        GSYNC();
    }
    { const int tid = opaque_tid(), wave = tid >> 6, lane = tid & 63; const float* fg = p.in[23];
        for (int row = blockIdx.x * 8 + wave; row < TOK; row += gridDim.x * 8) { float* xr = p.out + (size_t)row * DM;
            f32x4 v[4]; float ss = 0.f;
#pragma unroll
            for (int i = 0; i < 4; ++i) { v[i] = *(const f32x4*)(xr + i * 256 + lane * 4); ss += v[i][0] * v[i][0] + v[i][1] * v[i][1] + v[i][2] * v[i][2] + v[i][3] * v[i][3]; }
            ss = wave_sum(ss);
            const float rs = rsqrtf(ss * (1.f / DM) + 1e-6f);
#pragma unroll
            for (int i = 0; i < 4; ++i) { const f32x4 g = *(const f32x4*)(fg + i * 256 + lane * 4); *(f32x4*)(xr + i * 256 + lane * 4) = v[i] * rs * g; } } }
}

extern "C" void kernel_launch(void* const* d_in, const int* in_sizes, int n_in, void* d_out, int out_size, void* d_ws, size_t ws_size, hipStream_t stream) {
    static int grid_blocks = 0;
    if (grid_blocks == 0) {
        if (n_in != 24 || out_size != TOK * DM || ws_size < WS_NEED) { fprintf(stderr, "kernel_launch: unexpected shapes (n_in %d out %d ws %zu need %zu)\n", n_in, out_size, ws_size, (size_t)WS_NEED); grid_blocks = -1; return; }
        int dev = 0, cus = 0, per_cu = 0;
        hipGetDevice(&dev);
        hipDeviceGetAttribute(&cus, hipDeviceAttributeMultiprocessorCount, dev);
        hipFuncSetAttribute((const void*)mega, hipFuncAttributeMaxDynamicSharedMemorySize, LDS_BYTES);
        hipOccupancyMaxActiveBlocksPerMultiprocessor(&per_cu, (const void*)mega, 512, LDS_BYTES);
        if (per_cu < 1) { fprintf(stderr, "kernel_launch: occupancy query says %d blocks per CU\n", per_cu); grid_blocks = -1; return; }
        if (per_cu > 1) per_cu = 1;
        grid_blocks = cus * per_cu;
        grid_blocks &= ~7;
    }
    if (grid_blocks < 0) return;
    Params p{};
    for (int i = 0; i < 24; ++i) p.in[i] = (const float*)d_in[i];
    p.out = (float*)d_out; p.ws = (unsigned char*)d_ws;
    (void)hipMemsetAsync((unsigned char*)d_ws + OFF_BAR, 0, SZ_BAR, stream);
    void* args[] = {&p};
    hipError_t e = hipLaunchCooperativeKernel((const void*)mega, dim3(grid_blocks), dim3(512), args, LDS_BYTES, stream);
    if (e != hipSuccess) fprintf(stderr, "cooperative launch failed: %s (grid %d)\n", hipGetErrorString(e), grid_blocks);
}
```

```cpp
#include <hip/hip_runtime.h>
#include <hip/hip_cooperative_groups.h>
#include <cstdio>
namespace cg = cooperative_groups;

#define LAS __attribute__((address_space(3)))
typedef unsigned short bf16_t;
typedef short bf16x8 __attribute__((ext_vector_type(8)));
typedef float f32x4 __attribute__((ext_vector_type(4)));
typedef unsigned u32x4 __attribute__((ext_vector_type(4)));
typedef unsigned u32x2 __attribute__((ext_vector_type(2)));

constexpr int TOK = 16384, SEQ = 2048, DM = 1024, NIN = 9616;
constexpr int LDP = 7680;
constexpr int C_Q = 0, C_K = 512, C_V = 1024, C_SBG = 1536, C_Z = 2048, C_XBC = 3072, C_RW = 4352, C_DT = 6528, C_H = 6656;
constexpr int C_M = 0, C_G = 3072, C_YRW = 4352;
constexpr int R_GATE = 6656, R_SB = 9728, R_SSD = 10752, R_RWO = 11776, R_WO = 12800, WT_ROWS = 13824;
constexpr size_t OFF_P = 0, SZ_P = (size_t)TOK * LDP * 2;
constexpr size_t OFF_WT = OFF_P + SZ_P, SZ_WT = (size_t)WT_ROWS * 1024 * 2;
constexpr size_t OFF_YRAW = OFF_WT + SZ_WT, SZ_YRAW = (size_t)TOK * 512 * 2;
constexpr size_t OFF_SSQ = OFF_YRAW + SZ_YRAW, SZ_SSQ = (size_t)TOK * 32 * 4;
constexpr size_t OFF_RSTD = OFF_SSQ + SZ_SSQ, SZ_RSTD = (size_t)TOK * 4;
constexpr size_t OFF_BONUS = OFF_RSTD + SZ_RSTD, SZ_BONUS = (size_t)TOK * 8 * 4;
constexpr size_t OFF_BAR = OFF_BONUS + SZ_BONUS, SZ_BAR = 16384;
constexpr size_t OFF_BCC = OFF_BAR + SZ_BAR, SZ_BCC = (size_t)TOK * 256 * 2;
constexpr size_t WS_NEED = OFF_BCC + SZ_BCC;
constexpr int LDS_BYTES = 135168;

struct Params { const float* in[24]; float* out; unsigned char* ws; };

typedef float f32x2_t __attribute__((ext_vector_type(2)));
typedef __bf16 bf16x2_t __attribute__((ext_vector_type(2)));
__device__ __forceinline__ unsigned cvt_pk_bf16(float lo, float hi) { const f32x2_t v = {lo, hi}; return __builtin_bit_cast(unsigned, __builtin_convertvector(v, bf16x2_t)); }
__device__ __forceinline__ float bf_lo(unsigned u) { return __uint_as_float(u << 16); }
__device__ __forceinline__ float bf_hi(unsigned u) { return __uint_as_float(u & 0xFFFF0000u); }
__device__ __forceinline__ float bf2f(bf16_t h) { return __uint_as_float(((unsigned)h) << 16); }
__device__ __forceinline__ float sigmoidf_(float x) { return __builtin_amdgcn_rcpf(1.f + __expf(-x)); }
__device__ __forceinline__ float siluf_(float x) { return x * __builtin_amdgcn_rcpf(1.f + __expf(-x)); }
__device__ __forceinline__ float softplusf_(float x) { return fmaxf(x, 0.f) + __logf(1.f + __expf(-fabsf(x))); }
template <int CTRL> __device__ __forceinline__ float dppf(float x) { return __int_as_float(__builtin_amdgcn_update_dpp(0, __float_as_int(x), CTRL, 0xF, 0xF, true)); }
__device__ __forceinline__ float allred16(float x) { x += dppf<0xB1>(x); x += dppf<0x4E>(x); x += dppf<0x141>(x); x += dppf<0x140>(x); return x; }
__device__ __forceinline__ int opaque_tid() { int t; asm volatile("v_mov_b32 %0, %1" : "=v"(t) : "v"((int)threadIdx.x)); return t; }
__device__ __forceinline__ float wave_sum(float v) {
#pragma unroll
    for (int o = 1; o < 64; o <<= 1) v += __shfl_xor(v, o);
    return v;
}

namespace pg8 {
constexpr int BM = 256, BK = 64, HALF = 128, HTB = HALF * BK * 2, NXCD = 8, WGM = 8;
constexpr unsigned LDA_B = LDP * 2, LDB_B = 2048;
__device__ __forceinline__ int lds_byte(int r, int c) { const int st = (r >> 4) * 2 + (c >> 5), rr = r & 15, cc = c & 31, ob = rr * 64 + cc * 2; return st * 1024 + (ob ^ (((ob >> 9) & 1) << 5)); }
__device__ __forceinline__ void stage_rc(int b, int& R, int& C) { const int st = b / 1024, sb = b % 1024, swz = sb ^ (((sb >> 9) & 1) << 5); R = (st >> 1) * 16 + swz / 64; C = (st & 1) * 32 + (swz % 64) / 2; }
__device__ __forceinline__ int perm32(int rho) { const int n = rho >> 4, i = rho & 15; return 8 * (i >> 2) + 4 * n + (i & 3); }
struct UnitD { const char* A; const char* B; int nt, pm, pn, kind; };
__device__ __forceinline__ void tile_of(int L, int nM, int nN, int& pm, int& pn) {
    const int nwg = nM * nN; int wgid = L;
    { const int q = nwg / NXCD, r = nwg % NXCD, xcd = wgid % NXCD, off = wgid / NXCD; wgid = (xcd < r ? xcd * (q + 1) : r * (q + 1) + (xcd - r) * q) + off; }
    const int nig = WGM * nN, gid = wgid / nig, fm = gid * WGM, gsz = (nM - fm) < WGM ? (nM - fm) : WGM;
    pm = fm + ((wgid % nig) % gsz); pn = (wgid % nig) / gsz;
}

template <bool PERM, class Sched, class Epi>
__device__ __forceinline__ void gemm_phase(LAS unsigned char* lds, const Sched& S, const Epi& E) {
    const int tid = opaque_tid(), wid = __builtin_amdgcn_readfirstlane(tid >> 6), lane = tid & 63, wr = wid >> 2, wc = wid & 3, fr = lane & 15, fq = lane >> 4;
    unsigned voffA[2], voffB[2];
#pragma unroll
    for (int i = 0; i < 2; ++i) { int R, C; stage_rc(tid * 16 + i * 8192, R, C); const int Rb = PERM ? ((R & ~31) + perm32(R & 31)) : R;
        voffA[i] = (unsigned)R * LDA_B + (unsigned)C * 2u; voffB[i] = (unsigned)Rb * LDB_B + (unsigned)C * 2u; }
    const size_t kstep = (size_t)(BK * 2);
    const size_t hstepA = (size_t)HALF * LDA_B, hstepB = (size_t)HALF * LDB_B;
    const unsigned ldsw = (unsigned)wid * 1024u;
    const int aoff = lds_byte(wr * 64 + fr, fq * 8), boff = lds_byte(wc * 32 + fr, fq * 8);
#define PG8_SA(b, h) (((b) * 2 + (h)) * HTB)
#define PG8_SB(b, h) ((4 + (b) * 2 + (h)) * HTB)
#define PG8_STAGE(bufoff, gbase, voff) do { _Pragma("unroll") for (int _i = 0; _i < 2; ++_i) \
        __builtin_amdgcn_global_load_lds((const unsigned*)((const char*)(gbase) + (voff)[_i]), (LAS unsigned*)(lds + (bufoff) + ldsw + _i * 8192), 16, 0, 0); } while (0)
#define PG8_LDA(dst, b, h) do { _Pragma("unroll") for (int m = 0; m < 4; ++m) _Pragma("unroll") for (int k = 0; k < 2; ++k) dst[m][k] = *(const LAS bf16x8*)(lds + PG8_SA(b, h) + aoff + m * 2048 + k * 1024); } while (0)
#define PG8_LDB(dst, b, h) do { _Pragma("unroll") for (int n = 0; n < 2; ++n) _Pragma("unroll") for (int k = 0; k < 2; ++k) dst[n][k] = *(const LAS bf16x8*)(lds + PG8_SB(b, h) + boff + n * 2048 + k * 1024); } while (0)
#define PG8_MMA(ai, bj, At, Bt) do { __builtin_amdgcn_s_setprio(1); _Pragma("unroll") for (int m = 0; m < 4; ++m) _Pragma("unroll") for (int n = 0; n < 2; ++n) _Pragma("unroll") for (int k = 0; k < 2; ++k) \
        acc[ai][bj][m][n] = __builtin_amdgcn_mfma_f32_16x16x32_bf16(Bt[n][k], At[m][k], acc[ai][bj][m][n], 0, 0, 0); __builtin_amdgcn_s_setprio(0); } while (0)
#define PG8_WAIT_V(n) asm volatile("s_waitcnt vmcnt(" #n ")" ::: "memory")
#define PG8_WAIT_L(n) asm volatile("s_waitcnt lgkmcnt(" #n ")" ::: "memory")
#define PG8_BAR __builtin_amdgcn_s_barrier()
#define PG8_SCHED __builtin_amdgcn_sched_barrier(0)
    UnitD cur, nxt; int ui = 0;
    if (!S.next(0, cur)) return;
    f32x4 acc[2][2][4][2];
#pragma unroll
    for (int a = 0; a < 2; ++a)
#pragma unroll
        for (int b = 0; b < 2; ++b)
#pragma unroll
            for (int m = 0; m < 4; ++m)
#pragma unroll
                for (int n = 0; n < 2; ++n) acc[a][b][m][n] = (f32x4){0.f, 0.f, 0.f, 0.f};
    bf16x8 At[4][2], B0[2][2], B1[2][2];
    const char* cA = cur.A; const char* cB = cur.B;
    PG8_STAGE(PG8_SB(0, 0), cB, voffB); PG8_STAGE(PG8_SA(0, 0), cA, voffA); PG8_STAGE(PG8_SB(0, 1), cB + hstepB, voffB); PG8_STAGE(PG8_SA(0, 1), cA + hstepA, voffA);
    if (wr == 1) PG8_BAR;
    PG8_WAIT_V(4); PG8_BAR;
    PG8_STAGE(PG8_SB(1, 0), cB + kstep, voffB); PG8_STAGE(PG8_SA(1, 0), cA + kstep, voffA); PG8_STAGE(PG8_SB(1, 1), cB + hstepB + kstep, voffB);
    PG8_WAIT_V(6); PG8_BAR;
    for (;;) {
        const bool has_next = S.next(ui + 1, nxt);
        const char* nA = has_next ? nxt.A : cA; const char* nB = has_next ? nxt.B : cB;
        const int nt = cur.nt;
        for (int t = 0; t < nt; t += 2) {
            const bool last = (t == nt - 2);
            const char* a1 = cA + (size_t)(t + 1) * kstep;
            const char* a2 = last ? nA : cA + (size_t)(t + 2) * kstep; const char* b2 = last ? nB : cB + (size_t)(t + 2) * kstep;
            const char* a3 = a2 + kstep; const char* b3 = b2 + kstep;
            PG8_LDB(B0, 0, 0); PG8_SCHED; PG8_LDA(At, 0, 0); PG8_STAGE(PG8_SA(1, 1), a1 + hstepA, voffA);
            PG8_WAIT_L(8); PG8_BAR; PG8_WAIT_L(0); PG8_MMA(0, 0, At, B0); PG8_BAR; PG8_SCHED;
            PG8_LDB(B1, 0, 1); PG8_STAGE(PG8_SB(0, 0), b2, voffB);
            PG8_BAR; PG8_WAIT_L(0); PG8_MMA(0, 1, At, B1); PG8_BAR;
            PG8_LDA(At, 0, 1); PG8_STAGE(PG8_SA(0, 0), a2, voffA);
            PG8_BAR; PG8_WAIT_L(0); PG8_MMA(1, 0, At, B0); PG8_BAR; PG8_SCHED;
            PG8_STAGE(PG8_SB(0, 1), b2 + hstepB, voffB);
            PG8_WAIT_V(6); PG8_BAR; PG8_MMA(1, 1, At, B1); PG8_BAR;
            PG8_LDB(B0, 1, 0); PG8_SCHED; PG8_LDA(At, 1, 0); PG8_STAGE(PG8_SA(0, 1), a2 + hstepA, voffA);
            PG8_WAIT_L(8); PG8_BAR; PG8_WAIT_L(0); PG8_MMA(0, 0, At, B0); PG8_BAR; PG8_SCHED;
            PG8_LDB(B1, 1, 1); PG8_STAGE(PG8_SB(1, 0), b3, voffB);
            PG8_BAR; PG8_WAIT_L(0); PG8_MMA(0, 1, At, B1); PG8_BAR;
            PG8_LDA(At, 1, 1); PG8_STAGE(PG8_SA(1, 0), a3, voffA);
            PG8_BAR; PG8_WAIT_L(0); PG8_MMA(1, 0, At, B0); PG8_BAR; PG8_SCHED;
            PG8_STAGE(PG8_SB(1, 1), b3 + hstepB, voffB);
            PG8_WAIT_V(6); PG8_BAR; PG8_MMA(1, 1, At, B1); PG8_BAR;
        }
        E(acc, cur, wr, wc, fr, fq);
        if (!has_next) break;
#pragma unroll
        for (int a = 0; a < 2; ++a)
#pragma unroll
            for (int b = 0; b < 2; ++b)
#pragma unroll
                for (int m = 0; m < 4; ++m)
#pragma unroll
                    for (int n = 0; n < 2; ++n) acc[a][b][m][n] = (f32x4){0.f, 0.f, 0.f, 0.f};
        cur = nxt; cA = nA; cB = nB; ++ui;
    }
    PG8_WAIT_V(0);
    if (wr == 0) PG8_BAR;
    PG8_BAR;
#undef PG8_SA
#undef PG8_SB
#undef PG8_STAGE
#undef PG8_LDA
#undef PG8_LDB
#undef PG8_MMA
#undef PG8_WAIT_V
#undef PG8_WAIT_L
#undef PG8_BAR
#undef PG8_SCHED
}
}
using pg8::UnitD;

struct SchedInproj {
    const char* P; const char* WT; int G, c, nN, pn0, gap_lo, gap_n;
    __device__ __forceinline__ bool next(int i, UnitD& u) const {
        const int L = i * G + c; if (L >= 64 * nN) return false;
        int pm, pn; pg8::tile_of(L, 64, nN, pm, pn); pn += pn0; if (pn >= gap_lo) pn += gap_n;
        u.A = P + ((size_t)pm * 256 * LDP + C_H) * 2; u.B = WT + (size_t)pn * 256 * 2048; u.nt = 16; u.pm = pm; u.pn = pn; u.kind = 0; return true;
    }
};
struct EpiInproj {
    bf16_t* P;
    __device__ __forceinline__ void operator()(const f32x4 (&acc)[2][2][4][2], const UnitD& u, int wr, int wc, int fr, int fq) const {
        const int row0 = u.pm * 256 + wr * 64 + fr, col0 = u.pn * 256 + wc * 32 + 8 * fq;
#pragma unroll
        for (int ai = 0; ai < 2; ++ai)
#pragma unroll
            for (int m = 0; m < 4; ++m) { bf16_t* rowp = P + (size_t)(row0 + ai * 128 + m * 16) * LDP + col0;
#pragma unroll
                for (int bj = 0; bj < 2; ++bj) { const f32x4 v0 = acc[ai][bj][m][0], v1 = acc[ai][bj][m][1];
                    u32x4 o; o.x = cvt_pk_bf16(v0[0], v0[1]); o.y = cvt_pk_bf16(v0[2], v0[3]); o.z = cvt_pk_bf16(v1[0], v1[1]); o.w = cvt_pk_bf16(v1[2], v1[3]);
                    *(u32x4*)(rowp + bj * 128) = o; } }
    }
};
struct SchedC1 {
    const char* P; const char* WT; int G, c;
    __device__ __forceinline__ bool next(int i, UnitD& u) const {
        const int ti = i / 6, sub = i - ti * 6, L = ti * G + c; if (L >= 256) return false;
        int pm, pn; pg8::tile_of(L, 64, 4, pm, pn);
        const int br = sub >> 1;
        if (!(sub & 1)) { u.A = P + ((size_t)pm * 256 * LDP + C_H) * 2; u.B = WT + (size_t)(R_GATE + br * 1024 + pn * 256) * 2048; u.nt = 16; }
        else { const int acol = br == 0 ? C_SBG : (br == 1 ? C_Z : C_YRW); const int brow = br == 0 ? R_SB : (br == 1 ? R_SSD : R_RWO);
            u.A = P + ((size_t)pm * 256 * LDP + acol) * 2; u.B = WT + (size_t)(brow + pn * 256) * 2048; u.nt = br == 1 ? 16 : 8; }
        u.pm = pm; u.pn = pn; u.kind = sub; return true;
    }
};
struct EpiC1 {
    bf16_t* P; const float* rstd;
    __device__ __forceinline__ void operator()(const f32x4 (&acc)[2][2][4][2], const UnitD& u, int wr, int wc, int fr, int fq) const {
        const int row0 = u.pm * 256 + wr * 64 + fr, col0 = u.pn * 256 + wc * 32 + 8 * fq;
        const int kind = u.kind;
#pragma unroll
        for (int ai = 0; ai < 2; ++ai)
#pragma unroll
            for (int m = 0; m < 4; ++m) { const int row = row0 + ai * 128 + m * 16; bf16_t* rowp = P + (size_t)row * LDP + col0;
                const float sc = (kind == 3) ? rstd[row] : 1.f;
#pragma unroll
                for (int bj = 0; bj < 2; ++bj) { const f32x4 v0 = acc[ai][bj][m][0], v1 = acc[ai][bj][m][1];
                    float v[8] = {v0[0], v0[1], v0[2], v0[3], v1[0], v1[1], v1[2], v1[3]};
                    u32x4* gp = (u32x4*)(rowp + C_G + bj * 128); u32x4* mp = (u32x4*)(rowp + C_M + bj * 128);
                    if (!(kind & 1)) {
#pragma unroll
                        for (int e = 0; e < 8; ++e) v[e] = sigmoidf_(v[e]);
                        u32x4 o; o.x = cvt_pk_bf16(v[0], v[1]); o.y = cvt_pk_bf16(v[2], v[3]); o.z = cvt_pk_bf16(v[4], v[5]); o.w = cvt_pk_bf16(v[6], v[7]);
                        *gp = o;
                    } else {
                        const u32x4 g = *gp;
                        float r[8];
                        r[0] = bf_lo(g.x) * v[0] * sc; r[1] = bf_hi(g.x) * v[1] * sc; r[2] = bf_lo(g.y) * v[2] * sc; r[3] = bf_hi(g.y) * v[3] * sc;
                        r[4] = bf_lo(g.z) * v[4] * sc; r[5] = bf_hi(g.z) * v[5] * sc; r[6] = bf_lo(g.w) * v[6] * sc; r[7] = bf_hi(g.w) * v[7] * sc;
                        if (kind != 1) { const u32x4 mo = *mp;
                            r[0] += bf_lo(mo.x); r[1] += bf_hi(mo.x); r[2] += bf_lo(mo.y); r[3] += bf_hi(mo.y); r[4] += bf_lo(mo.z); r[5] += bf_hi(mo.z); r[6] += bf_lo(mo.w); r[7] += bf_hi(mo.w); }
                        u32x4 o; o.x = cvt_pk_bf16(r[0], r[1]); o.y = cvt_pk_bf16(r[2], r[3]); o.z = cvt_pk_bf16(r[4], r[5]); o.w = cvt_pk_bf16(r[6], r[7]);
                        *mp = o;
                    } } }
    }
};
struct SchedOut {
    const char* P; const char* WT; int G, c;
    __device__ __forceinline__ bool next(int i, UnitD& u) const {
        const int L = i * G + c; if (L >= 256) return false;
        int pm, pn; pg8::tile_of(L, 64, 4, pm, pn);
        u.A = P + ((size_t)pm * 256 * LDP + C_M) * 2; u.B = WT + (size_t)(R_WO + pn * 256) * 2048; u.nt = 16; u.pm = pm; u.pn = pn; u.kind = 0; return true;
    }
};
struct EpiOut {
    const float* Xin; float* Xout;
    __device__ __forceinline__ void operator()(const f32x4 (&acc)[2][2][4][2], const UnitD& u, int wr, int wc, int fr, int fq) const {
        const int row0 = u.pm * 256 + wr * 64 + fr, col0 = u.pn * 256 + wc * 32 + 4 * fq;
#pragma unroll
        for (int ai = 0; ai < 2; ++ai)
#pragma unroll
            for (int m = 0; m < 4; ++m) { const size_t ro = (size_t)(row0 + ai * 128 + m * 16) * DM + col0;
#pragma unroll
                for (int bj = 0; bj < 2; ++bj)
#pragma unroll
                    for (int n = 0; n < 2; ++n) { const f32x4 xi = *(const f32x4*)(Xin + ro + bj * 128 + n * 16); *(f32x4*)(Xout + ro + bj * 128 + n * 16) = xi + acc[ai][bj][m][n]; } }
    }
};

__device__ __forceinline__ void wt_jobs(const Params& p, int layer, unsigned char* shm, int job_lo, int job_hi, int widx, int wstride) {
    const int tid = opaque_tid(), wave = tid >> 6, lane = tid & 63;
    bf16_t* WT = (bf16_t*)(p.ws + OFF_WT);
    float* T = (float*)shm + wave * (64 * 65);
    const float* w_in = p.in[2] + (size_t)layer * DM * NIN;
    const float* sg = p.in[8] + layer * DM;
    for (int job = job_lo + widx; job < job_hi; job += wstride) {
        const float* src; int srcN, k0, n0, dstrow; bool is_in = false, is_ssd = false;
        if (job < 2432) { is_in = true; src = w_in; srcN = NIN; const int ntile = job >> 4; k0 = (job & 15) * 64; n0 = ntile * 64; dstrow = n0; }
        else { int r = job - 2432;
            if (r < 128) { src = p.in[19] + (size_t)layer * 512 * DM; k0 = (r >> 4) * 64; n0 = (r & 15) * 64; dstrow = R_SB + n0; }
            else if (r < 384) { r -= 128; src = p.in[20] + (size_t)layer * DM * DM; k0 = (r >> 4) * 64; n0 = (r & 15) * 64; dstrow = R_SSD + n0; is_ssd = true; }
            else if (r < 512) { r -= 384; src = p.in[21] + (size_t)layer * 512 * DM; k0 = (r >> 4) * 64; n0 = (r & 15) * 64; dstrow = R_RWO + n0; }
            else { r -= 512; src = p.in[22] + (size_t)layer * DM * DM; k0 = (r >> 4) * 64; n0 = (r & 15) * 64; dstrow = R_WO + n0; }
            srcN = DM; }
        const int n4 = (lane & 15) * 4, np = n0 + n4; int sc = np;
        if (is_in) { if (np < 4352) sc = np; else if (np < 6528) sc = np + 16; else if (np < 6544) sc = np - 6528 + 4352; else if (np < 6656) sc = -1; else sc = np - 112; }
        f32x4 v[16];
#pragma unroll
        for (int i = 0; i < 16; ++i) { const int k = (lane >> 4) + 4 * i; v[i] = (f32x4){0.f, 0.f, 0.f, 0.f};
            if (sc >= 0) v[i] = *(const f32x4*)(src + (size_t)(k0 + k) * srcN + sc); }
#pragma unroll
        for (int i = 0; i < 16; ++i) { const int k = (lane >> 4) + 4 * i; f32x4 x = v[i];
            if (is_ssd) x = x * sg[k0 + k];
            T[k * 65 + n4] = x[0]; T[k * 65 + n4 + 1] = x[1]; T[k * 65 + n4 + 2] = x[2]; T[k * 65 + n4 + 3] = x[3]; }
        asm volatile("s_waitcnt lgkmcnt(0)" ::: "memory"); __builtin_amdgcn_wave_barrier(); asm volatile("" ::: "memory");
#pragma unroll
        for (int j = 0; j < 8; ++j) { const int r = lane + 64 * j, n = r >> 3, kc = (r & 7) * 8; const float* sp = T + kc * 65 + n;
            u32x4 o; o.x = cvt_pk_bf16(sp[0], sp[65]); o.y = cvt_pk_bf16(sp[130], sp[195]); o.z = cvt_pk_bf16(sp[260], sp[325]); o.w = cvt_pk_bf16(sp[390], sp[455]);
            *(u32x4*)(WT + (size_t)(dstrow + n) * 1024 + k0 + kc) = o; }
        asm volatile("s_waitcnt lgkmcnt(0)" ::: "memory"); __builtin_amdgcn_wave_barrier(); asm volatile("" ::: "memory");
    }
    __syncthreads();
}

__device__ __forceinline__ void phase0(const Params& p, int layer, unsigned char* shm) {
    const int tid = opaque_tid(), wave = tid >> 6, lane = tid & 63;
    bf16_t* P = (bf16_t*)(p.ws + OFF_P); bf16_t* WT = (bf16_t*)(p.ws + OFF_WT);
    const float* Xin = layer == 0 ? p.in[0] : p.out;
    const float* ng = p.in[1] + layer * DM;
    f32x4 gn[4];
#pragma unroll
    for (int i = 0; i < 4; ++i) gn[i] = *(const f32x4*)(ng + i * 256 + lane * 4);
    for (int row0 = (blockIdx.x * 8 + wave) * 4; row0 < TOK; row0 += gridDim.x * 32) {
        f32x4 v[4][4]; float ss[4];
#pragma unroll
        for (int rr = 0; rr < 4; ++rr) { const float* xr = Xin + (size_t)(row0 + rr) * DM;
#pragma unroll
            for (int i = 0; i < 4; ++i) v[rr][i] = *(const f32x4*)(xr + i * 256 + lane * 4); }
#pragma unroll
        for (int rr = 0; rr < 4; ++rr) { float a = 0.f;
#pragma unroll
            for (int i = 0; i < 4; ++i) a += v[rr][i][0] * v[rr][i][0] + v[rr][i][1] * v[rr][i][1] + v[rr][i][2] * v[rr][i][2] + v[rr][i][3] * v[rr][i][3];
            ss[rr] = wave_sum(a); }
#pragma unroll
        for (int rr = 0; rr < 4; ++rr) { const float rs = rsqrtf(ss[rr] * (1.f / DM) + 1e-6f);
#pragma unroll
            for (int i = 0; i < 4; ++i) { const f32x4 g = gn[i];
                u32x2 o; o.x = cvt_pk_bf16(v[rr][i][0] * rs * g[0], v[rr][i][1] * rs * g[1]); o.y = cvt_pk_bf16(v[rr][i][2] * rs * g[2], v[rr][i][3] * rs * g[3]);
                *(u32x2*)(P + (size_t)(row0 + rr) * LDP + C_H + i * 256 + lane * 4) = o; } }
    }
    wt_jobs(p, layer, shm, (layer == 1) ? 1664 : 0, 3200, blockIdx.x * 8 + wave, gridDim.x * 8);
}

__device__ __forceinline__ void attn_item(const Params& p, unsigned char* shm, int item) {
    const int qb = item & 15, h = (item >> 4) & 7, b = item >> 7;
    bf16_t* P = (bf16_t*)(p.ws + OFF_P);
    const int tid = opaque_tid(), wave = tid >> 6, lane = tid & 63, lq = lane & 15, g = lane >> 4;
    const size_t rowbase = (size_t)b * SEQ;
    const int t = qb * 128 + wave * 16 + lq;
    const int tmax = qb * 128 + wave * 16 + 15;
    constexpr int ABUF = 64 * 144 + 64 * 136;
    const bf16_t* qp = P + (rowbase + t) * LDP + C_Q + h * 64 + 8 * g;
    const bf16x8 qf0 = *(const bf16x8*)qp, qf1 = *(const bf16x8*)(qp + 32);
    bf16x8 TT[4][2];
#pragma unroll
    for (int a = 0; a < 4; ++a)
#pragma unroll
        for (int ks = 0; ks < 2; ++ks)
#pragma unroll
            for (int e = 0; e < 8; ++e) { const int j = 16 * (2 * ks + (e >> 2)) + 4 * g + (e & 3); TT[a][ks][e] = (j > 16 * a + lq) ? (short)0x3F80 : (short)0; }
    f32x4 o[4];
#pragma unroll
    for (int i = 0; i < 4; ++i) o[i] = (f32x4){0.f, 0.f, 0.f, 0.f};
    float R = 0.f;
    LAS volatile int* flg = (LAS volatile int*)((LAS unsigned char*)shm + 2 * ABUF);
    const int st_s = tid >> 3, st_dc = (tid & 7) * 8;
    const bf16_t* st_base = P + (rowbase + st_s) * LDP + h * 64 + st_dc;
    auto stage_write = [&](unsigned char* buf, const u32x4& kv, const u32x4& vv) {
        bf16_t* Ksw = (bf16_t*)buf; bf16_t* Vtw = (bf16_t*)(buf + 64 * 144); const int s_ = st_s, dc = st_dc;
        *(u32x4*)(Ksw + s_ * 72 + dc) = kv;
        Vtw[(dc + 0) * 68 + s_] = (bf16_t)(vv.x & 0xFFFF); Vtw[(dc + 1) * 68 + s_] = (bf16_t)(vv.x >> 16);
        Vtw[(dc + 2) * 68 + s_] = (bf16_t)(vv.y & 0xFFFF); Vtw[(dc + 3) * 68 + s_] = (bf16_t)(vv.y >> 16);
        Vtw[(dc + 4) * 68 + s_] = (bf16_t)(vv.z & 0xFFFF); Vtw[(dc + 5) * 68 + s_] = (bf16_t)(vv.z >> 16);
        Vtw[(dc + 6) * 68 + s_] = (bf16_t)(vv.w & 0xFFFF); Vtw[(dc + 7) * 68 + s_] = (bf16_t)(vv.w >> 16);
    };
    if (tid == 0) { flg[0] = 1; flg[1] = 0; flg[2] = 0; }
    { const bf16_t* kr = st_base + (size_t)(2 * qb + 1) * 64 * LDP; const u32x4 kv0 = *(const u32x4*)(kr + C_K), vv0 = *(const u32x4*)(kr + C_V); stage_write(shm, kv0, vv0); }
    int itn = 0, cur = 0;
    for (int kt = 2 * qb + 1; kt >= 0; --kt) {
        __syncthreads();
        const int f0 = itn % 3, f1 = (itn + 1) % 3, f2 = (itn + 2) % 3;
        if (flg[f0] == 0) break;
        if (tid == 0) flg[f2] = 0;
        u32x4 kvn = (u32x4){0u, 0u, 0u, 0u}, vvn = (u32x4){0u, 0u, 0u, 0u};
        if (kt > 0) { const bf16_t* kr = st_base + (size_t)(kt - 1) * 64 * LDP; kvn = *(const u32x4*)(kr + C_K); vvn = *(const u32x4*)(kr + C_V); }
        const bf16_t* Ks = (const bf16_t*)(shm + cur * ABUF); const bf16_t* Vt = (const bf16_t*)(shm + cur * ABUF + 64 * 144);
        const bool walive = __any(R > -104.f);
        const bool act = (kt * 64 < tmax) && walive;
        if (act) {
            float lb[4][4], lk[4][4];
#pragma unroll
            for (int sub = 0; sub < 4; ++sub) {
                const bf16_t* kp = Ks + (16 * sub + lq) * 72 + 8 * g;
                const bf16x8 k0 = *(const bf16x8*)kp, k1 = *(const bf16x8*)(kp + 32);
                f32x4 s4 = (f32x4){0.f, 0.f, 0.f, 0.f};
                s4 = __builtin_amdgcn_mfma_f32_16x16x32_bf16(k0, qf0, s4, 0, 0, 0);
                s4 = __builtin_amdgcn_mfma_f32_16x16x32_bf16(k1, qf1, s4, 0, 0, 0);
#pragma unroll
                for (int r = 0; r < 4; ++r) { const float z = s4[r] * 0.125f; const bool mk = (kt * 64 + 16 * sub + 4 * g + r) < t;
                    const float l = fminf(z, 0.f) - 0.69314718f * __builtin_amdgcn_logf(1.f + __expf(-fabsf(z)));
                    lb[sub][r] = mk ? l : -1e30f; lk[sub][r] = mk ? (l - z) : 0.f; }
            }
            bf16x8 hi[2];
#pragma unroll
            for (int ks = 0; ks < 2; ++ks) {
                unsigned hw[4];
#pragma unroll
                for (int w2 = 0; w2 < 4; ++w2) { const int sub = 2 * ks + (w2 >> 1), r0 = (w2 & 1) * 2; const float a0 = lk[sub][r0], a1 = lk[sub][r0 + 1];
                    hw[w2] = cvt_pk_bf16(a0, a1); }
                u32x4 hv = (u32x4){hw[0], hw[1], hw[2], hw[3]};
                hi[ks] = __builtin_bit_cast(bf16x8, hv);
            }
            f32x4 aft[4];
#pragma unroll
            for (int a = 0; a < 4; ++a) { f32x4 c = (f32x4){0.f, 0.f, 0.f, 0.f};
#pragma unroll
                for (int ks = 0; ks < 2; ++ks) c = __builtin_amdgcn_mfma_f32_16x16x32_bf16(TT[a][ks], hi[ks], c, 0, 0, 0);
                aft[a] = c; }
            float tot = aft[0][0] + lk[0][0];
            tot = __shfl(tot, lq);
            bf16x8 pf[2];
#pragma unroll
            for (int ks = 0; ks < 2; ++ks) { unsigned pw[4];
#pragma unroll
                for (int w2 = 0; w2 < 4; ++w2) { const int sub = 2 * ks + (w2 >> 1), r0 = (w2 & 1) * 2;
                    const float e0 = __expf(lb[sub][r0] + aft[sub][r0] + R), e1 = __expf(lb[sub][r0 + 1] + aft[sub][r0 + 1] + R);
                    pw[w2] = cvt_pk_bf16(e0, e1); }
                u32x4 pv = (u32x4){pw[0], pw[1], pw[2], pw[3]}; pf[ks] = __builtin_bit_cast(bf16x8, pv); }
            R += tot;
#pragma unroll
            for (int ds = 0; ds < 4; ++ds)
#pragma unroll
                for (int ks = 0; ks < 2; ++ks) { const bf16_t* vp = Vt + (16 * ds + lq) * 68 + 32 * ks + 4 * g;
                    const u32x2 v0 = *(const u32x2*)vp, v1 = *(const u32x2*)(vp + 16);
                    u32x4 vv = (u32x4){v0.x, v0.y, v1.x, v1.y};
                    o[ds] = __builtin_amdgcn_mfma_f32_16x16x32_bf16(__builtin_bit_cast(bf16x8, vv), pf[ks], o[ds], 0, 0, 0); }
        }
        if (__any(R > -104.f) && lane == 0) flg[f1] = 1;
        if (kt > 0) stage_write(shm + (cur ^ 1) * ABUF, kvn, vvn);
        cur ^= 1; ++itn;
    }
#pragma unroll
    for (int ds = 0; ds < 4; ++ds) { bf16_t* gp = P + (rowbase + t) * LDP + C_SBG + h * 64 + 16 * ds + 4 * g;
        const u32x2 gv = *(const u32x2*)gp;
        u32x2 ov; ov.x = cvt_pk_bf16(o[ds][0] * siluf_(bf_lo(gv.x)), o[ds][1] * siluf_(bf_hi(gv.x))); ov.y = cvt_pk_bf16(o[ds][2] * siluf_(bf_lo(gv.y)), o[ds][3] * siluf_(bf_hi(gv.y)));
        *(u32x2*)gp = ov; }
    __syncthreads();
}

__device__ __forceinline__ void bc_prepass(const Params& p, int layer, int blk, int nblk) {
    const bf16_t* P = (const bf16_t*)(p.ws + OFF_P); bf16_t* BCc = (bf16_t*)(p.ws + OFF_BCC);
    const float* cw = p.in[3] + (size_t)layer * 4 * 1280; const float* cb = p.in[4] + layer * 1280;
    const int gt = blk * 512 + opaque_tid(), gs = nblk * 512;
    const int c = (gt & 63) * 4, chn = 1024 + c;
    const f32x4 bias = *(const f32x4*)(cb + chn);
    f32x4 w[4];
#pragma unroll
    for (int k = 0; k < 4; ++k) w[k] = *(const f32x4*)(cw + k * 1280 + chn);
    for (int idx0 = gt; idx0 < TOK * 64; idx0 += 4 * gs) {
        u32x2 xv[4][4]; bool ok[4];
#pragma unroll
        for (int u = 0; u < 4; ++u) { const int idx = idx0 + u * gs; ok[u] = idx < TOK * 64; const int tok = ok[u] ? (idx >> 6) : 0; const int t = tok & (SEQ - 1);
            const bf16_t* xp = P + (size_t)tok * LDP + C_XBC + chn;
#pragma unroll
            for (int k = 0; k < 4; ++k) { const int ts = t - 3 + k; const unsigned xm = ts >= 0 ? 0xFFFFFFFFu : 0u;
                u32x2 x = *(const u32x2*)(xp + (ptrdiff_t)(ts >= 0 ? k - 3 : 0) * LDP); x.x &= xm; x.y &= xm; xv[u][k] = x; } }
#pragma unroll
        for (int u = 0; u < 4; ++u) { const int idx = idx0 + u * gs; const int tok = ok[u] ? (idx >> 6) : 0;
            f32x4 a = bias;
#pragma unroll
            for (int k = 0; k < 4; ++k) { a[0] += w[k][0] * bf_lo(xv[u][k].x); a[1] += w[k][1] * bf_hi(xv[u][k].x); a[2] += w[k][2] * bf_lo(xv[u][k].y); a[3] += w[k][3] * bf_hi(xv[u][k].y); }
            u32x2 o; o.x = cvt_pk_bf16(siluf_(a[0]), siluf_(a[1])); o.y = cvt_pk_bf16(siluf_(a[2]), siluf_(a[3]));
            if (ok[u]) *(u32x2*)(BCc + (size_t)tok * 256 + c) = o; }
    }
}

__device__ __forceinline__ void ssd_item(const Params& p, int layer, unsigned char* shm, int item) {
    const int hh = item & 15, b = item >> 4, grp = hh >> 3;
    bf16_t* P = (bf16_t*)(p.ws + OFF_P); float* SSQ = (float*)(p.ws + OFF_SSQ);
    const int tid = opaque_tid(), wave = tid >> 6, lane = tid & 63, lq = lane & 15, g = lane >> 4;
    const size_t rowbase = (size_t)b * SEQ;
    const float* cw = p.in[3] + (size_t)layer * 4 * 1280; const float* cb = p.in[4] + layer * 1280;
    const float dtb = p.in[5][layer * 16 + hh], Aneg = -__expf(p.in[6][layer * 16 + hh]), Dsk = p.in[7][layer * 16 + hh];
    float* XS = (float*)shm;
    float* YS = XS + 4096;
    float* DTs = YS + 4096;
    float* ACS = DTs + 64;
    bf16_t* Cb = (bf16_t*)(ACS + 64);
    bf16_t* Bb = Cb + 64 * 72;
    bf16_t* BT = Bb + 64 * 72;
    bf16_t* Mx = BT + 64 * 72;
    bf16_t* XT = Mx + 64 * 72;
    bf16_t* XwT = XT + 64 * 72;
    bf16_t* SbT = XwT + 64 * 72;
    f32x4 Sacc[2] = {(f32x4){0.f, 0.f, 0.f, 0.f}, (f32x4){0.f, 0.f, 0.f, 0.f}};
    const bf16_t* BCc = (const bf16_t*)(p.ws + OFF_BCC);
    const int x_tt = tid >> 3, x_c = (tid & 7) * 4;
    const int bc_q = tid & 7;
    f32x4 xbias[2], xw[2][4];
#pragma unroll
    for (int h2 = 0; h2 < 2; ++h2) { const int chn = hh * 64 + x_c + 32 * h2; xbias[h2] = *(const f32x4*)(cb + chn);
#pragma unroll
        for (int k = 0; k < 4; ++k) xw[h2][k] = *(const f32x4*)(cw + k * 1280 + chn); }
    u32x2 sx[2][4]; u32x4 bc0, bc1; bf16_t sdt = 0;
    auto ssd_load = [&](int tb) {
        const int t = tb + x_tt;
#pragma unroll
        for (int h2 = 0; h2 < 2; ++h2) { const bf16_t* xp = P + (rowbase + t) * LDP + C_XBC + hh * 64 + x_c + 32 * h2;
#pragma unroll
            for (int k = 0; k < 4; ++k) { const int ts = t - 3 + k; const unsigned xm = ts >= 0 ? 0xFFFFFFFFu : 0u;
                u32x2 xv = *(const u32x2*)(xp + (ptrdiff_t)(ts >= 0 ? k - 3 : 0) * LDP); xv.x &= xm; xv.y &= xm; sx[h2][k] = xv; } }
        const bf16_t* bp = BCc + (rowbase + t) * 256 + (bc_q < 4 ? grp * 64 + bc_q * 16 : 128 + grp * 64 + (bc_q - 4) * 16);
        bc0 = *(const u32x4*)bp; bc1 = *(const u32x4*)(bp + 8);
        if (tid < 64) sdt = P[(rowbase + tb + tid) * LDP + C_DT + hh];
    };
    ssd_load(0);
    for (int ch = 0; ch < SEQ / 64; ++ch) {
        const int t0 = ch * 64;
        __syncthreads();
        const int o_tt = tid >> 3, o_p8 = (tid & 7) * 8;
        bf16_t* zp = P + (rowbase + t0 + o_tt) * LDP + C_Z + hh * 64 + o_p8;
        const u32x4 zv = *(const u32x4*)zp;
#pragma unroll
        for (int h2 = 0; h2 < 2; ++h2) { f32x4 a = xbias[h2];
#pragma unroll
            for (int k = 0; k < 4; ++k) { a[0] += xw[h2][k][0] * bf_lo(sx[h2][k].x); a[1] += xw[h2][k][1] * bf_hi(sx[h2][k].x); a[2] += xw[h2][k][2] * bf_lo(sx[h2][k].y); a[3] += xw[h2][k][3] * bf_hi(sx[h2][k].y); }
            a[0] = siluf_(a[0]); a[1] = siluf_(a[1]); a[2] = siluf_(a[2]); a[3] = siluf_(a[3]);
            const unsigned q0 = cvt_pk_bf16(a[0], a[1]), q1 = cvt_pk_bf16(a[2], a[3]); const int tt = x_tt, c = x_c + 32 * h2;
            *(f32x4*)(XS + tt * 64 + c) = a;
            XT[(c + 0) * 72 + tt] = (bf16_t)(q0 & 0xFFFF); XT[(c + 1) * 72 + tt] = (bf16_t)(q0 >> 16); XT[(c + 2) * 72 + tt] = (bf16_t)(q1 & 0xFFFF); XT[(c + 3) * 72 + tt] = (bf16_t)(q1 >> 16); }
        { const int tt = x_tt;
            if (bc_q < 4) { const int n = bc_q * 16; *(u32x4*)(Bb + tt * 72 + n) = bc0; *(u32x4*)(Bb + tt * 72 + n + 8) = bc1;
                const unsigned wv[8] = {bc0.x, bc0.y, bc0.z, bc0.w, bc1.x, bc1.y, bc1.z, bc1.w};
#pragma unroll
                for (int e = 0; e < 8; ++e) { BT[(n + 2 * e) * 72 + tt] = (bf16_t)(wv[e] & 0xFFFF); BT[(n + 2 * e + 1) * 72 + tt] = (bf16_t)(wv[e] >> 16); } }
            else { const int n = (bc_q - 4) * 16; *(u32x4*)(Cb + tt * 72 + n) = bc0; *(u32x4*)(Cb + tt * 72 + n + 8) = bc1; } }
        if (tid < 64) { const float dt = softplusf_(bf2f(sdt) + dtb); DTs[tid] = dt;
            float x = dt * Aneg;
#pragma unroll
            for (int o = 1; o < 64; o <<= 1) { const float v = __shfl_up(x, o); if (lane >= o) x += v; }
            ACS[tid] = x; }
        if (ch + 1 < SEQ / 64) ssd_load(t0 + 64);
        __syncthreads();
        const float acsL = ACS[63];
#pragma unroll
        for (int h2 = 0; h2 < 2; ++h2) { const int pp = (tid >> 4) + 32 * h2, s4 = (tid & 15) * 4; float v[4];
#pragma unroll
            for (int e = 0; e < 4; ++e) { const int sidx = s4 + e; v[e] = XS[sidx * 64 + pp] * DTs[sidx] * __expf(acsL - ACS[sidx]); }
            *(u32x2*)(XwT + pp * 72 + s4) = (u32x2){cvt_pk_bf16(v[0], v[1]), cvt_pk_bf16(v[2], v[3])}; }
#pragma unroll
        for (int h2 = 0; h2 < 2; ++h2) { const int pi = (wave >> 2) + 2 * h2, ni = wave & 3;
#pragma unroll
            for (int r = 0; r < 4; ++r) SbT[(16 * pi + 4 * g + r) * 72 + 16 * ni + lq] = (bf16_t)(cvt_pk_bf16(Sacc[h2][r], 0.f) & 0xFFFF); }
        { const int ti = wave >> 1;
#pragma unroll
            for (int sj = 0; sj < 2; ++sj) { const int si = 2 * (wave & 1) + sj;
                f32x4 acc = (f32x4){0.f, 0.f, 0.f, 0.f};
                if (si <= ti) {
                    const bf16_t* ap = Cb + (16 * ti + lq) * 72 + 8 * g; const bf16_t* bp = Bb + (16 * si + lq) * 72 + 8 * g;
                    acc = __builtin_amdgcn_mfma_f32_16x16x32_bf16(*(const bf16x8*)ap, *(const bf16x8*)bp, acc, 0, 0, 0);
                    acc = __builtin_amdgcn_mfma_f32_16x16x32_bf16(*(const bf16x8*)(ap + 32), *(const bf16x8*)(bp + 32), acc, 0, 0, 0);
                }
                const int sidx = 16 * si + lq; const float as = ACS[sidx], ds = DTs[sidx];
#pragma unroll
                for (int r = 0; r < 4; ++r) { const int t = 16 * ti + 4 * g + r; const float val = (sidx <= t) ? acc[r] * __expf(ACS[t] - as) * ds : 0.f;
                    Mx[t * 72 + sidx] = (bf16_t)(cvt_pk_bf16(val, 0.f) & 0xFFFF); } } }
        __syncthreads();
        { const int ti = wave >> 1;
            const bf16_t* ap = Mx + (16 * ti + lq) * 72 + 8 * g; const bf16_t* cp = Cb + (16 * ti + lq) * 72 + 8 * g;
            const bf16x8 mf0 = *(const bf16x8*)ap, mf1 = *(const bf16x8*)(ap + 32), cf0 = *(const bf16x8*)cp, cf1 = *(const bf16x8*)(cp + 32);
#pragma unroll
            for (int h2 = 0; h2 < 2; ++h2) { const int pi = (wave & 1) + 2 * h2;
                const bf16_t* bp = XT + (16 * pi + lq) * 72 + 8 * g; const bf16_t* sp = SbT + (16 * pi + lq) * 72 + 8 * g;
                f32x4 a1 = (f32x4){0.f, 0.f, 0.f, 0.f}, a2 = (f32x4){0.f, 0.f, 0.f, 0.f};
                a1 = __builtin_amdgcn_mfma_f32_16x16x32_bf16(mf0, *(const bf16x8*)bp, a1, 0, 0, 0);
                a1 = __builtin_amdgcn_mfma_f32_16x16x32_bf16(mf1, *(const bf16x8*)(bp + 32), a1, 0, 0, 0);
                a2 = __builtin_amdgcn_mfma_f32_16x16x32_bf16(cf0, *(const bf16x8*)sp, a2, 0, 0, 0);
                a2 = __builtin_amdgcn_mfma_f32_16x16x32_bf16(cf1, *(const bf16x8*)(sp + 32), a2, 0, 0, 0);
#pragma unroll
                for (int r = 0; r < 4; ++r) { const int t = 16 * ti + 4 * g + r, pc = 16 * pi + lq;
                    YS[t * 64 + pc] = a1[r] + __expf(ACS[t]) * a2[r] + Dsk * XS[t * 64 + pc]; } } }
        { const int ni = wave & 3; const float dl = __expf(acsL);
            const bf16_t* bp = BT + (16 * ni + lq) * 72 + 8 * g; const bf16x8 bf0 = *(const bf16x8*)bp, bf1 = *(const bf16x8*)(bp + 32);
#pragma unroll
            for (int h2 = 0; h2 < 2; ++h2) { const int pi = (wave >> 2) + 2 * h2;
                const bf16_t* ap = XwT + (16 * pi + lq) * 72 + 8 * g;
                f32x4 sa = Sacc[h2] * dl;
                sa = __builtin_amdgcn_mfma_f32_16x16x32_bf16(*(const bf16x8*)ap, bf0, sa, 0, 0, 0);
                sa = __builtin_amdgcn_mfma_f32_16x16x32_bf16(*(const bf16x8*)(ap + 32), bf1, sa, 0, 0, 0);
                Sacc[h2] = sa; } }
        __syncthreads();
        { const int tt = o_tt, p8 = o_p8; const f32x4 ya = *(const f32x4*)(YS + tt * 64 + p8), yb = *(const f32x4*)(YS + tt * 64 + p8 + 4);
            const float u0 = ya[0] * siluf_(bf_lo(zv.x)), u1 = ya[1] * siluf_(bf_hi(zv.x)), u2 = ya[2] * siluf_(bf_lo(zv.y)), u3 = ya[3] * siluf_(bf_hi(zv.y));
            const float u4 = yb[0] * siluf_(bf_lo(zv.z)), u5 = yb[1] * siluf_(bf_hi(zv.z)), u6 = yb[2] * siluf_(bf_lo(zv.w)), u7 = yb[3] * siluf_(bf_hi(zv.w));
            u32x4 ov; ov.x = cvt_pk_bf16(u0, u1); ov.y = cvt_pk_bf16(u2, u3); ov.z = cvt_pk_bf16(u4, u5); ov.w = cvt_pk_bf16(u6, u7); *(u32x4*)zp = ov;
            float q = (u0 * u0 + u1 * u1) + (u2 * u2 + u3 * u3) + (u4 * u4 + u5 * u5) + (u6 * u6 + u7 * u7);
            q += __shfl_xor(q, 1); q += __shfl_xor(q, 2); q += __shfl_xor(q, 4);
            if ((tid & 7) == 0) { SSQ[(rowbase + t0 + tt) * 32 + hh * 2] = q; SSQ[(rowbase + t0 + tt) * 32 + hh * 2 + 1] = 0.f; } }
    }
    __syncthreads();
}

__device__ __forceinline__ float fast_tanh(float x) { return 1.f - 2.f * __builtin_amdgcn_rcpf(1.f + __expf(2.f * x)); }
__device__ __forceinline__ void pbar4(LAS volatile unsigned* cnt, unsigned& tgt, int lane) {
    tgt += 4u;
    asm volatile("s_waitcnt lgkmcnt(0)" ::: "memory");
    if (lane == 0) __hip_atomic_fetch_add((LAS unsigned*)cnt, 1u, __ATOMIC_RELAXED, __HIP_MEMORY_SCOPE_WORKGROUP);
    while (*cnt < tgt) __builtin_amdgcn_s_sleep(1);
    asm volatile("" ::: "memory");
}
__device__ __forceinline__ void rwkv_item(const Params& p, int layer, unsigned char* shm, int item) {
    const int half = item & 1, h = (item >> 1) & 7, b = item >> 4;
    bf16_t* P = (bf16_t*)(p.ws + OFF_P); bf16_t* YRAW = (bf16_t*)(p.ws + OFF_YRAW); float* BONUS = (float*)(p.ws + OFF_BONUS);
    const int tid = opaque_tid(), wave = tid >> 6, lane = tid & 63, lq = lane & 15, g = lane >> 4;
    const size_t rowbase = (size_t)b * SEQ;
    const float* mu = p.in[9] + layer * 2176;
    const float* w0 = p.in[10] + layer * 512; const float* wup = p.in[11] + (size_t)layer * 64 * 512;
    const float* a0 = p.in[12] + layer * 512; const float* aup = p.in[13] + (size_t)layer * 64 * 512;
    const float* kkp = p.in[14] + layer * 512; const float* kap = p.in[15] + layer * 512; const float* rkp = p.in[16] + layer * 512;
    constexpr int SETF = 6 * 2048;
    float* SET0 = (float*)shm;
    float* AA = SET0 + 2 * SETF;
    float* Yb = AA + 2048;
    bf16_t* WLb = (bf16_t*)(Yb + 2048);
    bf16_t* ALb = WLb + 32 * 72;
    LAS volatile unsigned* pcnt = (LAS volatile unsigned*)((LAS unsigned char*)shm + (2 * SETF + 2048 + 2048) * 4 + 2 * 32 * 72 * 2);
    const int csub = wave & 3;
    bf16x8 bfr[2][2]; float lw0[2];
#pragma unroll
    for (int mat = 0; mat < 2; ++mat) { const float* up = (mat ? aup : wup) + h * 64 + csub * 16 + lq;
#pragma unroll
        for (int ks = 0; ks < 2; ++ks) { unsigned w[4];
#pragma unroll
            for (int e2 = 0; e2 < 4; ++e2) { const int m0 = 32 * ks + 8 * g + 2 * e2; w[e2] = cvt_pk_bf16(up[(size_t)m0 * 512], up[(size_t)(m0 + 1) * 512]); }
            u32x4 wv = (u32x4){w[0], w[1], w[2], w[3]}; bfr[mat][ks] = __builtin_bit_cast(bf16x8, wv); }
        lw0[mat] = (mat ? a0 : w0)[h * 64 + csub * 16 + lq]; }
    const int ej = (tid & 15) * 4;
    const f32x4 c_kk = *(const f32x4*)(kkp + h * 64 + ej), c_ka = *(const f32x4*)(kap + h * 64 + ej), c_rk = *(const f32x4*)(rkp + h * 64 + ej);
    const f32x4 mu_r = *(const f32x4*)(mu + h * 64 + ej), mu_k = *(const f32x4*)(mu + 512 + h * 64 + ej), mu_v = *(const f32x4*)(mu + 1024 + h * 64 + ej);
    const f32x4 mu_w = *(const f32x4*)(mu + 2048 + ej), mu_a = *(const f32x4*)(mu + 2112 + ej);
    f32x4 sA = (f32x4){0.f, 0.f, 0.f, 0.f}, sB = (f32x4){0.f, 0.f, 0.f, 0.f};
    const int irow = half * 32 + (wave & 3) * 8 + g * 2;
    unsigned ptgt = 0u;
    const int pm = tid - 256, e2t = pm >> 4;
    u32x2 cva[2][5], pva[2][5];
    auto rw_load = [&](int ch) {
#pragma unroll
        for (int ps = 0; ps < 2; ++ps) { const int tl = e2t + 16 * ps, t = ch * 32 + tl; const bf16_t* cur = P + (rowbase + t) * LDP + C_RW; const bool hp = t > 0; const bf16_t* prv = hp ? cur - LDP : cur;
#pragma unroll
            for (int i = 0; i < 5; ++i) { const int col = (i == 0 ? h * 64 : i == 1 ? 512 + h * 64 : i == 2 ? 1024 + h * 64 : i == 3 ? 2048 : 2112) + ej;
                cva[ps][i] = *(const u32x2*)(cur + col); pva[ps][i] = *(const u32x2*)(prv + col); } }
    };
    auto prep = [&](int ch, float* SET) {
        float* Rm = SET; float* Km = SET + 2048; float* Vm = SET + 4096; float* DEC = SET + 6144; float* KK = SET + 8192; float* BB = SET + 10240;
#pragma unroll
        for (int ps = 0; ps < 2; ++ps) { const int tl = e2t + 16 * ps, t = ch * 32 + tl; const unsigned pmask = t > 0 ? 0xFFFFFFFFu : 0u;
#pragma unroll
            for (int i = 0; i < 5; ++i) {
                const u32x2 cv = cva[ps][i]; u32x2 pv = pva[ps][i]; pv.x &= pmask; pv.y &= pmask;
                const f32x4 m4 = i == 0 ? mu_r : i == 1 ? mu_k : i == 2 ? mu_v : i == 3 ? mu_w : mu_a;
                float c[4] = {bf_lo(cv.x), bf_hi(cv.x), bf_lo(cv.y), bf_hi(cv.y)}; const float q[4] = {bf_lo(pv.x), bf_hi(pv.x), bf_lo(pv.y), bf_hi(pv.y)};
#pragma unroll
                for (int e = 0; e < 4; ++e) c[e] = c[e] + (q[e] - c[e]) * m4[e];
                if (i == 0) *(f32x4*)(Rm + tl * 64 + ej) = (f32x4){c[0], c[1], c[2], c[3]};
                else if (i == 1) *(f32x4*)(Km + tl * 64 + ej) = (f32x4){c[0], c[1], c[2], c[3]};
                else if (i == 2) *(f32x4*)(Vm + tl * 64 + ej) = (f32x4){c[0], c[1], c[2], c[3]};
                else if (i == 3) { u32x2 o; o.x = cvt_pk_bf16(fast_tanh(c[0]), fast_tanh(c[1])); o.y = cvt_pk_bf16(fast_tanh(c[2]), fast_tanh(c[3])); *(u32x2*)(WLb + tl * 72 + ej) = o; }
                else { u32x2 o; o.x = cvt_pk_bf16(c[0], c[1]); o.y = cvt_pk_bf16(c[2], c[3]); *(u32x2*)(ALb + tl * 72 + ej) = o; } } }
        if (ch + 1 < SEQ / 32) rw_load(ch + 1);
        pbar4(pcnt, ptgt, lane);
#pragma unroll
        for (int mat = 0; mat < 2; ++mat)
#pragma unroll
            for (int ts = 0; ts < 2; ++ts) { const bf16_t* ap = (mat ? ALb : WLb) + (16 * ts + lq) * 72 + 8 * g;
                const bf16x8 a0f = *(const bf16x8*)ap, a1f = *(const bf16x8*)(ap + 32);
                f32x4 c = (f32x4){0.f, 0.f, 0.f, 0.f};
                c = __builtin_amdgcn_mfma_f32_16x16x32_bf16(a0f, bfr[mat][0], c, 0, 0, 0);
                c = __builtin_amdgcn_mfma_f32_16x16x32_bf16(a1f, bfr[mat][1], c, 0, 0, 0);
#pragma unroll
                for (int r = 0; r < 4; ++r) { const int tt = 16 * ts + 4 * g + r; const float x = lw0[mat] + c[r];
                    if (mat == 0) DEC[tt * 64 + csub * 16 + lq] = __expf(-0.60653066f * sigmoidf_(x));
                    else AA[tt * 64 + csub * 16 + lq] = sigmoidf_(x); } }
        pbar4(pcnt, ptgt, lane);
#pragma unroll
        for (int ps = 0; ps < 2; ++ps) { const int tl = e2t + 16 * ps;
            const f32x4 k4 = *(const f32x4*)(Km + tl * 64 + ej), a4 = *(const f32x4*)(AA + tl * 64 + ej), r4 = *(const f32x4*)(Rm + tl * 64 + ej);
            f32x4 kr, kt; float ss = 0.f, bo = 0.f;
#pragma unroll
            for (int e = 0; e < 4; ++e) { kr[e] = k4[e] * c_kk[e]; ss += kr[e] * kr[e]; kt[e] = k4[e] * (1.f + (a4[e] - 1.f) * c_ka[e]); bo += r4[e] * kt[e] * c_rk[e]; }
            ss = allred16(ss); bo = allred16(bo);
            const float inv = __builtin_amdgcn_rsqf(fmaxf(ss, 1e-24f));
            f32x4 kk4, b4;
#pragma unroll
            for (int e = 0; e < 4; ++e) { kk4[e] = kr[e] * inv; b4[e] = kk4[e] * a4[e]; }
            *(f32x4*)(Km + tl * 64 + ej) = kt; *(f32x4*)(KK + tl * 64 + ej) = kk4; *(f32x4*)(BB + tl * 64 + ej) = b4;
            if (half == 0 && (tid & 15) == 0) BONUS[(rowbase + ch * 32 + tl) * 8 + h] = bo; }
    };
    auto yraw_store = [&](int ch) {
#pragma unroll
        for (int ps = 0; ps < 2; ++ps)
#pragma unroll
            for (int q = 0; q < 2; ++q) { const int tl = e2t + 16 * ps, il = (tid & 15) + 16 * q;
                YRAW[(rowbase + ch * 32 + tl) * 512 + h * 64 + half * 32 + il] = (bf16_t)(cvt_pk_bf16(Yb[(ch & 1) * 1024 + tl * 32 + il], 0.f) & 0xFFFF); }
    };
    if (tid == 0) *pcnt = 0u;
    __syncthreads();
    if (wave >= 4) { rw_load(0); prep(0, SET0); }
    for (int ch = 0; ch < SEQ / 32; ++ch) {
        __syncthreads();
        if (wave < 4) {
            const float* SET = SET0 + (ch & 1) * SETF;
            const float* Rm = SET; const float* Km = SET + 2048; const float* Vm = SET + 4096; const float* DEC = SET + 6144; const float* KK = SET + 8192; const float* BB = SET + 10240;
            float* Yw = Yb + (ch & 1) * 1024;
            struct Ops { f32x4 w, k, q, b, r; float v0, v1; };
            auto ld = [&](Ops& o, int tt) { const int off = tt * 64 + lq * 4;
                o.w = *(const f32x4*)(DEC + off); o.k = *(const f32x4*)(Km + off); o.q = *(const f32x4*)(KK + off); o.b = *(const f32x4*)(BB + off); o.r = *(const f32x4*)(Rm + off);
                const float* vp = Vm + tt * 64 + irow; o.v0 = vp[0]; o.v1 = vp[1]; };
            auto step = [&](const Ops& o, int tt) {
                const f32x4 da = sA * o.q, db = sB * o.q; const f32x2_t ha = da.lo + da.hi, hb = db.lo + db.hi;
                float sa0 = ha.x + ha.y, sa1 = hb.x + hb.y;
                const f32x4 uA = sA * o.w + o.k * o.v0, uB = sB * o.w + o.k * o.v1;
                sa0 = -allred16(sa0); sa1 = -allred16(sa1);
                sA = uA + o.b * sa0; sB = uB + o.b * sa1;
                const f32x4 ea = sA * o.r, eb = sB * o.r; const f32x2_t ga = ea.lo + ea.hi, gb = eb.lo + eb.hi; float y0 = ga.x + ga.y, y1 = gb.x + gb.y;
                asm("" : "+v"(y0)); asm("" : "+v"(y1));
                y0 += dppf<0xB1>(y0); y1 += dppf<0xB1>(y1);
                float z = (lq & 1) ? y1 : y0;
                z += dppf<0x4E>(z); z += dppf<0x124>(z); z += dppf<0x128>(z);
                if (lq < 2) Yw[tt * 32 + (wave & 3) * 8 + g * 2 + lq] = z; };
            Ops oa, ob;
            ld(oa, 0);
            for (int tt = 0; tt < 32; tt += 4) {
                ld(ob, tt + 1);
                step(oa, tt);
                ld(oa, tt + 2);
                step(ob, tt + 1);
                ld(ob, tt + 3);
                step(oa, tt + 2);
                ld(oa, (tt + 4 < 32) ? tt + 4 : 31);
                step(ob, tt + 3);
            }
        } else {
            if (ch > 0) yraw_store(ch - 1);
            if (ch + 1 < SEQ / 32) prep(ch + 1, SET0 + ((ch + 1) & 1) * SETF);
        }
    }
    __syncthreads();
    if (wave >= 4) yraw_store(SEQ / 32 - 1);
    __syncthreads();
}

__device__ __forceinline__ void rw_post(const Params& p, int layer) {
    bf16_t* P = (bf16_t*)(p.ws + OFF_P); const bf16_t* YRAW = (const bf16_t*)(p.ws + OFF_YRAW);
    const float* BONUS = (const float*)(p.ws + OFF_BONUS); const float* SSQ = (const float*)(p.ws + OFF_SSQ); float* RSTD = (float*)(p.ws + OFF_RSTD);
    const float* mu = p.in[9] + layer * 2176; const float* lng = p.in[17] + layer * 512; const float* lnb = p.in[18] + layer * 512;
    const int gt = blockIdx.x * 512 + opaque_tid(), gs = gridDim.x * 512;
    {
        const int c = (gt & 127) * 4, h = c >> 6;
        const f32x4 muv = *(const f32x4*)(mu + 1024 + c), mug = *(const f32x4*)(mu + 1536 + c);
        const f32x4 lg = *(const f32x4*)(lng + c), lb = *(const f32x4*)(lnb + c);
        for (int idx0 = gt; idx0 < TOK * 128; idx0 += 4 * gs) {
            u32x2 yv[4], vc[4], gc[4], vp[4], gp[4]; float bn[4]; unsigned pm[4]; bool ok[4];
#pragma unroll
            for (int u = 0; u < 4; ++u) { const int idx = idx0 + u * gs; ok[u] = idx < TOK * 128; const int tok = ok[u] ? (idx >> 7) : 0;
                const bf16_t* cur = P + (size_t)tok * LDP + C_RW; const bool hp = (tok & (SEQ - 1)) > 0; const bf16_t* prv = hp ? cur - LDP : cur; pm[u] = hp ? 0xFFFFFFFFu : 0u;
                yv[u] = *(const u32x2*)(YRAW + (size_t)tok * 512 + c);
                vc[u] = *(const u32x2*)(cur + 1024 + c); gc[u] = *(const u32x2*)(cur + 1536 + c);
                vp[u] = *(const u32x2*)(prv + 1024 + c); gp[u] = *(const u32x2*)(prv + 1536 + c);
                bn[u] = BONUS[(size_t)tok * 8 + h]; }
#pragma unroll
            for (int u = 0; u < 4; ++u) { const int idx = idx0 + u * gs; const int tok = ok[u] ? (idx >> 7) : 0;
                float y[4] = {bf_lo(yv[u].x), bf_hi(yv[u].x), bf_lo(yv[u].y), bf_hi(yv[u].y)};
                const float mean = allred16(y[0] + y[1] + y[2] + y[3]) * (1.f / 64.f);
                float d[4], vs = 0.f;
#pragma unroll
                for (int e = 0; e < 4; ++e) { d[e] = y[e] - mean; vs += d[e] * d[e]; }
                const float var = allred16(vs) * (1.f / 64.f);
                const float rs = rsqrtf(var + 64e-5f);
                const unsigned m = pm[u];
                const float vcur[4] = {bf_lo(vc[u].x), bf_hi(vc[u].x), bf_lo(vc[u].y), bf_hi(vc[u].y)}, vprv[4] = {bf_lo(vp[u].x & m), bf_hi(vp[u].x & m), bf_lo(vp[u].y & m), bf_hi(vp[u].y & m)};
                const float gcur[4] = {bf_lo(gc[u].x), bf_hi(gc[u].x), bf_lo(gc[u].y), bf_hi(gc[u].y)}, gprv[4] = {bf_lo(gp[u].x & m), bf_hi(gp[u].x & m), bf_lo(gp[u].y & m), bf_hi(gp[u].y & m)};
                float o[4];
#pragma unroll
                for (int e = 0; e < 4; ++e) { const float vm = vcur[e] + (vprv[e] - vcur[e]) * muv[e], gm = gcur[e] + (gprv[e] - gcur[e]) * mug[e];
                    o[e] = (d[e] * rs * lg[e] + lb[e] + bn[u] * vm) * siluf_(gm); }
                u32x2 ov; ov.x = cvt_pk_bf16(o[0], o[1]); ov.y = cvt_pk_bf16(o[2], o[3]);
                if (ok[u]) *(u32x2*)(P + (size_t)tok * LDP + C_YRW + c) = ov; }
        }
    }
    for (int tok = gt; tok < TOK; tok += gs) { const f32x4* q = (const f32x4*)(SSQ + (size_t)tok * 32); float s = 0.f;
#pragma unroll
        for (int i = 0; i < 8; ++i) { const f32x4 v = q[i]; s += v[0] + v[1] + v[2] + v[3]; }
        RSTD[tok] = rsqrtf(s * (1.f / 1024.f) + 1e-6f); }
}

#define XB_TMO      128
#define XB_XCNT(j)  (256  + 64 * (j))
#define XB_XSUB(j)  (1280 + 64 * (j))
#define XB_XGEN(j)  (2304 + 64 * (j))
#define XB_TOP      3328
#define XB_TOPGEN   3392
#define XCD_BAR_WORDS 3456
#define XB_SPIN_CAP (1u << 18)
__device__ __forceinline__ unsigned xb_ld(unsigned* p)              { return __hip_atomic_load(p, __ATOMIC_RELAXED, __HIP_MEMORY_SCOPE_AGENT); }
__device__ __forceinline__ unsigned xb_add(unsigned* p, unsigned v) { return __hip_atomic_fetch_add(p, v, __ATOMIC_RELAXED, __HIP_MEMORY_SCOPE_AGENT); }
__device__ __forceinline__ unsigned xb_xcc_id() { return (unsigned)__builtin_amdgcn_s_getreg((3 << 11) | 20) & 0xFu; }
#define XB_SPIN(cond, bar) do { unsigned _sp = 0; while (cond) { __builtin_amdgcn_s_sleep(1); \
    if ((++_sp & 255u) == 0u) { if (xb_ld(&(bar)[XB_TMO])) break; if (_sp > XB_SPIN_CAP) { atomicAdd(&(bar)[XB_TMO], 1u); break; } } } } while (0)
struct XcdBarrier { unsigned* bar; unsigned x; volatile LAS unsigned* st; };
__device__ __forceinline__ XcdBarrier xcd_barrier_post(unsigned* bar, volatile LAS unsigned* st) {
    XcdBarrier b; b.bar = bar; b.x = xb_xcc_id(); b.st = st;
    if (threadIdx.x == 0) (void)xb_add(&bar[XB_XCNT(b.x)], 1u);
    return b;
}
__device__ __forceinline__ void xcd_barrier_complete(unsigned* bar, unsigned x, unsigned& nloc, unsigned& nx) {
    const unsigned G = gridDim.x * gridDim.y * gridDim.z;
    unsigned sum, cnt, mine, sp = 0u;
    for (;;) {
        sum = 0u; cnt = 0u; mine = 0u;
#pragma unroll
        for (unsigned j = 0; j < 16; ++j) { const unsigned c = xb_ld(&bar[XB_XCNT(j)]); sum += c; cnt += (c > 0u) ? 1u : 0u; mine = (j == x) ? c : mine; }
        if (sum == G) break;
        __builtin_amdgcn_s_sleep(1);
        if ((++sp & 255u) == 0u) { if (xb_ld(&bar[XB_TMO])) break; if (sp > XB_SPIN_CAP) { atomicAdd(&bar[XB_TMO], 1u); break; } }
    }
    nloc = mine > 0u ? mine : 1u; nx = cnt > 0u ? cnt : 1u;
}
__device__ __forceinline__ void xcd_barrier(const XcdBarrier& b) {
    asm volatile("s_waitcnt vmcnt(0)" ::: "memory");
    __syncthreads();
    if (threadIdx.x == 0) {
        unsigned* bar = b.bar;
        __builtin_amdgcn_s_waitcnt(0);
        unsigned nloc = b.st[0], nx = b.st[1];
        if (nloc == 0u) { xcd_barrier_complete(bar, b.x, nloc, nx); b.st[0] = nloc; b.st[1] = nx; }
        const unsigned old = xb_add(&bar[XB_XSUB(b.x)], 1u);
        const unsigned gen = old / nloc;
        if (old + 1u == (gen + 1u) * nloc) {
            __builtin_amdgcn_fence(__ATOMIC_RELEASE, "agent");
            asm volatile("s_waitcnt vmcnt(0)" ::: "memory");
            const unsigned og = xb_add(&bar[XB_TOP], 1u);
            const unsigned tg = og / nx;
            if (og + 1u == (tg + 1u) * nx) xb_add(&bar[XB_TOPGEN], 1u);
            else XB_SPIN(xb_ld(&bar[XB_TOPGEN]) == tg, bar);
            __builtin_amdgcn_fence(__ATOMIC_ACQUIRE, "agent");
            xb_add(&bar[XB_XGEN(b.x)], 1u);
            asm volatile("s_waitcnt vmcnt(0)" ::: "memory");
        } else {
            XB_SPIN(xb_ld(&bar[XB_XGEN(b.x)]) == gen, bar);
            __builtin_amdgcn_fence(__ATOMIC_ACQUIRE, "agent");
            asm volatile("s_waitcnt vmcnt(0)" ::: "memory");
        }
    }
    __syncthreads();
}

#define GSYNC() xcd_barrier(xb)
__global__ void __launch_bounds__(512, 2) mega(Params p) {
    extern __shared__ __attribute__((aligned(16))) unsigned char shm[];
    cg::grid_group grid = cg::this_grid();
    volatile LAS unsigned* xst = (volatile LAS unsigned*)((LAS unsigned char*)shm + LDS_BYTES - 16);
    if (threadIdx.x == 0) { xst[0] = 0u; xst[1] = 0u; }
    __syncthreads();
    const XcdBarrier xb = xcd_barrier_post((unsigned*)(p.ws + OFF_BAR), xst);
    const char* Pc = (const char*)(p.ws + OFF_P); const char* WTc = (const char*)(p.ws + OFF_WT);
    bf16_t* P = (bf16_t*)(p.ws + OFF_P);
    const int G = gridDim.x, c = blockIdx.x;
    for (int layer = 0; layer < 2; ++layer) {
        phase0(p, layer, shm);
        if (layer == 0) grid.sync(); else GSYNC();
        { SchedInproj S{Pc, WTc, G, c, 24, 0, 4, 2}; EpiInproj E{P}; pg8::gemm_phase<true>((LAS unsigned char*)shm, S, E); }
        GSYNC();
        { const int Gh = G >> 1;
            constexpr int ATT_B = 1024;
            if (c < Gh) { for (int it = c; it < 128; it += Gh) rwkv_item(p, layer, shm, it);
                for (int it = ATT_B + c; it < 1024; it += Gh) attn_item(p, shm, it); }
            else { const int c2 = c - Gh;
                bc_prepass(p, layer, c2, G - Gh);
                asm volatile("s_waitcnt vmcnt(0)" ::: "memory");
                __syncthreads();
                if (threadIdx.x == 0) { unsigned* cw_ = (unsigned*)(p.ws + OFF_BAR) + 3520; const unsigned need = (unsigned)(G - Gh) * (unsigned)(layer + 1);
                    __builtin_amdgcn_fence(__ATOMIC_RELEASE, "agent"); asm volatile("s_waitcnt vmcnt(0)" ::: "memory");
                    (void)xb_add(cw_, 1u);
                    unsigned sp_ = 0; while (xb_ld(cw_) < need) { __builtin_amdgcn_s_sleep(2); if (++sp_ > (1u << 22)) break; }
                    __builtin_amdgcn_fence(__ATOMIC_ACQUIRE, "agent"); asm volatile("s_waitcnt vmcnt(0)" ::: "memory"); }
                __syncthreads();
                for (int it = c2; it < 128; it += Gh) ssd_item(p, layer, shm, it);
                { SchedInproj S2{Pc, WTc, G - Gh, c2, 2, 4, 1000, 0}; EpiInproj E2{P}; pg8::gemm_phase<true>((LAS unsigned char*)shm, S2, E2); }
                asm volatile("s_waitcnt vmcnt(0)" ::: "memory");
                __syncthreads();
                if (threadIdx.x == 0) { unsigned* cw_ = (unsigned*)(p.ws + OFF_BAR) + 3584; const unsigned need = (unsigned)(G - Gh) * (unsigned)(layer + 1);
                    __builtin_amdgcn_fence(__ATOMIC_RELEASE, "agent"); asm volatile("s_waitcnt vmcnt(0)" ::: "memory");
                    (void)xb_add(cw_, 1u);
                    unsigned sp_ = 0; while (xb_ld(cw_) < need) { __builtin_amdgcn_s_sleep(2); if (++sp_ > (1u << 22)) break; }
                    __builtin_amdgcn_fence(__ATOMIC_ACQUIRE, "agent"); asm volatile("s_waitcnt vmcnt(0)" ::: "memory"); }
                __syncthreads();
                for (int it = c2; it < ATT_B; it += Gh) attn_item(p, shm, it);
                if (layer == 0) wt_jobs(p, 1, shm, 0, 1664, c2 * 8 + (int)(threadIdx.x >> 6), (G - Gh) * 8); } }
        GSYNC();
        rw_post(p, layer);
        GSYNC();
        { SchedC1 S{Pc, WTc, G, c}; EpiC1 E{P, (const float*)(p.ws + OFF_RSTD)}; pg8::gemm_phase<true>((LAS unsigned char*)shm, S, E); }
        GSYNC();
        { SchedOut S{Pc, WTc, G, c}; EpiOut E{layer == 0 ? p.in[0] : p.out, p.out}; pg8::gemm_phase<false>((LAS unsigned char*)shm, S, E); }
        GSYNC();
    }
    { const int tid = opaque_tid(), wave = tid >> 6, lane = tid & 63; const float* fg = p.in[23];
        for (int row = blockIdx.x * 8 + wave; row < TOK; row += gridDim.x * 8) { float* xr = p.out + (size_t)row * DM;
            f32x4 v[4]; float ss = 0.f;
#pragma unroll
            for (int i = 0; i < 4; ++i) { v[i] = *(const f32x4*)(xr + i * 256 + lane * 4); ss += v[i][0] * v[i][0] + v[i][1] * v[i][1] + v[i][2] * v[i][2] + v[i][3] * v[i][3]; }
            ss = wave_sum(ss);
            const float rs = rsqrtf(ss * (1.f / DM) + 1e-6f);
#pragma unroll
            for (int i = 0; i < 4; ++i) { const f32x4 g = *(const f32x4*)(fg + i * 256 + lane * 4); *(f32x4*)(xr + i * 256 + lane * 4) = v[i] * rs * g; } } }
}

extern "C" void kernel_launch(void* const* d_in, const int* in_sizes, int n_in, void* d_out, int out_size, void* d_ws, size_t ws_size, hipStream_t stream) {
    static int grid_blocks = 0;
    if (grid_blocks == 0) {
        if (n_in != 24 || out_size != TOK * DM || ws_size < WS_NEED) { fprintf(stderr, "kernel_launch: unexpected shapes (n_in %d out %d ws %zu need %zu)\n", n_in, out_size, ws_size, (size_t)WS_NEED); grid_blocks = -1; return; }
        int dev = 0, cus = 0, per_cu = 0;
        hipGetDevice(&dev);
        hipDeviceGetAttribute(&cus, hipDeviceAttributeMultiprocessorCount, dev);
        hipFuncSetAttribute((const void*)mega, hipFuncAttributeMaxDynamicSharedMemorySize, LDS_BYTES);
        hipOccupancyMaxActiveBlocksPerMultiprocessor(&per_cu, (const void*)mega, 512, LDS_BYTES);
        if (per_cu < 1) { fprintf(stderr, "kernel_launch: occupancy query says %d blocks per CU\n", per_cu); grid_blocks = -1; return; }
        if (per_cu > 1) per_cu = 1;
        grid_blocks = cus * per_cu;
        grid_blocks &= ~7;
    }
    if (grid_blocks < 0) return;
    Params p{};
    for (int i = 0; i < 24; ++i) p.in[i] = (const float*)d_in[i];
    p.out = (float*)d_out; p.ws = (unsigned char*)d_ws;
    (void)hipMemsetAsync((unsigned char*)d_ws + OFF_BAR, 0, SZ_BAR, stream);
    void* args[] = {&p};
    hipError_t e = hipLaunchCooperativeKernel((const void*)mega, dim3(grid_blocks), dim3(512), args, LDS_BYTES, stream);
    if (e != hipSuccess) fprintf(stderr, "cooperative launch failed: %s (grid %d)\n", hipGetErrorString(e), grid_blocks);
}
```

```cpp
#include <hip/hip_runtime.h>
#include <hip/hip_cooperative_groups.h>
#include <cstdio>
namespace cg = cooperative_groups;

#define LAS __attribute__((address_space(3)))
typedef unsigned short bf16_t;
typedef short bf16x8 __attribute__((ext_vector_type(8)));
typedef float f32x4 __attribute__((ext_vector_type(4)));
typedef unsigned u32x4 __attribute__((ext_vector_type(4)));
typedef unsigned u32x2 __attribute__((ext_vector_type(2)));

constexpr int TOK = 16384, SEQ = 2048, DM = 1024, NIN = 9616;
constexpr int LDP = 7680;
constexpr int C_Q = 0, C_K = 512, C_V = 1024, C_SBG = 1536, C_Z = 2048, C_XBC = 3072, C_RW = 4352, C_DT = 6528, C_H = 6656;
constexpr int C_M = 0, C_G = 3072, C_YRW = 4352;
constexpr int R_GATE = 6656, R_SB = 9728, R_SSD = 10752, R_RWO = 11776, R_WO = 12800, WT_ROWS = 13824;
constexpr size_t OFF_P = 0, SZ_P = (size_t)TOK * LDP * 2;
constexpr size_t OFF_WT = OFF_P + SZ_P, SZ_WT = (size_t)WT_ROWS * 1024 * 2;
constexpr size_t OFF_YRAW = OFF_WT + SZ_WT, SZ_YRAW = (size_t)TOK * 512 * 2;
constexpr size_t OFF_SSQ = OFF_YRAW + SZ_YRAW, SZ_SSQ = (size_t)TOK * 32 * 4;
constexpr size_t OFF_RSTD = OFF_SSQ + SZ_SSQ, SZ_RSTD = (size_t)TOK * 4;
constexpr size_t OFF_BONUS = OFF_RSTD + SZ_RSTD, SZ_BONUS = (size_t)TOK * 8 * 4;
constexpr size_t OFF_BAR = OFF_BONUS + SZ_BONUS, SZ_BAR = 16384;
constexpr size_t OFF_BCC = OFF_BAR + SZ_BAR, SZ_BCC = (size_t)TOK * 256 * 2;
constexpr size_t WS_NEED = OFF_BCC + SZ_BCC;
constexpr int LDS_BYTES = 135168;

struct Params { const float* in[24]; float* out; unsigned char* ws; };

typedef float f32x2_t __attribute__((ext_vector_type(2)));
typedef __bf16 bf16x2_t __attribute__((ext_vector_type(2)));
__device__ __forceinline__ unsigned cvt_pk_bf16(float lo, float hi) { const f32x2_t v = {lo, hi}; return __builtin_bit_cast(unsigned, __builtin_convertvector(v, bf16x2_t)); }
__device__ __forceinline__ float bf_lo(unsigned u) { return __uint_as_float(u << 16); }
__device__ __forceinline__ float bf_hi(unsigned u) { return __uint_as_float(u & 0xFFFF0000u); }
__device__ __forceinline__ float bf2f(bf16_t h) { return __uint_as_float(((unsigned)h) << 16); }
__device__ __forceinline__ float sigmoidf_(float x) { return __builtin_amdgcn_rcpf(1.f + __expf(-x)); }
__device__ __forceinline__ float siluf_(float x) { return x * __builtin_amdgcn_rcpf(1.f + __expf(-x)); }
__device__ __forceinline__ float softplusf_(float x) { return fmaxf(x, 0.f) + __logf(1.f + __expf(-fabsf(x))); }
template <int CTRL> __device__ __forceinline__ float dppf(float x) { return __int_as_float(__builtin_amdgcn_update_dpp(0, __float_as_int(x), CTRL, 0xF, 0xF, true)); }
__device__ __forceinline__ float allred16(float x) { x += dppf<0xB1>(x); x += dppf<0x4E>(x); x += dppf<0x141>(x); x += dppf<0x140>(x); return x; }
__device__ __forceinline__ int opaque_tid() { int t; asm volatile("v_mov_b32 %0, %1" : "=v"(t) : "v"((int)threadIdx.x)); return t; }
__device__ __forceinline__ float wave_sum(float v) {
#pragma unroll
    for (int o = 1; o < 64; o <<= 1) v += __shfl_xor(v, o);
    return v;
}

namespace pg8 {
constexpr int BM = 256, BK = 64, HALF = 128, HTB = HALF * BK * 2, NXCD = 8, WGM = 8;
constexpr unsigned LDA_B = LDP * 2, LDB_B = 2048;
__device__ __forceinline__ int lds_byte(int r, int c) { const int st = (r >> 4) * 2 + (c >> 5), rr = r & 15, cc = c & 31, ob = rr * 64 + cc * 2; return st * 1024 + (ob ^ (((ob >> 9) & 1) << 5)); }
__device__ __forceinline__ void stage_rc(int b, int& R, int& C) { const int st = b / 1024, sb = b % 1024, swz = sb ^ (((sb >> 9) & 1) << 5); R = (st >> 1) * 16 + swz / 64; C = (st & 1) * 32 + (swz % 64) / 2; }
__device__ __forceinline__ int perm32(int rho) { const int n = rho >> 4, i = rho & 15; return 8 * (i >> 2) + 4 * n + (i & 3); }
struct UnitD { const char* A; const char* B; int nt, pm, pn, kind; };
__device__ __forceinline__ void tile_of(int L, int nM, int nN, int& pm, int& pn) {
    const int nwg = nM * nN; int wgid = L;
    { const int q = nwg / NXCD, r = nwg % NXCD, xcd = wgid % NXCD, off = wgid / NXCD; wgid = (xcd < r ? xcd * (q + 1) : r * (q + 1) + (xcd - r) * q) + off; }
    const int nig = WGM * nN, gid = wgid / nig, fm = gid * WGM, gsz = (nM - fm) < WGM ? (nM - fm) : WGM;
    pm = fm + ((wgid % nig) % gsz); pn = (wgid % nig) / gsz;
}

template <bool PERM, class Sched, class Epi>
__device__ __forceinline__ void gemm_phase(LAS unsigned char* lds, const Sched& S, const Epi& E) {
    const int tid = opaque_tid(), wid = __builtin_amdgcn_readfirstlane(tid >> 6), lane = tid & 63, wr = wid >> 2, wc = wid & 3, fr = lane & 15, fq = lane >> 4;
    unsigned voffA[2], voffB[2];
#pragma unroll
    for (int i = 0; i < 2; ++i) { int R, C; stage_rc(tid * 16 + i * 8192, R, C); const int Rb = PERM ? ((R & ~31) + perm32(R & 31)) : R;
        voffA[i] = (unsigned)R * LDA_B + (unsigned)C * 2u; voffB[i] = (unsigned)Rb * LDB_B + (unsigned)C * 2u; }
    const size_t kstep = (size_t)(BK * 2);
    const size_t hstepA = (size_t)HALF * LDA_B, hstepB = (size_t)HALF * LDB_B;
    const unsigned ldsw = (unsigned)wid * 1024u;
    const int aoff = lds_byte(wr * 64 + fr, fq * 8), boff = lds_byte(wc * 32 + fr, fq * 8);
#define PG8_SA(b, h) (((b) * 2 + (h)) * HTB)
#define PG8_SB(b, h) ((4 + (b) * 2 + (h)) * HTB)
#define PG8_STAGE(bufoff, gbase, voff) do { _Pragma("unroll") for (int _i = 0; _i < 2; ++_i) \
        __builtin_amdgcn_global_load_lds((const unsigned*)((const char*)(gbase) + (voff)[_i]), (LAS unsigned*)(lds + (bufoff) + ldsw + _i * 8192), 16, 0, 0); } while (0)
#define PG8_LDA(dst, b, h) do { _Pragma("unroll") for (int m = 0; m < 4; ++m) _Pragma("unroll") for (int k = 0; k < 2; ++k) dst[m][k] = *(const LAS bf16x8*)(lds + PG8_SA(b, h) + aoff + m * 2048 + k * 1024); } while (0)
#define PG8_LDB(dst, b, h) do { _Pragma("unroll") for (int n = 0; n < 2; ++n) _Pragma("unroll") for (int k = 0; k < 2; ++k) dst[n][k] = *(const LAS bf16x8*)(lds + PG8_SB(b, h) + boff + n * 2048 + k * 1024); } while (0)
#define PG8_MMA(ai, bj, At, Bt) do { __builtin_amdgcn_s_setprio(1); _Pragma("unroll") for (int m = 0; m < 4; ++m) _Pragma("unroll") for (int n = 0; n < 2; ++n) _Pragma("unroll") for (int k = 0; k < 2; ++k) \
        acc[ai][bj][m][n] = __builtin_amdgcn_mfma_f32_16x16x32_bf16(Bt[n][k], At[m][k], acc[ai][bj][m][n], 0, 0, 0); __builtin_amdgcn_s_setprio(0); } while (0)
#define PG8_WAIT_V(n) asm volatile("s_waitcnt vmcnt(" #n ")" ::: "memory")
#define PG8_WAIT_L(n) asm volatile("s_waitcnt lgkmcnt(" #n ")" ::: "memory")
#define PG8_BAR __builtin_amdgcn_s_barrier()
#define PG8_SCHED __builtin_amdgcn_sched_barrier(0)
    UnitD cur, nxt; int ui = 0;
    if (!S.next(0, cur)) return;
    f32x4 acc[2][2][4][2];
#pragma unroll
    for (int a = 0; a < 2; ++a)
#pragma unroll
        for (int b = 0; b < 2; ++b)
#pragma unroll
            for (int m = 0; m < 4; ++m)
#pragma unroll
                for (int n = 0; n < 2; ++n) acc[a][b][m][n] = (f32x4){0.f, 0.f, 0.f, 0.f};
    bf16x8 At[4][2], B0[2][2], B1[2][2];
    const char* cA = cur.A; const char* cB = cur.B;
    PG8_STAGE(PG8_SB(0, 0), cB, voffB); PG8_STAGE(PG8_SA(0, 0), cA, voffA); PG8_STAGE(PG8_SB(0, 1), cB + hstepB, voffB); PG8_STAGE(PG8_SA(0, 1), cA + hstepA, voffA);
    if (wr == 1) PG8_BAR;
    PG8_WAIT_V(4); PG8_BAR;
    PG8_STAGE(PG8_SB(1, 0), cB + kstep, voffB); PG8_STAGE(PG8_SA(1, 0), cA + kstep, voffA); PG8_STAGE(PG8_SB(1, 1), cB + hstepB + kstep, voffB);
    PG8_WAIT_V(6); PG8_BAR;
    for (;;) {
        const bool has_next = S.next(ui + 1, nxt);
        const char* nA = has_next ? nxt.A : cA; const char* nB = has_next ? nxt.B : cB;
        const int nt = cur.nt;
        for (int t = 0; t < nt; t += 2) {
            const bool last = (t == nt - 2);
            const char* a1 = cA + (size_t)(t + 1) * kstep;
            const char* a2 = last ? nA : cA + (size_t)(t + 2) * kstep; const char* b2 = last ? nB : cB + (size_t)(t + 2) * kstep;
            const char* a3 = a2 + kstep; const char* b3 = b2 + kstep;
            PG8_LDB(B0, 0, 0); PG8_SCHED; PG8_LDA(At, 0, 0); PG8_STAGE(PG8_SA(1, 1), a1 + hstepA, voffA);
            PG8_WAIT_L(8); PG8_BAR; PG8_WAIT_L(0); PG8_MMA(0, 0, At, B0); PG8_BAR; PG8_SCHED;
            PG8_LDB(B1, 0, 1); PG8_STAGE(PG8_SB(0, 0), b2, voffB);
            PG8_BAR; PG8_WAIT_L(0); PG8_MMA(0, 1, At, B1); PG8_BAR;
            PG8_LDA(At, 0, 1); PG8_STAGE(PG8_SA(0, 0), a2, voffA);
            PG8_BAR; PG8_WAIT_L(0); PG8_MMA(1, 0, At, B0); PG8_BAR; PG8_SCHED;
            PG8_STAGE(PG8_SB(0, 1), b2 + hstepB, voffB);
            PG8_WAIT_V(6); PG8_BAR; PG8_MMA(1, 1, At, B1); PG8_BAR;
            PG8_LDB(B0, 1, 0); PG8_SCHED; PG8_LDA(At, 1, 0); PG8_STAGE(PG8_SA(0, 1), a2 + hstepA, voffA);
            PG8_WAIT_L(8); PG8_BAR; PG8_WAIT_L(0); PG8_MMA(0, 0, At, B0); PG8_BAR; PG8_SCHED;
            PG8_LDB(B1, 1, 1); PG8_STAGE(PG8_SB(1, 0), b3, voffB);
            PG8_BAR; PG8_WAIT_L(0); PG8_MMA(0, 1, At, B1); PG8_BAR;
            PG8_LDA(At, 1, 1); PG8_STAGE(PG8_SA(1, 0), a3, voffA);
            PG8_BAR; PG8_WAIT_L(0); PG8_MMA(1, 0, At, B0); PG8_BAR; PG8_SCHED;
            PG8_STAGE(PG8_SB(1, 1), b3 + hstepB, voffB);
            PG8_WAIT_V(6); PG8_BAR; PG8_MMA(1, 1, At, B1); PG8_BAR;
        }
        E(acc, cur, wr, wc, fr, fq);
        if (!has_next) break;
#pragma unroll
        for (int a = 0; a < 2; ++a)
#pragma unroll
            for (int b = 0; b < 2; ++b)
#pragma unroll
                for (int m = 0; m < 4; ++m)
#pragma unroll
                    for (int n = 0; n < 2; ++n) acc[a][b][m][n] = (f32x4){0.f, 0.f, 0.f, 0.f};
        cur = nxt; cA = nA; cB = nB; ++ui;
    }
    PG8_WAIT_V(0);
    if (wr == 0) PG8_BAR;
    PG8_BAR;
#undef PG8_SA
#undef PG8_SB
#undef PG8_STAGE
#undef PG8_LDA
#undef PG8_LDB
#undef PG8_MMA
#undef PG8_WAIT_V
#undef PG8_WAIT_L
#undef PG8_BAR
#undef PG8_SCHED
}
}
using pg8::UnitD;

struct SchedInproj {
    const char* P; const char* WT; int G, c, nN, pn0, gap_lo, gap_n;
    __device__ __forceinline__ bool next(int i, UnitD& u) const {
        const int L = i * G + c; if (L >= 64 * nN) return false;
        int pm, pn; pg8::tile_of(L, 64, nN, pm, pn); pn += pn0; if (pn >= gap_lo) pn += gap_n;
        u.A = P + ((size_t)pm * 256 * LDP + C_H) * 2; u.B = WT + (size_t)pn * 256 * 2048; u.nt = 16; u.pm = pm; u.pn = pn; u.kind = 0; return true;
    }
};
struct EpiInproj {
    bf16_t* P;
    __device__ __forceinline__ void operator()(const f32x4 (&acc)[2][2][4][2], const UnitD& u, int wr, int wc, int fr, int fq) const {
        const int row0 = u.pm * 256 + wr * 64 + fr, col0 = u.pn * 256 + wc * 32 + 8 * fq;
#pragma unroll
        for (int ai = 0; ai < 2; ++ai)
#pragma unroll
            for (int m = 0; m < 4; ++m) { bf16_t* rowp = P + (size_t)(row0 + ai * 128 + m * 16) * LDP + col0;
#pragma unroll
                for (int bj = 0; bj < 2; ++bj) { const f32x4 v0 = acc[ai][bj][m][0], v1 = acc[ai][bj][m][1];
                    u32x4 o; o.x = cvt_pk_bf16(v0[0], v0[1]); o.y = cvt_pk_bf16(v0[2], v0[3]); o.z = cvt_pk_bf16(v1[0], v1[1]); o.w = cvt_pk_bf16(v1[2], v1[3]);
                    *(u32x4*)(rowp + bj * 128) = o; } }
    }
};
struct SchedC1 {
    const char* P; const char* WT; int G, c;
    __device__ __forceinline__ bool next(int i, UnitD& u) const {
        const int ti = i / 6, sub = i - ti * 6, L = ti * G + c; if (L >= 256) return false;
        int pm, pn; pg8::tile_of(L, 64, 4, pm, pn);
        const int br = sub >> 1;
        if (!(sub & 1)) { u.A = P + ((size_t)pm * 256 * LDP + C_H) * 2; u.B = WT + (size_t)(R_GATE + br * 1024 + pn * 256) * 2048; u.nt = 16; }
        else { const int acol = br == 0 ? C_SBG : (br == 1 ? C_Z : C_YRW); const int brow = br == 0 ? R_SB : (br == 1 ? R_SSD : R_RWO);
            u.A = P + ((size_t)pm * 256 * LDP + acol) * 2; u.B = WT + (size_t)(brow + pn * 256) * 2048; u.nt = br == 1 ? 16 : 8; }
        u.pm = pm; u.pn = pn; u.kind = sub; return true;
    }
};
struct EpiC1 {
    bf16_t* P; const float* rstd;
    __device__ __forceinline__ void operator()(const f32x4 (&acc)[2][2][4][2], const UnitD& u, int wr, int wc, int fr, int fq) const {
        const int row0 = u.pm * 256 + wr * 64 + fr, col0 = u.pn * 256 + wc * 32 + 8 * fq;
        const int kind = u.kind;
#pragma unroll
        for (int ai = 0; ai < 2; ++ai)
#pragma unroll
            for (int m = 0; m < 4; ++m) { const int row = row0 + ai * 128 + m * 16; bf16_t* rowp = P + (size_t)row * LDP + col0;
                const float sc = (kind == 3) ? rstd[row] : 1.f;
#pragma unroll
                for (int bj = 0; bj < 2; ++bj) { const f32x4 v0 = acc[ai][bj][m][0], v1 = acc[ai][bj][m][1];
                    float v[8] = {v0[0], v0[1], v0[2], v0[3], v1[0], v1[1], v1[2], v1[3]};
                    u32x4* gp = (u32x4*)(rowp + C_G + bj * 128); u32x4* mp = (u32x4*)(rowp + C_M + bj * 128);
                    if (!(kind & 1)) {
#pragma unroll
                        for (int e = 0; e < 8; ++e) v[e] = sigmoidf_(v[e]);
                        u32x4 o; o.x = cvt_pk_bf16(v[0], v[1]); o.y = cvt_pk_bf16(v[2], v[3]); o.z = cvt_pk_bf16(v[4], v[5]); o.w = cvt_pk_bf16(v[6], v[7]);
                        *gp = o;
                    } else {
                        const u32x4 g = *gp;
                        float r[8];
                        r[0] = bf_lo(g.x) * v[0] * sc; r[1] = bf_hi(g.x) * v[1] * sc; r[2] = bf_lo(g.y) * v[2] * sc; r[3] = bf_hi(g.y) * v[3] * sc;
                        r[4] = bf_lo(g.z) * v[4] * sc; r[5] = bf_hi(g.z) * v[5] * sc; r[6] = bf_lo(g.w) * v[6] * sc; r[7] = bf_hi(g.w) * v[7] * sc;
                        if (kind != 1) { const u32x4 mo = *mp;
                            r[0] += bf_lo(mo.x); r[1] += bf_hi(mo.x); r[2] += bf_lo(mo.y); r[3] += bf_hi(mo.y); r[4] += bf_lo(mo.z); r[5] += bf_hi(mo.z); r[6] += bf_lo(mo.w); r[7] += bf_hi(mo.w); }
                        u32x4 o; o.x = cvt_pk_bf16(r[0], r[1]); o.y = cvt_pk_bf16(r[2], r[3]); o.z = cvt_pk_bf16(r[4], r[5]); o.w = cvt_pk_bf16(r[6], r[7]);
                        *mp = o;
                    } } }
    }
};
struct SchedOut {
    const char* P; const char* WT; int G, c;
    __device__ __forceinline__ bool next(int i, UnitD& u) const {
        const int L = i * G + c; if (L >= 256) return false;
        int pm, pn; pg8::tile_of(L, 64, 4, pm, pn);
        u.A = P + ((size_t)pm * 256 * LDP + C_M) * 2; u.B = WT + (size_t)(R_WO + pn * 256) * 2048; u.nt = 16; u.pm = pm; u.pn = pn; u.kind = 0; return true;
    }
};
struct EpiOut {
    const float* Xin; float* Xout;
    __device__ __forceinline__ void operator()(const f32x4 (&acc)[2][2][4][2], const UnitD& u, int wr, int wc, int fr, int fq) const {
        const int row0 = u.pm * 256 + wr * 64 + fr, col0 = u.pn * 256 + wc * 32 + 4 * fq;
#pragma unroll
        for (int ai = 0; ai < 2; ++ai)
#pragma unroll
            for (int m = 0; m < 4; ++m) { const size_t ro = (size_t)(row0 + ai * 128 + m * 16) * DM + col0;
#pragma unroll
                for (int bj = 0; bj < 2; ++bj)
#pragma unroll
                    for (int n = 0; n < 2; ++n) { const f32x4 xi = *(const f32x4*)(Xin + ro + bj * 128 + n * 16); *(f32x4*)(Xout + ro + bj * 128 + n * 16) = xi + acc[ai][bj][m][n]; } }
    }
};

__device__ __forceinline__ void wt_jobs(const Params& p, int layer, unsigned char* shm, int job_lo, int job_hi, int widx, int wstride) {
    const int tid = opaque_tid(), wave = tid >> 6, lane = tid & 63;
    bf16_t* WT = (bf16_t*)(p.ws + OFF_WT);
    float* T = (float*)shm + wave * (64 * 65);
    const float* w_in = p.in[2] + (size_t)layer * DM * NIN;
    const float* sg = p.in[8] + layer * DM;
    for (int job = job_lo + widx; job < job_hi; job += wstride) {
        const float* src; int srcN, k0, n0, dstrow; bool is_in = false, is_ssd = false;
        if (job < 2432) { is_in = true; src = w_in; srcN = NIN; const int ntile = job >> 4; k0 = (job & 15) * 64; n0 = ntile * 64; dstrow = n0; }
        else { int r = job - 2432;
            if (r < 128) { src = p.in[19] + (size_t)layer * 512 * DM; k0 = (r >> 4) * 64; n0 = (r & 15) * 64; dstrow = R_SB + n0; }
            else if (r < 384) { r -= 128; src = p.in[20] + (size_t)layer * DM * DM; k0 = (r >> 4) * 64; n0 = (r & 15) * 64; dstrow = R_SSD + n0; is_ssd = true; }
            else if (r < 512) { r -= 384; src = p.in[21] + (size_t)layer * 512 * DM; k0 = (r >> 4) * 64; n0 = (r & 15) * 64; dstrow = R_RWO + n0; }
            else { r -= 512; src = p.in[22] + (size_t)layer * DM * DM; k0 = (r >> 4) * 64; n0 = (r & 15) * 64; dstrow = R_WO + n0; }
            srcN = DM; }
        const int n4 = (lane & 15) * 4, np = n0 + n4; int sc = np;
        if (is_in) { if (np < 4352) sc = np; else if (np < 6528) sc = np + 16; else if (np < 6544) sc = np - 6528 + 4352; else if (np < 6656) sc = -1; else sc = np - 112; }
        f32x4 v[16];
#pragma unroll
        for (int i = 0; i < 16; ++i) { const int k = (lane >> 4) + 4 * i; v[i] = (f32x4){0.f, 0.f, 0.f, 0.f};
            if (sc >= 0) v[i] = *(const f32x4*)(src + (size_t)(k0 + k) * srcN + sc); }
#pragma unroll
        for (int i = 0; i < 16; ++i) { const int k = (lane >> 4) + 4 * i; f32x4 x = v[i];
            if (is_ssd) x = x * sg[k0 + k];
            T[k * 65 + n4] = x[0]; T[k * 65 + n4 + 1] = x[1]; T[k * 65 + n4 + 2] = x[2]; T[k * 65 + n4 + 3] = x[3]; }
        asm volatile("s_waitcnt lgkmcnt(0)" ::: "memory"); __builtin_amdgcn_wave_barrier(); asm volatile("" ::: "memory");
#pragma unroll
        for (int j = 0; j < 8; ++j) { const int r = lane + 64 * j, n = r >> 3, kc = (r & 7) * 8; const float* sp = T + kc * 65 + n;
            u32x4 o; o.x = cvt_pk_bf16(sp[0], sp[65]); o.y = cvt_pk_bf16(sp[130], sp[195]); o.z = cvt_pk_bf16(sp[260], sp[325]); o.w = cvt_pk_bf16(sp[390], sp[455]);
            *(u32x4*)(WT + (size_t)(dstrow + n) * 1024 + k0 + kc) = o; }
        asm volatile("s_waitcnt lgkmcnt(0)" ::: "memory"); __builtin_amdgcn_wave_barrier(); asm volatile("" ::: "memory");
    }
    __syncthreads();
}

__device__ __forceinline__ void phase0(const Params& p, int layer, unsigned char* shm) {
    const int tid = opaque_tid(), wave = tid >> 6, lane = tid & 63;
    bf16_t* P = (bf16_t*)(p.ws + OFF_P); bf16_t* WT = (bf16_t*)(p.ws + OFF_WT);
    const float* Xin = layer == 0 ? p.in[0] : p.out;
    const float* ng = p.in[1] + layer * DM;
    f32x4 gn[4];
#pragma unroll
    for (int i = 0; i < 4; ++i) gn[i] = *(const f32x4*)(ng + i * 256 + lane * 4);
    for (int row0 = (blockIdx.x * 8 + wave) * 4; row0 < TOK; row0 += gridDim.x * 32) {
        f32x4 v[4][4]; float ss[4];
#pragma unroll
        for (int rr = 0; rr < 4; ++rr) { const float* xr = Xin + (size_t)(row0 + rr) * DM;
#pragma unroll
            for (int i = 0; i < 4; ++i) v[rr][i] = *(const f32x4*)(xr + i * 256 + lane * 4); }
#pragma unroll
        for (int rr = 0; rr < 4; ++rr) { float a = 0.f;
#pragma unroll
            for (int i = 0; i < 4; ++i) a += v[rr][i][0] * v[rr][i][0] + v[rr][i][1] * v[rr][i][1] + v[rr][i][2] * v[rr][i][2] + v[rr][i][3] * v[rr][i][3];
            ss[rr] = wave_sum(a); }
#pragma unroll
        for (int rr = 0; rr < 4; ++rr) { const float rs = rsqrtf(ss[rr] * (1.f / DM) + 1e-6f);
#pragma unroll
            for (int i = 0; i < 4; ++i) { const f32x4 g = gn[i];
                u32x2 o; o.x = cvt_pk_bf16(v[rr][i][0] * rs * g[0], v[rr][i][1] * rs * g[1]); o.y = cvt_pk_bf16(v[rr][i][2] * rs * g[2], v[rr][i][3] * rs * g[3]);
                *(u32x2*)(P + (size_t)(row0 + rr) * LDP + C_H + i * 256 + lane * 4) = o; } }
    }
    wt_jobs(p, layer, shm, (layer == 1) ? 1664 : 0, 3200, blockIdx.x * 8 + wave, gridDim.x * 8);
}

__device__ __forceinline__ void attn_item(const Params& p, unsigned char* shm, int item) {
    const int qb = item & 15, h = (item >> 4) & 7, b = item >> 7;
    bf16_t* P = (bf16_t*)(p.ws + OFF_P);
    const int tid = opaque_tid(), wave = tid >> 6, lane = tid & 63, lq = lane & 15, g = lane >> 4;
    const size_t rowbase = (size_t)b * SEQ;
    const int t = qb * 128 + wave * 16 + lq;
    const int tmax = qb * 128 + wave * 16 + 15;
    constexpr int ABUF = 64 * 144 + 64 * 136;
    const bf16_t* qp = P + (rowbase + t) * LDP + C_Q + h * 64 + 8 * g;
    const bf16x8 qf0 = *(const bf16x8*)qp, qf1 = *(const bf16x8*)(qp + 32);
    bf16x8 TT[4][2];
#pragma unroll
    for (int a = 0; a < 4; ++a)
#pragma unroll
        for (int ks = 0; ks < 2; ++ks)
#pragma unroll
            for (int e = 0; e < 8; ++e) { const int j = 16 * (2 * ks + (e >> 2)) + 4 * g + (e & 3); TT[a][ks][e] = (j > 16 * a + lq) ? (short)0x3F80 : (short)0; }
    f32x4 o[4];
#pragma unroll
    for (int i = 0; i < 4; ++i) o[i] = (f32x4){0.f, 0.f, 0.f, 0.f};
    float R = 0.f;
    LAS volatile int* flg = (LAS volatile int*)((LAS unsigned char*)shm + 2 * ABUF);
    const int st_s = tid >> 3, st_dc = (tid & 7) * 8;
    const bf16_t* st_base = P + (rowbase + st_s) * LDP + h * 64 + st_dc;
    auto stage_write = [&](unsigned char* buf, const u32x4& kv, const u32x4& vv) {
        bf16_t* Ksw = (bf16_t*)buf; bf16_t* Vtw = (bf16_t*)(buf + 64 * 144); const int s_ = st_s, dc = st_dc;
        *(u32x4*)(Ksw + s_ * 72 + dc) = kv;
        Vtw[(dc + 0) * 68 + s_] = (bf16_t)(vv.x & 0xFFFF); Vtw[(dc + 1) * 68 + s_] = (bf16_t)(vv.x >> 16);
        Vtw[(dc + 2) * 68 + s_] = (bf16_t)(vv.y & 0xFFFF); Vtw[(dc + 3) * 68 + s_] = (bf16_t)(vv.y >> 16);
        Vtw[(dc + 4) * 68 + s_] = (bf16_t)(vv.z & 0xFFFF); Vtw[(dc + 5) * 68 + s_] = (bf16_t)(vv.z >> 16);
        Vtw[(dc + 6) * 68 + s_] = (bf16_t)(vv.w & 0xFFFF); Vtw[(dc + 7) * 68 + s_] = (bf16_t)(vv.w >> 16);
    };
    if (tid == 0) { flg[0] = 1; flg[1] = 0; flg[2] = 0; }
    { const bf16_t* kr = st_base + (size_t)(2 * qb + 1) * 64 * LDP; const u32x4 kv0 = *(const u32x4*)(kr + C_K), vv0 = *(const u32x4*)(kr + C_V); stage_write(shm, kv0, vv0); }
    int itn = 0, cur = 0;
    for (int kt = 2 * qb + 1; kt >= 0; --kt) {
        __syncthreads();
        const int f0 = itn % 3, f1 = (itn + 1) % 3, f2 = (itn + 2) % 3;
        if (flg[f0] == 0) break;
        if (tid == 0) flg[f2] = 0;
        u32x4 kvn = (u32x4){0u, 0u, 0u, 0u}, vvn = (u32x4){0u, 0u, 0u, 0u};
        if (kt > 0) { const bf16_t* kr = st_base + (size_t)(kt - 1) * 64 * LDP; kvn = *(const u32x4*)(kr + C_K); vvn = *(const u32x4*)(kr + C_V); }
        const bf16_t* Ks = (const bf16_t*)(shm + cur * ABUF); const bf16_t* Vt = (const bf16_t*)(shm + cur * ABUF + 64 * 144);
        const bool walive = __any(R > -104.f);
        const bool act = (kt * 64 < tmax) && walive;
        if (act) {
            float lb[4][4], lk[4][4];
#pragma unroll
            for (int sub = 0; sub < 4; ++sub) {
                const bf16_t* kp = Ks + (16 * sub + lq) * 72 + 8 * g;
                const bf16x8 k0 = *(const bf16x8*)kp, k1 = *(const bf16x8*)(kp + 32);
                f32x4 s4 = (f32x4){0.f, 0.f, 0.f, 0.f};
                s4 = __builtin_amdgcn_mfma_f32_16x16x32_bf16(k0, qf0, s4, 0, 0, 0);
                s4 = __builtin_amdgcn_mfma_f32_16x16x32_bf16(k1, qf1, s4, 0, 0, 0);
#pragma unroll
                for (int r = 0; r < 4; ++r) { const float z = s4[r] * 0.125f; const bool mk = (kt * 64 + 16 * sub + 4 * g + r) < t;
                    const float l = fminf(z, 0.f) - 0.69314718f * __builtin_amdgcn_logf(1.f + __expf(-fabsf(z)));
                    lb[sub][r] = mk ? l : -1e30f; lk[sub][r] = mk ? (l - z) : 0.f; }
            }
            bf16x8 hi[2];
#pragma unroll
            for (int ks = 0; ks < 2; ++ks) {
                unsigned hw[4];
#pragma unroll
                for (int w2 = 0; w2 < 4; ++w2) { const int sub = 2 * ks + (w2 >> 1), r0 = (w2 & 1) * 2; const float a0 = lk[sub][r0], a1 = lk[sub][r0 + 1];
                    hw[w2] = cvt_pk_bf16(a0, a1); }
                u32x4 hv = (u32x4){hw[0], hw[1], hw[2], hw[3]};
                hi[ks] = __builtin_bit_cast(bf16x8, hv);
            }
            f32x4 aft[4];
#pragma unroll
            for (int a = 0; a < 4; ++a) { f32x4 c = (f32x4){0.f, 0.f, 0.f, 0.f};
#pragma unroll
                for (int ks = 0; ks < 2; ++ks) c = __builtin_amdgcn_mfma_f32_16x16x32_bf16(TT[a][ks], hi[ks], c, 0, 0, 0);
                aft[a] = c; }
            float tot = aft[0][0] + lk[0][0];
            tot = __shfl(tot, lq);
            bf16x8 pf[2];
#pragma unroll
            for (int ks = 0; ks < 2; ++ks) { unsigned pw[4];
#pragma unroll
                for (int w2 = 0; w2 < 4; ++w2) { const int sub = 2 * ks + (w2 >> 1), r0 = (w2 & 1) * 2;
                    const float e0 = __expf(lb[sub][r0] + aft[sub][r0] + R), e1 = __expf(lb[sub][r0 + 1] + aft[sub][r0 + 1] + R);
                    pw[w2] = cvt_pk_bf16(e0, e1); }
                u32x4 pv = (u32x4){pw[0], pw[1], pw[2], pw[3]}; pf[ks] = __builtin_bit_cast(bf16x8, pv); }
            R += tot;
#pragma unroll
            for (int ds = 0; ds < 4; ++ds)
#pragma unroll
                for (int ks = 0; ks < 2; ++ks) { const bf16_t* vp = Vt + (16 * ds + lq) * 68 + 32 * ks + 4 * g;
                    const u32x2 v0 = *(const u32x2*)vp, v1 = *(const u32x2*)(vp + 16);
                    u32x4 vv = (u32x4){v0.x, v0.y, v1.x, v1.y};
                    o[ds] = __builtin_amdgcn_mfma_f32_16x16x32_bf16(__builtin_bit_cast(bf16x8, vv), pf[ks], o[ds], 0, 0, 0); }
        }
        if (__any(R > -104.f) && lane == 0) flg[f1] = 1;
        if (kt > 0) stage_write(shm + (cur ^ 1) * ABUF, kvn, vvn);
        cur ^= 1; ++itn;
    }
#pragma unroll
    for (int ds = 0; ds < 4; ++ds) { bf16_t* gp = P + (rowbase + t) * LDP + C_SBG + h * 64 + 16 * ds + 4 * g;
        const u32x2 gv = *(const u32x2*)gp;
        u32x2 ov; ov.x = cvt_pk_bf16(o[ds][0] * siluf_(bf_lo(gv.x)), o[ds][1] * siluf_(bf_hi(gv.x))); ov.y = cvt_pk_bf16(o[ds][2] * siluf_(bf_lo(gv.y)), o[ds][3] * siluf_(bf_hi(gv.y)));
        *(u32x2*)gp = ov; }
    __syncthreads();
}

__device__ __forceinline__ void bc_prepass(const Params& p, int layer, int blk, int nblk) {
    const bf16_t* P = (const bf16_t*)(p.ws + OFF_P); bf16_t* BCc = (bf16_t*)(p.ws + OFF_BCC);
    const float* cw = p.in[3] + (size_t)layer * 4 * 1280; const float* cb = p.in[4] + layer * 1280;
    const int gt = blk * 512 + opaque_tid(), gs = nblk * 512;
    const int c = (gt & 63) * 4, chn = 1024 + c;
    const f32x4 bias = *(const f32x4*)(cb + chn);
    f32x4 w[4];
#pragma unroll
    for (int k = 0; k < 4; ++k) w[k] = *(const f32x4*)(cw + k * 1280 + chn);
    for (int idx0 = gt; idx0 < TOK * 64; idx0 += 4 * gs) {
        u32x2 xv[4][4]; bool ok[4];
#pragma unroll
        for (int u = 0; u < 4; ++u) { const int idx = idx0 + u * gs; ok[u] = idx < TOK * 64; const int tok = ok[u] ? (idx >> 6) : 0; const int t = tok & (SEQ - 1);
            const bf16_t* xp = P + (size_t)tok * LDP + C_XBC + chn;
#pragma unroll
            for (int k = 0; k < 4; ++k) { const int ts = t - 3 + k; const unsigned xm = ts >= 0 ? 0xFFFFFFFFu : 0u;
                u32x2 x = *(const u32x2*)(xp + (ptrdiff_t)(ts >= 0 ? k - 3 : 0) * LDP); x.x &= xm; x.y &= xm; xv[u][k] = x; } }
#pragma unroll
        for (int u = 0; u < 4; ++u) { const int idx = idx0 + u * gs; const int tok = ok[u] ? (idx >> 6) : 0;
            f32x4 a = bias;
#pragma unroll
            for (int k = 0; k < 4; ++k) { a[0] += w[k][0] * bf_lo(xv[u][k].x); a[1] += w[k][1] * bf_hi(xv[u][k].x); a[2] += w[k][2] * bf_lo(xv[u][k].y); a[3] += w[k][3] * bf_hi(xv[u][k].y); }
            u32x2 o; o.x = cvt_pk_bf16(siluf_(a[0]), siluf_(a[1])); o.y = cvt_pk_bf16(siluf_(a[2]), siluf_(a[3]));
            if (ok[u]) *(u32x2*)(BCc + (size_t)tok * 256 + c) = o; }
    }
}

__device__ __forceinline__ void ssd_item(const Params& p, int layer, unsigned char* shm, int item) {
    const int hh = item & 15, b = item >> 4, grp = hh >> 3;
    bf16_t* P = (bf16_t*)(p.ws + OFF_P); float* SSQ = (float*)(p.ws + OFF_SSQ);
    const int tid = opaque_tid(), wave = tid >> 6, lane = tid & 63, lq = lane & 15, g = lane >> 4;
    const size_t rowbase = (size_t)b * SEQ;
    const float* cw = p.in[3] + (size_t)layer * 4 * 1280; const float* cb = p.in[4] + layer * 1280;
    const float dtb = p.in[5][layer * 16 + hh], Aneg = -__expf(p.in[6][layer * 16 + hh]), Dsk = p.in[7][layer * 16 + hh];
    float* XS = (float*)shm;
    float* YS = XS + 4096;
    float* DTs = YS + 4096;
    float* ACS = DTs + 64;
    bf16_t* Cb = (bf16_t*)(ACS + 64);
    bf16_t* Bb = Cb + 64 * 72;
    bf16_t* BT = Bb + 64 * 72;
    bf16_t* Mx = BT + 64 * 72;
    bf16_t* XT = Mx + 64 * 72;
    bf16_t* XwT = XT + 64 * 72;
    bf16_t* SbT = XwT + 64 * 72;
    f32x4 Sacc[2] = {(f32x4){0.f, 0.f, 0.f, 0.f}, (f32x4){0.f, 0.f, 0.f, 0.f}};
    const bf16_t* BCc = (const bf16_t*)(p.ws + OFF_BCC);
    const int x_tt = tid >> 3, x_c = (tid & 7) * 4;
    const int bc_q = tid & 7;
    f32x4 xbias[2], xw[2][4];
#pragma unroll
    for (int h2 = 0; h2 < 2; ++h2) { const int chn = hh * 64 + x_c + 32 * h2; xbias[h2] = *(const f32x4*)(cb + chn);
#pragma unroll
        for (int k = 0; k < 4; ++k) xw[h2][k] = *(const f32x4*)(cw + k * 1280 + chn); }
    u32x2 sx[2][4]; u32x4 bc0, bc1; bf16_t sdt = 0;
    auto ssd_load = [&](int tb) {
        const int t = tb + x_tt;
#pragma unroll
        for (int h2 = 0; h2 < 2; ++h2) { const bf16_t* xp = P + (rowbase + t) * LDP + C_XBC + hh * 64 + x_c + 32 * h2;
#pragma unroll
            for (int k = 0; k < 4; ++k) { const int ts = t - 3 + k; const unsigned xm = ts >= 0 ? 0xFFFFFFFFu : 0u;
                u32x2 xv = *(const u32x2*)(xp + (ptrdiff_t)(ts >= 0 ? k - 3 : 0) * LDP); xv.x &= xm; xv.y &= xm; sx[h2][k] = xv; } }
        const bf16_t* bp = BCc + (rowbase + t) * 256 + (bc_q < 4 ? grp * 64 + bc_q * 16 : 128 + grp * 64 + (bc_q - 4) * 16);
        bc0 = *(const u32x4*)bp; bc1 = *(const u32x4*)(bp + 8);
        if (tid < 64) sdt = P[(rowbase + tb + tid) * LDP + C_DT + hh];
    };
    ssd_load(0);
    for (int ch = 0; ch < SEQ / 64; ++ch) {
        const int t0 = ch * 64;
        __syncthreads();
        const int o_tt = tid >> 3, o_p8 = (tid & 7) * 8;
        bf16_t* zp = P + (rowbase + t0 + o_tt) * LDP + C_Z + hh * 64 + o_p8;
        const u32x4 zv = *(const u32x4*)zp;
#pragma unroll
        for (int h2 = 0; h2 < 2; ++h2) { f32x4 a = xbias[h2];
#pragma unroll
            for (int k = 0; k < 4; ++k) { a[0] += xw[h2][k][0] * bf_lo(sx[h2][k].x); a[1] += xw[h2][k][1] * bf_hi(sx[h2][k].x); a[2] += xw[h2][k][2] * bf_lo(sx[h2][k].y); a[3] += xw[h2][k][3] * bf_hi(sx[h2][k].y); }
            a[0] = siluf_(a[0]); a[1] = siluf_(a[1]); a[2] = siluf_(a[2]); a[3] = siluf_(a[3]);
            const unsigned q0 = cvt_pk_bf16(a[0], a[1]), q1 = cvt_pk_bf16(a[2], a[3]); const int tt = x_tt, c = x_c + 32 * h2;
            *(f32x4*)(XS + tt * 64 + c) = a;
            XT[(c + 0) * 72 + tt] = (bf16_t)(q0 & 0xFFFF); XT[(c + 1) * 72 + tt] = (bf16_t)(q0 >> 16); XT[(c + 2) * 72 + tt] = (bf16_t)(q1 & 0xFFFF); XT[(c + 3) * 72 + tt] = (bf16_t)(q1 >> 16); }
        { const int tt = x_tt;
            if (bc_q < 4) { const int n = bc_q * 16; *(u32x4*)(Bb + tt * 72 + n) = bc0; *(u32x4*)(Bb + tt * 72 + n + 8) = bc1;
                const unsigned wv[8] = {bc0.x, bc0.y, bc0.z, bc0.w, bc1.x, bc1.y, bc1.z, bc1.w};
#pragma unroll
                for (int e = 0; e < 8; ++e) { BT[(n + 2 * e) * 72 + tt] = (bf16_t)(wv[e] & 0xFFFF); BT[(n + 2 * e + 1) * 72 + tt] = (bf16_t)(wv[e] >> 16); } }
            else { const int n = (bc_q - 4) * 16; *(u32x4*)(Cb + tt * 72 + n) = bc0; *(u32x4*)(Cb + tt * 72 + n + 8) = bc1; } }
        if (tid < 64) { const float dt = softplusf_(bf2f(sdt) + dtb); DTs[tid] = dt;
            float x = dt * Aneg;
#pragma unroll
            for (int o = 1; o < 64; o <<= 1) { const float v = __shfl_up(x, o); if (lane >= o) x += v; }
            ACS[tid] = x; }
        if (ch + 1 < SEQ / 64) ssd_load(t0 + 64);
        __syncthreads();
        const float acsL = ACS[63];
#pragma unroll
        for (int h2 = 0; h2 < 2; ++h2) { const int pp = (tid >> 4) + 32 * h2, s4 = (tid & 15) * 4; float v[4];
#pragma unroll
            for (int e = 0; e < 4; ++e) { const int sidx = s4 + e; v[e] = XS[sidx * 64 + pp] * DTs[sidx] * __expf(acsL - ACS[sidx]); }
            *(u32x2*)(XwT + pp * 72 + s4) = (u32x2){cvt_pk_bf16(v[0], v[1]), cvt_pk_bf16(v[2], v[3])}; }
#pragma unroll
        for (int h2 = 0; h2 < 2; ++h2) { const int pi = (wave >> 2) + 2 * h2, ni = wave & 3;
#pragma unroll
            for (int r = 0; r < 4; ++r) SbT[(16 * pi + 4 * g + r) * 72 + 16 * ni + lq] = (bf16_t)(cvt_pk_bf16(Sacc[h2][r], 0.f) & 0xFFFF); }
        { const int ti = wave >> 1;
#pragma unroll
            for (int sj = 0; sj < 2; ++sj) { const int si = 2 * (wave & 1) + sj;
                f32x4 acc = (f32x4){0.f, 0.f, 0.f, 0.f};
                if (si <= ti) {
                    const bf16_t* ap = Cb + (16 * ti + lq) * 72 + 8 * g; const bf16_t* bp = Bb + (16 * si + lq) * 72 + 8 * g;
                    acc = __builtin_amdgcn_mfma_f32_16x16x32_bf16(*(const bf16x8*)ap, *(const bf16x8*)bp, acc, 0, 0, 0);
                    acc = __builtin_amdgcn_mfma_f32_16x16x32_bf16(*(const bf16x8*)(ap + 32), *(const bf16x8*)(bp + 32), acc, 0, 0, 0);
                }
                const int sidx = 16 * si + lq; const float as = ACS[sidx], ds = DTs[sidx];
#pragma unroll
                for (int r = 0; r < 4; ++r) { const int t = 16 * ti + 4 * g + r; const float val = (sidx <= t) ? acc[r] * __expf(ACS[t] - as) * ds : 0.f;
                    Mx[t * 72 + sidx] = (bf16_t)(cvt_pk_bf16(val, 0.f) & 0xFFFF); } } }
        __syncthreads();
        { const int ti = wave >> 1;
            const bf16_t* ap = Mx + (16 * ti + lq) * 72 + 8 * g; const bf16_t* cp = Cb + (16 * ti + lq) * 72 + 8 * g;
            const bf16x8 mf0 = *(const bf16x8*)ap, mf1 = *(const bf16x8*)(ap + 32), cf0 = *(const bf16x8*)cp, cf1 = *(const bf16x8*)(cp + 32);
#pragma unroll
            for (int h2 = 0; h2 < 2; ++h2) { const int pi = (wave & 1) + 2 * h2;
                const bf16_t* bp = XT + (16 * pi + lq) * 72 + 8 * g; const bf16_t* sp = SbT + (16 * pi + lq) * 72 + 8 * g;
                f32x4 a1 = (f32x4){0.f, 0.f, 0.f, 0.f}, a2 = (f32x4){0.f, 0.f, 0.f, 0.f};
                a1 = __builtin_amdgcn_mfma_f32_16x16x32_bf16(mf0, *(const bf16x8*)bp, a1, 0, 0, 0);
                a1 = __builtin_amdgcn_mfma_f32_16x16x32_bf16(mf1, *(const bf16x8*)(bp + 32), a1, 0, 0, 0);
                a2 = __builtin_amdgcn_mfma_f32_16x16x32_bf16(cf0, *(const bf16x8*)sp, a2, 0, 0, 0);
                a2 = __builtin_amdgcn_mfma_f32_16x16x32_bf16(cf1, *(const bf16x8*)(sp + 32), a2, 0, 0, 0);
#pragma unroll
                for (int r = 0; r < 4; ++r) { const int t = 16 * ti + 4 * g + r, pc = 16 * pi + lq;
                    YS[t * 64 + pc] = a1[r] + __expf(ACS[t]) * a2[r] + Dsk * XS[t * 64 + pc]; } } }
        { const int ni = wave & 3; const float dl = __expf(acsL);
            const bf16_t* bp = BT + (16 * ni + lq) * 72 + 8 * g; const bf16x8 bf0 = *(const bf16x8*)bp, bf1 = *(const bf16x8*)(bp + 32);
#pragma unroll
            for (int h2 = 0; h2 < 2; ++h2) { const int pi = (wave >> 2) + 2 * h2;
                const bf16_t* ap = XwT + (16 * pi + lq) * 72 + 8 * g;
                f32x4 sa = Sacc[h2] * dl;
                sa = __builtin_amdgcn_mfma_f32_16x16x32_bf16(*(const bf16x8*)ap, bf0, sa, 0, 0, 0);
                sa = __builtin_amdgcn_mfma_f32_16x16x32_bf16(*(const bf16x8*)(ap + 32), bf1, sa, 0, 0, 0);
                Sacc[h2] = sa; } }
        __syncthreads();
        { const int tt = o_tt, p8 = o_p8; const f32x4 ya = *(const f32x4*)(YS + tt * 64 + p8), yb = *(const f32x4*)(YS + tt * 64 + p8 + 4);
            const float u0 = ya[0] * siluf_(bf_lo(zv.x)), u1 = ya[1] * siluf_(bf_hi(zv.x)), u2 = ya[2] * siluf_(bf_lo(zv.y)), u3 = ya[3] * siluf_(bf_hi(zv.y));
            const float u4 = yb[0] * siluf_(bf_lo(zv.z)), u5 = yb[1] * siluf_(bf_hi(zv.z)), u6 = yb[2] * siluf_(bf_lo(zv.w)), u7 = yb[3] * siluf_(bf_hi(zv.w));
            u32x4 ov; ov.x = cvt_pk_bf16(u0, u1); ov.y = cvt_pk_bf16(u2, u3); ov.z = cvt_pk_bf16(u4, u5); ov.w = cvt_pk_bf16(u6, u7); *(u32x4*)zp = ov;
            float q = (u0 * u0 + u1 * u1) + (u2 * u2 + u3 * u3) + (u4 * u4 + u5 * u5) + (u6 * u6 + u7 * u7);
            q += __shfl_xor(q, 1); q += __shfl_xor(q, 2); q += __shfl_xor(q, 4);
            if ((tid & 7) == 0) { SSQ[(rowbase + t0 + tt) * 32 + hh * 2] = q; SSQ[(rowbase + t0 + tt) * 32 + hh * 2 + 1] = 0.f; } }
    }
    __syncthreads();
}

__device__ __forceinline__ float fast_tanh(float x) { return 1.f - 2.f * __builtin_amdgcn_rcpf(1.f + __expf(2.f * x)); }
__device__ __forceinline__ void pbar4(LAS volatile unsigned* cnt, unsigned& tgt, int lane) {
    tgt += 4u;
    asm volatile("s_waitcnt lgkmcnt(0)" ::: "memory");
    if (lane == 0) __hip_atomic_fetch_add((LAS unsigned*)cnt, 1u, __ATOMIC_RELAXED, __HIP_MEMORY_SCOPE_WORKGROUP);
    while (*cnt < tgt) __builtin_amdgcn_s_sleep(1);
    asm volatile("" ::: "memory");
}
__device__ __forceinline__ void rwkv_item(const Params& p, int layer, unsigned char* shm, int item) {
    const int half = item & 1, h = (item >> 1) & 7, b = item >> 4;
    bf16_t* P = (bf16_t*)(p.ws + OFF_P); bf16_t* YRAW = (bf16_t*)(p.ws + OFF_YRAW); float* BONUS = (float*)(p.ws + OFF_BONUS);
    const int tid = opaque_tid(), wave = tid >> 6, lane = tid & 63, lq = lane & 15, g = lane >> 4;
    const size_t rowbase = (size_t)b * SEQ;
    const float* mu = p.in[9] + layer * 2176;
    const float* w0 = p.in[10] + layer * 512; const float* wup = p.in[11] + (size_t)layer * 64 * 512;
    const float* a0 = p.in[12] + layer * 512; const float* aup = p.in[13] + (size_t)layer * 64 * 512;
    const float* kkp = p.in[14] + layer * 512; const float* kap = p.in[15] + layer * 512; const float* rkp = p.in[16] + layer * 512;
    constexpr int SETF = 6 * 2048;
    float* SET0 = (float*)shm;
    float* AA = SET0 + 2 * SETF;
    float* Yb = AA + 2048;
    bf16_t* WLb = (bf16_t*)(Yb + 2048);
    bf16_t* ALb = WLb + 32 * 72;
    LAS volatile unsigned* pcnt = (LAS volatile unsigned*)((LAS unsigned char*)shm + (2 * SETF + 2048 + 2048) * 4 + 2 * 32 * 72 * 2);
    const int csub = wave & 3;
    bf16x8 bfr[2][2]; float lw0[2];
#pragma unroll
    for (int mat = 0; mat < 2; ++mat) { const float* up = (mat ? aup : wup) + h * 64 + csub * 16 + lq;
#pragma unroll
        for (int ks = 0; ks < 2; ++ks) { unsigned w[4];
#pragma unroll
            for (int e2 = 0; e2 < 4; ++e2) { const int m0 = 32 * ks + 8 * g + 2 * e2; w[e2] = cvt_pk_bf16(up[(size_t)m0 * 512], up[(size_t)(m0 + 1) * 512]); }
            u32x4 wv = (u32x4){w[0], w[1], w[2], w[3]}; bfr[mat][ks] = __builtin_bit_cast(bf16x8, wv); }
        lw0[mat] = (mat ? a0 : w0)[h * 64 + csub * 16 + lq]; }
    const int ej = (tid & 15) * 4;
    const f32x4 c_kk = *(const f32x4*)(kkp + h * 64 + ej), c_ka = *(const f32x4*)(kap + h * 64 + ej), c_rk = *(const f32x4*)(rkp + h * 64 + ej);
    const f32x4 mu_r = *(const f32x4*)(mu + h * 64 + ej), mu_k = *(const f32x4*)(mu + 512 + h * 64 + ej), mu_v = *(const f32x4*)(mu + 1024 + h * 64 + ej);
    const f32x4 mu_w = *(const f32x4*)(mu + 2048 + ej), mu_a = *(const f32x4*)(mu + 2112 + ej);
    f32x4 sA = (f32x4){0.f, 0.f, 0.f, 0.f}, sB = (f32x4){0.f, 0.f, 0.f, 0.f};
    const int irow = half * 32 + (wave & 3) * 8 + g * 2;
    unsigned ptgt = 0u;
    const int pm = tid - 256, e2t = pm >> 4;
    u32x2 cva[2][5], pva[2][5];
    auto rw_load = [&](int ch) {
#pragma unroll
        for (int ps = 0; ps < 2; ++ps) { const int tl = e2t + 16 * ps, t = ch * 32 + tl; const bf16_t* cur = P + (rowbase + t) * LDP + C_RW; const bool hp = t > 0; const bf16_t* prv = hp ? cur - LDP : cur;
#pragma unroll
            for (int i = 0; i < 5; ++i) { const int col = (i == 0 ? h * 64 : i == 1 ? 512 + h * 64 : i == 2 ? 1024 + h * 64 : i == 3 ? 2048 : 2112) + ej;
                cva[ps][i] = *(const u32x2*)(cur + col); pva[ps][i] = *(const u32x2*)(prv + col); } }
    };
    auto prep = [&](int ch, float* SET) {
        float* Rm = SET; float* Km = SET + 2048; float* Vm = SET + 4096; float* DEC = SET + 6144; float* KK = SET + 8192; float* BB = SET + 10240;
#pragma unroll
        for (int ps = 0; ps < 2; ++ps) { const int tl = e2t + 16 * ps, t = ch * 32 + tl; const unsigned pmask = t > 0 ? 0xFFFFFFFFu : 0u;
#pragma unroll
            for (int i = 0; i < 5; ++i) {
                const u32x2 cv = cva[ps][i]; u32x2 pv = pva[ps][i]; pv.x &= pmask; pv.y &= pmask;
                const f32x4 m4 = i == 0 ? mu_r : i == 1 ? mu_k : i == 2 ? mu_v : i == 3 ? mu_w : mu_a;
                float c[4] = {bf_lo(cv.x), bf_hi(cv.x), bf_lo(cv.y), bf_hi(cv.y)}; const float q[4] = {bf_lo(pv.x), bf_hi(pv.x), bf_lo(pv.y), bf_hi(pv.y)};
#pragma unroll
                for (int e = 0; e < 4; ++e) c[e] = c[e] + (q[e] - c[e]) * m4[e];
                if (i == 0) *(f32x4*)(Rm + tl * 64 + ej) = (f32x4){c[0], c[1], c[2], c[3]};
                else if (i == 1) *(f32x4*)(Km + tl * 64 + ej) = (f32x4){c[0], c[1], c[2], c[3]};
                else if (i == 2) *(f32x4*)(Vm + tl * 64 + ej) = (f32x4){c[0], c[1], c[2], c[3]};
                else if (i == 3) { u32x2 o; o.x = cvt_pk_bf16(fast_tanh(c[0]), fast_tanh(c[1])); o.y = cvt_pk_bf16(fast_tanh(c[2]), fast_tanh(c[3])); *(u32x2*)(WLb + tl * 72 + ej) = o; }
                else { u32x2 o; o.x = cvt_pk_bf16(c[0], c[1]); o.y = cvt_pk_bf16(c[2], c[3]); *(u32x2*)(ALb + tl * 72 + ej) = o; } } }
        if (ch + 1 < SEQ / 32) rw_load(ch + 1);
        pbar4(pcnt, ptgt, lane);
#pragma unroll
        for (int mat = 0; mat < 2; ++mat)
#pragma unroll
            for (int ts = 0; ts < 2; ++ts) { const bf16_t* ap = (mat ? ALb : WLb) + (16 * ts + lq) * 72 + 8 * g;
                const bf16x8 a0f = *(const bf16x8*)ap, a1f = *(const bf16x8*)(ap + 32);
                f32x4 c = (f32x4){0.f, 0.f, 0.f, 0.f};
                c = __builtin_amdgcn_mfma_f32_16x16x32_bf16(a0f, bfr[mat][0], c, 0, 0, 0);
                c = __builtin_amdgcn_mfma_f32_16x16x32_bf16(a1f, bfr[mat][1], c, 0, 0, 0);
#pragma unroll
                for (int r = 0; r < 4; ++r) { const int tt = 16 * ts + 4 * g + r; const float x = lw0[mat] + c[r];
                    if (mat == 0) DEC[tt * 64 + csub * 16 + lq] = __expf(-0.60653066f * sigmoidf_(x));
                    else AA[tt * 64 + csub * 16 + lq] = sigmoidf_(x); } }
        pbar4(pcnt, ptgt, lane);
#pragma unroll
        for (int ps = 0; ps < 2; ++ps) { const int tl = e2t + 16 * ps;
            const f32x4 k4 = *(const f32x4*)(Km + tl * 64 + ej), a4 = *(const f32x4*)(AA + tl * 64 + ej), r4 = *(const f32x4*)(Rm + tl * 64 + ej);
            f32x4 kr, kt; float ss = 0.f, bo = 0.f;
#pragma unroll
            for (int e = 0; e < 4; ++e) { kr[e] = k4[e] * c_kk[e]; ss += kr[e] * kr[e]; kt[e] = k4[e] * (1.f + (a4[e] - 1.f) * c_ka[e]); bo += r4[e] * kt[e] * c_rk[e]; }
            ss = allred16(ss); bo = allred16(bo);
            const float inv = __builtin_amdgcn_rsqf(fmaxf(ss, 1e-24f));
            f32x4 kk4, b4;
#pragma unroll
            for (int e = 0; e < 4; ++e) { kk4[e] = kr[e] * inv; b4[e] = kk4[e] * a4[e]; }
            *(f32x4*)(Km + tl * 64 + ej) = kt; *(f32x4*)(KK + tl * 64 + ej) = kk4; *(f32x4*)(BB + tl * 64 + ej) = b4;
            if (half == 0 && (tid & 15) == 0) BONUS[(rowbase + ch * 32 + tl) * 8 + h] = bo; }
    };
    auto yraw_store = [&](int ch) {
#pragma unroll
        for (int ps = 0; ps < 2; ++ps)
#pragma unroll
            for (int q = 0; q < 2; ++q) { const int tl = e2t + 16 * ps, il = (tid & 15) + 16 * q;
                YRAW[(rowbase + ch * 32 + tl) * 512 + h * 64 + half * 32 + il] = (bf16_t)(cvt_pk_bf16(Yb[(ch & 1) * 1024 + tl * 32 + il], 0.f) & 0xFFFF); }
    };
    if (tid == 0) *pcnt = 0u;
    __syncthreads();
    if (wave >= 4) { rw_load(0); prep(0, SET0); }
    for (int ch = 0; ch < SEQ / 32; ++ch) {
        __syncthreads();
        if (wave < 4) {
            const float* SET = SET0 + (ch & 1) * SETF;
            const float* Rm = SET; const float* Km = SET + 2048; const float* Vm = SET + 4096; const float* DEC = SET + 6144; const float* KK = SET + 8192; const float* BB = SET + 10240;
            float* Yw = Yb + (ch & 1) * 1024;
            struct Ops { f32x4 w, k, q, b, r; float v0, v1; };
            auto ld = [&](Ops& o, int tt) { const int off = tt * 64 + lq * 4;
                o.w = *(const f32x4*)(DEC + off); o.k = *(const f32x4*)(Km + off); o.q = *(const f32x4*)(KK + off); o.b = *(const f32x4*)(BB + off); o.r = *(const f32x4*)(Rm + off);
                const float* vp = Vm + tt * 64 + irow; o.v0 = vp[0]; o.v1 = vp[1]; };
            auto step = [&](const Ops& o, int tt) {
                const f32x4 da = sA * o.q, db = sB * o.q; const f32x2_t ha = da.lo + da.hi, hb = db.lo + db.hi;
                float sa0 = ha.x + ha.y, sa1 = hb.x + hb.y;
                const f32x4 uA = sA * o.w + o.k * o.v0, uB = sB * o.w + o.k * o.v1;
                sa0 = -allred16(sa0); sa1 = -allred16(sa1);
                sA = uA + o.b * sa0; sB = uB + o.b * sa1;
                const f32x4 ea = sA * o.r, eb = sB * o.r; const f32x2_t ga = ea.lo + ea.hi, gb = eb.lo + eb.hi; float y0 = ga.x + ga.y, y1 = gb.x + gb.y;
                asm("" : "+v"(y0)); asm("" : "+v"(y1));
                y0 += dppf<0xB1>(y0); y1 += dppf<0xB1>(y1);
                float z = (lq & 1) ? y1 : y0;
                z += dppf<0x4E>(z); z += dppf<0x124>(z); z += dppf<0x128>(z);
                if (lq < 2) Yw[tt * 32 + (wave & 3) * 8 + g * 2 + lq] = z; };
            Ops oa, ob;
            ld(oa, 0);
            for (int tt = 0; tt < 32; tt += 4) {
                ld(ob, tt + 1);
                step(oa, tt);
                ld(oa, tt + 2);
                step(ob, tt + 1);
                ld(ob, tt + 3);
                step(oa, tt + 2);
                ld(oa, (tt + 4 < 32) ? tt + 4 : 31);
                step(ob, tt + 3);
            }
        } else {
            if (ch > 0) yraw_store(ch - 1);
            if (ch + 1 < SEQ / 32) prep(ch + 1, SET0 + ((ch + 1) & 1) * SETF);
        }
    }
    __syncthreads();
    if (wave >= 4) yraw_store(SEQ / 32 - 1);
    __syncthreads();
}

__device__ __forceinline__ void rw_post(const Params& p, int layer) {
    bf16_t* P = (bf16_t*)(p.ws + OFF_P); const bf16_t* YRAW = (const bf16_t*)(p.ws + OFF_YRAW);
    const float* BONUS = (const float*)(p.ws + OFF_BONUS); const float* SSQ = (const float*)(p.ws + OFF_SSQ); float* RSTD = (float*)(p.ws + OFF_RSTD);
    const float* mu = p.in[9] + layer * 2176; const float* lng = p.in[17] + layer * 512; const float* lnb = p.in[18] + layer * 512;
    const int gt = blockIdx.x * 512 + opaque_tid(), gs = gridDim.x * 512;
    {
        const int c = (gt & 127) * 4, h = c >> 6;
        const f32x4 muv = *(const f32x4*)(mu + 1024 + c), mug = *(const f32x4*)(mu + 1536 + c);
        const f32x4 lg = *(const f32x4*)(lng + c), lb = *(const f32x4*)(lnb + c);
        for (int idx0 = gt; idx0 < TOK * 128; idx0 += 4 * gs) {
            u32x2 yv[4], vc[4], gc[4], vp[4], gp[4]; float bn[4]; unsigned pm[4]; bool ok[4];
#pragma unroll
            for (int u = 0; u < 4; ++u) { const int idx = idx0 + u * gs; ok[u] = idx < TOK * 128; const int tok = ok[u] ? (idx >> 7) : 0;
                const bf16_t* cur = P + (size_t)tok * LDP + C_RW; const bool hp = (tok & (SEQ - 1)) > 0; const bf16_t* prv = hp ? cur - LDP : cur; pm[u] = hp ? 0xFFFFFFFFu : 0u;
                yv[u] = *(const u32x2*)(YRAW + (size_t)tok * 512 + c);
                vc[u] = *(const u32x2*)(cur + 1024 + c); gc[u] = *(const u32x2*)(cur + 1536 + c);
                vp[u] = *(const u32x2*)(prv + 1024 + c); gp[u] = *(const u32x2*)(prv + 1536 + c);
                bn[u] = BONUS[(size_t)tok * 8 + h]; }
#pragma unroll
            for (int u = 0; u < 4; ++u) { const int idx = idx0 + u * gs; const int tok = ok[u] ? (idx >> 7) : 0;
                float y[4] = {bf_lo(yv[u].x), bf_hi(yv[u].x), bf_lo(yv[u].y), bf_hi(yv[u].y)};
                const float mean = allred16(y[0] + y[1] + y[2] + y[3]) * (1.f / 64.f);
                float d[4], vs = 0.f;
#pragma unroll
                for (int e = 0; e < 4; ++e) { d[e] = y[e] - mean; vs += d[e] * d[e]; }
                const float var = allred16(vs) * (1.f / 64.f);
                const float rs = rsqrtf(var + 64e-5f);
                const unsigned m = pm[u];
                const float vcur[4] = {bf_lo(vc[u].x), bf_hi(vc[u].x), bf_lo(vc[u].y), bf_hi(vc[u].y)}, vprv[4] = {bf_lo(vp[u].x & m), bf_hi(vp[u].x & m), bf_lo(vp[u].y & m), bf_hi(vp[u].y & m)};
                const float gcur[4] = {bf_lo(gc[u].x), bf_hi(gc[u].x), bf_lo(gc[u].y), bf_hi(gc[u].y)}, gprv[4] = {bf_lo(gp[u].x & m), bf_hi(gp[u].x & m), bf_lo(gp[u].y & m), bf_hi(gp[u].y & m)};
                float o[4];
#pragma unroll
                for (int e = 0; e < 4; ++e) { const float vm = vcur[e] + (vprv[e] - vcur[e]) * muv[e], gm = gcur[e] + (gprv[e] - gcur[e]) * mug[e];
                    o[e] = (d[e] * rs * lg[e] + lb[e] + bn[u] * vm) * siluf_(gm); }
                u32x2 ov; ov.x = cvt_pk_bf16(o[0], o[1]); ov.y = cvt_pk_bf16(o[2], o[3]);
                if (ok[u]) *(u32x2*)(P + (size_t)tok * LDP + C_YRW + c) = ov; }
        }
    }
    for (int tok = gt; tok < TOK; tok += gs) { const f32x4* q = (const f32x4*)(SSQ + (size_t)tok * 32); float s = 0.f;
#pragma unroll
        for (int i = 0; i < 8; ++i) { const f32x4 v = q[i]; s += v[0] + v[1] + v[2] + v[3]; }
        RSTD[tok] = rsqrtf(s * (1.f / 1024.f) + 1e-6f); }
}

#define XB_TMO      128
#define XB_XCNT(j)  (256  + 64 * (j))
#define XB_XSUB(j)  (1280 + 64 * (j))
#define XB_XGEN(j)  (2304 + 64 * (j))
#define XB_TOP      3328
#define XB_TOPGEN   3392
#define XCD_BAR_WORDS 3456
#define XB_SPIN_CAP (1u << 18)
__device__ __forceinline__ unsigned xb_ld(unsigned* p)              { return __hip_atomic_load(p, __ATOMIC_RELAXED, __HIP_MEMORY_SCOPE_AGENT); }
__device__ __forceinline__ unsigned xb_add(unsigned* p, unsigned v) { return __hip_atomic_fetch_add(p, v, __ATOMIC_RELAXED, __HIP_MEMORY_SCOPE_AGENT); }
__device__ __forceinline__ unsigned xb_xcc_id() { return (unsigned)__builtin_amdgcn_s_getreg((3 << 11) | 20) & 0xFu; }
#define XB_SPIN(cond, bar) do { unsigned _sp = 0; while (cond) { __builtin_amdgcn_s_sleep(1); \
    if ((++_sp & 255u) == 0u) { if (xb_ld(&(bar)[XB_TMO])) break; if (_sp > XB_SPIN_CAP) { atomicAdd(&(bar)[XB_TMO], 1u); break; } } } } while (0)
struct XcdBarrier { unsigned* bar; unsigned x; volatile LAS unsigned* st; };
__device__ __forceinline__ XcdBarrier xcd_barrier_post(unsigned* bar, volatile LAS unsigned* st) {
    XcdBarrier b; b.bar = bar; b.x = xb_xcc_id(); b.st = st;
    if (threadIdx.x == 0) (void)xb_add(&bar[XB_XCNT(b.x)], 1u);
    return b;
}
__device__ __forceinline__ void xcd_barrier_complete(unsigned* bar, unsigned x, unsigned& nloc, unsigned& nx) {
    const unsigned G = gridDim.x * gridDim.y * gridDim.z;
    unsigned sum, cnt, mine, sp = 0u;
    for (;;) {
        sum = 0u; cnt = 0u; mine = 0u;
#pragma unroll
        for (unsigned j = 0; j < 16; ++j) { const unsigned c = xb_ld(&bar[XB_XCNT(j)]); sum += c; cnt += (c > 0u) ? 1u : 0u; mine = (j == x) ? c : mine; }
        if (sum == G) break;
        __builtin_amdgcn_s_sleep(1);
        if ((++sp & 255u) == 0u) { if (xb_ld(&bar[XB_TMO])) break; if (sp > XB_SPIN_CAP) { atomicAdd(&bar[XB_TMO], 1u); break; } }
    }
    nloc = mine > 0u ? mine : 1u; nx = cnt > 0u ? cnt : 1u;
}
__device__ __forceinline__ void xcd_barrier(const XcdBarrier& b) {
    asm volatile("s_waitcnt vmcnt(0)" ::: "memory");
    __syncthreads();
    if (threadIdx.x == 0) {
        unsigned* bar = b.bar;
        __builtin_amdgcn_s_waitcnt(0);
        unsigned nloc = b.st[0], nx = b.st[1];
        if (nloc == 0u) { xcd_barrier_complete(bar, b.x, nloc, nx); b.st[0] = nloc; b.st[1] = nx; }
        const unsigned old = xb_add(&bar[XB_XSUB(b.x)], 1u);
        const unsigned gen = old / nloc;
        if (old + 1u == (gen + 1u) * nloc) {
            __builtin_amdgcn_fence(__ATOMIC_RELEASE, "agent");
            asm volatile("s_waitcnt vmcnt(0)" ::: "memory");
            const unsigned og = xb_add(&bar[XB_TOP], 1u);
            const unsigned tg = og / nx;
            if (og + 1u == (tg + 1u) * nx) xb_add(&bar[XB_TOPGEN], 1u);
            else XB_SPIN(xb_ld(&bar[XB_TOPGEN]) == tg, bar);
            __builtin_amdgcn_fence(__ATOMIC_ACQUIRE, "agent");
            xb_add(&bar[XB_XGEN(b.x)], 1u);
            asm volatile("s_waitcnt vmcnt(0)" ::: "memory");
        } else {
            XB_SPIN(xb_ld(&bar[XB_XGEN(b.x)]) == gen, bar);
            __builtin_amdgcn_fence(__ATOMIC_ACQUIRE, "agent");
            asm volatile("s_waitcnt vmcnt(0)" ::: "memory");
        }
    }
    __syncthreads();
}

#define GSYNC() xcd_barrier(xb)
__global__ void __launch_bounds__(512, 2) mega(Params p) {
    extern __shared__ __attribute__((aligned(16))) unsigned char shm[];
    cg::grid_group grid = cg::this_grid();
    volatile LAS unsigned* xst = (volatile LAS unsigned*)((LAS unsigned char*)shm + LDS_BYTES - 16);
    if (threadIdx.x == 0) { xst[0] = 0u; xst[1] = 0u; }
    __syncthreads();
    const XcdBarrier xb = xcd_barrier_post((unsigned*)(p.ws + OFF_BAR), xst);
    const char* Pc = (const char*)(p.ws + OFF_P); const char* WTc = (const char*)(p.ws + OFF_WT);
    bf16_t* P = (bf16_t*)(p.ws + OFF_P);
    const int G = gridDim.x, c = blockIdx.x;
    for (int layer = 0; layer < 2; ++layer) {
        phase0(p, layer, shm);
        if (layer == 0) grid.sync(); else GSYNC();
        { SchedInproj S{Pc, WTc, G, c, 24, 0, 4, 2}; EpiInproj E{P}; pg8::gemm_phase<true>((LAS unsigned char*)shm, S, E); }
        GSYNC();
        { const int Gh = G >> 1;
            constexpr int ATT_B = 1024;
            if (c < Gh) { for (int it = c; it < 128; it += Gh) rwkv_item(p, layer, shm, it);
                for (int it = ATT_B + c; it < 1024; it += Gh) attn_item(p, shm, it); }
            else { const int c2 = c - Gh;
                bc_prepass(p, layer, c2, G - Gh);
                { SchedInproj S2{Pc, WTc, G - Gh, c2, 2, 4, 1000, 0}; EpiInproj E2{P}; pg8::gemm_phase<true>((LAS unsigned char*)shm, S2, E2); }
                asm volatile("s_waitcnt vmcnt(0)" ::: "memory");
                __syncthreads();
                if (threadIdx.x == 0) { unsigned* cw_ = (unsigned*)(p.ws + OFF_BAR) + 3520; const unsigned need = (unsigned)(G - Gh) * (unsigned)(layer + 1);
                    __builtin_amdgcn_fence(__ATOMIC_RELEASE, "agent"); asm volatile("s_waitcnt vmcnt(0)" ::: "memory");
                    (void)xb_add(cw_, 1u);
                    unsigned sp_ = 0; while (xb_ld(cw_) < need) { __builtin_amdgcn_s_sleep(2); if (++sp_ > (1u << 22)) break; }
                    __builtin_amdgcn_fence(__ATOMIC_ACQUIRE, "agent"); asm volatile("s_waitcnt vmcnt(0)" ::: "memory"); }
                __syncthreads();
                for (int it = c2; it < 128; it += Gh) ssd_item(p, layer, shm, it);
                for (int it = c2; it < ATT_B; it += Gh) attn_item(p, shm, it);
                if (layer == 0) wt_jobs(p, 1, shm, 0, 1664, c2 * 8 + (int)(threadIdx.x >> 6), (G - Gh) * 8); } }
        GSYNC();
        rw_post(p, layer);
        GSYNC();
        { SchedC1 S{Pc, WTc, G, c}; EpiC1 E{P, (const float*)(p.ws + OFF_RSTD)}; pg8::gemm_phase<true>((LAS unsigned char*)shm, S, E); }
        GSYNC();
        { SchedOut S{Pc, WTc, G, c}; EpiOut E{layer == 0 ? p.in[0] : p.out, p.out}; pg8::gemm_phase<false>((LAS unsigned char*)shm, S, E); }
        GSYNC();
    }
    { const int tid = opaque_tid(), wave = tid >> 6, lane = tid & 63; const float* fg = p.in[23];
        for (int row = blockIdx.x * 8 + wave; row < TOK; row += gridDim.x * 8) { float* xr = p.out + (size_t)row * DM;
            f32x4 v[4]; float ss = 0.f;
#pragma unroll
            for (int i = 0; i < 4; ++i) { v[i] = *(const f32x4*)(xr + i * 256 + lane * 4); ss += v[i][0] * v[i][0] + v[i][1] * v[i][1] + v[i][2] * v[i][2] + v[i][3] * v[i][3]; }
            ss = wave_sum(ss);
            const float rs = rsqrtf(ss * (1.f / DM) + 1e-6f);
#pragma unroll
            for (int i = 0; i < 4; ++i) { const f32x4 g = *(const f32x4*)(fg + i * 256 + lane * 4); *(f32x4*)(xr + i * 256 + lane * 4) = v[i] * rs * g; } } }
}

extern "C" void kernel_launch(void* const* d_in, const int* in_sizes, int n_in, void* d_out, int out_size, void* d_ws, size_t ws_size, hipStream_t stream) {
    static int grid_blocks = 0;
    if (grid_blocks == 0) {
        if (n_in != 24 || out_size != TOK * DM || ws_size < WS_NEED) { fprintf(stderr, "kernel_launch: unexpected shapes (n_in %d out %d ws %zu need %zu)\n", n_in, out_size, ws_size, (size_t)WS_NEED); grid_blocks = -1; return; }
        int dev = 0, cus = 0, per_cu = 0;
        hipGetDevice(&dev);
        hipDeviceGetAttribute(&cus, hipDeviceAttributeMultiprocessorCount, dev);
        hipFuncSetAttribute((const void*)mega, hipFuncAttributeMaxDynamicSharedMemorySize, LDS_BYTES);
        hipOccupancyMaxActiveBlocksPerMultiprocessor(&per_cu, (const void*)mega, 512, LDS_BYTES);
        if (per_cu < 1) { fprintf(stderr, "kernel_launch: occupancy query says %d blocks per CU\n", per_cu); grid_blocks = -1; return; }
        if (per_cu > 1) per_cu = 1;
        grid_blocks = cus * per_cu;
        grid_blocks &= ~7;
    }
    if (grid_blocks < 0) return;
    Params p{};
    for (int i = 0; i < 24; ++i) p.in[i] = (const float*)d_in[i];
    p.out = (float*)d_out; p.ws = (unsigned char*)d_ws;
    (void)hipMemsetAsync((unsigned char*)d_ws + OFF_BAR, 0, SZ_BAR, stream);
    void* args[] = {&p};
    hipError_t e = hipLaunchCooperativeKernel((const void*)mega, dim3(grid_blocks), dim3(512), args, LDS_BYTES, stream);
    if (e != hipSuccess) fprintf(stderr, "cooperative launch failed: %s (grid %d)\n", hipGetErrorString(e), grid_blocks);
}
```
